# Optimizing an MI355X kernel written in HIP

```python
import jax, jax.numpy as jnp
from jax import lax
import numpy as np

D_MODEL = 1024
BATCH = 8
SEQ = 2048
DEPTH = 4

CHUNK = 64
N_MIXERS = 3
PLE_DIM = 256
EPS = 1e-6
MLA_HEADS = 16
MLA_Q_LORA = 384
MLA_KV_LORA = 256
MLA_NOPE = 64
MLA_ROPE = 32
MLA_V = 64
MLA_WIDTH = MLA_HEADS * MLA_V
MLA_IN = MLA_Q_LORA + MLA_KV_LORA + MLA_ROPE + MLA_WIDTH
ROPE_THETA = 10000.0
Q_BLOCK = 128
CONV_WIDTH = 3
CONV_DIM = D_MODEL
CONV_IN = 4 * CONV_DIM
MLSTM_HEADS = 4
MLSTM_INNER = 2 * D_MODEL
MLSTM_DV = MLSTM_INNER // MLSTM_HEADS
MLSTM_DK = MLSTM_DV // 2
MLSTM_IN = 2 * MLSTM_HEADS * MLSTM_DK + 3 * MLSTM_INNER + 2 * MLSTM_HEADS

kernel_name = "hybrid_mla_shortconv_mlstm_ple"


def rmsnorm(x, g=None):
    xf = x.astype(jnp.float32)
    y = xf * lax.rsqrt(jnp.mean(xf * xf, axis=-1, keepdims=True) + EPS)
    if g is not None:
        y = y * g.astype(jnp.float32)
    return y.astype(x.dtype)


def rope_cos_sin(positions, dim, dtype):
    inv = ROPE_THETA ** (-jnp.arange(0, dim, 2, dtype=jnp.float32) / dim)
    ang = positions.astype(jnp.float32)[..., None] * inv
    return jnp.cos(ang).astype(dtype), jnp.sin(ang).astype(dtype)


def apply_rope(x, cos, sin):
    x1, x2 = jnp.split(x, 2, axis=-1)
    return jnp.concatenate([x1 * cos - x2 * sin, x1 * sin + x2 * cos], axis=-1)


def mla_mixer(h, cos, sin, w_in, q_norm, w_q_b, kv_norm, w_kv_b, w_out):
    B, S, _ = h.shape
    u = h @ w_in
    c_q, c_kv, k_rope, z = jnp.split(
        u, [MLA_Q_LORA, MLA_Q_LORA + MLA_KV_LORA, MLA_Q_LORA + MLA_KV_LORA + MLA_ROPE], axis=-1)
    q = (rmsnorm(c_q, q_norm) @ w_q_b).reshape(B, S, MLA_HEADS, MLA_NOPE + MLA_ROPE)
    q_nope = q[..., :MLA_NOPE]
    q_rope = apply_rope(q[..., MLA_NOPE:], cos[:, :, None], sin[:, :, None])
    kv = (rmsnorm(c_kv, kv_norm) @ w_kv_b).reshape(B, S, MLA_HEADS, MLA_NOPE + MLA_V)
    k_nope, v = kv[..., :MLA_NOPE], kv[..., MLA_NOPE:]
    k_rope = apply_rope(k_rope, cos, sin)
    scale = (MLA_NOPE + MLA_ROPE) ** -0.5
    outs = []
    for blk in range(S // Q_BLOCK):
        q0, q1 = blk * Q_BLOCK, (blk + 1) * Q_BLOCK
        s = (jnp.einsum('bqhd,bkhd->bhqk', q_nope[:, q0:q1], k_nope[:, :q1])
             + jnp.einsum('bqhd,bkd->bhqk', q_rope[:, q0:q1], k_rope[:, :q1])).astype(jnp.float32) * scale
        q_chunk = (q0 + jnp.arange(Q_BLOCK)) // CHUNK
        k_chunk = jnp.arange(q1) // CHUNK
        s = jnp.where(k_chunk[None, :] <= q_chunk[:, None], s, -jnp.inf)
        prob = jax.nn.softmax(s, axis=-1).astype(v.dtype)
        outs.append(jnp.einsum('bhqk,bkhd->bqhd', prob, v[:, :q1]))
    o = jnp.concatenate(outs, axis=1).reshape(B, S, MLA_WIDTH)
    return (o * jax.nn.silu(z)) @ w_out


def shortconv_mixer(h, w_in, conv_w, w_out):
    b_gate, c_gate, hx, z = jnp.split(h @ w_in, 4, axis=-1)
    y = lax.conv_general_dilated(
        c_gate * hx, conv_w[:, None, :].astype(hx.dtype), window_strides=(1,),
        padding=[(CONV_WIDTH - 1, 0)], dimension_numbers=('NWC', 'WIO', 'NWC'),
        feature_group_count=CONV_DIM)
    return (b_gate * y * jax.nn.silu(z)) @ w_out


def mlstm_chunk_step(carry, xs):
    C, n, m = carry
    q, k, v, ig, lf = xs
    L = q.shape[2]
    b = jnp.cumsum(lf, axis=-1)
    causal = jnp.tril(jnp.ones((L, L), dtype=bool))
    d_log = jnp.where(causal, b[..., :, None] - b[..., None, :] + ig[..., None, :], -jnp.inf)
    g = b + m[..., None]
    m_t = jnp.maximum(g, jnp.max(d_log, axis=-1))
    w_intra = jnp.exp(d_log - m_t[..., None])
    w_inter = jnp.exp(g - m_t)
    s = jnp.einsum('bhtd,bhsd->bhts', q, k) * w_intra
    num = (w_inter[..., None] * jnp.einsum('bhtd,bhdv->bhtv', q, C)
           + jnp.einsum('bhts,bhsv->bhtv', s, v))
    den = w_inter * jnp.einsum('bhtd,bhd->bht', q, n) + jnp.sum(s, axis=-1)
    h = num / jnp.maximum(jnp.abs(den), jnp.exp(-m_t))[..., None]
    b_last = b[..., -1]
    d_state = b_last[..., None] - b + ig
    m_new = jnp.maximum(b_last + m, jnp.max(d_state, axis=-1))
    w_s = jnp.exp(d_state - m_new[..., None])
    decay = jnp.exp(b_last + m - m_new)
    C = decay[..., None, None] * C + jnp.einsum('bhs,bhsd,bhsv->bhdv', w_s, k, v)
    n = decay[..., None] * n + jnp.einsum('bhs,bhsd->bhd', w_s, k)
    return (C, n, m_new), h


def mlstm_mixer(h, w_in, b_gates, w_out):
    B, S, _ = h.shape
    H, DK, DV = MLSTM_HEADS, MLSTM_DK, MLSTM_DV
    qk = H * DK
    u = h @ w_in
    q, k, v, o, z, gates = jnp.split(
        u, [qk, 2 * qk, 2 * qk + MLSTM_INNER, 2 * qk + 2 * MLSTM_INNER, 2 * qk + 3 * MLSTM_INNER], axis=-1)
    gates = gates.astype(jnp.float32) + b_gates.astype(jnp.float32)
    ig = gates[..., :H]
    lf = jax.nn.log_sigmoid(gates[..., H:])
    nc = S // CHUNK

    def to_chunks(t, d):
        return t.astype(jnp.float32).reshape(B, nc, CHUNK, H, d).transpose(1, 0, 3, 2, 4)

    def gate_chunks(t):
        return t.reshape(B, nc, CHUNK, H).transpose(1, 0, 3, 2)

    xs = (to_chunks(q, DK), to_chunks(k, DK) * (DK ** -0.5), to_chunks(v, DV),
          gate_chunks(ig), gate_chunks(lf))
    init = (jnp.zeros((B, H, DK, DV), jnp.float32), jnp.zeros((B, H, DK), jnp.float32),
            jnp.zeros((B, H), jnp.float32))
    _, hc = lax.scan(mlstm_chunk_step, init, xs)
    hs = hc.transpose(1, 0, 3, 2, 4).reshape(B, S, MLSTM_INNER).astype(h.dtype)
    return (jax.nn.sigmoid(o) * hs * jax.nn.silu(z)) @ w_out


def setup_inputs(seed: int = 0) -> dict:
    key = jax.random.key(seed)
    ks = iter(jax.random.split(key, 32))
    n_mla = max(0, (DEPTH - 0 + 2) // 3)
    n_conv = max(0, (DEPTH - 1 + 2) // 3)
    n_mlstm = max(0, (DEPTH - 2 + 2) // 3)
    res_scale = (2.0 * DEPTH) ** -0.5

    def nrm(shape, scale):
        return jax.random.normal(next(ks), shape, jnp.float32) * scale

    def gain(shape):
        return 1.0 + nrm(shape, 0.02)

    x = nrm((BATCH, SEQ, D_MODEL), 1.0)
    p = nrm((DEPTH, BATCH, SEQ, PLE_DIM), 1.0)
    offsets = jax.random.randint(next(ks), (BATCH, 1), 0, 4096, dtype=jnp.int32)
    positions = (offsets + jnp.arange(SEQ, dtype=jnp.int32)[None, :]).astype(jnp.int32)
    norm_g = gain((DEPTH, D_MODEL))
    mla_w_in = nrm((n_mla, D_MODEL, MLA_IN), D_MODEL ** -0.5)
    mla_q_norm = gain((n_mla, MLA_Q_LORA))
    mla_w_q_b = nrm((n_mla, MLA_Q_LORA, MLA_HEADS * (MLA_NOPE + MLA_ROPE)), MLA_Q_LORA ** -0.5)
    mla_kv_norm = gain((n_mla, MLA_KV_LORA))
    mla_w_kv_b = nrm((n_mla, MLA_KV_LORA, MLA_HEADS * (MLA_NOPE + MLA_V)), MLA_KV_LORA ** -0.5)
    mla_w_out = nrm((n_mla, MLA_WIDTH, D_MODEL), MLA_WIDTH ** -0.5 * res_scale)
    conv_w_in = nrm((n_conv, D_MODEL, CONV_IN), D_MODEL ** -0.5)
    conv_w = nrm((n_conv, CONV_WIDTH, CONV_DIM), CONV_WIDTH ** -0.5)
    conv_w_out = nrm((n_conv, CONV_DIM, D_MODEL), CONV_DIM ** -0.5 * res_scale)
    mlstm_w_in = nrm((n_mlstm, D_MODEL, MLSTM_IN), D_MODEL ** -0.5)
    b_in = nrm((n_mlstm, MLSTM_HEADS), 0.1)
    b_f = jnp.linspace(3.0, 6.0, MLSTM_HEADS, dtype=jnp.float32)[None, :] + nrm((n_mlstm, MLSTM_HEADS), 0.1)
    mlstm_b_gates = jnp.concatenate([b_in, b_f], axis=-1)
    mlstm_w_out = nrm((n_mlstm, MLSTM_INNER, D_MODEL), MLSTM_INNER ** -0.5 * res_scale)
    ple_proj = nrm((DEPTH, PLE_DIM, D_MODEL), PLE_DIM ** -0.5 * res_scale)
    ple_gate = nrm((DEPTH, D_MODEL, D_MODEL), D_MODEL ** -0.5)
    final_norm = gain((D_MODEL,))
    return {"x": x, "p": p, "positions": positions, "norm_g": norm_g,
            "mla_w_in": mla_w_in, "mla_q_norm": mla_q_norm, "mla_w_q_b": mla_w_q_b,
            "mla_kv_norm": mla_kv_norm, "mla_w_kv_b": mla_w_kv_b, "mla_w_out": mla_w_out,
            "conv_w_in": conv_w_in, "conv_w": conv_w, "conv_w_out": conv_w_out,
            "mlstm_w_in": mlstm_w_in, "mlstm_b_gates": mlstm_b_gates, "mlstm_w_out": mlstm_w_out,
            "ple_proj": ple_proj, "ple_gate": ple_gate, "final_norm": final_norm}


def reference(x, p, positions, norm_g, mla_w_in, mla_q_norm, mla_w_q_b, mla_kv_norm, mla_w_kv_b,
              mla_w_out, conv_w_in, conv_w, conv_w_out, mlstm_w_in, mlstm_b_gates, mlstm_w_out,
              ple_proj, ple_gate, final_norm):
    cos, sin = rope_cos_sin(positions, MLA_ROPE, x.dtype)
    for i in range(DEPTH):
        kind, j = i % N_MIXERS, i // N_MIXERS
        h = rmsnorm(x, norm_g[i])
        if kind == 0:
            y = mla_mixer(h, cos, sin, mla_w_in[j], mla_q_norm[j], mla_w_q_b[j],
                          mla_kv_norm[j], mla_w_kv_b[j], mla_w_out[j])
        elif kind == 1:
            y = shortconv_mixer(h, conv_w_in[j], conv_w[j], conv_w_out[j])
        else:
            y = mlstm_mixer(h, mlstm_w_in[j], mlstm_b_gates[j], mlstm_w_out[j])
        x = x + y
        gate = jax.nn.sigmoid(rmsnorm(x) @ ple_gate[i])
        x = x + gate * (p[i] @ ple_proj[i])
    return rmsnorm(x, final_norm)
```

```cpp
#include <hip/hip_runtime.h>
#include <math.h>
#include <stdint.h>

namespace nv {
constexpr int NB = 8, S = 2048, D = 1024;
constexpr int MLA_IN = 1696, QL = 384, KVL = 256, NH = 16;
constexpr int LIN = 8200;
constexpr float EPS = 1e-6f;

__device__ __forceinline__ float sigmoidf_(float x) { return 1.f / (1.f + expf(-x)); }
__device__ __forceinline__ float siluf_(float x) { return x * sigmoidf_(x); }
__device__ __forceinline__ float logsigmoidf_(float x) { return fminf(x, 0.f) - log1pf(expf(-fabsf(x))); }

__global__ void rmsnorm_k(const float* in, int ldi, int c0, int n, const float* g, float* out, int ldo) {
    const int r = blockIdx.x;
    const float* ip = in + (size_t)r * ldi + c0;
    float v[4]; float ss = 0.f;
#pragma unroll
    for (int i = 0; i < 4; ++i) { int c = threadIdx.x + i * 256; v[i] = c < n ? ip[c] : 0.f; ss += v[i] * v[i]; }
    __shared__ float red[256];
    red[threadIdx.x] = ss; __syncthreads();
    for (int s = 128; s > 0; s >>= 1) { if (threadIdx.x < s) red[threadIdx.x] += red[threadIdx.x + s]; __syncthreads(); }
    const float rstd = rsqrtf(red[0] / (float)n + EPS);
#pragma unroll
    for (int i = 0; i < 4; ++i) { int c = threadIdx.x + i * 256; if (c < n) out[(size_t)r * ldo + c] = v[i] * rstd * (g ? g[c] : 1.f); }
}

__global__ void ngemm(const float* A, int lda, const float* B, int ldb, int tb, float* C, int ldc, int M, int N, int K) {
    __shared__ float As[16][65], Bs[16][65];
    const int tx = threadIdx.x & 15, ty = threadIdx.x >> 4;
    const int row0 = blockIdx.y * 64, col0 = blockIdx.x * 64;
    float acc[4][4];
#pragma unroll
    for (int i = 0; i < 4; ++i)
#pragma unroll
        for (int j = 0; j < 4; ++j) acc[i][j] = 0.f;
    for (int k0 = 0; k0 < K; k0 += 16) {
#pragma unroll
        for (int i = 0; i < 4; ++i) {
            int e = threadIdx.x + i * 256;
            { int kk = e & 15, r = e >> 4; int gr = row0 + r, gk = k0 + kk; As[kk][r] = (gr < M && gk < K) ? A[(size_t)gr * lda + gk] : 0.f; }
            if (tb) { int kk = e & 15, c = e >> 4; int gc = col0 + c, gk = k0 + kk; Bs[kk][c] = (gc < N && gk < K) ? B[(size_t)gc * ldb + gk] : 0.f; }
            else    { int c = e & 63, kk = e >> 6; int gc = col0 + c, gk = k0 + kk; Bs[kk][c] = (gc < N && gk < K) ? B[(size_t)gk * ldb + gc] : 0.f; }
        }
        __syncthreads();
#pragma unroll
        for (int kk = 0; kk < 16; ++kk) {
            float a[4], b[4];
#pragma unroll
            for (int i = 0; i < 4; ++i) { a[i] = As[kk][ty * 4 + i]; b[i] = Bs[kk][tx * 4 + i]; }
#pragma unroll
            for (int i = 0; i < 4; ++i)
#pragma unroll
                for (int j = 0; j < 4; ++j) acc[i][j] += a[i] * b[j];
        }
        __syncthreads();
    }
#pragma unroll
    for (int i = 0; i < 4; ++i)
#pragma unroll
        for (int j = 0; j < 4; ++j) { int r = row0 + ty * 4 + i, c = col0 + tx * 4 + j; if (r < M && c < N) C[(size_t)r * ldc + c] = acc[i][j]; }
}

__global__ void rope_table_k(const int* pos, float* cs, float* sn) {
    int i = blockIdx.x * blockDim.x + threadIdx.x; if (i >= S * 16) return;
    int t = i >> 4, j = i & 15;
    float inv = powf(10000.0f, -(float)(2 * j) / 32.0f);
    float ang = (float)pos[t] * inv;
    double rev = (double)ang * 0.15915494309189533577;
    rev -= rint(rev);
    float fr = (float)rev;
    cs[i] = __builtin_amdgcn_cosf(fr); sn[i] = __builtin_amdgcn_sinf(fr);
}
__global__ void rope_apply_k(float* buf, int ld, int base, int hstride, int nheads, const float* cs, const float* sn) {
    int i = blockIdx.x * blockDim.x + threadIdx.x; if (i >= S * nheads * 16) return;
    int j = i & 15, h = (i >> 4) % nheads, t = (i >> 4) / nheads;
    float* p = buf + (size_t)t * ld + base + h * hstride;
    float x1 = p[j], x2 = p[16 + j], c = cs[t * 16 + j], s = sn[t * 16 + j];
    p[j] = x1 * c - x2 * s; p[16 + j] = x1 * s + x2 * c;
}

__global__ __launch_bounds__(64) void attn_naive_k(const float* q, const float* kv, const float* kr, int ldkr, float* o) {
    const int t = blockIdx.x * 64 + threadIdx.x, h = blockIdx.y;
    const int nk = (t / 64 + 1) * 64;
    float qr[96];
#pragma unroll
    for (int d = 0; d < 96; ++d) qr[d] = q[(size_t)t * 1536 + h * 96 + d];
    const float scale = 0.10206207261596577f;
    float mx = -INFINITY;
    for (int s = 0; s < nk; ++s) {
        const float* kp = kv + (size_t)s * 2048 + h * 128; const float* rp = kr + (size_t)s * ldkr;
        float a = 0.f;
#pragma unroll
        for (int d = 0; d < 64; ++d) a += qr[d] * kp[d];
#pragma unroll
        for (int d = 0; d < 32; ++d) a += qr[64 + d] * rp[d];
        mx = fmaxf(mx, a * scale);
    }
    float acc[64]; float l = 0.f;
#pragma unroll
    for (int d = 0; d < 64; ++d) acc[d] = 0.f;
    for (int s = 0; s < nk; ++s) {
        const float* kp = kv + (size_t)s * 2048 + h * 128; const float* rp = kr + (size_t)s * ldkr;
        float a = 0.f;
#pragma unroll
        for (int d = 0; d < 64; ++d) a += qr[d] * kp[d];
#pragma unroll
        for (int d = 0; d < 32; ++d) a += qr[64 + d] * rp[d];
        float pz = expf(a * scale - mx); l += pz;
#pragma unroll
        for (int d = 0; d < 64; ++d) acc[d] += pz * kp[64 + d];
    }
    const float il = 1.f / l;
#pragma unroll
    for (int d = 0; d < 64; ++d) o[(size_t)t * 1024 + h * 64 + d] = acc[d] * il;
}

__global__ void mla_gate_k(const float* o, const float* U, float* g) {
    size_t i = (size_t)blockIdx.x * blockDim.x + threadIdx.x; if (i >= (size_t)S * 1024) return;
    int t = i >> 10, c = i & 1023;
    g[i] = o[i] * siluf_(U[(size_t)t * MLA_IN + 672 + c]);
}
__global__ void conv_gate_k(const float* U, const float* cw, float* g) {
    size_t i = (size_t)blockIdx.x * blockDim.x + threadIdx.x; if (i >= (size_t)S * 1024) return;
    int t = i >> 10, c = i & 1023;
    float y = 0.f;
#pragma unroll
    for (int k = 0; k < 3; ++k) { int tt = t - 2 + k; if (tt >= 0) { const float* up = U + (size_t)tt * 4096; y += cw[k * 1024 + c] * up[1024 + c] * up[2048 + c]; } }
    const float* up = U + (size_t)t * 4096;
    g[i] = up[c] * y * siluf_(up[3072 + c]);
}
__global__ void mlstm_gates_k(const float* U, const float* bg, float* ig, float* bc) {
    int h = threadIdx.x; float run = 0.f;
    for (int t = 0; t < S; ++t) {
        const float* up = U + (size_t)t * LIN + 8192;
        ig[t * 4 + h] = up[h] + bg[h];
        run += logsigmoidf_(up[4 + h] + bg[4 + h]);
        bc[t * 4 + h] = run;
    }
}
__global__ void mlstm_score_k(float* sc, const float* ig, const float* bc) {
    size_t i = (size_t)blockIdx.x * blockDim.x + threadIdx.x; if (i >= (size_t)4 * S * S) return;
    int s = i % S, t = (i / S) % S, h = i / ((size_t)S * S);
    float v = 0.f;
    if (s <= t) v = sc[i] * 0.0625f * expf(bc[t * 4 + h] - bc[s * 4 + h] + ig[s * 4 + h]);
    sc[i] = v;
}
__global__ void rowsum_k(const float* sc, float* den) {
    const int t = blockIdx.x, h = blockIdx.y; const float* p = sc + ((size_t)h * S + t) * S;
    float a = 0.f; for (int s = threadIdx.x; s <= t; s += 256) a += p[s];
    __shared__ float red[256]; red[threadIdx.x] = a; __syncthreads();
    for (int k = 128; k > 0; k >>= 1) { if (threadIdx.x < k) red[threadIdx.x] += red[threadIdx.x + k]; __syncthreads(); }
    if (threadIdx.x == 0) den[h * S + t] = red[0];
}
__global__ void mlstm_gate_k(const float* num, const float* den, const float* U, float* g) {
    size_t i = (size_t)blockIdx.x * blockDim.x + threadIdx.x; if (i >= (size_t)S * 2048) return;
    int t = i >> 11, c = i & 2047, h = c >> 9;
    float hs = num[i] / fmaxf(fabsf(den[h * S + t]), 1.f);
    const float* up = U + (size_t)t * LIN;
    g[i] = sigmoidf_(up[4096 + c]) * hs * siluf_(up[6144 + c]);
}
__global__ void add_k(float* x, const float* y, size_t n) { size_t i = (size_t)blockIdx.x * blockDim.x + threadIdx.x; if (i < n) x[i] += y[i]; }
__global__ void copy_k(float* x, const float* y, size_t n) { size_t i = (size_t)blockIdx.x * blockDim.x + threadIdx.x; if (i < n) x[i] = y[i]; }
__global__ void ple_k(float* x, const float* gate, const float* pp, size_t n) { size_t i = (size_t)blockIdx.x * blockDim.x + threadIdx.x; if (i < n) x[i] += sigmoidf_(gate[i]) * pp[i]; }

static void gemm(hipStream_t st, const float* A, int lda, const float* B, int ldb, int tb, float* C, int ldc, int M, int N, int K) {
    dim3 g((N + 63) / 64, (M + 63) / 64); ngemm<<<g, 256, 0, st>>>(A, lda, B, ldb, tb, C, ldc, M, N, K);
}

struct In {
    const float *x, *p; const int* pos; const float *norm_g, *mla_w_in, *mla_q_norm, *mla_w_q_b, *mla_kv_norm, *mla_w_kv_b, *mla_w_out,
        *conv_w_in, *conv_w, *conv_w_out, *mlstm_w_in, *mlstm_b_gates, *mlstm_w_out, *ple_proj, *ple_gate, *final_norm;
};

static void forward(const In& in, float* out, float* ws, hipStream_t st) {
    float* H = ws;
    float* U = H + (size_t)S * 1024;
    float* T1 = U + (size_t)S * 8200;
    float* T2 = T1 + (size_t)S * 2048;
    float* T3 = T2 + (size_t)S * 2048;
    float* Y = T3 + (size_t)S * 2048;
    float* SC = Y + (size_t)S * 1024;
    float* IG = SC + (size_t)4 * S * S;
    float* BC = IG + S * 4;
    float* DEN = BC + S * 4;
    float* CS = DEN + S * 4;
    float* SN = CS + S * 16;
    const size_t nx = (size_t)S * D;
    const int EB = 256;
    for (int b = 0; b < NB; ++b) {
        float* x = out + (size_t)b * nx;
        copy_k<<<(nx + EB - 1) / EB, EB, 0, st>>>(x, in.x + (size_t)b * nx, nx);
        rope_table_k<<<(S * 16 + EB - 1) / EB, EB, 0, st>>>(in.pos + b * S, CS, SN);
        for (int i = 0; i < 4; ++i) {
            const int kind = i % 3, j = i / 3;
            rmsnorm_k<<<S, 256, 0, st>>>(x, D, 0, D, in.norm_g + i * D, H, D);
            if (kind == 0) {
                const float* w_in = in.mla_w_in + (size_t)j * D * MLA_IN;
                gemm(st, H, D, w_in, MLA_IN, 0, U, MLA_IN, S, MLA_IN, D);
                rmsnorm_k<<<S, 256, 0, st>>>(U, MLA_IN, 0, QL, in.mla_q_norm + j * QL, T3, QL);
                gemm(st, T3, QL, in.mla_w_q_b + (size_t)j * QL * 1536, 1536, 0, T1, 1536, S, 1536, QL);
                rmsnorm_k<<<S, 256, 0, st>>>(U, MLA_IN, QL, KVL, in.mla_kv_norm + j * KVL, T3, KVL);
                gemm(st, T3, KVL, in.mla_w_kv_b + (size_t)j * KVL * 2048, 2048, 0, T2, 2048, S, 2048, KVL);
                rope_apply_k<<<(S * NH * 16 + EB - 1) / EB, EB, 0, st>>>(T1, 1536, 64, 96, NH, CS, SN);
                rope_apply_k<<<(S * 16 + EB - 1) / EB, EB, 0, st>>>(U, MLA_IN, 640, 0, 1, CS, SN);
                attn_naive_k<<<dim3(S / 64, NH), 64, 0, st>>>(T1, T2, U + 640, MLA_IN, Y);
                mla_gate_k<<<(nx + EB - 1) / EB, EB, 0, st>>>(Y, U, T3);
                gemm(st, T3, 1024, in.mla_w_out + (size_t)j * 1024 * 1024, 1024, 0, Y, 1024, S, 1024, 1024);
            } else if (kind == 1) {
                gemm(st, H, D, in.conv_w_in + (size_t)j * D * 4096, 4096, 0, U, 4096, S, 4096, D);
                conv_gate_k<<<(nx + EB - 1) / EB, EB, 0, st>>>(U, in.conv_w + (size_t)j * 3 * 1024, T3);
                gemm(st, T3, 1024, in.conv_w_out + (size_t)j * 1024 * 1024, 1024, 0, Y, 1024, S, 1024, 1024);
            } else {
                gemm(st, H, D, in.mlstm_w_in + (size_t)j * D * LIN, LIN, 0, U, LIN, S, LIN, D);
                mlstm_gates_k<<<1, 4, 0, st>>>(U, in.mlstm_b_gates + j * 8, IG, BC);
                for (int h = 0; h < 4; ++h)
                    gemm(st, U + h * 256, LIN, U + 1024 + h * 256, LIN, 1, SC + (size_t)h * S * S, S, S, S, 256);
                mlstm_score_k<<<((size_t)4 * S * S + EB - 1) / EB, EB, 0, st>>>(SC, IG, BC);
                rowsum_k<<<dim3(S, 4), 256, 0, st>>>(SC, DEN);
                for (int h = 0; h < 4; ++h)
                    gemm(st, SC + (size_t)h * S * S, S, U + 2048 + h * 512, LIN, 0, T1 + h * 512, 2048, S, 512, S);
                mlstm_gate_k<<<((size_t)S * 2048 + EB - 1) / EB, EB, 0, st>>>(T1, DEN, U, T3);
                gemm(st, T3, 2048, in.mlstm_w_out + (size_t)j * 2048 * 1024, 1024, 0, Y, 1024, S, 1024, 2048);
            }
            add_k<<<(nx + EB - 1) / EB, EB, 0, st>>>(x, Y, nx);
            rmsnorm_k<<<S, 256, 0, st>>>(x, D, 0, D, nullptr, H, D);
            gemm(st, H, D, in.ple_gate + (size_t)i * D * D, D, 0, T1, D, S, D, D);
            gemm(st, in.p + ((size_t)i * NB + b) * S * 256, 256, in.ple_proj + (size_t)i * 256 * D, D, 0, T2, D, S, D, 256);
            ple_k<<<(nx + EB - 1) / EB, EB, 0, st>>>(x, T1, T2, nx);
        }
        rmsnorm_k<<<S, 256, 0, st>>>(x, D, 0, D, in.final_norm, x, D);
    }
}
}

extern "C" void kernel_launch(void* const* d_in, const int* in_sizes, int n_in, void* d_out, int out_size, void* d_ws, size_t ws_size, hipStream_t stream) {
    nv::In in;
    in.x = (const float*)d_in[0]; in.p = (const float*)d_in[1]; in.pos = (const int*)d_in[2]; in.norm_g = (const float*)d_in[3];
    in.mla_w_in = (const float*)d_in[4]; in.mla_q_norm = (const float*)d_in[5]; in.mla_w_q_b = (const float*)d_in[6];
    in.mla_kv_norm = (const float*)d_in[7]; in.mla_w_kv_b = (const float*)d_in[8]; in.mla_w_out = (const float*)d_in[9];
    in.conv_w_in = (const float*)d_in[10]; in.conv_w = (const float*)d_in[11]; in.conv_w_out = (const float*)d_in[12];
    in.mlstm_w_in = (const float*)d_in[13]; in.mlstm_b_gates = (const float*)d_in[14]; in.mlstm_w_out = (const float*)d_in[15];
    in.ple_proj = (const float*)d_in[16]; in.ple_gate = (const float*)d_in[17]; in.final_norm = (const float*)d_in[18];
    nv::forward(in, (float*)d_out, (float*)d_ws, stream);
}
```

```cpp
#include <hip/hip_runtime.h>
#include <cstdio>
#include <cstdint>
#include <math.h>
#define LAS __attribute__((address_space(3)))
#define GAS __attribute__((address_space(1)))
#define FAST_LAYERS 15
#define ONE_LAUNCH 0
namespace pg8 {
#define PG8_LAS __attribute__((address_space(3)))
typedef unsigned short bf16_t;
typedef short bf16x8 __attribute__((ext_vector_type(8)));
typedef float f32x4 __attribute__((ext_vector_type(4)));
typedef unsigned u32x4 __attribute__((ext_vector_type(4)));
constexpr int BM = 256, BK = 64, HALF = 128, HTB = HALF * BK * 2  , STAGE_BYTES = 8 * HTB, NXCD = 8, WGM = 8;

__host__ __device__ __forceinline__ int lds_byte(int r, int c) { const int st = (r >> 4) * 2 + (c >> 5), rr = r & 15, cc = c & 31, ob = rr * 64 + cc * 2; return st * 1024 + (ob ^ (((ob >> 9) & 1) << 5)); }
__host__ __device__ __forceinline__ void stage_rc(int b, int& R, int& C) { const int st = b / 1024, sb = b % 1024, swz = sb ^ (((sb >> 9) & 1) << 5); R = (st >> 1) * 16 + swz / 64; C = (st & 1) * 32 + (swz % 64) / 2; }
__host__ __device__ __forceinline__ int perm32(int rho) { const int n = rho >> 4, i = rho & 15; return 8 * (i >> 2) + 4 * n + (i & 3); }

struct Unit { int pm, pn; };
struct Gemm { const bf16_t* A; const bf16_t* Bt; int M, N, K; };

struct StaticOrder {
    int nM, nN, nwg, G, c;
    __host__ __device__ void init(int M, int N, int G_, int c_) { nM = M / BM; nN = N / BM; nwg = nM * nN; G = G_; c = c_; }
    __host__ __device__ bool next(int i, Unit& u) const {
        const long L = (long)i * G + c; if (L >= nwg) return false;
        int wgid = (int)L; { const int q = nwg / NXCD, r = nwg % NXCD, xcd = wgid % NXCD, off = wgid / NXCD; wgid = (xcd < r ? xcd * (q + 1) : r * (q + 1) + (xcd - r) * q) + off; }
        const int nig = WGM * nN, gid = wgid / nig, fm = gid * WGM, gsz = (nM - fm) < WGM ? (nM - fm) : WGM;
        u.pm = fm + ((wgid % nig) % gsz); u.pn = (wgid % nig) / gsz; return true;
    }
    __device__ __forceinline__ void a_ready(const Unit&) const {}
    __device__ __forceinline__ void done(const Unit&) const {}
};

template <class Epi, class Sched, bool ALIGN_EPI = false, bool SP2 = false>
__device__ __forceinline__ void gemm_phase(PG8_LAS unsigned char* lds, const Gemm g, const Sched& S, const Epi& E) {
    int tid_ = threadIdx.x; asm volatile("" : "+v"(tid_));
    const int tid = tid_, wid = __builtin_amdgcn_readfirstlane(tid >> 6), lane = tid & 63, wr = wid >> 2, wc = wid & 3, fr = lane & 15, fq = lane >> 4;
    const int K = g.K, nt = K / BK;
    unsigned voffA[2], voffB[2];
#pragma unroll
    for (int i = 0; i < 2; ++i) { int R, C; stage_rc(tid * 16 + i * 8192, R, C); const int Rb = Epi::PERM ? ((R & ~31) + perm32(R & 31)) : R;
        voffA[i] = (unsigned)(R * K + C) * 2u; voffB[i] = (unsigned)(Rb * K + C) * 2u; }
    const size_t kstep = (size_t)(BK * 2);
    const size_t hstep = (size_t)HALF * K * 2;
    const size_t tstep = 2 * hstep;
    const unsigned ldsw = (unsigned)wid * 1024u;
    const int aoff = lds_byte(wr * 64 + fr, fq * 8), boff = lds_byte(wc * 32 + fr, fq * 8);
#define PG8_SA(b, h) (((b) * 2 + (h)) * HTB)
#define PG8_SB(b, h) ((4 + (b) * 2 + (h)) * HTB)
#define PG8_STAGE(bufoff, gbase, voff) do { _Pragma("unroll") for (int _i = 0; _i < 2; ++_i) \
        __builtin_amdgcn_global_load_lds((const unsigned*)((const char*)(gbase) + (voff)[_i]), (PG8_LAS unsigned*)(lds + (bufoff) + ldsw + _i * 8192), 16, 0, 0); } while (0)
#define PG8_LDA(dst, b, h) do { _Pragma("unroll") for (int m = 0; m < 4; ++m) _Pragma("unroll") for (int k = 0; k < 2; ++k) dst[m][k] = *(const PG8_LAS bf16x8*)(lds + PG8_SA(b, h) + aoff + m * 2048 + k * 1024); } while (0)
#define PG8_LDB(dst, b, h) do { _Pragma("unroll") for (int n = 0; n < 2; ++n) _Pragma("unroll") for (int k = 0; k < 2; ++k) dst[n][k] = *(const PG8_LAS bf16x8*)(lds + PG8_SB(b, h) + boff + n * 2048 + k * 1024); } while (0)
#define PG8_MMA(ai, bj, At, Bt) do { __builtin_amdgcn_s_setprio(1); _Pragma("unroll") for (int m = 0; m < 4; ++m) _Pragma("unroll") for (int n = 0; n < 2; ++n) _Pragma("unroll") for (int k = 0; k < 2; ++k) \
        acc[ai][bj][m][n] = __builtin_amdgcn_mfma_f32_16x16x32_bf16(Bt[n][k], At[m][k], acc[ai][bj][m][n], 0, 0, 0); __builtin_amdgcn_s_setprio(0); } while (0)
#define PG8_WAIT_V(n) asm volatile("s_waitcnt vmcnt(" #n ")" ::: "memory")
#define PG8_WAIT_L(n) asm volatile("s_waitcnt lgkmcnt(" #n ")" ::: "memory")
#define PG8_BAR __builtin_amdgcn_s_barrier()
#define PG8_SCHED __builtin_amdgcn_sched_barrier(0)
    Unit cur, nxt; int ui = 0;
    if (!S.next(0, cur)) return;
    f32x4 acc[2][2][4][2];
#pragma unroll
    for (int a = 0; a < 2; ++a)
#pragma unroll
        for (int b = 0; b < 2; ++b)
#pragma unroll
            for (int m = 0; m < 4; ++m)
#pragma unroll
                for (int n = 0; n < 2; ++n) acc[a][b][m][n] = (f32x4){0.f, 0.f, 0.f, 0.f};
    bf16x8 At[4][2], B0[2][2], B1[2][2];
    const char* cA = (const char*)g.A + (size_t)cur.pm * tstep; const char* cB = (const char*)g.Bt + (size_t)cur.pn * tstep;
    S.a_ready(cur);
    if constexpr (SP2) {
        PG8_STAGE(PG8_SB(0, 0), cB, voffB); PG8_STAGE(PG8_SB(0, 1), cB + hstep, voffB); PG8_STAGE(PG8_SA(0, 0), cA, voffA); PG8_STAGE(PG8_SA(0, 1), cA + hstep, voffA);
        if (wr == 1) PG8_BAR;
        PG8_WAIT_V(2); PG8_BAR;
        PG8_STAGE(PG8_SB(1, 0), cB + kstep, voffB); PG8_STAGE(PG8_SA(1, 0), cA + kstep, voffA); PG8_STAGE(PG8_SB(1, 1), cB + hstep + kstep, voffB);
        PG8_WAIT_V(6); PG8_BAR;
    } else {
        PG8_STAGE(PG8_SB(0, 0), cB, voffB); PG8_STAGE(PG8_SA(0, 0), cA, voffA); PG8_STAGE(PG8_SB(0, 1), cB + hstep, voffB); PG8_STAGE(PG8_SA(0, 1), cA + hstep, voffA);
        if (wr == 1) PG8_BAR;
        PG8_WAIT_V(4); PG8_BAR;
        PG8_STAGE(PG8_SB(1, 0), cB + kstep, voffB); PG8_STAGE(PG8_SA(1, 0), cA + kstep, voffA); PG8_STAGE(PG8_SB(1, 1), cB + hstep + kstep, voffB);
        PG8_WAIT_V(6); PG8_BAR;
    }
    for (;;) {
        const bool has_next = S.next(ui + 1, nxt);
        const char* nA = has_next ? (const char*)g.A + (size_t)nxt.pm * tstep : cA; const char* nB = has_next ? (const char*)g.Bt + (size_t)nxt.pn * tstep : cB;
        for (int t = 0; t < nt; t += 2) {
            const bool last = (t == nt - 2);
            const char* a1 = cA + (size_t)(t + 1) * kstep;
            const char* a2 = last ? nA : cA + (size_t)(t + 2) * kstep; const char* b2 = last ? nB : cB + (size_t)(t + 2) * kstep;
            const char* a3 = a2 + kstep; const char* b3 = b2 + kstep;
            if (last && has_next) S.a_ready(nxt);
            if constexpr (SP2) {
            PG8_LDB(B0, 0, 0); PG8_LDB(B1, 0, 1); PG8_SCHED; PG8_LDA(At, 0, 0); PG8_STAGE(PG8_SA(1, 1), a1 + hstep, voffA);
            PG8_WAIT_V(8); PG8_WAIT_L(0); PG8_BAR; PG8_MMA(0, 0, At, B0); PG8_MMA(0, 1, At, B1); PG8_BAR; PG8_SCHED;
            PG8_LDA(At, 0, 1); PG8_STAGE(PG8_SB(0, 0), b2, voffB); PG8_STAGE(PG8_SB(0, 1), b2 + hstep, voffB); PG8_STAGE(PG8_SA(0, 0), a2, voffA);
            PG8_WAIT_V(8); PG8_WAIT_L(0); PG8_BAR; PG8_MMA(1, 0, At, B0); PG8_MMA(1, 1, At, B1); PG8_BAR; PG8_SCHED;
            PG8_LDB(B0, 1, 0); PG8_LDB(B1, 1, 1); PG8_SCHED; PG8_LDA(At, 1, 0); PG8_STAGE(PG8_SA(0, 1), a2 + hstep, voffA);
            PG8_WAIT_V(8); PG8_WAIT_L(0); PG8_BAR; PG8_MMA(0, 0, At, B0); PG8_MMA(0, 1, At, B1); PG8_BAR; PG8_SCHED;
            PG8_LDA(At, 1, 1); PG8_STAGE(PG8_SB(1, 0), b3, voffB); PG8_STAGE(PG8_SB(1, 1), b3 + hstep, voffB); PG8_STAGE(PG8_SA(1, 0), a3, voffA);
            PG8_WAIT_V(8); PG8_WAIT_L(0); PG8_BAR; PG8_MMA(1, 0, At, B0); PG8_MMA(1, 1, At, B1); PG8_BAR; PG8_SCHED;
            } else {
            PG8_LDB(B0, 0, 0); PG8_SCHED; PG8_LDA(At, 0, 0); PG8_STAGE(PG8_SA(1, 1), a1 + hstep, voffA);
            PG8_WAIT_L(8); PG8_BAR; PG8_WAIT_L(0); PG8_MMA(0, 0, At, B0); PG8_BAR; PG8_SCHED;
            PG8_LDB(B1, 0, 1); PG8_STAGE(PG8_SB(0, 0), b2, voffB);
            PG8_BAR; PG8_WAIT_L(0); PG8_MMA(0, 1, At, B1); PG8_BAR;
            PG8_LDA(At, 0, 1); PG8_STAGE(PG8_SA(0, 0), a2, voffA);
            PG8_BAR; PG8_WAIT_L(0); PG8_MMA(1, 0, At, B0); PG8_BAR; PG8_SCHED;
            PG8_STAGE(PG8_SB(0, 1), b2 + hstep, voffB);
            PG8_WAIT_V(6); PG8_BAR; PG8_MMA(1, 1, At, B1); PG8_BAR;
            PG8_LDB(B0, 1, 0); PG8_SCHED; PG8_LDA(At, 1, 0); PG8_STAGE(PG8_SA(0, 1), a2 + hstep, voffA);
            PG8_WAIT_L(8); PG8_BAR; PG8_WAIT_L(0); PG8_MMA(0, 0, At, B0); PG8_BAR; PG8_SCHED;
            PG8_LDB(B1, 1, 1); PG8_STAGE(PG8_SB(1, 0), b3, voffB);
            PG8_BAR; PG8_WAIT_L(0); PG8_MMA(0, 1, At, B1); PG8_BAR;
            PG8_LDA(At, 1, 1); PG8_STAGE(PG8_SA(1, 0), a3, voffA);
            PG8_BAR; PG8_WAIT_L(0); PG8_MMA(1, 0, At, B0); PG8_BAR; PG8_SCHED;
            PG8_STAGE(PG8_SB(1, 1), b3 + hstep, voffB);
            PG8_WAIT_V(6); PG8_BAR; PG8_MMA(1, 1, At, B1); PG8_BAR;
            }
        }
        if constexpr (ALIGN_EPI) { if (wr == 0) PG8_BAR; }
        if constexpr (!Epi::AFTER_DRAIN) { E(acc, cur, wr, wc, fr, fq); S.done(cur); }
        if (!has_next) break;
#pragma unroll
        for (int a = 0; a < 2; ++a)
#pragma unroll
            for (int b = 0; b < 2; ++b)
#pragma unroll
                for (int m = 0; m < 4; ++m)
#pragma unroll
                    for (int n = 0; n < 2; ++n) acc[a][b][m][n] = (f32x4){0.f, 0.f, 0.f, 0.f};
        cur = nxt; cA = nA; cB = nB; ++ui;
        if constexpr (ALIGN_EPI) { if (wr == 1) PG8_BAR; }
    }
    PG8_WAIT_V(0);
    if constexpr (!ALIGN_EPI) { if (wr == 0) PG8_BAR; }
    PG8_BAR;
    if constexpr (Epi::AFTER_DRAIN) { E.fused(acc, cur, wr, wc, fr, fq, lds, wid, lane); S.done(cur); }
#undef PG8_SA
#undef PG8_SB
#undef PG8_STAGE
#undef PG8_LDA
#undef PG8_LDB
#undef PG8_MMA
#undef PG8_WAIT_V
#undef PG8_WAIT_L
#undef PG8_BAR
#undef PG8_SCHED
}
}
#define XB_TMO      128
#define XB_XCNT(j)  (256  + 64 * (j))
#define XB_XSUB(j)  (1280 + 64 * (j))
#define XB_XGEN(j)  (2304 + 64 * (j))
#define XB_TOP      3328
#define XB_TOPGEN   3392
#define XCD_BAR_WORDS 3456
#define XB_SPIN_CAP (1u << 18)

__device__ __forceinline__ unsigned xb_ld(unsigned* p)              { return __hip_atomic_load(p, __ATOMIC_RELAXED, __HIP_MEMORY_SCOPE_AGENT); }
__device__ __forceinline__ unsigned xb_add(unsigned* p, unsigned v) { return __hip_atomic_fetch_add(p, v, __ATOMIC_RELAXED, __HIP_MEMORY_SCOPE_AGENT); }
__device__ __forceinline__ unsigned xb_xcc_id() { return (unsigned)__builtin_amdgcn_s_getreg((3 << 11) | 20) & 0xFu; }
#define XB_SPIN(cond, bar) do { unsigned _sp = 0; while (cond) { __builtin_amdgcn_s_sleep(1); \
    if ((++_sp & 255u) == 0u) { if (xb_ld(&(bar)[XB_TMO])) break; if (_sp > XB_SPIN_CAP) { atomicAdd(&(bar)[XB_TMO], 1u); break; } } } } while (0)

struct XcdBarrier {
    unsigned* bar; unsigned x;
    volatile LAS unsigned* st;
};

__device__ __forceinline__ XcdBarrier xcd_barrier_post(unsigned* bar, volatile LAS unsigned* st) {
    XcdBarrier b; b.bar = bar; b.x = xb_xcc_id(); b.st = st;
    if (threadIdx.x == 0) (void)xb_add(&bar[XB_XCNT(b.x)], 1u);
    return b;
}
__device__ __forceinline__ void xcd_barrier_complete(unsigned* bar, unsigned x, unsigned& nloc, unsigned& nx) {
    const unsigned G = gridDim.x * gridDim.y * gridDim.z;
    unsigned sum, cnt, mine, sp = 0u;
    for (;;) {
        sum = 0u; cnt = 0u; mine = 0u;
#pragma unroll
        for (unsigned j = 0; j < 16; ++j) { const unsigned c = xb_ld(&bar[XB_XCNT(j)]); sum += c; cnt += (c > 0u) ? 1u : 0u; mine = (j == x) ? c : mine; }
        if (sum == G) break;
        __builtin_amdgcn_s_sleep(1);
        if ((++sp & 255u) == 0u) { if (xb_ld(&bar[XB_TMO])) break; if (sp > XB_SPIN_CAP) { atomicAdd(&bar[XB_TMO], 1u); break; } }
    }
    nloc = mine > 0u ? mine : 1u; nx = cnt > 0u ? cnt : 1u;
}

__device__ __forceinline__ void xcd_barrier(const XcdBarrier& b) {
    asm volatile("s_waitcnt vmcnt(0)" ::: "memory");
    __syncthreads();
    if (threadIdx.x == 0) {
        unsigned* bar = b.bar;
        __builtin_amdgcn_s_waitcnt(0);
        unsigned nloc = b.st[0], nx = b.st[1];
        if (nloc == 0u) { xcd_barrier_complete(bar, b.x, nloc, nx); b.st[0] = nloc; b.st[1] = nx; }
        const unsigned old = xb_add(&bar[XB_XSUB(b.x)], 1u);
        const unsigned gen = old / nloc;
        if (old + 1u == (gen + 1u) * nloc) {
            __builtin_amdgcn_fence(__ATOMIC_RELEASE, "agent");
            asm volatile("s_waitcnt vmcnt(0)" ::: "memory");
            const unsigned og = xb_add(&bar[XB_TOP], 1u);
            const unsigned tg = og / nx;
            if (og + 1u == (tg + 1u) * nx) xb_add(&bar[XB_TOPGEN], 1u);
            else XB_SPIN(xb_ld(&bar[XB_TOPGEN]) == tg, bar);
            __builtin_amdgcn_fence(__ATOMIC_ACQUIRE, "agent");
            xb_add(&bar[XB_XGEN(b.x)], 1u);
            asm volatile("s_waitcnt vmcnt(0)" ::: "memory");
        } else {
            XB_SPIN(xb_ld(&bar[XB_XGEN(b.x)]) == gen, bar);
            __builtin_amdgcn_fence(__ATOMIC_ACQUIRE, "agent");
            asm volatile("s_waitcnt vmcnt(0)" ::: "memory");
        }
    }
    __syncthreads();
}
namespace fk {
using pg8::bf16_t; using pg8::bf16x8; using pg8::f32x4; using pg8::u32x4; using pg8::Unit;
typedef float f32x16 __attribute__((ext_vector_type(16)));
typedef float f32x2 __attribute__((ext_vector_type(2)));
typedef __bf16 bf16x2_t __attribute__((ext_vector_type(2)));
typedef short s16x4 __attribute__((ext_vector_type(4)));
typedef unsigned u32x2 __attribute__((ext_vector_type(2)));
#define DI __device__ __forceinline__

constexpr int NB = 8, S = 2048, M = NB * S, D = 1024;
constexpr float EPS = 1e-6f, LOG2E = 1.4426950408889634f;
constexpr int NTHR = 512;

DI int tidx() { int t = threadIdx.x; asm volatile("" : "+v"(t)); return t; }
DI unsigned pk2(float lo, float hi) { f32x2 v = {lo, hi}; return __builtin_bit_cast(unsigned, __builtin_convertvector(v, bf16x2_t)); }
DI float bflo(unsigned u) { return __uint_as_float(u << 16); }
DI float bfhi(unsigned u) { return __uint_as_float(u & 0xffff0000u); }
DI float bf1(unsigned short b) { return __uint_as_float((unsigned)b << 16); }
DI float sigm(float x) { return 1.f / (1.f + __expf(-x)); }
DI float silu(float x) { return x * sigm(x); }
DI float ex2(float x) { return __builtin_amdgcn_exp2f(x); }
DI u32x4 pk8(const f32x4& a, const f32x4& b) { u32x4 w; w.x = pk2(a[0], a[1]); w.y = pk2(a[2], a[3]); w.z = pk2(b[0], b[1]); w.w = pk2(b[2], b[3]); return w; }
DI void unpk8(u32x4 w, f32x4& a, f32x4& b) { a[0] = bflo(w.x); a[1] = bfhi(w.x); a[2] = bflo(w.y); a[3] = bfhi(w.y); b[0] = bflo(w.z); b[1] = bfhi(w.z); b[2] = bflo(w.w); b[3] = bfhi(w.w); }

constexpr size_t KiB = 1024, MiB = 1u << 20;
constexpr size_t WS_CTL = 0;
constexpr size_t WS_SSQ = 64 * KiB;
constexpr int SSQ_X = 0  , SSQ_1 = 5  , SSQ_Q = 9  , SSQ_KV = 11  ;
constexpr size_t ZERO_BYTES = 1792 * KiB;
constexpr size_t WS_GW8 = 1792 * KiB;
constexpr size_t WS_WMIX = 2 * MiB;
constexpr size_t WS_WPLE = 23 * MiB;
constexpr size_t WS_XBA = 26 * MiB;
constexpr size_t WS_BIG = 58 * MiB;
constexpr size_t WS_CS = WS_BIG + 192 * MiB, WS_SN = WS_CS + 1 * MiB, WS_IG = WS_SN + 1 * MiB, WS_LF = WS_IG + 256 * KiB;
constexpr size_t WS_END = 256 * MiB;
static_assert(WS_LF + 256 * KiB <= WS_END, "ws map");
constexpr size_t WM_IN = 0, WM_QB = 4 * MiB, WM_KVB = 6 * MiB, WM_OUT_MLA = 8 * MiB, WM_OUT_CONV = 8 * MiB, WM_OUT_LSTM = 16 * MiB;
constexpr size_t A_SZ = 0, A_Q = 32 * MiB, A_KN = 80 * MiB, A_VT = 112 * MiB, A_CQ = 144 * MiB, A_CKV = 156 * MiB, A_KR = 164 * MiB, A_XBB = 32 * MiB, A_PP = 80 * MiB, A_PB = 166 * MiB;
constexpr size_t C_CH = 0, C_BZ = 32 * MiB, C_XBB = 64 * MiB, C_PP = 96 * MiB, C_PB = 166 * MiB;
constexpr size_t L_Q = 0, L_K = 32 * MiB, L_VT = 64 * MiB, L_OG = 128 * MiB, L_XBB = 0, L_PP = 64 * MiB;

struct Args { const float* in[19]; float* out; unsigned char* ws; int ph_lo, ph_hi; };
enum { I_X = 0, I_P, I_POS, I_NORMG, I_MLA_WIN, I_MLA_QN, I_MLA_WQB, I_MLA_KVN, I_MLA_WKVB, I_MLA_WOUT, I_CONV_WIN, I_CONV_W, I_CONV_WOUT, I_L_WIN, I_L_BG, I_L_WOUT, I_PLE_PROJ, I_PLE_GATE, I_FNORM };

enum { PM_ID = 0, PM_MLA_IN, PM_MLA_QB, PM_MLA_KVB, PM_CONV_IN, PM_LSTM_IN };
DI int prep_src(int mode, int n, float& sc) {
    sc = 1.f;
    switch (mode) {
    case PM_MLA_IN: { if (n < 1024) return 672 + n; if (n < 1408) return n - 1024; if (n < 1664) return 384 + (n - 1408); if (n < 1696) { const int jj = n - 1664; return 640 + (jj >> 1) + 16 * (jj & 1); } return -1; }
    case PM_MLA_QB: { sc = 0.10206207261596577f * LOG2E; const int hd = n / 96, d = n % 96; if (d < 64) return n; const int jj = d - 64; return 96 * hd + 64 + (jj >> 1) + 16 * (jj & 1); }
    case PM_MLA_KVB: { if (n < 1024) return 128 * (n >> 6) + (n & 63); const int n2 = n - 1024; return 128 * (n2 >> 6) + 64 + (n2 & 63); }
    case PM_CONV_IN: { const int pn = n >> 8, bj = (n >> 7) & 1, i = n & 127; if (pn < 8) return (bj ? 2048 : 1024) + 128 * pn + i; return (bj ? 3072 : 0) + 128 * (pn - 8) + i; }
    case PM_LSTM_IN: { if (n < 4096) { if (n >= 1024 && n < 2048) sc = 0.0625f; return n; } const int n2 = n - 4096, pn = n2 >> 8, bj = (n2 >> 7) & 1, i = n2 & 127; return (bj ? 6144 : 4096) + 128 * pn + i; }
    default: return n;
    }
}
struct PrepTask { const float* W; int ldw; const float* gk; int K, Nst, mode; bf16_t* out; };
DI void prep_tile(const PrepTask& t, int tile, LAS float* scr) {
    const int tid = tidx(), nkb = t.K >> 6, nb = tile / nkb, kb = tile % nkb, n0 = nb << 6, k0 = kb << 6;
#pragma unroll
    for (int i = 0; i < 8; ++i) {
        const int e = tid + i * NTHR, nn = e & 63, kk = e >> 6;
        float sc; const int src = prep_src(t.mode, n0 + nn, sc);
        float v = 0.f;
        if (src >= 0) { v = t.W[(size_t)(k0 + kk) * t.ldw + src] * sc; if (t.gk) v *= t.gk[k0 + kk]; }
        scr[nn * 65 + kk] = v;
    }
    __syncthreads();
    { const int nn = tid >> 3, c = tid & 7; const LAS float* s = scr + nn * 65 + 8 * c;
      u32x4 o; o.x = pk2(s[0], s[1]); o.y = pk2(s[2], s[3]); o.z = pk2(s[4], s[5]); o.w = pk2(s[6], s[7]);
      *(u32x4*)(t.out + (size_t)(n0 + nn) * t.K + k0 + 8 * c) = o; }
    __syncthreads();
}
DI void prep_run1(const PrepTask& t, LAS float* scr, int cu, int G) {
    const int total = (t.Nst >> 6) * (t.K >> 6);
#pragma unroll 1
    for (int it = cu; it < total; it += G) prep_tile(t, it, scr);
}

DI float wave_sum(float v) {
#pragma unroll
    for (int o = 1; o < 64; o <<= 1) v += __shfl_xor(v, o);
    return v;
}
DI void rows_to_bf16_ssq(const float* x, bf16_t* xb, unsigned long long* ssq, int gw, int NGW, int lane) {
    for (int m = gw; m < M; m += NGW) {
        const f32x4* xr = (const f32x4*)(x + (size_t)m * D) + lane; float s = 0.f;
        u32x2* o8 = (u32x2*)(xb + (size_t)m * D) + lane;
#pragma unroll
        for (int j = 0; j < 4; ++j) { const f32x4 v = xr[64 * j]; s += (v[0] * v[0] + v[1] * v[1]) + (v[2] * v[2] + v[3] * v[3]); u32x2 w; w.x = pk2(v[0], v[1]); w.y = pk2(v[2], v[3]); o8[64 * j] = w; }
        s = wave_sum(s); if (lane == 0) ssq[m] = (unsigned long long)(s * 16777216.f);
    }
}
DI void p_to_bf16(const float* p, bf16_t* pb, int gt, int NGT) {
    for (size_t i = gt; i < (size_t)M * 256 / 8; i += NGT) { const f32x4 a = ((const f32x4*)p)[2 * i], b = ((const f32x4*)p)[2 * i + 1]; ((u32x4*)pb)[i] = pk8(a, b); }
}
DI void rope_tables(const int* pos, float* cs, float* sn, int gt, int NGT) {
    for (int i = gt; i < M * 16; i += NGT) {
        const int t = i >> 4, j = i & 15;
        const float inv = powf(10000.0f, -(float)(2 * j) / 32.0f);
        const float ang = (float)pos[t] * inv;
        double rev = (double)ang * 0.15915494309189533577; rev -= rint(rev);
        const float fr = (float)rev;
        cs[i] = __builtin_amdgcn_cosf(fr); sn[i] = __builtin_amdgcn_sinf(fr);
    }
}

#define EPI_ROW(u, ai, m) ((u).pm * 256 + (ai) * 128 + wr * 64 + (m) * 16 + fr)
#define EPI_LOOP_AM _Pragma("unroll") for (int ai = 0; ai < 2; ++ai) _Pragma("unroll") for (int m = 0; m < 4; ++m)
typedef const f32x4 (&AccRef)[2][2][4][2];
DI float sq8(const f32x4& a, const f32x4& b) { return (a[0] * a[0] + a[1] * a[1]) + (a[2] * a[2] + a[3] * a[3]) + (b[0] * b[0] + b[1] * b[1]) + (b[2] * b[2] + b[3] * b[3]); }
DI float red_fq(float s) { s += __shfl_xor(s, 16); s += __shfl_xor(s, 32); return s; }
DI void rope8(f32x4& a, f32x4& b, const float* cs, const float* sn, int row, int p0) {
    const f32x4 c = *(const f32x4*)(cs + (size_t)row * 16 + p0), s = *(const f32x4*)(sn + (size_t)row * 16 + p0);
    const f32x4 a0 = a, b0 = b;
    a[0] = a0[0] * c[0] - a0[1] * s[0]; a[1] = a0[0] * s[0] + a0[1] * c[0];
    a[2] = a0[2] * c[1] - a0[3] * s[1]; a[3] = a0[2] * s[1] + a0[3] * c[1];
    b[0] = b0[0] * c[2] - b0[1] * s[2]; b[1] = b0[0] * s[2] + b0[1] * c[2];
    b[2] = b0[2] * c[3] - b0[3] * s[3]; b[3] = b0[2] * s[3] + b0[3] * c[3];
}

DI int opaque(int v) { asm volatile("" : "+s"(v)); return v; }
template <class T> DI T* launder(T* p) { asm volatile("" : "+s"(p)); return p; }
typedef unsigned long long u64;
constexpr float SSQ_SCALE = 16777216.f, SSQ_INV = 1.f / 16777216.f;
DI u64* ssq_arr(unsigned char* ws, int idx) { return (u64*)(ws + WS_SSQ) + (size_t)idx * M; }
DI void ssq_add(u64* p, float s) { atomicAdd(p, (u64)(s * SSQ_SCALE)); }
DI float ssq_rstd(const u64* p, float invn) { return rsqrtf((float)(*p) * SSQ_INV * invn + EPS); }

struct EpiA1 {
    static constexpr bool PERM = true, AFTER_DRAIN = false;
    unsigned char* ws; int i, j;
    DI void operator()(AccRef acc, const Unit& u, int wr, int wc, int fr, int fq) const {
        unsigned char* w = launder(ws); unsigned char* big = w + WS_BIG;
        const u64* ssq_x = ssq_arr(w, SSQ_X + i); u64* ssq_q = ssq_arr(w, SSQ_Q + j); u64* ssq_kv = ssq_arr(w, SSQ_KV + j);
        bf16_t *SZ = (bf16_t*)(big + A_SZ), *CQ = (bf16_t*)(big + A_CQ), *CKV = (bf16_t*)(big + A_CKV), *KR = (bf16_t*)(big + A_KR);
        const float *CS = (const float*)(w + WS_CS), *SN = (const float*)(w + WS_SN);
        EPI_LOOP_AM {
            const int row = EPI_ROW(u, ai, m); const float rs = ssq_rstd(ssq_x + row, 1.f / 1024.f);
            float sq = 0.f, skv = 0.f; bool hq = false, hkv = false;
#pragma unroll
            for (int bj = 0; bj < 2; ++bj) {
                f32x4 v0 = acc[ai][bj][m][0] * rs, v1 = acc[ai][bj][m][1] * rs;
                if (u.pn < 4) {
                    const int col = u.pn * 256 + bj * 128 + wc * 32 + 8 * fq;
#pragma unroll
                    for (int jj = 0; jj < 4; ++jj) { v0[jj] = silu(v0[jj]); v1[jj] = silu(v1[jj]); }
                    *(u32x4*)(SZ + (size_t)row * 1024 + col) = pk8(v0, v1);
                } else {
                    const int c = (u.pn - 4) * 256 + bj * 128 + wc * 32 + 8 * fq;
                    if (c < 384) { *(u32x4*)(CQ + (size_t)row * 384 + c) = pk8(v0, v1); sq += sq8(v0, v1); hq = true; }
                    else if (c < 640) { *(u32x4*)(CKV + (size_t)row * 256 + (c - 384)) = pk8(v0, v1); skv += sq8(v0, v1); hkv = true; }
                    else if (c < 672) { const int jj0 = c - 640; rope8(v0, v1, CS, SN, row, jj0 >> 1); *(u32x4*)(KR + (size_t)row * 32 + jj0) = pk8(v0, v1); }
                }
            }
            if (u.pn >= 4) {
                sq = red_fq(sq); skv = red_fq(skv);
                if (fq == 0 && hq) ssq_add(ssq_q + row, sq);
                if (fq == 0 && hkv) ssq_add(ssq_kv + row, skv);
            }
        }
    }
};
struct EpiQ {
    static constexpr bool PERM = true, AFTER_DRAIN = false;
    unsigned char* ws; int j;
    DI void operator()(AccRef acc, const Unit& u, int wr, int wc, int fr, int fq) const {
        unsigned char* w = launder(ws); const u64* ssq_q = ssq_arr(w, SSQ_Q + j); bf16_t* Q = (bf16_t*)(w + WS_BIG + A_Q);
        const float *CS = (const float*)(w + WS_CS), *SN = (const float*)(w + WS_SN);
        EPI_LOOP_AM {
            const int row = EPI_ROW(u, ai, m); const float rs = ssq_rstd(ssq_q + row, 1.f / 384.f);
#pragma unroll
            for (int bj = 0; bj < 2; ++bj) {
                const int col = u.pn * 256 + bj * 128 + wc * 32 + 8 * fq, d = col % 96;
                f32x4 v0 = acc[ai][bj][m][0] * rs, v1 = acc[ai][bj][m][1] * rs;
                if (d >= 64) rope8(v0, v1, CS, SN, row, (d - 64) >> 1);
                *(u32x4*)(Q + (size_t)row * 1536 + col) = pk8(v0, v1);
            }
        }
    }
};
DI void store_vt8(bf16_t* vp, const u32x4& w) {
    vp[0 * (size_t)S] = (bf16_t)(w.x & 0xffff); vp[1 * (size_t)S] = (bf16_t)(w.x >> 16); vp[2 * (size_t)S] = (bf16_t)(w.y & 0xffff); vp[3 * (size_t)S] = (bf16_t)(w.y >> 16);
    vp[4 * (size_t)S] = (bf16_t)(w.z & 0xffff); vp[5 * (size_t)S] = (bf16_t)(w.z >> 16); vp[6 * (size_t)S] = (bf16_t)(w.w & 0xffff); vp[7 * (size_t)S] = (bf16_t)(w.w >> 16);
}
struct EpiKV {
    static constexpr bool PERM = true, AFTER_DRAIN = false;
    unsigned char* ws; int j;
    DI void operator()(AccRef acc, const Unit& u, int wr, int wc, int fr, int fq) const {
        unsigned char* w = launder(ws); const u64* ssq_kv = ssq_arr(w, SSQ_KV + j); bf16_t *KN = (bf16_t*)(w + WS_BIG + A_KN), *VT = (bf16_t*)(w + WS_BIG + A_VT);
        EPI_LOOP_AM {
            const int row = EPI_ROW(u, ai, m); const float rs = ssq_rstd(ssq_kv + row, 1.f / 256.f);
#pragma unroll
            for (int bj = 0; bj < 2; ++bj) {
                const int col = u.pn * 256 + bj * 128 + wc * 32 + 8 * fq;
                const f32x4 v0 = acc[ai][bj][m][0] * rs, v1 = acc[ai][bj][m][1] * rs;
                if (u.pn < 4) *(u32x4*)(KN + (size_t)row * 1024 + col) = pk8(v0, v1);
                else { const int b = row >> 11, s = row & 2047; store_vt8(VT + ((size_t)(b * 1024 + (col - 1024))) * S + s, pk8(v0, v1)); }
            }
        }
    }
};
struct EpiOut {
    static constexpr bool PERM = true, AFTER_DRAIN = false;
    unsigned char* ws; const float* xin; float* xout; size_t xbb_off; int i;
    DI void operator()(AccRef acc, const Unit& u, int wr, int wc, int fr, int fq) const {
        unsigned char* w = launder(ws); u64* ssq = ssq_arr(w, SSQ_1 + i); bf16_t* XB = (bf16_t*)(w + WS_BIG + xbb_off);
        EPI_LOOP_AM {
            const int row = EPI_ROW(u, ai, m); float sq = 0.f;
#pragma unroll
            for (int bj = 0; bj < 2; ++bj) {
                const size_t off = (size_t)row * 1024 + u.pn * 256 + bj * 128 + wc * 32 + 8 * fq;
                const f32x4 y0 = *(const f32x4*)(xin + off) + acc[ai][bj][m][0], y1 = *(const f32x4*)(xin + off + 4) + acc[ai][bj][m][1];
                *(f32x4*)(xout + off) = y0; *(f32x4*)(xout + off + 4) = y1; *(u32x4*)(XB + off) = pk8(y0, y1); sq += sq8(y0, y1);
            }
            sq = red_fq(sq); if (fq == 0) ssq_add(ssq + row, sq);
        }
    }
};
struct EpiPP {
    static constexpr bool PERM = true, AFTER_DRAIN = false;
    unsigned char* ws; size_t pp_off;
    DI void operator()(AccRef acc, const Unit& u, int wr, int wc, int fr, int fq) const {
        bf16_t* PP = (bf16_t*)(launder(ws) + WS_BIG + pp_off);
        EPI_LOOP_AM { const int row = EPI_ROW(u, ai, m);
#pragma unroll
            for (int bj = 0; bj < 2; ++bj) { const size_t off = (size_t)row * 1024 + u.pn * 256 + bj * 128 + wc * 32 + 8 * fq; *(u32x4*)(PP + off) = pk8(acc[ai][bj][m][0], acc[ai][bj][m][1]); } }
    }
};
struct EpiPle {
    static constexpr bool PERM = true, AFTER_DRAIN = false;
    unsigned char* ws; float* x; size_t pp_off; int i;
    DI void operator()(AccRef acc, const Unit& u, int wr, int wc, int fr, int fq) const {
        unsigned char* w = launder(ws); const u64* ssq1 = ssq_arr(w, SSQ_1 + i); u64* ssq = ssq_arr(w, SSQ_X + i + 1);
        const bf16_t* PP = (const bf16_t*)(w + WS_BIG + pp_off); bf16_t* XB = (bf16_t*)(w + WS_XBA);
        EPI_LOOP_AM {
            const int row = EPI_ROW(u, ai, m); const float rs = ssq_rstd(ssq1 + row, 1.f / 1024.f); float sq = 0.f;
#pragma unroll
            for (int bj = 0; bj < 2; ++bj) {
                const size_t off = (size_t)row * 1024 + u.pn * 256 + bj * 128 + wc * 32 + 8 * fq;
                f32x4 p0, p1; unpk8(*(const u32x4*)(PP + off), p0, p1);
                f32x4 y0 = *(const f32x4*)(x + off), y1 = *(const f32x4*)(x + off + 4);
#pragma unroll
                for (int jj = 0; jj < 4; ++jj) { y0[jj] += sigm(acc[ai][bj][m][0][jj] * rs) * p0[jj]; y1[jj] += sigm(acc[ai][bj][m][1][jj] * rs) * p1[jj]; }
                *(f32x4*)(x + off) = y0; *(f32x4*)(x + off + 4) = y1; *(u32x4*)(XB + off) = pk8(y0, y1); sq += sq8(y0, y1);
            }
            sq = red_fq(sq); if (fq == 0) ssq_add(ssq + row, sq);
        }
    }
};
struct EpiC1 {
    static constexpr bool PERM = true, AFTER_DRAIN = false;
    unsigned char* ws; int i;
    DI void operator()(AccRef acc, const Unit& u, int wr, int wc, int fr, int fq) const {
        unsigned char* w = launder(ws); const u64* ssq_x = ssq_arr(w, SSQ_X + i); bf16_t *CH = (bf16_t*)(w + WS_BIG + C_CH), *BZ = (bf16_t*)(w + WS_BIG + C_BZ);
        EPI_LOOP_AM {
            const int row = EPI_ROW(u, ai, m); const float rs = ssq_rstd(ssq_x + row, 1.f / 1024.f);
            const size_t off = (size_t)row * 1024 + (u.pn & 7) * 128 + wc * 32 + 8 * fq;
            f32x4 r0, r1;
            if (u.pn < 8) { r0 = (acc[ai][0][m][0] * rs) * (acc[ai][1][m][0] * rs); r1 = (acc[ai][0][m][1] * rs) * (acc[ai][1][m][1] * rs); *(u32x4*)(CH + off) = pk8(r0, r1); }
            else {
#pragma unroll
                for (int jj = 0; jj < 4; ++jj) { r0[jj] = (acc[ai][0][m][0][jj] * rs) * silu(acc[ai][1][m][0][jj] * rs); r1[jj] = (acc[ai][0][m][1][jj] * rs) * silu(acc[ai][1][m][1][jj] * rs); }
                *(u32x4*)(BZ + off) = pk8(r0, r1);
            }
        }
    }
};
struct EpiL1 {
    static constexpr bool PERM = true, AFTER_DRAIN = false;
    unsigned char* ws; int i;
    DI void operator()(AccRef acc, const Unit& u, int wr, int wc, int fr, int fq) const {
        unsigned char* w = launder(ws); const u64* ssq_x = ssq_arr(w, SSQ_X + i); unsigned char* big = w + WS_BIG;
        bf16_t *Q = (bf16_t*)(big + L_Q), *K = (bf16_t*)(big + L_K), *VT = (bf16_t*)(big + L_VT), *OG = (bf16_t*)(big + L_OG);
        EPI_LOOP_AM {
            const int row = EPI_ROW(u, ai, m); const float rs = ssq_rstd(ssq_x + row, 1.f / 1024.f);
            if (u.pn < 16) {
#pragma unroll
                for (int bj = 0; bj < 2; ++bj) {
                    const int col = u.pn * 256 + bj * 128 + wc * 32 + 8 * fq;
                    const f32x4 v0 = acc[ai][bj][m][0] * rs, v1 = acc[ai][bj][m][1] * rs; const u32x4 wv = pk8(v0, v1);
                    if (u.pn < 4) *(u32x4*)(Q + (size_t)row * 1024 + col) = wv;
                    else if (u.pn < 8) *(u32x4*)(K + (size_t)row * 1024 + (col - 1024)) = wv;
                    else { const int b = row >> 11, s = row & 2047; store_vt8(VT + ((size_t)(b * 2048 + (col - 2048))) * S + s, wv); }
                }
            } else {
                const size_t off = (size_t)row * 2048 + (u.pn - 16) * 128 + wc * 32 + 8 * fq; f32x4 r0, r1;
#pragma unroll
                for (int jj = 0; jj < 4; ++jj) { r0[jj] = sigm(acc[ai][0][m][0][jj] * rs) * silu(acc[ai][1][m][0][jj] * rs); r1[jj] = sigm(acc[ai][0][m][1][jj] * rs) * silu(acc[ai][1][m][1][jj] * rs); }
                *(u32x4*)(OG + off) = pk8(r0, r1);
            }
        }
    }
};
constexpr int AT_KSTR = 208, AT_VSTR = 136, AT_KB = 64 * AT_KSTR, AT_VB = 64 * AT_VSTR;
#define MFMA32(a, b, c) __builtin_amdgcn_mfma_f32_32x32x16_bf16((a), (b), (c), 0, 0, 0)
#define MFMA16(a, b, c) __builtin_amdgcn_mfma_f32_16x16x32_bf16((a), (b), (c), 0, 0, 0)
DI bf16x8 cat4(s16x4 lo, s16x4 hi) { return __builtin_shufflevector(lo, hi, 0, 1, 2, 3, 4, 5, 6, 7); }

struct AttnT { const bf16_t *Q, *KN, *KR, *VT; bf16_t* SZOG; };
DI void attn_unit(LAS unsigned char* lds, const AttnT& T, int b, int h, int qb) {
    const int tid = tidx(), w = __builtin_amdgcn_readfirstlane(tid >> 6), lane = tid & 63, r = lane & 31, hh = lane >> 5;
    const int tok0 = b * S, row0 = tok0 + qb * 256 + 32 * w;
    bf16x8 qf[6];
#pragma unroll
    for (int ks = 0; ks < 6; ++ks) qf[ks] = *(const bf16x8*)(T.Q + (size_t)(row0 + r) * 1536 + 96 * h + 16 * ks + 8 * hh);
    f32x16 O0, O1;
#pragma unroll
    for (int i = 0; i < 16; ++i) { O0[i] = 0.f; O1[i] = 0.f; }
    float mrun = -1e30f, lrun = 0.f;
    const int ntiles = 4 * qb + 4, myvis = 4 * qb + (w >> 1);
    const int kkey = tid >> 3, kch = tid & 7, rkey = tid >> 2, rch = tid & 3;
    const bf16_t* gK = T.KN + (size_t)(tok0 + kkey) * 1024 + 64 * h + 8 * kch;
    const bf16_t* gR = T.KR + (size_t)(tok0 + rkey) * 32 + 8 * rch;
    const bf16_t* gV = T.VT + ((size_t)(b * 1024 + 64 * h + kkey)) * S + 8 * kch;
    const int lK = kkey * AT_KSTR + 16 * kch, lR = rkey * AT_KSTR + 128 + 16 * rch, lV = kkey * AT_VSTR + 16 * kch;
    u32x4 sK, sR, sV;
    sK = *(const u32x4*)gK; if (tid < 256) sR = *(const u32x4*)gR; sV = *(const u32x4*)gV;
    {   LAS unsigned char* kb = lds; LAS unsigned char* vb = lds + 2 * AT_KB;
        *(LAS u32x4*)(kb + lK) = sK; if (tid < 256) *(LAS u32x4*)(kb + lR) = sR;
        *(LAS u32x2*)(vb + lV) = (u32x2){sV.x, sV.y}; *(LAS u32x2*)(vb + lV + 8) = (u32x2){sV.z, sV.w}; }
    __syncthreads();
    for (int kt = 0; kt < ntiles; ++kt) {
        const bool more = kt + 1 < ntiles;
        if (more) { sK = *(const u32x4*)(gK + (size_t)(kt + 1) * 64 * 1024); if (tid < 256) sR = *(const u32x4*)(gR + (size_t)(kt + 1) * 64 * 32); sV = *(const u32x4*)(gV + (kt + 1) * 64); }
        if (kt <= myvis) {
            const LAS unsigned char* kb = lds + (kt & 1) * AT_KB; const LAS unsigned char* vb = lds + 2 * AT_KB + (kt & 1) * AT_VB;
            f32x16 s0, s1;
#pragma unroll
            for (int i = 0; i < 16; ++i) { s0[i] = 0.f; s1[i] = 0.f; }
#pragma unroll
            for (int ks = 0; ks < 6; ++ks) {
                const bf16x8 a0 = *(const LAS bf16x8*)(kb + r * AT_KSTR + (16 * ks + 8 * hh) * 2);
                const bf16x8 a1 = *(const LAS bf16x8*)(kb + (32 + r) * AT_KSTR + (16 * ks + 8 * hh) * 2);
                s0 = MFMA32(a0, qf[ks], s0); s1 = MFMA32(a1, qf[ks], s1);
            }
            float mx = s0[0];
#pragma unroll
            for (int i = 1; i < 16; ++i) mx = fmaxf(mx, s0[i]);
#pragma unroll
            for (int i = 0; i < 16; ++i) mx = fmaxf(mx, s1[i]);
            mx = fmaxf(mx, __shfl_xor(mx, 32));
            const float mnew = fmaxf(mrun, mx), alpha = ex2(mrun - mnew); mrun = mnew;
            float ps = 0.f;
#pragma unroll
            for (int i = 0; i < 16; ++i) { s0[i] = ex2(s0[i] - mnew); s1[i] = ex2(s1[i] - mnew); ps += s0[i] + s1[i]; }
            lrun = lrun * alpha + ps;
#pragma unroll
            for (int i = 0; i < 16; ++i) { O0[i] *= alpha; O1[i] *= alpha; }
#pragma unroll
            for (int kb2 = 0; kb2 < 2; ++kb2)
#pragma unroll
                for (int s = 0; s < 2; ++s) {
                    const f32x16& sx = kb2 ? s1 : s0;
                    u32x4 pw; pw.x = pk2(sx[8 * s + 0], sx[8 * s + 1]); pw.y = pk2(sx[8 * s + 2], sx[8 * s + 3]); pw.z = pk2(sx[8 * s + 4], sx[8 * s + 5]); pw.w = pk2(sx[8 * s + 6], sx[8 * s + 7]);
                    const bf16x8 pf = __builtin_bit_cast(bf16x8, pw);
                    const int ko = (32 * kb2 + 16 * s + 4 * hh) * 2;
                    const bf16x8 v0 = cat4(*(const LAS s16x4*)(vb + r * AT_VSTR + ko), *(const LAS s16x4*)(vb + r * AT_VSTR + ko + 16));
                    const bf16x8 v1 = cat4(*(const LAS s16x4*)(vb + (32 + r) * AT_VSTR + ko), *(const LAS s16x4*)(vb + (32 + r) * AT_VSTR + ko + 16));
                    O0 = MFMA32(v0, pf, O0); O1 = MFMA32(v1, pf, O1);
                }
        }
        if (more) { LAS unsigned char* kb = lds + ((kt + 1) & 1) * AT_KB; LAS unsigned char* vb = lds + 2 * AT_KB + ((kt + 1) & 1) * AT_VB;
            *(LAS u32x4*)(kb + lK) = sK; if (tid < 256) *(LAS u32x4*)(kb + lR) = sR;
            *(LAS u32x2*)(vb + lV) = (u32x2){sV.x, sV.y}; *(LAS u32x2*)(vb + lV + 8) = (u32x2){sV.z, sV.w}; }
        __syncthreads();
    }
    const float linv = 1.f / (lrun + __shfl_xor(lrun, 32));
    bf16_t* op = T.SZOG + (size_t)(row0 + r) * 1024 + 64 * h + 4 * hh;
#pragma unroll
    for (int db = 0; db < 2; ++db)
#pragma unroll
        for (int g4 = 0; g4 < 4; ++g4) {
            const f32x16& ox = db ? O1 : O0; bf16_t* p = op + 32 * db + 8 * g4;
            const u32x2 z = *(const u32x2*)p; u32x2 o;
            o.x = pk2(ox[4 * g4 + 0] * linv * bflo(z.x), ox[4 * g4 + 1] * linv * bfhi(z.x)); o.y = pk2(ox[4 * g4 + 2] * linv * bflo(z.y), ox[4 * g4 + 3] * linv * bfhi(z.y));
            *(u32x2*)p = o;
        }
}
DI void attn_phase(LAS unsigned char* lds, const AttnT& T, int cu) {
    const int bh = (cu & 7) + 8 * (cu >> 4), half = (cu >> 3) & 1, b = bh >> 4, h = bh & 15;
#pragma unroll 1
    for (int ui = 0; ui < 4; ++ui) attn_unit(lds, T, b, h, ((half ? 0x2516 : 0x3407) >> (4 * ui)) & 0xF);
}

DI void conv_phase(const bf16_t* CH, bf16_t* BZ, const float* cw, int gt, int NGT) {
    for (int i = gt; i < M * 128; i += NGT) {
        const int m = i >> 7, c8 = (i & 127) * 8, t = m & (S - 1);
        f32x4 w0a = *(const f32x4*)(cw + c8), w0b = *(const f32x4*)(cw + c8 + 4), w1a = *(const f32x4*)(cw + 1024 + c8), w1b = *(const f32x4*)(cw + 1024 + c8 + 4), w2a = *(const f32x4*)(cw + 2048 + c8), w2b = *(const f32x4*)(cw + 2048 + c8 + 4);
        f32x4 a, b2, ya, yb; unpk8(*(const u32x4*)(CH + (size_t)m * 1024 + c8), a, b2); ya = w2a * a; yb = w2b * b2;
        if (t >= 1) { unpk8(*(const u32x4*)(CH + (size_t)(m - 1) * 1024 + c8), a, b2); ya += w1a * a; yb += w1b * b2; }
        if (t >= 2) { unpk8(*(const u32x4*)(CH + (size_t)(m - 2) * 1024 + c8), a, b2); ya += w0a * a; yb += w0b * b2; }
        unpk8(*(const u32x4*)(BZ + (size_t)m * 1024 + c8), a, b2);
        *(u32x4*)(BZ + (size_t)m * 1024 + c8) = pk8(a * ya, b2 * yb);
    }
}

DI void gates_phase(const bf16_t* XB, const u64* ssq_x, const float* Wg8, const float* bg, float* IG, float* LF, int gw, int NGW, int lane) {
    for (int m = gw; m < M; m += NGW) {
        float acc[8];
#pragma unroll
        for (int j = 0; j < 8; ++j) acc[j] = 0.f;
#pragma unroll
        for (int half = 0; half < 2; ++half) {
            const int k0 = half * 512 + lane * 8; f32x4 xa, xb2; unpk8(*(const u32x4*)(XB + (size_t)m * 1024 + k0), xa, xb2);
#pragma unroll
            for (int j = 0; j < 8; ++j) { const f32x4 wa = *(const f32x4*)(Wg8 + j * 1024 + k0), wb = *(const f32x4*)(Wg8 + j * 1024 + k0 + 4);
                acc[j] += (xa[0] * wa[0] + xa[1] * wa[1]) + (xa[2] * wa[2] + xa[3] * wa[3]) + (xb2[0] * wb[0] + xb2[1] * wb[1]) + (xb2[2] * wb[2] + xb2[3] * wb[3]); }
        }
        const float rs = ssq_rstd(ssq_x + m, 1.f / 1024.f);
#pragma unroll
        for (int j = 0; j < 8; ++j) acc[j] = wave_sum(acc[j]) * rs + bg[j];
        if (lane == 0) {
            *(f32x4*)(IG + (size_t)m * 4) = (f32x4){acc[0], acc[1], acc[2], acc[3]};
            f32x4 lf;
#pragma unroll
            for (int j = 0; j < 4; ++j) { const float x = acc[4 + j]; lf[j] = fminf(x, 0.f) - log1pf(__expf(-fabsf(x))); }
            *(f32x4*)(LF + (size_t)m * 4) = lf;
        }
    }
}
DI void gw8_prep(const float* w_in, const float* g, float* Wg8, int gt, int NGT) {
    for (int i = gt; i < 8 * 1024; i += NGT) { const int j = i >> 10, k = i & 1023; Wg8[i] = w_in[(size_t)k * 8200 + 8192 + j] * g[k]; }
}

constexpr int SC_QSTR = 528, SC_VSTR = 136;
constexpr int SC_QS = 0, SC_KS = 64 * SC_QSTR, SC_VS = 2 * 64 * SC_QSTR, SC_SP = SC_VS + 64 * SC_VSTR, SC_QCX = SC_SP + 64 * SC_VSTR, SC_VEC = SC_QCX + 16384;
constexpr int V_A2 = 0, V_C2 = 64, V_WI = 128, V_EM = 192, V_WS = 256, V_QN = 320, V_RS = 384  , V_NV = 640, V_MISC = 896;
constexpr int SC_END = SC_VEC + 904 * 4;
static_assert(SC_END <= 131072, "scan LDS");
struct ScanT { const bf16_t *Q, *K, *VT; bf16_t* OG; const float *IG, *LF; };
DI float scan_add(float v, int lane) {
#pragma unroll
    for (int o = 1; o < 64; o <<= 1) { const float t = __shfl_up(v, o); if (lane >= o) v += t; }
    return v;
}
DI float scan_max(float v, int lane) {
#pragma unroll
    for (int o = 1; o < 64; o <<= 1) { const float t = __shfl_up(v, o); if (lane >= o) v = fmaxf(v, t); }
    return v;
}
DI void scan_item(LAS unsigned char* lds, const ScanT& T, int b, int h, int sl) {
    const int tid = tidx(), w = __builtin_amdgcn_readfirstlane(tid >> 6), lane = tid & 63, g = w >> 2, c = w & 3, l15 = lane & 15, q = lane >> 4;
    const int tok0 = b * S;
    LAS float* vec = (LAS float*)(lds + SC_VEC);
    f32x4 Cacc[8];
#pragma unroll
    for (int i = 0; i < 8; ++i) Cacc[i] = (f32x4){0.f, 0.f, 0.f, 0.f};
    float nreg = 0.f, mrun = 0.f;
    if (tid < 256) vec[V_NV + tid] = 0.f;
    u32x4 sQ[4], sK[4], sV;
    const int vd = tid >> 3, vch = tid & 7;
    const bf16_t* gQ = T.Q + (size_t)tok0 * 1024 + 256 * h;
    const bf16_t* gK = T.K + (size_t)tok0 * 1024 + 256 * h;
    const bf16_t* gV = T.VT + ((size_t)(b * 2048 + 512 * h + 64 * sl + vd)) * S + 8 * vch;
#define SC_LOAD(ci) do { _Pragma("unroll") for (int i = 0; i < 4; ++i) { const int e = tid + i * NTHR, row = e >> 5, ch = e & 31; \
        sQ[i] = *(const u32x4*)(gQ + (size_t)((ci) * 64 + row) * 1024 + 8 * ch); sK[i] = *(const u32x4*)(gK + (size_t)((ci) * 64 + row) * 1024 + 8 * ch); } \
        sV = *(const u32x4*)(gV + (ci) * 64); } while (0)
    SC_LOAD(0);
    for (int ci = 0; ci < S / 64; ++ci) {
#pragma unroll
        for (int i = 0; i < 4; ++i) { const int e = tid + i * NTHR, row = e >> 5, ch = e & 31; *(LAS u32x4*)(lds + SC_QS + row * SC_QSTR + 16 * ch) = sQ[i]; *(LAS u32x4*)(lds + SC_KS + row * SC_QSTR + 16 * ch) = sK[i]; }
        *(LAS u32x2*)(lds + SC_VS + vd * SC_VSTR + 16 * vch) = (u32x2){sV.x, sV.y}; *(LAS u32x2*)(lds + SC_VS + vd * SC_VSTR + 16 * vch + 8) = (u32x2){sV.z, sV.w};
        if (w == 0) {
            const size_t gi = (size_t)(tok0 + ci * 64 + lane) * 4 + h;
            const float lfv = T.LF[gi], igv = T.IG[gi];
            const float bb = scan_add(lfv, lane), cc = igv - bb, pm = scan_max(cc, lane);
            const float mt = fmaxf(bb + mrun, bb + pm);
            const float blast = __shfl(bb, 63), cmax = __shfl(pm, 63);
            const float mnew = fmaxf(blast + mrun, blast + cmax);
            vec[V_A2 + lane] = (bb - mt) * LOG2E; vec[V_C2 + lane] = cc * LOG2E; vec[V_WI + lane] = __expf(bb + mrun - mt); vec[V_EM + lane] = __expf(-mt);
            vec[V_WS + lane] = __expf(blast + cc - mnew);
            if (lane == 0) vec[V_MISC] = __expf(blast + mrun - mnew);
            mrun = mnew;
        }
        __syncthreads();
        if (ci + 1 < S / 64) SC_LOAD(ci + 1);
        {
            const int sb = w >> 1;
#pragma unroll
            for (int tt = 0; tt < 2; ++tt) {
                const int tb = 2 * (w & 1) + tt;
                if (sb <= tb) {
                    f32x4 a4 = (f32x4){0.f, 0.f, 0.f, 0.f};
#pragma unroll
                    for (int ks = 0; ks < 8; ++ks) {
                        const bf16x8 ka = *(const LAS bf16x8*)(lds + SC_KS + (16 * sb + l15) * SC_QSTR + 64 * ks + 16 * q);
                        const bf16x8 qb2 = *(const LAS bf16x8*)(lds + SC_QS + (16 * tb + l15) * SC_QSTR + 64 * ks + 16 * q);
                        a4 = MFMA16(ka, qb2, a4);
                    }
                    const int t = 16 * tb + l15, s0 = 16 * sb + 4 * q; const float a2 = vec[V_A2 + t]; const f32x4 c2 = *(const LAS f32x4*)(vec + V_C2 + s0);
                    float rsum = 0.f;
#pragma unroll
                    for (int r2 = 0; r2 < 4; ++r2) { const float wgt = (s0 + r2 <= t) ? ex2(a2 + c2[r2]) : 0.f; a4[r2] *= wgt; rsum += a4[r2]; }
                    u32x2 pw; pw.x = pk2(a4[0], a4[1]); pw.y = pk2(a4[2], a4[3]);
                    *(LAS u32x2*)(lds + SC_SP + t * SC_VSTR + s0 * 2) = pw;
                    rsum = red_fq(rsum); if (q == 0) vec[V_RS + 64 * sb + t] = rsum;
                } else {
                    const int t = 16 * tb + l15, s0 = 16 * sb + 4 * q;
                    *(LAS u32x2*)(lds + SC_SP + t * SC_VSTR + s0 * 2) = (u32x2){0u, 0u};
                    if (q == 0) vec[V_RS + 64 * sb + t] = 0.f;
                }
            }
        }
        f32x4 qc[4];
        {
            bf16x8 cf[4];
#pragma unroll
            for (int ks = 0; ks < 4; ++ks) { u32x4 cw; cw.x = pk2(Cacc[2 * ks][0], Cacc[2 * ks][1]); cw.y = pk2(Cacc[2 * ks][2], Cacc[2 * ks][3]); cw.z = pk2(Cacc[2 * ks + 1][0], Cacc[2 * ks + 1][1]); cw.w = pk2(Cacc[2 * ks + 1][2], Cacc[2 * ks + 1][3]); cf[ks] = __builtin_bit_cast(bf16x8, cw); }
#pragma unroll
            for (int tb = 0; tb < 4; ++tb) {
                qc[tb] = (f32x4){0.f, 0.f, 0.f, 0.f};
#pragma unroll
                for (int ks = 0; ks < 4; ++ks) {
                    const LAS unsigned char* qp = lds + SC_QS + (16 * tb + l15) * SC_QSTR + (128 * g + 32 * ks + 4 * q) * 2;
                    const bf16x8 qa = cat4(*(const LAS s16x4*)qp, *(const LAS s16x4*)(qp + 32));
                    qc[tb] = MFMA16(qa, cf[ks], qc[tb]);
                }
            }
            LAS f32x4* qx = (LAS f32x4*)(lds + SC_QCX) + (w * 2) * 64 + lane;
            qx[0] = g ? qc[0] : qc[2]; qx[64] = g ? qc[1] : qc[3];
        }
        {
            const int t = tid >> 3, part = tid & 7; float a = 0.f;
#pragma unroll
            for (int i = 0; i < 4; ++i) { f32x4 x0, x1; unpk8(*(const LAS u32x4*)(lds + SC_QS + t * SC_QSTR + 64 * part + 16 * i), x0, x1);
                const f32x4 n0 = *(const LAS f32x4*)(vec + V_NV + 32 * part + 8 * i), n1 = *(const LAS f32x4*)(vec + V_NV + 32 * part + 8 * i + 4);
                a += (x0[0] * n0[0] + x0[1] * n0[1]) + (x0[2] * n0[2] + x0[3] * n0[3]) + (x1[0] * n1[0] + x1[1] * n1[1]) + (x1[2] * n1[2] + x1[3] * n1[3]); }
            a += __shfl_xor(a, 1); a += __shfl_xor(a, 2); a += __shfl_xor(a, 4);
            if (part == 0) vec[V_QN + t] = a;
        }
        __syncthreads();
        bf16x8 vf[2];
#pragma unroll
        for (int ks = 0; ks < 2; ++ks) { const LAS unsigned char* vp = lds + SC_VS + (16 * c + l15) * SC_VSTR + 64 * ks + 16 * q; vf[ks] = cat4(*(const LAS s16x4*)vp, *(const LAS s16x4*)(vp + 8)); }
        {
            const LAS f32x4* px = (const LAS f32x4*)(lds + SC_QCX) + ((w ^ 4) * 2) * 64 + lane;
#pragma unroll
            for (int tt = 0; tt < 2; ++tt) {
                const int tb = 2 * g + tt;
                f32x4 sv = (f32x4){0.f, 0.f, 0.f, 0.f};
#pragma unroll
                for (int ks = 0; ks < 2; ++ks) { const LAS unsigned char* sp = lds + SC_SP + (16 * tb + l15) * SC_VSTR + 64 * ks + 16 * q; const bf16x8 sa = cat4(*(const LAS s16x4*)sp, *(const LAS s16x4*)(sp + 8)); sv = MFMA16(sa, vf[ks], sv); }
                const f32x4 qct = (g ? qc[2 + tt] : qc[tt]) + px[64 * tt];
                const int t0 = 16 * tb + 4 * q;
                const f32x4 wi = *(const LAS f32x4*)(vec + V_WI + t0), em = *(const LAS f32x4*)(vec + V_EM + t0), qn = *(const LAS f32x4*)(vec + V_QN + t0),
                    rs = (*(const LAS f32x4*)(vec + V_RS + t0) + *(const LAS f32x4*)(vec + V_RS + 64 + t0)) + (*(const LAS f32x4*)(vec + V_RS + 128 + t0) + *(const LAS f32x4*)(vec + V_RS + 192 + t0));
#pragma unroll
                for (int r2 = 0; r2 < 4; ++r2) {
                    const float num = wi[r2] * qct[r2] + sv[r2], den = wi[r2] * qn[r2] + rs[r2];
                    const float hv = num / fmaxf(fabsf(den), em[r2]);
                    bf16_t* op = T.OG + (size_t)(tok0 + ci * 64 + t0 + r2) * 2048 + 512 * h + 64 * sl + 16 * c + l15;
                    *op = (bf16_t)(pk2(hv * bf1(*op), 0.f) & 0xffff);
                }
            }
        }
        {
            const float decay = vec[V_MISC];
            bf16x8 vw[2];
#pragma unroll
            for (int ks = 0; ks < 2; ++ks) {
                const f32x4 w0 = *(const LAS f32x4*)(vec + V_WS + 32 * ks + 8 * q), w1 = *(const LAS f32x4*)(vec + V_WS + 32 * ks + 8 * q + 4);
                f32x4 x0, x1; unpk8(__builtin_bit_cast(u32x4, vf[ks]), x0, x1); vw[ks] = __builtin_bit_cast(bf16x8, pk8(x0 * w0, x1 * w1));
            }
#pragma unroll
            for (int i = 0; i < 8; ++i) {
                Cacc[i] *= decay;
#pragma unroll
                for (int ks = 0; ks < 2; ++ks) {
                    LAS unsigned char* kp = lds + SC_KS + (32 * ks + 8 * q + (l15 >> 2)) * SC_QSTR + (128 * g + 16 * i + 4 * (lane & 3)) * 2;
                    const s16x4 lo = __builtin_amdgcn_ds_read_tr16_b64_v4i16((LAS s16x4*)kp), hi = __builtin_amdgcn_ds_read_tr16_b64_v4i16((LAS s16x4*)(kp + 4 * SC_QSTR));
                    Cacc[i] = MFMA16(cat4(lo, hi), vw[ks], Cacc[i]);
                }
            }
            if (tid < 256) {
                float a = 0.f;
#pragma unroll 8
                for (int s = 0; s < 64; ++s) a += vec[V_WS + s] * bf1(*(const LAS bf16_t*)(lds + SC_KS + s * SC_QSTR + 2 * tid));
                nreg = decay * nreg + a; vec[V_NV + tid] = nreg;
            }
        }
        __syncthreads();
    }
#undef SC_LOAD
}
DI void scan_phase(LAS unsigned char* lds, const ScanT& T, int cu) {
    const int xcd = cu & 7, idx = cu >> 3, bh = xcd * 4 + (idx >> 3), sl = idx & 7;
    scan_item(lds, T, bh >> 2, bh & 3, sl);
}

DI void final_phase(float* x, const u64* ssq, const float* g, int gw, int NGW, int lane) {
    for (int m = gw; m < M; m += NGW) {
        const float rs = ssq_rstd(ssq + m, 1.f / 1024.f);
        f32x4* xr = (f32x4*)(x + (size_t)m * D) + lane;
#pragma unroll
        for (int j = 0; j < 4; ++j) { const f32x4 gv = ((const f32x4*)g)[lane + 64 * j]; xr[64 * j] = xr[64 * j] * rs * gv; }
    }
}
constexpr int LDS_BYTES = 147456, MISC_OFF = 131072;
constexpr int PH_PER_LAYER = 6, PH_FINAL = 1 + 4 * PH_PER_LAYER, PH_REFRESH = 100;
#ifndef PHM
#define PHM 0xFFFF
#endif
#define PH_ON(b) ((PHM >> (b)) & 1)
typedef const __attribute__((address_space(4))) Args* KArgs;
DI KArgs kargs() { KArgs p = (KArgs)__builtin_amdgcn_kernarg_segment_ptr(); asm volatile("" : "+s"(p)); return p; }

__global__ void __launch_bounds__(NTHR, 2) fwd(Args a_) {
    extern __shared__ __attribute__((aligned(16))) unsigned char lds_[];
    LAS unsigned char* lds = (LAS unsigned char*)lds_;
    const int cu = blockIdx.x, G = gridDim.x;
#define TID_DEFS const int tid = tidx(), w = __builtin_amdgcn_readfirstlane(tid >> 6), lane = tid & 63; (void)w; (void)lane
#define GW (cu * 8 + w)
#define NGW (G * 8)
#define GT (cu * NTHR + tid)
#define NGT (G * NTHR)
    const int lo = a_.ph_lo, hi = a_.ph_hi;
    volatile LAS unsigned* misc = (volatile LAS unsigned*)(lds + MISC_OFF);
    { TID_DEFS; if (tid < 32) misc[tid] = 0u; }
    __syncthreads();
    const bool multi = (hi - lo) > 1;
    XcdBarrier bar; bar.bar = nullptr; bar.x = 0; bar.st = misc + 8;
    if (multi) bar = xcd_barrier_post((unsigned*)(kargs()->ws + WS_CTL), misc + 8);
#define IN(k) (lo <= (k) && (k) < hi)
#define SEAM(k) do { if (multi && (k) + 1 < hi) { XcdBarrier b2 = bar; b2.bar = (unsigned*)(kargs()->ws + WS_CTL); xcd_barrier(b2); } } while (0)

    if (lo >= PH_REFRESH) {
        TID_DEFS; KArgs A = kargs(); const int i = lo - PH_REFRESH; rows_to_bf16_ssq(A->out, (bf16_t*)(A->ws + WS_XBA), ssq_arr(A->ws, SSQ_X + i), GW, NGW, lane); return;
    }
    if (IN(0)) {
        TID_DEFS; KArgs A = kargs(); unsigned char* ws = A->ws;
        rows_to_bf16_ssq(A->in[I_X], (bf16_t*)(ws + WS_XBA), ssq_arr(ws, SSQ_X), GW, NGW, lane);
        rope_tables((const int*)A->in[I_POS], (float*)(ws + WS_CS), (float*)(ws + WS_SN), GT, NGT);
        SEAM(0);
    }
#pragma unroll 1
    for (int i = 0; i < 4; ++i) {
        const int kind = i % 3, j = i / 3, base = 1 + PH_PER_LAYER * i;
        if (hi <= base || lo >= base + PH_PER_LAYER) continue;
        if (IN(base + 0) && PH_ON(0)) {
            TID_DEFS; KArgs A = kargs(); unsigned char* ws = A->ws;
            LAS float* scr = (LAS float*)lds;
            const float* normg = A->in[I_NORMG] + (size_t)i * D;
            bf16_t* wmix = (bf16_t*)(ws + WS_WMIX);
            prep_run1(PrepTask{A->in[I_PLE_GATE] + (size_t)i * D * D, D, nullptr, D, D, PM_ID, (bf16_t*)(ws + WS_WPLE)}, scr, cu, G);
            prep_run1(PrepTask{A->in[I_PLE_PROJ] + (size_t)i * 256 * D, D, nullptr, 256, D, PM_ID, (bf16_t*)(ws + WS_WPLE + 2 * MiB)}, scr, cu, G);
            if (kind == 0) {
                prep_run1(PrepTask{A->in[I_MLA_WIN] + (size_t)j * D * 1696, 1696, normg, D, 1792, PM_MLA_IN, wmix}, scr, cu, G);
                prep_run1(PrepTask{A->in[I_MLA_WQB] + (size_t)j * 384 * 1536, 1536, A->in[I_MLA_QN] + j * 384, 384, 1536, PM_MLA_QB, (bf16_t*)(ws + WS_WMIX + WM_QB)}, scr, cu, G);
                prep_run1(PrepTask{A->in[I_MLA_WKVB] + (size_t)j * 256 * 2048, 2048, A->in[I_MLA_KVN] + j * 256, 256, 2048, PM_MLA_KVB, (bf16_t*)(ws + WS_WMIX + WM_KVB)}, scr, cu, G);
                prep_run1(PrepTask{A->in[I_MLA_WOUT] + (size_t)j * D * D, D, nullptr, D, D, PM_ID, (bf16_t*)(ws + WS_WMIX + WM_OUT_MLA)}, scr, cu, G);
            } else if (kind == 1) {
                prep_run1(PrepTask{A->in[I_CONV_WIN] + (size_t)j * D * 4096, 4096, normg, D, 4096, PM_CONV_IN, wmix}, scr, cu, G);
                prep_run1(PrepTask{A->in[I_CONV_WOUT] + (size_t)j * D * D, D, nullptr, D, D, PM_ID, (bf16_t*)(ws + WS_WMIX + WM_OUT_CONV)}, scr, cu, G);
            } else {
                prep_run1(PrepTask{A->in[I_L_WIN] + (size_t)j * D * 8200, 8200, normg, D, 8192, PM_LSTM_IN, wmix}, scr, cu, G);
                prep_run1(PrepTask{A->in[I_L_WOUT] + (size_t)j * 2048 * D, D, nullptr, 2048, D, PM_ID, (bf16_t*)(ws + WS_WMIX + WM_OUT_LSTM)}, scr, cu, G);
                gw8_prep(A->in[I_L_WIN] + (size_t)j * D * 8200, normg, (float*)(ws + WS_GW8), GT, NGT);
            }
            if (kind != 2) p_to_bf16(A->in[I_P] + (size_t)i * M * 256, (bf16_t*)(ws + WS_BIG + A_PB), GT, NGT);
        }
        if (IN(base + 0)) SEAM(base + 0);
        if (IN(base + 1)) {
            if (kind == 0 && PH_ON(1)) {
                unsigned char* ws = kargs()->ws;
                pg8::Gemm g{(bf16_t*)(ws + WS_XBA), (bf16_t*)(ws + WS_WMIX), M, 1792, opaque(D)}; pg8::StaticOrder So; So.init(M, 1792, G, cu);
                EpiA1 E{ws, i, j};
                pg8::gemm_phase<EpiA1, pg8::StaticOrder, true, true>(lds, g, So, E);
            } else if (kind == 1 && PH_ON(2)) {
                unsigned char* ws = kargs()->ws;
                pg8::Gemm g{(bf16_t*)(ws + WS_XBA), (bf16_t*)(ws + WS_WMIX), M, 4096, opaque(D)}; pg8::StaticOrder So; So.init(M, 4096, G, cu);
                EpiC1 E{ws, i};
                pg8::gemm_phase<EpiC1, pg8::StaticOrder, true, true>(lds, g, So, E);
            } else if (kind == 2 && PH_ON(3)) {
                { TID_DEFS; KArgs A = kargs(); unsigned char* ws = A->ws;
                  gates_phase((bf16_t*)(ws + WS_XBA), ssq_arr(ws, SSQ_X + i), (const float*)(ws + WS_GW8), A->in[I_L_BG] + j * 8, (float*)(ws + WS_IG), (float*)(ws + WS_LF), GW, NGW, lane); }
                unsigned char* ws = kargs()->ws;
                pg8::Gemm g{(bf16_t*)(ws + WS_XBA), (bf16_t*)(ws + WS_WMIX), M, 8192, opaque(D)}; pg8::StaticOrder So; So.init(M, 8192, G, cu);
                EpiL1 E{ws, i};
                pg8::gemm_phase<EpiL1, pg8::StaticOrder, true, true>(lds, g, So, E);
            }
            SEAM(base + 1);
        }
        if (IN(base + 2) && kind != 2) {
            if (kind == 0 && PH_ON(4)) {
                { unsigned char* ws = kargs()->ws;
                  pg8::Gemm g{(bf16_t*)(ws + WS_BIG + A_CQ), (bf16_t*)(ws + WS_WMIX + WM_QB), M, 1536, opaque(384)}; pg8::StaticOrder So; So.init(M, 1536, G, cu);
                  EpiQ E{ws, j};
                  pg8::gemm_phase<EpiQ, pg8::StaticOrder, true, true>(lds, g, So, E); }
                { unsigned char* ws = kargs()->ws;
                  pg8::Gemm g{(bf16_t*)(ws + WS_BIG + A_CKV), (bf16_t*)(ws + WS_WMIX + WM_KVB), M, 2048, opaque(256)}; pg8::StaticOrder So; So.init(M, 2048, G, G - 1 - cu);
                  EpiKV E{ws, j};
                  pg8::gemm_phase<EpiKV, pg8::StaticOrder, true, true>(lds, g, So, E); }
            } else if (kind == 1 && PH_ON(5)) {
                TID_DEFS; KArgs A = kargs(); unsigned char* ws = A->ws;
                conv_phase((const bf16_t*)(ws + WS_BIG + C_CH), (bf16_t*)(ws + WS_BIG + C_BZ), A->in[I_CONV_W] + (size_t)j * 3 * 1024, GT, NGT);
            }
            SEAM(base + 2);
        }
        if (IN(base + 3) && kind != 1) {
            if (kind == 0 && PH_ON(6)) {
                unsigned char* big = kargs()->ws + WS_BIG;
                AttnT T{(bf16_t*)(big + A_Q), (bf16_t*)(big + A_KN), (bf16_t*)(big + A_KR), (bf16_t*)(big + A_VT), (bf16_t*)(big + A_SZ)};
                attn_phase(lds, T, cu);
            } else if (kind == 2 && PH_ON(7)) {
                { unsigned char* ws = kargs()->ws; unsigned char* big = ws + WS_BIG;
                  ScanT T{(bf16_t*)(big + L_Q), (bf16_t*)(big + L_K), (bf16_t*)(big + L_VT), (bf16_t*)(big + L_OG), (float*)(ws + WS_IG), (float*)(ws + WS_LF)};
                  scan_phase(lds, T, cu); }
                TID_DEFS; KArgs A = kargs();
                p_to_bf16(A->in[I_P] + (size_t)i * M * 256, (bf16_t*)(A->ws + WS_XBA), GT, NGT);
            }
            SEAM(base + 3);
        }
        if (IN(base + 4)) {
            const size_t xbb_off = kind == 0 ? A_XBB : kind == 1 ? C_XBB : L_XBB, pp_off = kind == 0 ? A_PP : kind == 1 ? C_PP : L_PP;
            if (PH_ON(8)) { KArgs A = kargs(); unsigned char* ws = A->ws;
              const size_t oin = kind == 0 ? A_SZ : kind == 1 ? C_BZ : L_OG, wout = kind == 2 ? WM_OUT_LSTM : WM_OUT_MLA;
              pg8::Gemm g{(bf16_t*)(ws + WS_BIG + oin), (bf16_t*)(ws + WS_WMIX + wout), M, D, opaque(kind == 2 ? 2048 : 1024)}; pg8::StaticOrder So; So.init(M, D, G, cu);
              EpiOut E{ws, i == 0 ? A->in[I_X] : A->out, A->out, xbb_off, i};
              pg8::gemm_phase<EpiOut, pg8::StaticOrder, true, true>(lds, g, So, E); }
            if (PH_ON(9)) { unsigned char* ws = kargs()->ws;
              pg8::Gemm g{kind == 2 ? (bf16_t*)(ws + WS_XBA) : (bf16_t*)(ws + WS_BIG + A_PB), (bf16_t*)(ws + WS_WPLE + 2 * MiB), M, D, opaque(256)}; pg8::StaticOrder So; So.init(M, D, G, cu);
              EpiPP E{ws, pp_off};
              pg8::gemm_phase<EpiPP, pg8::StaticOrder, true, true>(lds, g, So, E); }
            SEAM(base + 4);
        }
        if (IN(base + 5)) {
            if (PH_ON(10)) { KArgs A = kargs(); unsigned char* ws = A->ws;
              const size_t xbb_off = kind == 0 ? A_XBB : kind == 1 ? C_XBB : L_XBB, pp_off = kind == 0 ? A_PP : kind == 1 ? C_PP : L_PP;
              pg8::Gemm g{(bf16_t*)(ws + WS_BIG + xbb_off), (bf16_t*)(ws + WS_WPLE), M, D, opaque(D)}; pg8::StaticOrder So; So.init(M, D, G, cu);
              EpiPle E{ws, A->out, pp_off, i};
              pg8::gemm_phase<EpiPle, pg8::StaticOrder, true, true>(lds, g, So, E); }
            SEAM(base + 5);
        }
    }
    if (IN(PH_FINAL)) { TID_DEFS; KArgs A = kargs(); final_phase(A->out, ssq_arr(A->ws, SSQ_X + 4), A->in[I_FNORM], GW, NGW, lane); }
#undef IN
#undef SEAM
}
}
namespace nv {
constexpr int NB = 8, S = 2048, D = 1024;
constexpr int MLA_IN = 1696, QL = 384, KVL = 256, NH = 16;
constexpr int LIN = 8200;
constexpr float EPS = 1e-6f;

__device__ __forceinline__ float sigmoidf_(float x) { return 1.f / (1.f + expf(-x)); }
__device__ __forceinline__ float siluf_(float x) { return x * sigmoidf_(x); }
__device__ __forceinline__ float logsigmoidf_(float x) { return fminf(x, 0.f) - log1pf(expf(-fabsf(x))); }

__global__ void rmsnorm_k(const float* in, int ldi, int c0, int n, const float* g, float* out, int ldo) {
    const int r = blockIdx.x;
    const float* ip = in + (size_t)r * ldi + c0;
    float v[4]; float ss = 0.f;
#pragma unroll
    for (int i = 0; i < 4; ++i) { int c = threadIdx.x + i * 256; v[i] = c < n ? ip[c] : 0.f; ss += v[i] * v[i]; }
    __shared__ float red[256];
    red[threadIdx.x] = ss; __syncthreads();
    for (int s = 128; s > 0; s >>= 1) { if (threadIdx.x < s) red[threadIdx.x] += red[threadIdx.x + s]; __syncthreads(); }
    const float rstd = rsqrtf(red[0] / (float)n + EPS);
#pragma unroll
    for (int i = 0; i < 4; ++i) { int c = threadIdx.x + i * 256; if (c < n) out[(size_t)r * ldo + c] = v[i] * rstd * (g ? g[c] : 1.f); }
}

__global__ void ngemm(const float* A, int lda, const float* B, int ldb, int tb, float* C, int ldc, int M, int N, int K) {
    __shared__ float As[16][65], Bs[16][65];
    const int tx = threadIdx.x & 15, ty = threadIdx.x >> 4;
    const int row0 = blockIdx.y * 64, col0 = blockIdx.x * 64;
    float acc[4][4];
#pragma unroll
    for (int i = 0; i < 4; ++i)
#pragma unroll
        for (int j = 0; j < 4; ++j) acc[i][j] = 0.f;
    for (int k0 = 0; k0 < K; k0 += 16) {
#pragma unroll
        for (int i = 0; i < 4; ++i) {
            int e = threadIdx.x + i * 256;
            { int kk = e & 15, r = e >> 4; int gr = row0 + r, gk = k0 + kk; As[kk][r] = (gr < M && gk < K) ? A[(size_t)gr * lda + gk] : 0.f; }
            if (tb) { int kk = e & 15, c = e >> 4; int gc = col0 + c, gk = k0 + kk; Bs[kk][c] = (gc < N && gk < K) ? B[(size_t)gc * ldb + gk] : 0.f; }
            else    { int c = e & 63, kk = e >> 6; int gc = col0 + c, gk = k0 + kk; Bs[kk][c] = (gc < N && gk < K) ? B[(size_t)gk * ldb + gc] : 0.f; }
        }
        __syncthreads();
#pragma unroll
        for (int kk = 0; kk < 16; ++kk) {
            float a[4], b[4];
#pragma unroll
            for (int i = 0; i < 4; ++i) { a[i] = As[kk][ty * 4 + i]; b[i] = Bs[kk][tx * 4 + i]; }
#pragma unroll
            for (int i = 0; i < 4; ++i)
#pragma unroll
                for (int j = 0; j < 4; ++j) acc[i][j] += a[i] * b[j];
        }
        __syncthreads();
    }
#pragma unroll
    for (int i = 0; i < 4; ++i)
#pragma unroll
        for (int j = 0; j < 4; ++j) { int r = row0 + ty * 4 + i, c = col0 + tx * 4 + j; if (r < M && c < N) C[(size_t)r * ldc + c] = acc[i][j]; }
}

__global__ void rope_table_k(const int* pos, float* cs, float* sn) {
    int i = blockIdx.x * blockDim.x + threadIdx.x; if (i >= S * 16) return;
    int t = i >> 4, j = i & 15;
    float inv = powf(10000.0f, -(float)(2 * j) / 32.0f);
    float ang = (float)pos[t] * inv;
    double rev = (double)ang * 0.15915494309189533577;
    rev -= rint(rev);
    float fr = (float)rev;
    cs[i] = __builtin_amdgcn_cosf(fr); sn[i] = __builtin_amdgcn_sinf(fr);
}
__global__ void rope_apply_k(float* buf, int ld, int base, int hstride, int nheads, const float* cs, const float* sn) {
    int i = blockIdx.x * blockDim.x + threadIdx.x; if (i >= S * nheads * 16) return;
    int j = i & 15, h = (i >> 4) % nheads, t = (i >> 4) / nheads;
    float* p = buf + (size_t)t * ld + base + h * hstride;
    float x1 = p[j], x2 = p[16 + j], c = cs[t * 16 + j], s = sn[t * 16 + j];
    p[j] = x1 * c - x2 * s; p[16 + j] = x1 * s + x2 * c;
}

__global__ __launch_bounds__(64) void attn_naive_k(const float* q, const float* kv, const float* kr, int ldkr, float* o) {
    const int t = blockIdx.x * 64 + threadIdx.x, h = blockIdx.y;
    const int nk = (t / 64 + 1) * 64;
    float qr[96];
#pragma unroll
    for (int d = 0; d < 96; ++d) qr[d] = q[(size_t)t * 1536 + h * 96 + d];
    const float scale = 0.10206207261596577f;
    float mx = -INFINITY;
    for (int s = 0; s < nk; ++s) {
        const float* kp = kv + (size_t)s * 2048 + h * 128; const float* rp = kr + (size_t)s * ldkr;
        float a = 0.f;
#pragma unroll
        for (int d = 0; d < 64; ++d) a += qr[d] * kp[d];
#pragma unroll
        for (int d = 0; d < 32; ++d) a += qr[64 + d] * rp[d];
        mx = fmaxf(mx, a * scale);
    }
    float acc[64]; float l = 0.f;
#pragma unroll
    for (int d = 0; d < 64; ++d) acc[d] = 0.f;
    for (int s = 0; s < nk; ++s) {
        const float* kp = kv + (size_t)s * 2048 + h * 128; const float* rp = kr + (size_t)s * ldkr;
        float a = 0.f;
#pragma unroll
        for (int d = 0; d < 64; ++d) a += qr[d] * kp[d];
#pragma unroll
        for (int d = 0; d < 32; ++d) a += qr[64 + d] * rp[d];
        float pz = expf(a * scale - mx); l += pz;
#pragma unroll
        for (int d = 0; d < 64; ++d) acc[d] += pz * kp[64 + d];
    }
    const float il = 1.f / l;
#pragma unroll
    for (int d = 0; d < 64; ++d) o[(size_t)t * 1024 + h * 64 + d] = acc[d] * il;
}

__global__ void mla_gate_k(const float* o, const float* U, float* g) {
    size_t i = (size_t)blockIdx.x * blockDim.x + threadIdx.x; if (i >= (size_t)S * 1024) return;
    int t = i >> 10, c = i & 1023;
    g[i] = o[i] * siluf_(U[(size_t)t * MLA_IN + 672 + c]);
}
__global__ void conv_gate_k(const float* U, const float* cw, float* g) {
    size_t i = (size_t)blockIdx.x * blockDim.x + threadIdx.x; if (i >= (size_t)S * 1024) return;
    int t = i >> 10, c = i & 1023;
    float y = 0.f;
#pragma unroll
    for (int k = 0; k < 3; ++k) { int tt = t - 2 + k; if (tt >= 0) { const float* up = U + (size_t)tt * 4096; y += cw[k * 1024 + c] * up[1024 + c] * up[2048 + c]; } }
    const float* up = U + (size_t)t * 4096;
    g[i] = up[c] * y * siluf_(up[3072 + c]);
}
__global__ void mlstm_gates_k(const float* U, const float* bg, float* ig, float* bc) {
    int h = threadIdx.x; float run = 0.f;
    for (int t = 0; t < S; ++t) {
        const float* up = U + (size_t)t * LIN + 8192;
        ig[t * 4 + h] = up[h] + bg[h];
        run += logsigmoidf_(up[4 + h] + bg[4 + h]);
        bc[t * 4 + h] = run;
    }
}
__global__ void mlstm_score_k(float* sc, const float* ig, const float* bc) {
    size_t i = (size_t)blockIdx.x * blockDim.x + threadIdx.x; if (i >= (size_t)4 * S * S) return;
    int s = i % S, t = (i / S) % S, h = i / ((size_t)S * S);
    float v = 0.f;
    if (s <= t) v = sc[i] * 0.0625f * expf(bc[t * 4 + h] - bc[s * 4 + h] + ig[s * 4 + h]);
    sc[i] = v;
}
__global__ void rowsum_k(const float* sc, float* den) {
    const int t = blockIdx.x, h = blockIdx.y; const float* p = sc + ((size_t)h * S + t) * S;
    float a = 0.f; for (int s = threadIdx.x; s <= t; s += 256) a += p[s];
    __shared__ float red[256]; red[threadIdx.x] = a; __syncthreads();
    for (int k = 128; k > 0; k >>= 1) { if (threadIdx.x < k) red[threadIdx.x] += red[threadIdx.x + k]; __syncthreads(); }
    if (threadIdx.x == 0) den[h * S + t] = red[0];
}
__global__ void mlstm_gate_k(const float* num, const float* den, const float* U, float* g) {
    size_t i = (size_t)blockIdx.x * blockDim.x + threadIdx.x; if (i >= (size_t)S * 2048) return;
    int t = i >> 11, c = i & 2047, h = c >> 9;
    float hs = num[i] / fmaxf(fabsf(den[h * S + t]), 1.f);
    const float* up = U + (size_t)t * LIN;
    g[i] = sigmoidf_(up[4096 + c]) * hs * siluf_(up[6144 + c]);
}
__global__ void add_k(float* x, const float* y, size_t n) { size_t i = (size_t)blockIdx.x * blockDim.x + threadIdx.x; if (i < n) x[i] += y[i]; }
__global__ void copy_k(float* x, const float* y, size_t n) { size_t i = (size_t)blockIdx.x * blockDim.x + threadIdx.x; if (i < n) x[i] = y[i]; }
__global__ void ple_k(float* x, const float* gate, const float* pp, size_t n) { size_t i = (size_t)blockIdx.x * blockDim.x + threadIdx.x; if (i < n) x[i] += sigmoidf_(gate[i]) * pp[i]; }

static void gemm(hipStream_t st, const float* A, int lda, const float* B, int ldb, int tb, float* C, int ldc, int M, int N, int K) {
    dim3 g((N + 63) / 64, (M + 63) / 64); ngemm<<<g, 256, 0, st>>>(A, lda, B, ldb, tb, C, ldc, M, N, K);
}

struct In {
    const float *x, *p; const int* pos; const float *norm_g, *mla_w_in, *mla_q_norm, *mla_w_q_b, *mla_kv_norm, *mla_w_kv_b, *mla_w_out,
        *conv_w_in, *conv_w, *conv_w_out, *mlstm_w_in, *mlstm_b_gates, *mlstm_w_out, *ple_proj, *ple_gate, *final_norm;
};


struct Tmp { float *H, *U, *T1, *T2, *T3, *Y, *SC, *IG, *BC, *DEN, *CS, *SN; };
static Tmp carve(float* ws) {
    Tmp t; t.H = ws; t.U = t.H + (size_t)S * 1024; t.T1 = t.U + (size_t)S * 8200; t.T2 = t.T1 + (size_t)S * 2048; t.T3 = t.T2 + (size_t)S * 2048;
    t.Y = t.T3 + (size_t)S * 2048; t.SC = t.Y + (size_t)S * 1024; t.IG = t.SC + (size_t)4 * S * S; t.BC = t.IG + S * 4; t.DEN = t.BC + S * 4; t.CS = t.DEN + S * 4; t.SN = t.CS + S * 16; return t;
}
static void layer(const In& in, float* out, float* ws, hipStream_t st, int i, int first) {
    const Tmp t = carve(ws); float *H = t.H, *U = t.U, *T1 = t.T1, *T2 = t.T2, *T3 = t.T3, *Y = t.Y, *SC = t.SC, *IG = t.IG, *BC = t.BC, *DEN = t.DEN, *CS = t.CS, *SN = t.SN;
    const size_t nx = (size_t)S * D; const int EB = 256;
    for (int b = 0; b < NB; ++b) {
        float* x = out + (size_t)b * nx;
        if (first) copy_k<<<(nx + EB - 1) / EB, EB, 0, st>>>(x, in.x + (size_t)b * nx, nx);
        const int kind = i % 3, j = i / 3;
        rmsnorm_k<<<S, 256, 0, st>>>(x, D, 0, D, in.norm_g + i * D, H, D);
        if (kind == 0) {
            rope_table_k<<<(S * 16 + EB - 1) / EB, EB, 0, st>>>(in.pos + b * S, CS, SN);
            const float* w_in = in.mla_w_in + (size_t)j * D * MLA_IN;
            gemm(st, H, D, w_in, MLA_IN, 0, U, MLA_IN, S, MLA_IN, D);
            rmsnorm_k<<<S, 256, 0, st>>>(U, MLA_IN, 0, QL, in.mla_q_norm + j * QL, T3, QL);
            gemm(st, T3, QL, in.mla_w_q_b + (size_t)j * QL * 1536, 1536, 0, T1, 1536, S, 1536, QL);
            rmsnorm_k<<<S, 256, 0, st>>>(U, MLA_IN, QL, KVL, in.mla_kv_norm + j * KVL, T3, KVL);
            gemm(st, T3, KVL, in.mla_w_kv_b + (size_t)j * KVL * 2048, 2048, 0, T2, 2048, S, 2048, KVL);
            rope_apply_k<<<(S * NH * 16 + EB - 1) / EB, EB, 0, st>>>(T1, 1536, 64, 96, NH, CS, SN);
            rope_apply_k<<<(S * 16 + EB - 1) / EB, EB, 0, st>>>(U, MLA_IN, 640, 0, 1, CS, SN);
            attn_naive_k<<<dim3(S / 64, NH), 64, 0, st>>>(T1, T2, U + 640, MLA_IN, Y);
            mla_gate_k<<<(nx + EB - 1) / EB, EB, 0, st>>>(Y, U, T3);
            gemm(st, T3, 1024, in.mla_w_out + (size_t)j * 1024 * 1024, 1024, 0, Y, 1024, S, 1024, 1024);
        } else if (kind == 1) {
            gemm(st, H, D, in.conv_w_in + (size_t)j * D * 4096, 4096, 0, U, 4096, S, 4096, D);
            conv_gate_k<<<(nx + EB - 1) / EB, EB, 0, st>>>(U, in.conv_w + (size_t)j * 3 * 1024, T3);
            gemm(st, T3, 1024, in.conv_w_out + (size_t)j * 1024 * 1024, 1024, 0, Y, 1024, S, 1024, 1024);
        } else {
            gemm(st, H, D, in.mlstm_w_in + (size_t)j * D * LIN, LIN, 0, U, LIN, S, LIN, D);
            mlstm_gates_k<<<1, 4, 0, st>>>(U, in.mlstm_b_gates + j * 8, IG, BC);
            for (int h = 0; h < 4; ++h) gemm(st, U + h * 256, LIN, U + 1024 + h * 256, LIN, 1, SC + (size_t)h * S * S, S, S, S, 256);
            mlstm_score_k<<<((size_t)4 * S * S + EB - 1) / EB, EB, 0, st>>>(SC, IG, BC);
            rowsum_k<<<dim3(S, 4), 256, 0, st>>>(SC, DEN);
            for (int h = 0; h < 4; ++h) gemm(st, SC + (size_t)h * S * S, S, U + 2048 + h * 512, LIN, 0, T1 + h * 512, 2048, S, 512, S);
            mlstm_gate_k<<<((size_t)S * 2048 + EB - 1) / EB, EB, 0, st>>>(T1, DEN, U, T3);
            gemm(st, T3, 2048, in.mlstm_w_out + (size_t)j * 2048 * 1024, 1024, 0, Y, 1024, S, 1024, 2048);
        }
        add_k<<<(nx + EB - 1) / EB, EB, 0, st>>>(x, Y, nx);
        rmsnorm_k<<<S, 256, 0, st>>>(x, D, 0, D, nullptr, H, D);
        gemm(st, H, D, in.ple_gate + (size_t)i * D * D, D, 0, T1, D, S, D, D);
        gemm(st, in.p + ((size_t)i * NB + b) * S * 256, 256, in.ple_proj + (size_t)i * 256 * D, D, 0, T2, D, S, D, 256);
        ple_k<<<(nx + EB - 1) / EB, EB, 0, st>>>(x, T1, T2, nx);
    }
}
static void final_norm(const In& in, float* out, hipStream_t st) {
    for (int b = 0; b < NB; ++b) { float* x = out + (size_t)b * S * D; rmsnorm_k<<<S, 256, 0, st>>>(x, D, 0, D, in.final_norm, x, D); }
}
}

#ifndef FAST_LAYERS
#define FAST_LAYERS 15
#endif
#ifndef ONE_LAUNCH
#define ONE_LAUNCH 1
#endif

extern "C" void kernel_launch(void* const* d_in, const int* in_sizes, int n_in, void* d_out, int out_size, void* d_ws, size_t ws_size, hipStream_t stream) {
    static int grid = 0;
    if (grid == 0) {
        int dev = 0, cus = 0;
        if (n_in != 19 || ws_size < fk::WS_END || out_size != fk::M * fk::D) { fprintf(stderr, "kernel_launch: unexpected shapes (n_in %d, ws %zu, out %d)\n", n_in, ws_size, out_size); grid = -1; return; }
        if (hipGetDevice(&dev) != hipSuccess || hipDeviceGetAttribute(&cus, hipDeviceAttributeMultiprocessorCount, dev) != hipSuccess) { grid = -1; return; }
        if (hipFuncSetAttribute((const void*)fk::fwd, hipFuncAttributeMaxDynamicSharedMemorySize, fk::LDS_BYTES) != hipSuccess) { fprintf(stderr, "kernel_launch: hipFuncSetAttribute failed\n"); grid = -1; return; }
        int per_cu = 0;
        if (hipOccupancyMaxActiveBlocksPerMultiprocessor(&per_cu, (const void*)fk::fwd, fk::NTHR, fk::LDS_BYTES) != hipSuccess || per_cu < 1) { fprintf(stderr, "kernel_launch: occupancy query says %d\n", per_cu); }
        (void)hipGetLastError();
        grid = cus;
        if (grid != 256) fprintf(stderr, "kernel_launch: %d CUs (built for 256)\n", grid);
    }
    if (grid < 0) return;
    (void)hipMemsetAsync(d_ws, 0, fk::ZERO_BYTES, stream);
    fk::Args a{};
    for (int i = 0; i < 19; ++i) a.in[i] = (const float*)d_in[i];
    a.out = (float*)d_out; a.ws = (unsigned char*)d_ws;
#define LAUNCH(lo_, hi_) do { a.ph_lo = (lo_); a.ph_hi = (hi_); hipLaunchKernelGGL(fk::fwd, dim3(grid), dim3(fk::NTHR), fk::LDS_BYTES, stream, a); } while (0)
#if ONE_LAUNCH && (FAST_LAYERS == 15)
    LAUNCH(0, fk::PH_FINAL + 1);
#else
    nv::In in;
    in.x = (const float*)d_in[0]; in.p = (const float*)d_in[1]; in.pos = (const int*)d_in[2]; in.norm_g = (const float*)d_in[3];
    in.mla_w_in = (const float*)d_in[4]; in.mla_q_norm = (const float*)d_in[5]; in.mla_w_q_b = (const float*)d_in[6];
    in.mla_kv_norm = (const float*)d_in[7]; in.mla_w_kv_b = (const float*)d_in[8]; in.mla_w_out = (const float*)d_in[9];
    in.conv_w_in = (const float*)d_in[10]; in.conv_w = (const float*)d_in[11]; in.conv_w_out = (const float*)d_in[12];
    in.mlstm_w_in = (const float*)d_in[13]; in.mlstm_b_gates = (const float*)d_in[14]; in.mlstm_w_out = (const float*)d_in[15];
    in.ple_proj = (const float*)d_in[16]; in.ple_gate = (const float*)d_in[17]; in.final_norm = (const float*)d_in[18];
    float* nws = (float*)((char*)d_ws + 2 * fk::MiB);
    LAUNCH(0, 1);
    for (int i = 0; i < 4; ++i) {
        if ((FAST_LAYERS >> i) & 1) {
            if (i > 0 && !((FAST_LAYERS >> (i - 1)) & 1)) LAUNCH(fk::PH_REFRESH + i, fk::PH_REFRESH + i + 1);
            for (int s = 0; s < fk::PH_PER_LAYER; ++s) LAUNCH(1 + fk::PH_PER_LAYER * i + s, 1 + fk::PH_PER_LAYER * i + s + 1);
        } else {
            nv::layer(in, (float*)d_out, nws, stream, i, i == 0);
        }
    }
    if ((FAST_LAYERS >> 3) & 1) LAUNCH(fk::PH_FINAL, fk::PH_FINAL + 1);
    else nv::final_norm(in, (float*)d_out, stream);
#endif
#undef LAUNCH
}
```

```cpp
#include <hip/hip_runtime.h>
#include <cstdio>
#include <cstdint>
#include <math.h>
#define LAS __attribute__((address_space(3)))
#define GAS __attribute__((address_space(1)))
#define FAST_LAYERS 15
#define ONE_LAUNCH 1
namespace pg8 {
#define PG8_LAS __attribute__((address_space(3)))
typedef unsigned short bf16_t;
typedef short bf16x8 __attribute__((ext_vector_type(8)));
typedef float f32x4 __attribute__((ext_vector_type(4)));
typedef unsigned u32x4 __attribute__((ext_vector_type(4)));
constexpr int BM = 256, BK = 64, HALF = 128, HTB = HALF * BK * 2  , STAGE_BYTES = 8 * HTB, NXCD = 8, WGM = 8;

__host__ __device__ __forceinline__ int lds_byte(int r, int c) { const int st = (r >> 4) * 2 + (c >> 5), rr = r & 15, cc = c & 31, ob = rr * 64 + cc * 2; return st * 1024 + (ob ^ (((ob >> 9) & 1) << 5)); }
__host__ __device__ __forceinline__ void stage_rc(int b, int& R, int& C) { const int st = b / 1024, sb = b % 1024, swz = sb ^ (((sb >> 9) & 1) << 5); R = (st >> 1) * 16 + swz / 64; C = (st & 1) * 32 + (swz % 64) / 2; }
__host__ __device__ __forceinline__ int perm32(int rho) { const int n = rho >> 4, i = rho & 15; return 8 * (i >> 2) + 4 * n + (i & 3); }

struct Unit { int pm, pn; };
struct Gemm { const bf16_t* A; const bf16_t* Bt; int M, N, K; };

struct StaticOrder {
    int nM, nN, nwg, G, c;
    __host__ __device__ void init(int M, int N, int G_, int c_) { nM = M / BM; nN = N / BM; nwg = nM * nN; G = G_; c = c_; }
    __host__ __device__ bool next(int i, Unit& u) const {
        const long L = (long)i * G + c; if (L >= nwg) return false;
        int wgid = (int)L; { const int q = nwg / NXCD, r = nwg % NXCD, xcd = wgid % NXCD, off = wgid / NXCD; wgid = (xcd < r ? xcd * (q + 1) : r * (q + 1) + (xcd - r) * q) + off; }
        const int nig = WGM * nN, gid = wgid / nig, fm = gid * WGM, gsz = (nM - fm) < WGM ? (nM - fm) : WGM;
        u.pm = fm + ((wgid % nig) % gsz); u.pn = (wgid % nig) / gsz; return true;
    }
    __device__ __forceinline__ void a_ready(const Unit&) const {}
    __device__ __forceinline__ void done(const Unit&) const {}
};

template <class Epi, class Sched, bool ALIGN_EPI = false, bool SP2 = false>
__device__ __forceinline__ void gemm_phase(PG8_LAS unsigned char* lds, const Gemm g, const Sched& S, const Epi& E) {
    int tid_ = threadIdx.x; asm volatile("" : "+v"(tid_));
    const int tid = tid_, wid = __builtin_amdgcn_readfirstlane(tid >> 6), lane = tid & 63, wr = wid >> 2, wc = wid & 3, fr = lane & 15, fq = lane >> 4;
    const int K = g.K, nt = K / BK;
    unsigned voffA[2], voffB[2];
#pragma unroll
    for (int i = 0; i < 2; ++i) { int R, C; stage_rc(tid * 16 + i * 8192, R, C); const int Rb = Epi::PERM ? ((R & ~31) + perm32(R & 31)) : R;
        voffA[i] = (unsigned)(R * K + C) * 2u; voffB[i] = (unsigned)(Rb * K + C) * 2u; }
    const size_t kstep = (size_t)(BK * 2);
    const size_t hstep = (size_t)HALF * K * 2;
    const size_t tstep = 2 * hstep;
    const unsigned ldsw = (unsigned)wid * 1024u;
    const int aoff = lds_byte(wr * 64 + fr, fq * 8), boff = lds_byte(wc * 32 + fr, fq * 8);
#define PG8_SA(b, h) (((b) * 2 + (h)) * HTB)
#define PG8_SB(b, h) ((4 + (b) * 2 + (h)) * HTB)
#define PG8_STAGE(bufoff, gbase, voff) do { _Pragma("unroll") for (int _i = 0; _i < 2; ++_i) \
        __builtin_amdgcn_global_load_lds((const unsigned*)((const char*)(gbase) + (voff)[_i]), (PG8_LAS unsigned*)(lds + (bufoff) + ldsw + _i * 8192), 16, 0, 0); } while (0)
#define PG8_LDA(dst, b, h) do { _Pragma("unroll") for (int m = 0; m < 4; ++m) _Pragma("unroll") for (int k = 0; k < 2; ++k) dst[m][k] = *(const PG8_LAS bf16x8*)(lds + PG8_SA(b, h) + aoff + m * 2048 + k * 1024); } while (0)
#define PG8_LDB(dst, b, h) do { _Pragma("unroll") for (int n = 0; n < 2; ++n) _Pragma("unroll") for (int k = 0; k < 2; ++k) dst[n][k] = *(const PG8_LAS bf16x8*)(lds + PG8_SB(b, h) + boff + n * 2048 + k * 1024); } while (0)
#define PG8_MMA(ai, bj, At, Bt) do { __builtin_amdgcn_s_setprio(1); _Pragma("unroll") for (int m = 0; m < 4; ++m) _Pragma("unroll") for (int n = 0; n < 2; ++n) _Pragma("unroll") for (int k = 0; k < 2; ++k) \
        acc[ai][bj][m][n] = __builtin_amdgcn_mfma_f32_16x16x32_bf16(Bt[n][k], At[m][k], acc[ai][bj][m][n], 0, 0, 0); __builtin_amdgcn_s_setprio(0); } while (0)
#define PG8_WAIT_V(n) asm volatile("s_waitcnt vmcnt(" #n ")" ::: "memory")
#define PG8_WAIT_L(n) asm volatile("s_waitcnt lgkmcnt(" #n ")" ::: "memory")
#define PG8_BAR __builtin_amdgcn_s_barrier()
#define PG8_SCHED __builtin_amdgcn_sched_barrier(0)
    Unit cur, nxt; int ui = 0;
    if (!S.next(0, cur)) return;
    f32x4 acc[2][2][4][2];
#pragma unroll
    for (int a = 0; a < 2; ++a)
#pragma unroll
        for (int b = 0; b < 2; ++b)
#pragma unroll
            for (int m = 0; m < 4; ++m)
#pragma unroll
                for (int n = 0; n < 2; ++n) acc[a][b][m][n] = (f32x4){0.f, 0.f, 0.f, 0.f};
    bf16x8 At[4][2], B0[2][2], B1[2][2];
    const char* cA = (const char*)g.A + (size_t)cur.pm * tstep; const char* cB = (const char*)g.Bt + (size_t)cur.pn * tstep;
    S.a_ready(cur);
    if constexpr (SP2) {
        PG8_STAGE(PG8_SB(0, 0), cB, voffB); PG8_STAGE(PG8_SB(0, 1), cB + hstep, voffB); PG8_STAGE(PG8_SA(0, 0), cA, voffA); PG8_STAGE(PG8_SA(0, 1), cA + hstep, voffA);
        if (wr == 1) PG8_BAR;
        PG8_WAIT_V(2); PG8_BAR;
        PG8_STAGE(PG8_SB(1, 0), cB + kstep, voffB); PG8_STAGE(PG8_SA(1, 0), cA + kstep, voffA); PG8_STAGE(PG8_SB(1, 1), cB + hstep + kstep, voffB);
        PG8_WAIT_V(6); PG8_BAR;
    } else {
        PG8_STAGE(PG8_SB(0, 0), cB, voffB); PG8_STAGE(PG8_SA(0, 0), cA, voffA); PG8_STAGE(PG8_SB(0, 1), cB + hstep, voffB); PG8_STAGE(PG8_SA(0, 1), cA + hstep, voffA);
        if (wr == 1) PG8_BAR;
        PG8_WAIT_V(4); PG8_BAR;
        PG8_STAGE(PG8_SB(1, 0), cB + kstep, voffB); PG8_STAGE(PG8_SA(1, 0), cA + kstep, voffA); PG8_STAGE(PG8_SB(1, 1), cB + hstep + kstep, voffB);
        PG8_WAIT_V(6); PG8_BAR;
    }
    for (;;) {
        const bool has_next = S.next(ui + 1, nxt);
        const char* nA = has_next ? (const char*)g.A + (size_t)nxt.pm * tstep : cA; const char* nB = has_next ? (const char*)g.Bt + (size_t)nxt.pn * tstep : cB;
        for (int t = 0; t < nt; t += 2) {
            const bool last = (t == nt - 2);
            const char* a1 = cA + (size_t)(t + 1) * kstep;
            const char* a2 = last ? nA : cA + (size_t)(t + 2) * kstep; const char* b2 = last ? nB : cB + (size_t)(t + 2) * kstep;
            const char* a3 = a2 + kstep; const char* b3 = b2 + kstep;
            if (last && has_next) S.a_ready(nxt);
            if constexpr (SP2) {
            PG8_LDB(B0, 0, 0); PG8_LDB(B1, 0, 1); PG8_SCHED; PG8_LDA(At, 0, 0); PG8_STAGE(PG8_SA(1, 1), a1 + hstep, voffA);
            PG8_WAIT_V(8); PG8_WAIT_L(0); PG8_BAR; PG8_MMA(0, 0, At, B0); PG8_MMA(0, 1, At, B1); PG8_BAR; PG8_SCHED;
            PG8_LDA(At, 0, 1); PG8_STAGE(PG8_SB(0, 0), b2, voffB); PG8_STAGE(PG8_SB(0, 1), b2 + hstep, voffB); PG8_STAGE(PG8_SA(0, 0), a2, voffA);
            PG8_WAIT_V(8); PG8_WAIT_L(0); PG8_BAR; PG8_MMA(1, 0, At, B0); PG8_MMA(1, 1, At, B1); PG8_BAR; PG8_SCHED;
            PG8_LDB(B0, 1, 0); PG8_LDB(B1, 1, 1); PG8_SCHED; PG8_LDA(At, 1, 0); PG8_STAGE(PG8_SA(0, 1), a2 + hstep, voffA);
            PG8_WAIT_V(8); PG8_WAIT_L(0); PG8_BAR; PG8_MMA(0, 0, At, B0); PG8_MMA(0, 1, At, B1); PG8_BAR; PG8_SCHED;
            PG8_LDA(At, 1, 1); PG8_STAGE(PG8_SB(1, 0), b3, voffB); PG8_STAGE(PG8_SB(1, 1), b3 + hstep, voffB); PG8_STAGE(PG8_SA(1, 0), a3, voffA);
            PG8_WAIT_V(8); PG8_WAIT_L(0); PG8_BAR; PG8_MMA(1, 0, At, B0); PG8_MMA(1, 1, At, B1); PG8_BAR; PG8_SCHED;
            } else {
            PG8_LDB(B0, 0, 0); PG8_SCHED; PG8_LDA(At, 0, 0); PG8_STAGE(PG8_SA(1, 1), a1 + hstep, voffA);
            PG8_WAIT_L(8); PG8_BAR; PG8_WAIT_L(0); PG8_MMA(0, 0, At, B0); PG8_BAR; PG8_SCHED;
            PG8_LDB(B1, 0, 1); PG8_STAGE(PG8_SB(0, 0), b2, voffB);
            PG8_BAR; PG8_WAIT_L(0); PG8_MMA(0, 1, At, B1); PG8_BAR;
            PG8_LDA(At, 0, 1); PG8_STAGE(PG8_SA(0, 0), a2, voffA);
            PG8_BAR; PG8_WAIT_L(0); PG8_MMA(1, 0, At, B0); PG8_BAR; PG8_SCHED;
            PG8_STAGE(PG8_SB(0, 1), b2 + hstep, voffB);
            PG8_WAIT_V(6); PG8_BAR; PG8_MMA(1, 1, At, B1); PG8_BAR;
            PG8_LDB(B0, 1, 0); PG8_SCHED; PG8_LDA(At, 1, 0); PG8_STAGE(PG8_SA(0, 1), a2 + hstep, voffA);
            PG8_WAIT_L(8); PG8_BAR; PG8_WAIT_L(0); PG8_MMA(0, 0, At, B0); PG8_BAR; PG8_SCHED;
            PG8_LDB(B1, 1, 1); PG8_STAGE(PG8_SB(1, 0), b3, voffB);
            PG8_BAR; PG8_WAIT_L(0); PG8_MMA(0, 1, At, B1); PG8_BAR;
            PG8_LDA(At, 1, 1); PG8_STAGE(PG8_SA(1, 0), a3, voffA);
            PG8_BAR; PG8_WAIT_L(0); PG8_MMA(1, 0, At, B0); PG8_BAR; PG8_SCHED;
            PG8_STAGE(PG8_SB(1, 1), b3 + hstep, voffB);
            PG8_WAIT_V(6); PG8_BAR; PG8_MMA(1, 1, At, B1); PG8_BAR;
            }
        }
        if constexpr (ALIGN_EPI) { if (wr == 0) PG8_BAR; }
        if constexpr (!Epi::AFTER_DRAIN) { E(acc, cur, wr, wc, fr, fq); S.done(cur); }
        if (!has_next) break;
#pragma unroll
        for (int a = 0; a < 2; ++a)
#pragma unroll
            for (int b = 0; b < 2; ++b)
#pragma unroll
                for (int m = 0; m < 4; ++m)
#pragma unroll
                    for (int n = 0; n < 2; ++n) acc[a][b][m][n] = (f32x4){0.f, 0.f, 0.f, 0.f};
        cur = nxt; cA = nA; cB = nB; ++ui;
        if constexpr (ALIGN_EPI) { if (wr == 1) PG8_BAR; }
    }
    PG8_WAIT_V(0);
    if constexpr (!ALIGN_EPI) { if (wr == 0) PG8_BAR; }
    PG8_BAR;
    if constexpr (Epi::AFTER_DRAIN) { E.fused(acc, cur, wr, wc, fr, fq, lds, wid, lane); S.done(cur); }
#undef PG8_SA
#undef PG8_SB
#undef PG8_STAGE
#undef PG8_LDA
#undef PG8_LDB
#undef PG8_MMA
#undef PG8_WAIT_V
#undef PG8_WAIT_L
#undef PG8_BAR
#undef PG8_SCHED
}
}
#define XB_TMO      128
#define XB_XCNT(j)  (256  + 64 * (j))
#define XB_XSUB(j)  (1280 + 64 * (j))
#define XB_XGEN(j)  (2304 + 64 * (j))
#define XB_TOP      3328
#define XB_TOPGEN   3392
#define XCD_BAR_WORDS 3456
#define XB_SPIN_CAP (1u << 18)

__device__ __forceinline__ unsigned xb_ld(unsigned* p)              { return __hip_atomic_load(p, __ATOMIC_RELAXED, __HIP_MEMORY_SCOPE_AGENT); }
__device__ __forceinline__ unsigned xb_add(unsigned* p, unsigned v) { return __hip_atomic_fetch_add(p, v, __ATOMIC_RELAXED, __HIP_MEMORY_SCOPE_AGENT); }
__device__ __forceinline__ unsigned xb_xcc_id() { return (unsigned)__builtin_amdgcn_s_getreg((3 << 11) | 20) & 0xFu; }
#define XB_SPIN(cond, bar) do { unsigned _sp = 0; while (cond) { __builtin_amdgcn_s_sleep(1); \
    if ((++_sp & 255u) == 0u) { if (xb_ld(&(bar)[XB_TMO])) break; if (_sp > XB_SPIN_CAP) { atomicAdd(&(bar)[XB_TMO], 1u); break; } } } } while (0)

struct XcdBarrier {
    unsigned* bar; unsigned x;
    volatile LAS unsigned* st;
};

__device__ __forceinline__ XcdBarrier xcd_barrier_post(unsigned* bar, volatile LAS unsigned* st) {
    XcdBarrier b; b.bar = bar; b.x = xb_xcc_id(); b.st = st;
    if (threadIdx.x == 0) (void)xb_add(&bar[XB_XCNT(b.x)], 1u);
    return b;
}
__device__ __forceinline__ void xcd_barrier_complete(unsigned* bar, unsigned x, unsigned& nloc, unsigned& nx) {
    const unsigned G = gridDim.x * gridDim.y * gridDim.z;
    unsigned sum, cnt, mine, sp = 0u;
    for (;;) {
        sum = 0u; cnt = 0u; mine = 0u;
#pragma unroll
        for (unsigned j = 0; j < 16; ++j) { const unsigned c = xb_ld(&bar[XB_XCNT(j)]); sum += c; cnt += (c > 0u) ? 1u : 0u; mine = (j == x) ? c : mine; }
        if (sum == G) break;
        __builtin_amdgcn_s_sleep(1);
        if ((++sp & 255u) == 0u) { if (xb_ld(&bar[XB_TMO])) break; if (sp > XB_SPIN_CAP) { atomicAdd(&bar[XB_TMO], 1u); break; } }
    }
    nloc = mine > 0u ? mine : 1u; nx = cnt > 0u ? cnt : 1u;
}

__device__ __forceinline__ void xcd_barrier(const XcdBarrier& b) {
    asm volatile("s_waitcnt vmcnt(0)" ::: "memory");
    __syncthreads();
    if (threadIdx.x == 0) {
        unsigned* bar = b.bar;
        __builtin_amdgcn_s_waitcnt(0);
        unsigned nloc = b.st[0], nx = b.st[1];
        if (nloc == 0u) { xcd_barrier_complete(bar, b.x, nloc, nx); b.st[0] = nloc; b.st[1] = nx; }
        const unsigned old = xb_add(&bar[XB_XSUB(b.x)], 1u);
        const unsigned gen = old / nloc;
        if (old + 1u == (gen + 1u) * nloc) {
            __builtin_amdgcn_fence(__ATOMIC_RELEASE, "agent");
            asm volatile("s_waitcnt vmcnt(0)" ::: "memory");
            const unsigned og = xb_add(&bar[XB_TOP], 1u);
            const unsigned tg = og / nx;
            if (og + 1u == (tg + 1u) * nx) xb_add(&bar[XB_TOPGEN], 1u);
            else XB_SPIN(xb_ld(&bar[XB_TOPGEN]) == tg, bar);
            __builtin_amdgcn_fence(__ATOMIC_ACQUIRE, "agent");
            xb_add(&bar[XB_XGEN(b.x)], 1u);
            asm volatile("s_waitcnt vmcnt(0)" ::: "memory");
        } else {
            XB_SPIN(xb_ld(&bar[XB_XGEN(b.x)]) == gen, bar);
            __builtin_amdgcn_fence(__ATOMIC_ACQUIRE, "agent");
            asm volatile("s_waitcnt vmcnt(0)" ::: "memory");
        }
    }
    __syncthreads();
}
namespace fk {
using pg8::bf16_t; using pg8::bf16x8; using pg8::f32x4; using pg8::u32x4; using pg8::Unit;
typedef float f32x16 __attribute__((ext_vector_type(16)));
typedef float f32x2 __attribute__((ext_vector_type(2)));
typedef __bf16 bf16x2_t __attribute__((ext_vector_type(2)));
typedef short s16x4 __attribute__((ext_vector_type(4)));
typedef unsigned u32x2 __attribute__((ext_vector_type(2)));
#define DI __device__ __forceinline__

constexpr int NB = 8, S = 2048, M = NB * S, D = 1024;
constexpr float EPS = 1e-6f, LOG2E = 1.4426950408889634f;
constexpr int NTHR = 512;

DI int tidx() { int t = threadIdx.x; asm volatile("" : "+v"(t)); return t; }
DI unsigned pk2(float lo, float hi) { f32x2 v = {lo, hi}; return __builtin_bit_cast(unsigned, __builtin_convertvector(v, bf16x2_t)); }
DI float bflo(unsigned u) { return __uint_as_float(u << 16); }
DI float bfhi(unsigned u) { return __uint_as_float(u & 0xffff0000u); }
DI float bf1(unsigned short b) { return __uint_as_float((unsigned)b << 16); }
DI float sigm(float x) { return 1.f / (1.f + __expf(-x)); }
DI float silu(float x) { return x * sigm(x); }
DI float ex2(float x) { return __builtin_amdgcn_exp2f(x); }
DI u32x4 pk8(const f32x4& a, const f32x4& b) { u32x4 w; w.x = pk2(a[0], a[1]); w.y = pk2(a[2], a[3]); w.z = pk2(b[0], b[1]); w.w = pk2(b[2], b[3]); return w; }
DI void unpk8(u32x4 w, f32x4& a, f32x4& b) { a[0] = bflo(w.x); a[1] = bfhi(w.x); a[2] = bflo(w.y); a[3] = bfhi(w.y); b[0] = bflo(w.z); b[1] = bfhi(w.z); b[2] = bflo(w.w); b[3] = bfhi(w.w); }

constexpr size_t KiB = 1024, MiB = 1u << 20;
constexpr size_t WS_CTL = 0;
constexpr size_t WS_SSQ = 64 * KiB;
constexpr int SSQ_X = 0  , SSQ_1 = 5  , SSQ_Q = 9  , SSQ_KV = 11  ;
constexpr size_t ZERO_BYTES = 1792 * KiB;
constexpr size_t WS_GW8 = 1792 * KiB;
constexpr size_t WS_WMIX = 2 * MiB;
constexpr size_t WS_WPLE = 23 * MiB;
constexpr size_t WS_XBA = 26 * MiB;
constexpr size_t WS_BIG = 58 * MiB;
constexpr size_t WS_CS = WS_BIG + 192 * MiB, WS_SN = WS_CS + 1 * MiB, WS_IG = WS_SN + 1 * MiB, WS_LF = WS_IG + 256 * KiB;
constexpr size_t WS_END = 256 * MiB;
static_assert(WS_LF + 256 * KiB <= WS_END, "ws map");
constexpr size_t WM_IN = 0, WM_QB = 4 * MiB, WM_KVB = 6 * MiB, WM_OUT_MLA = 8 * MiB, WM_OUT_CONV = 8 * MiB, WM_OUT_LSTM = 16 * MiB;
constexpr size_t A_SZ = 0, A_Q = 32 * MiB, A_KN = 80 * MiB, A_VT = 112 * MiB, A_CQ = 144 * MiB, A_CKV = 156 * MiB, A_KR = 164 * MiB, A_XBB = 32 * MiB, A_PP = 80 * MiB, A_PB = 166 * MiB;
constexpr size_t C_CH = 0, C_BZ = 32 * MiB, C_XBB = 64 * MiB, C_PP = 96 * MiB, C_PB = 166 * MiB;
constexpr size_t L_Q = 0, L_K = 32 * MiB, L_VT = 64 * MiB, L_OG = 128 * MiB, L_XBB = 0, L_PP = 64 * MiB;

struct Args { const float* in[19]; float* out; unsigned char* ws; int ph_lo, ph_hi; };
enum { I_X = 0, I_P, I_POS, I_NORMG, I_MLA_WIN, I_MLA_QN, I_MLA_WQB, I_MLA_KVN, I_MLA_WKVB, I_MLA_WOUT, I_CONV_WIN, I_CONV_W, I_CONV_WOUT, I_L_WIN, I_L_BG, I_L_WOUT, I_PLE_PROJ, I_PLE_GATE, I_FNORM };

enum { PM_ID = 0, PM_MLA_IN, PM_MLA_QB, PM_MLA_KVB, PM_CONV_IN, PM_LSTM_IN };
DI int prep_src(int mode, int n, float& sc) {
    sc = 1.f;
    switch (mode) {
    case PM_MLA_IN: { if (n < 1024) return 672 + n; if (n < 1408) return n - 1024; if (n < 1664) return 384 + (n - 1408); if (n < 1696) { const int jj = n - 1664; return 640 + (jj >> 1) + 16 * (jj & 1); } return -1; }
    case PM_MLA_QB: { sc = 0.10206207261596577f * LOG2E; const int hd = n / 96, d = n % 96; if (d < 64) return n; const int jj = d - 64; return 96 * hd + 64 + (jj >> 1) + 16 * (jj & 1); }
    case PM_MLA_KVB: { if (n < 1024) return 128 * (n >> 6) + (n & 63); const int n2 = n - 1024; return 128 * (n2 >> 6) + 64 + (n2 & 63); }
    case PM_CONV_IN: { const int pn = n >> 8, bj = (n >> 7) & 1, i = n & 127; if (pn < 8) return (bj ? 2048 : 1024) + 128 * pn + i; return (bj ? 3072 : 0) + 128 * (pn - 8) + i; }
    case PM_LSTM_IN: { if (n < 4096) { if (n >= 1024 && n < 2048) sc = 0.0625f; return n; } const int n2 = n - 4096, pn = n2 >> 8, bj = (n2 >> 7) & 1, i = n2 & 127; return (bj ? 6144 : 4096) + 128 * pn + i; }
    default: return n;
    }
}
struct PrepTask { const float* W; int ldw; const float* gk; int K, Nst, mode; bf16_t* out; };
DI void prep_tile(const PrepTask& t, int tile, LAS float* scr) {
    const int tid = tidx(), nkb = t.K >> 6, nb = tile / nkb, kb = tile % nkb, n0 = nb << 6, k0 = kb << 6;
#pragma unroll
    for (int i = 0; i < 8; ++i) {
        const int e = tid + i * NTHR, nn = e & 63, kk = e >> 6;
        float sc; const int src = prep_src(t.mode, n0 + nn, sc);
        float v = 0.f;
        if (src >= 0) { v = t.W[(size_t)(k0 + kk) * t.ldw + src] * sc; if (t.gk) v *= t.gk[k0 + kk]; }
        scr[nn * 65 + kk] = v;
    }
    __syncthreads();
    { const int nn = tid >> 3, c = tid & 7; const LAS float* s = scr + nn * 65 + 8 * c;
      u32x4 o; o.x = pk2(s[0], s[1]); o.y = pk2(s[2], s[3]); o.z = pk2(s[4], s[5]); o.w = pk2(s[6], s[7]);
      *(u32x4*)(t.out + (size_t)(n0 + nn) * t.K + k0 + 8 * c) = o; }
    __syncthreads();
}
DI void prep_run1(const PrepTask& t, LAS float* scr, int cu, int G) {
    const int total = (t.Nst >> 6) * (t.K >> 6);
#pragma unroll 1
    for (int it = cu; it < total; it += G) prep_tile(t, it, scr);
}

DI float wave_sum(float v) {
#pragma unroll
    for (int o = 1; o < 64; o <<= 1) v += __shfl_xor(v, o);
    return v;
}
DI void rows_to_bf16_ssq(const float* x, bf16_t* xb, unsigned long long* ssq, int gw, int NGW, int lane) {
    for (int m = gw; m < M; m += NGW) {
        const f32x4* xr = (const f32x4*)(x + (size_t)m * D) + lane; float s = 0.f;
        u32x2* o8 = (u32x2*)(xb + (size_t)m * D) + lane;
#pragma unroll
        for (int j = 0; j < 4; ++j) { const f32x4 v = xr[64 * j]; s += (v[0] * v[0] + v[1] * v[1]) + (v[2] * v[2] + v[3] * v[3]); u32x2 w; w.x = pk2(v[0], v[1]); w.y = pk2(v[2], v[3]); o8[64 * j] = w; }
        s = wave_sum(s); if (lane == 0) ssq[m] = (unsigned long long)(s * 16777216.f);
    }
}
DI void p_to_bf16(const float* p, bf16_t* pb, int gt, int NGT) {
    for (size_t i = gt; i < (size_t)M * 256 / 8; i += NGT) { const f32x4 a = ((const f32x4*)p)[2 * i], b = ((const f32x4*)p)[2 * i + 1]; ((u32x4*)pb)[i] = pk8(a, b); }
}
DI void rope_tables(const int* pos, float* cs, float* sn, int gt, int NGT) {
    for (int i = gt; i < M * 16; i += NGT) {
        const int t = i >> 4, j = i & 15;
        const float inv = powf(10000.0f, -(float)(2 * j) / 32.0f);
        const float ang = (float)pos[t] * inv;
        double rev = (double)ang * 0.15915494309189533577; rev -= rint(rev);
        const float fr = (float)rev;
        cs[i] = __builtin_amdgcn_cosf(fr); sn[i] = __builtin_amdgcn_sinf(fr);
    }
}

#define EPI_ROW(u, ai, m) ((u).pm * 256 + (ai) * 128 + wr * 64 + (m) * 16 + fr)
#define EPI_LOOP_AM _Pragma("unroll") for (int ai = 0; ai < 2; ++ai) _Pragma("unroll") for (int m = 0; m < 4; ++m)
typedef const f32x4 (&AccRef)[2][2][4][2];
DI float sq8(const f32x4& a, const f32x4& b) { return (a[0] * a[0] + a[1] * a[1]) + (a[2] * a[2] + a[3] * a[3]) + (b[0] * b[0] + b[1] * b[1]) + (b[2] * b[2] + b[3] * b[3]); }
DI float red_fq(float s) { s += __shfl_xor(s, 16); s += __shfl_xor(s, 32); return s; }
DI void rope8(f32x4& a, f32x4& b, const float* cs, const float* sn, int row, int p0) {
    const f32x4 c = *(const f32x4*)(cs + (size_t)row * 16 + p0), s = *(const f32x4*)(sn + (size_t)row * 16 + p0);
    const f32x4 a0 = a, b0 = b;
    a[0] = a0[0] * c[0] - a0[1] * s[0]; a[1] = a0[0] * s[0] + a0[1] * c[0];
    a[2] = a0[2] * c[1] - a0[3] * s[1]; a[3] = a0[2] * s[1] + a0[3] * c[1];
    b[0] = b0[0] * c[2] - b0[1] * s[2]; b[1] = b0[0] * s[2] + b0[1] * c[2];
    b[2] = b0[2] * c[3] - b0[3] * s[3]; b[3] = b0[2] * s[3] + b0[3] * c[3];
}

DI int opaque(int v) { asm volatile("" : "+s"(v)); return v; }
template <class T> DI T* launder(T* p) { asm volatile("" : "+s"(p)); return p; }
typedef unsigned long long u64;
constexpr float SSQ_SCALE = 16777216.f, SSQ_INV = 1.f / 16777216.f;
DI u64* ssq_arr(unsigned char* ws, int idx) { return (u64*)(ws + WS_SSQ) + (size_t)idx * M; }
DI void ssq_add(u64* p, float s) { atomicAdd(p, (u64)(s * SSQ_SCALE)); }
DI float ssq_rstd(const u64* p, float invn) { return rsqrtf((float)(*p) * SSQ_INV * invn + EPS); }

struct EpiA1 {
    static constexpr bool PERM = true, AFTER_DRAIN = false;
    unsigned char* ws; int i, j;
    DI void operator()(AccRef acc, const Unit& u, int wr, int wc, int fr, int fq) const {
        unsigned char* w = launder(ws); unsigned char* big = w + WS_BIG;
        const u64* ssq_x = ssq_arr(w, SSQ_X + i); u64* ssq_q = ssq_arr(w, SSQ_Q + j); u64* ssq_kv = ssq_arr(w, SSQ_KV + j);
        bf16_t *SZ = (bf16_t*)(big + A_SZ), *CQ = (bf16_t*)(big + A_CQ), *CKV = (bf16_t*)(big + A_CKV), *KR = (bf16_t*)(big + A_KR);
        const float *CS = (const float*)(w + WS_CS), *SN = (const float*)(w + WS_SN);
        EPI_LOOP_AM {
            const int row = EPI_ROW(u, ai, m); const float rs = ssq_rstd(ssq_x + row, 1.f / 1024.f);
            float sq = 0.f, skv = 0.f; bool hq = false, hkv = false;
#pragma unroll
            for (int bj = 0; bj < 2; ++bj) {
                f32x4 v0 = acc[ai][bj][m][0] * rs, v1 = acc[ai][bj][m][1] * rs;
                if (u.pn < 4) {
                    const int col = u.pn * 256 + bj * 128 + wc * 32 + 8 * fq;
#pragma unroll
                    for (int jj = 0; jj < 4; ++jj) { v0[jj] = silu(v0[jj]); v1[jj] = silu(v1[jj]); }
                    *(u32x4*)(SZ + (size_t)row * 1024 + col) = pk8(v0, v1);
                } else {
                    const int c = (u.pn - 4) * 256 + bj * 128 + wc * 32 + 8 * fq;
                    if (c < 384) { *(u32x4*)(CQ + (size_t)row * 384 + c) = pk8(v0, v1); sq += sq8(v0, v1); hq = true; }
                    else if (c < 640) { *(u32x4*)(CKV + (size_t)row * 256 + (c - 384)) = pk8(v0, v1); skv += sq8(v0, v1); hkv = true; }
                    else if (c < 672) { const int jj0 = c - 640; rope8(v0, v1, CS, SN, row, jj0 >> 1); *(u32x4*)(KR + (size_t)row * 32 + jj0) = pk8(v0, v1); }
                }
            }
            if (u.pn >= 4) {
                sq = red_fq(sq); skv = red_fq(skv);
                if (fq == 0 && hq) ssq_add(ssq_q + row, sq);
                if (fq == 0 && hkv) ssq_add(ssq_kv + row, skv);
            }
        }
    }
};
struct EpiQ {
    static constexpr bool PERM = true, AFTER_DRAIN = false;
    unsigned char* ws; int j;
    DI void operator()(AccRef acc, const Unit& u, int wr, int wc, int fr, int fq) const {
        unsigned char* w = launder(ws); const u64* ssq_q = ssq_arr(w, SSQ_Q + j); bf16_t* Q = (bf16_t*)(w + WS_BIG + A_Q);
        const float *CS = (const float*)(w + WS_CS), *SN = (const float*)(w + WS_SN);
        EPI_LOOP_AM {
            const int row = EPI_ROW(u, ai, m); const float rs = ssq_rstd(ssq_q + row, 1.f / 384.f);
#pragma unroll
            for (int bj = 0; bj < 2; ++bj) {
                const int col = u.pn * 256 + bj * 128 + wc * 32 + 8 * fq, d = col % 96;
                f32x4 v0 = acc[ai][bj][m][0] * rs, v1 = acc[ai][bj][m][1] * rs;
                if (d >= 64) rope8(v0, v1, CS, SN, row, (d - 64) >> 1);
                *(u32x4*)(Q + (size_t)row * 1536 + col) = pk8(v0, v1);
            }
        }
    }
};
DI void store_vt8(bf16_t* vp, const u32x4& w) {
    vp[0 * (size_t)S] = (bf16_t)(w.x & 0xffff); vp[1 * (size_t)S] = (bf16_t)(w.x >> 16); vp[2 * (size_t)S] = (bf16_t)(w.y & 0xffff); vp[3 * (size_t)S] = (bf16_t)(w.y >> 16);
    vp[4 * (size_t)S] = (bf16_t)(w.z & 0xffff); vp[5 * (size_t)S] = (bf16_t)(w.z >> 16); vp[6 * (size_t)S] = (bf16_t)(w.w & 0xffff); vp[7 * (size_t)S] = (bf16_t)(w.w >> 16);
}
struct EpiKV {
    static constexpr bool PERM = true, AFTER_DRAIN = false;
    unsigned char* ws; int j;
    DI void operator()(AccRef acc, const Unit& u, int wr, int wc, int fr, int fq) const {
        unsigned char* w = launder(ws); const u64* ssq_kv = ssq_arr(w, SSQ_KV + j); bf16_t *KN = (bf16_t*)(w + WS_BIG + A_KN), *VT = (bf16_t*)(w + WS_BIG + A_VT);
        EPI_LOOP_AM {
            const int row = EPI_ROW(u, ai, m); const float rs = ssq_rstd(ssq_kv + row, 1.f / 256.f);
#pragma unroll
            for (int bj = 0; bj < 2; ++bj) {
                const int col = u.pn * 256 + bj * 128 + wc * 32 + 8 * fq;
                const f32x4 v0 = acc[ai][bj][m][0] * rs, v1 = acc[ai][bj][m][1] * rs;
                if (u.pn < 4) *(u32x4*)(KN + (size_t)row * 1024 + col) = pk8(v0, v1);
                else { const int b = row >> 11, s = row & 2047; store_vt8(VT + ((size_t)(b * 1024 + (col - 1024))) * S + s, pk8(v0, v1)); }
            }
        }
    }
};
struct EpiOut {
    static constexpr bool PERM = true, AFTER_DRAIN = false;
    unsigned char* ws; const float* xin; float* xout; size_t xbb_off; int i;
    DI void operator()(AccRef acc, const Unit& u, int wr, int wc, int fr, int fq) const {
        unsigned char* w = launder(ws); u64* ssq = ssq_arr(w, SSQ_1 + i); bf16_t* XB = (bf16_t*)(w + WS_BIG + xbb_off);
        EPI_LOOP_AM {
            const int row = EPI_ROW(u, ai, m); float sq = 0.f;
#pragma unroll
            for (int bj = 0; bj < 2; ++bj) {
                const size_t off = (size_t)row * 1024 + u.pn * 256 + bj * 128 + wc * 32 + 8 * fq;
                const f32x4 y0 = *(const f32x4*)(xin + off) + acc[ai][bj][m][0], y1 = *(const f32x4*)(xin + off + 4) + acc[ai][bj][m][1];
                *(f32x4*)(xout + off) = y0; *(f32x4*)(xout + off + 4) = y1; *(u32x4*)(XB + off) = pk8(y0, y1); sq += sq8(y0, y1);
            }
            sq = red_fq(sq); if (fq == 0) ssq_add(ssq + row, sq);
        }
    }
};
struct EpiPP {
    static constexpr bool PERM = true, AFTER_DRAIN = false;
    unsigned char* ws; size_t pp_off;
    DI void operator()(AccRef acc, const Unit& u, int wr, int wc, int fr, int fq) const {
        bf16_t* PP = (bf16_t*)(launder(ws) + WS_BIG + pp_off);
        EPI_LOOP_AM { const int row = EPI_ROW(u, ai, m);
#pragma unroll
            for (int bj = 0; bj < 2; ++bj) { const size_t off = (size_t)row * 1024 + u.pn * 256 + bj * 128 + wc * 32 + 8 * fq; *(u32x4*)(PP + off) = pk8(acc[ai][bj][m][0], acc[ai][bj][m][1]); } }
    }
};
struct EpiPle {
    static constexpr bool PERM = true, AFTER_DRAIN = false;
    unsigned char* ws; float* x; size_t pp_off; int i;
    DI void operator()(AccRef acc, const Unit& u, int wr, int wc, int fr, int fq) const {
        unsigned char* w = launder(ws); const u64* ssq1 = ssq_arr(w, SSQ_1 + i); u64* ssq = ssq_arr(w, SSQ_X + i + 1);
        const bf16_t* PP = (const bf16_t*)(w + WS_BIG + pp_off); bf16_t* XB = (bf16_t*)(w + WS_XBA);
        EPI_LOOP_AM {
            const int row = EPI_ROW(u, ai, m); const float rs = ssq_rstd(ssq1 + row, 1.f / 1024.f); float sq = 0.f;
#pragma unroll
            for (int bj = 0; bj < 2; ++bj) {
                const size_t off = (size_t)row * 1024 + u.pn * 256 + bj * 128 + wc * 32 + 8 * fq;
                f32x4 p0, p1; unpk8(*(const u32x4*)(PP + off), p0, p1);
                f32x4 y0 = *(const f32x4*)(x + off), y1 = *(const f32x4*)(x + off + 4);
#pragma unroll
                for (int jj = 0; jj < 4; ++jj) { y0[jj] += sigm(acc[ai][bj][m][0][jj] * rs) * p0[jj]; y1[jj] += sigm(acc[ai][bj][m][1][jj] * rs) * p1[jj]; }
                *(f32x4*)(x + off) = y0; *(f32x4*)(x + off + 4) = y1; *(u32x4*)(XB + off) = pk8(y0, y1); sq += sq8(y0, y1);
            }
            sq = red_fq(sq); if (fq == 0) ssq_add(ssq + row, sq);
        }
    }
};
struct EpiC1 {
    static constexpr bool PERM = true, AFTER_DRAIN = false;
    unsigned char* ws; int i;
    DI void operator()(AccRef acc, const Unit& u, int wr, int wc, int fr, int fq) const {
        unsigned char* w = launder(ws); const u64* ssq_x = ssq_arr(w, SSQ_X + i); bf16_t *CH = (bf16_t*)(w + WS_BIG + C_CH), *BZ = (bf16_t*)(w + WS_BIG + C_BZ);
        EPI_LOOP_AM {
            const int row = EPI_ROW(u, ai, m); const float rs = ssq_rstd(ssq_x + row, 1.f / 1024.f);
            const size_t off = (size_t)row * 1024 + (u.pn & 7) * 128 + wc * 32 + 8 * fq;
            f32x4 r0, r1;
            if (u.pn < 8) { r0 = (acc[ai][0][m][0] * rs) * (acc[ai][1][m][0] * rs); r1 = (acc[ai][0][m][1] * rs) * (acc[ai][1][m][1] * rs); *(u32x4*)(CH + off) = pk8(r0, r1); }
            else {
#pragma unroll
                for (int jj = 0; jj < 4; ++jj) { r0[jj] = (acc[ai][0][m][0][jj] * rs) * silu(acc[ai][1][m][0][jj] * rs); r1[jj] = (acc[ai][0][m][1][jj] * rs) * silu(acc[ai][1][m][1][jj] * rs); }
                *(u32x4*)(BZ + off) = pk8(r0, r1);
            }
        }
    }
};
struct EpiL1 {
    static constexpr bool PERM = true, AFTER_DRAIN = false;
    unsigned char* ws; int i;
    DI void operator()(AccRef acc, const Unit& u, int wr, int wc, int fr, int fq) const {
        unsigned char* w = launder(ws); const u64* ssq_x = ssq_arr(w, SSQ_X + i); unsigned char* big = w + WS_BIG;
        bf16_t *Q = (bf16_t*)(big + L_Q), *K = (bf16_t*)(big + L_K), *VT = (bf16_t*)(big + L_VT), *OG = (bf16_t*)(big + L_OG);
        EPI_LOOP_AM {
            const int row = EPI_ROW(u, ai, m); const float rs = ssq_rstd(ssq_x + row, 1.f / 1024.f);
            if (u.pn < 16) {
#pragma unroll
                for (int bj = 0; bj < 2; ++bj) {
                    const int col = u.pn * 256 + bj * 128 + wc * 32 + 8 * fq;
                    const f32x4 v0 = acc[ai][bj][m][0] * rs, v1 = acc[ai][bj][m][1] * rs; const u32x4 wv = pk8(v0, v1);
                    if (u.pn < 4) *(u32x4*)(Q + (size_t)row * 1024 + col) = wv;
                    else if (u.pn < 8) *(u32x4*)(K + (size_t)row * 1024 + (col - 1024)) = wv;
                    else { const int b = row >> 11, s = row & 2047; store_vt8(VT + ((size_t)(b * 2048 + (col - 2048))) * S + s, wv); }
                }
            } else {
                const size_t off = (size_t)row * 2048 + (u.pn - 16) * 128 + wc * 32 + 8 * fq; f32x4 r0, r1;
#pragma unroll
                for (int jj = 0; jj < 4; ++jj) { r0[jj] = sigm(acc[ai][0][m][0][jj] * rs) * silu(acc[ai][1][m][0][jj] * rs); r1[jj] = sigm(acc[ai][0][m][1][jj] * rs) * silu(acc[ai][1][m][1][jj] * rs); }
                *(u32x4*)(OG + off) = pk8(r0, r1);
            }
        }
    }
};
constexpr int AT_KSTR = 208, AT_VSTR = 136, AT_KB = 64 * AT_KSTR, AT_VB = 64 * AT_VSTR;
#define MFMA32(a, b, c) __builtin_amdgcn_mfma_f32_32x32x16_bf16((a), (b), (c), 0, 0, 0)
#define MFMA16(a, b, c) __builtin_amdgcn_mfma_f32_16x16x32_bf16((a), (b), (c), 0, 0, 0)
DI bf16x8 cat4(s16x4 lo, s16x4 hi) { return __builtin_shufflevector(lo, hi, 0, 1, 2, 3, 4, 5, 6, 7); }

struct AttnT { const bf16_t *Q, *KN, *KR, *VT; bf16_t* SZOG; };
DI void attn_unit(LAS unsigned char* lds, const AttnT& T, int b, int h, int qb) {
    const int tid = tidx(), w = __builtin_amdgcn_readfirstlane(tid >> 6), lane = tid & 63, r = lane & 31, hh = lane >> 5;
    const int tok0 = b * S, row0 = tok0 + qb * 256 + 32 * w;
    bf16x8 qf[6];
#pragma unroll
    for (int ks = 0; ks < 6; ++ks) qf[ks] = *(const bf16x8*)(T.Q + (size_t)(row0 + r) * 1536 + 96 * h + 16 * ks + 8 * hh);
    f32x16 O0, O1;
#pragma unroll
    for (int i = 0; i < 16; ++i) { O0[i] = 0.f; O1[i] = 0.f; }
    float mrun = -1e30f, lrun = 0.f;
    const int ntiles = 4 * qb + 4, myvis = 4 * qb + (w >> 1);
    const int kkey = tid >> 3, kch = tid & 7, rkey = tid >> 2, rch = tid & 3;
    const bf16_t* gK = T.KN + (size_t)(tok0 + kkey) * 1024 + 64 * h + 8 * kch;
    const bf16_t* gR = T.KR + (size_t)(tok0 + rkey) * 32 + 8 * rch;
    const bf16_t* gV = T.VT + ((size_t)(b * 1024 + 64 * h + kkey)) * S + 8 * kch;
    const int lK = kkey * AT_KSTR + 16 * kch, lR = rkey * AT_KSTR + 128 + 16 * rch, lV = kkey * AT_VSTR + 16 * kch;
    u32x4 sK, sR, sV;
    sK = *(const u32x4*)gK; if (tid < 256) sR = *(const u32x4*)gR; sV = *(const u32x4*)gV;
    {   LAS unsigned char* kb = lds; LAS unsigned char* vb = lds + 2 * AT_KB;
        *(LAS u32x4*)(kb + lK) = sK; if (tid < 256) *(LAS u32x4*)(kb + lR) = sR;
        *(LAS u32x2*)(vb + lV) = (u32x2){sV.x, sV.y}; *(LAS u32x2*)(vb + lV + 8) = (u32x2){sV.z, sV.w}; }
    __syncthreads();
    for (int kt = 0; kt < ntiles; ++kt) {
        const bool more = kt + 1 < ntiles;
        if (more) { sK = *(const u32x4*)(gK + (size_t)(kt + 1) * 64 * 1024); if (tid < 256) sR = *(const u32x4*)(gR + (size_t)(kt + 1) * 64 * 32); sV = *(const u32x4*)(gV + (kt + 1) * 64); }
        if (kt <= myvis) {
            const LAS unsigned char* kb = lds + (kt & 1) * AT_KB; const LAS unsigned char* vb = lds + 2 * AT_KB + (kt & 1) * AT_VB;
            f32x16 s0, s1;
#pragma unroll
            for (int i = 0; i < 16; ++i) { s0[i] = 0.f; s1[i] = 0.f; }
#pragma unroll
            for (int ks = 0; ks < 6; ++ks) {
                const bf16x8 a0 = *(const LAS bf16x8*)(kb + r * AT_KSTR + (16 * ks + 8 * hh) * 2);
                const bf16x8 a1 = *(const LAS bf16x8*)(kb + (32 + r) * AT_KSTR + (16 * ks + 8 * hh) * 2);
                s0 = MFMA32(a0, qf[ks], s0); s1 = MFMA32(a1, qf[ks], s1);
            }
            float mx = s0[0];
#pragma unroll
            for (int i = 1; i < 16; ++i) mx = fmaxf(mx, s0[i]);
#pragma unroll
            for (int i = 0; i < 16; ++i) mx = fmaxf(mx, s1[i]);
            mx = fmaxf(mx, __shfl_xor(mx, 32));
            const float mnew = fmaxf(mrun, mx), alpha = ex2(mrun - mnew); mrun = mnew;
            float ps = 0.f;
#pragma unroll
            for (int i = 0; i < 16; ++i) { s0[i] = ex2(s0[i] - mnew); s1[i] = ex2(s1[i] - mnew); ps += s0[i] + s1[i]; }
            lrun = lrun * alpha + ps;
#pragma unroll
            for (int i = 0; i < 16; ++i) { O0[i] *= alpha; O1[i] *= alpha; }
#pragma unroll
            for (int kb2 = 0; kb2 < 2; ++kb2)
#pragma unroll
                for (int s = 0; s < 2; ++s) {
                    const f32x16& sx = kb2 ? s1 : s0;
                    u32x4 pw; pw.x = pk2(sx[8 * s + 0], sx[8 * s + 1]); pw.y = pk2(sx[8 * s + 2], sx[8 * s + 3]); pw.z = pk2(sx[8 * s + 4], sx[8 * s + 5]); pw.w = pk2(sx[8 * s + 6], sx[8 * s + 7]);
                    const bf16x8 pf = __builtin_bit_cast(bf16x8, pw);
                    const int ko = (32 * kb2 + 16 * s + 4 * hh) * 2;
                    const bf16x8 v0 = cat4(*(const LAS s16x4*)(vb + r * AT_VSTR + ko), *(const LAS s16x4*)(vb + r * AT_VSTR + ko + 16));
                    const bf16x8 v1 = cat4(*(const LAS s16x4*)(vb + (32 + r) * AT_VSTR + ko), *(const LAS s16x4*)(vb + (32 + r) * AT_VSTR + ko + 16));
                    O0 = MFMA32(v0, pf, O0); O1 = MFMA32(v1, pf, O1);
                }
        }
        if (more) { LAS unsigned char* kb = lds + ((kt + 1) & 1) * AT_KB; LAS unsigned char* vb = lds + 2 * AT_KB + ((kt + 1) & 1) * AT_VB;
            *(LAS u32x4*)(kb + lK) = sK; if (tid < 256) *(LAS u32x4*)(kb + lR) = sR;
            *(LAS u32x2*)(vb + lV) = (u32x2){sV.x, sV.y}; *(LAS u32x2*)(vb + lV + 8) = (u32x2){sV.z, sV.w}; }
        __syncthreads();
    }
    const float linv = 1.f / (lrun + __shfl_xor(lrun, 32));
    bf16_t* op = T.SZOG + (size_t)(row0 + r) * 1024 + 64 * h + 4 * hh;
#pragma unroll
    for (int db = 0; db < 2; ++db)
#pragma unroll
        for (int g4 = 0; g4 < 4; ++g4) {
            const f32x16& ox = db ? O1 : O0; bf16_t* p = op + 32 * db + 8 * g4;
            const u32x2 z = *(const u32x2*)p; u32x2 o;
            o.x = pk2(ox[4 * g4 + 0] * linv * bflo(z.x), ox[4 * g4 + 1] * linv * bfhi(z.x)); o.y = pk2(ox[4 * g4 + 2] * linv * bflo(z.y), ox[4 * g4 + 3] * linv * bfhi(z.y));
            *(u32x2*)p = o;
        }
}
DI void attn_phase(LAS unsigned char* lds, const AttnT& T, int cu) {
    const int bh = (cu & 7) + 8 * (cu >> 4), half = (cu >> 3) & 1, b = bh >> 4, h = bh & 15;
#pragma unroll 1
    for (int ui = 0; ui < 4; ++ui) attn_unit(lds, T, b, h, ((half ? 0x2516 : 0x3407) >> (4 * ui)) & 0xF);
}

DI void conv_phase(const bf16_t* CH, bf16_t* BZ, const float* cw, int gt, int NGT) {
    for (int i = gt; i < M * 128; i += NGT) {
        const int m = i >> 7, c8 = (i & 127) * 8, t = m & (S - 1);
        f32x4 w0a = *(const f32x4*)(cw + c8), w0b = *(const f32x4*)(cw + c8 + 4), w1a = *(const f32x4*)(cw + 1024 + c8), w1b = *(const f32x4*)(cw + 1024 + c8 + 4), w2a = *(const f32x4*)(cw + 2048 + c8), w2b = *(const f32x4*)(cw + 2048 + c8 + 4);
        f32x4 a, b2, ya, yb; unpk8(*(const u32x4*)(CH + (size_t)m * 1024 + c8), a, b2); ya = w2a * a; yb = w2b * b2;
        if (t >= 1) { unpk8(*(const u32x4*)(CH + (size_t)(m - 1) * 1024 + c8), a, b2); ya += w1a * a; yb += w1b * b2; }
        if (t >= 2) { unpk8(*(const u32x4*)(CH + (size_t)(m - 2) * 1024 + c8), a, b2); ya += w0a * a; yb += w0b * b2; }
        unpk8(*(const u32x4*)(BZ + (size_t)m * 1024 + c8), a, b2);
        *(u32x4*)(BZ + (size_t)m * 1024 + c8) = pk8(a * ya, b2 * yb);
    }
}

DI void gates_phase(const bf16_t* XB, const u64* ssq_x, const float* Wg8, const float* bg, float* IG, float* LF, int gw, int NGW, int lane) {
    for (int m = gw; m < M; m += NGW) {
        float acc[8];
#pragma unroll
        for (int j = 0; j < 8; ++j) acc[j] = 0.f;
#pragma unroll
        for (int half = 0; half < 2; ++half) {
            const int k0 = half * 512 + lane * 8; f32x4 xa, xb2; unpk8(*(const u32x4*)(XB + (size_t)m * 1024 + k0), xa, xb2);
#pragma unroll
            for (int j = 0; j < 8; ++j) { const f32x4 wa = *(const f32x4*)(Wg8 + j * 1024 + k0), wb = *(const f32x4*)(Wg8 + j * 1024 + k0 + 4);
                acc[j] += (xa[0] * wa[0] + xa[1] * wa[1]) + (xa[2] * wa[2] + xa[3] * wa[3]) + (xb2[0] * wb[0] + xb2[1] * wb[1]) + (xb2[2] * wb[2] + xb2[3] * wb[3]); }
        }
        const float rs = ssq_rstd(ssq_x + m, 1.f / 1024.f);
#pragma unroll
        for (int j = 0; j < 8; ++j) acc[j] = wave_sum(acc[j]) * rs + bg[j];
        if (lane == 0) {
            *(f32x4*)(IG + (size_t)m * 4) = (f32x4){acc[0], acc[1], acc[2], acc[3]};
            f32x4 lf;
#pragma unroll
            for (int j = 0; j < 4; ++j) { const float x = acc[4 + j]; lf[j] = fminf(x, 0.f) - log1pf(__expf(-fabsf(x))); }
            *(f32x4*)(LF + (size_t)m * 4) = lf;
        }
    }
}
DI void gw8_prep(const float* w_in, const float* g, float* Wg8, int gt, int NGT) {
    for (int i = gt; i < 8 * 1024; i += NGT) { const int j = i >> 10, k = i & 1023; Wg8[i] = w_in[(size_t)k * 8200 + 8192 + j] * g[k]; }
}

constexpr int SC_QSTR = 528, SC_VSTR = 136;
constexpr int SC_QS = 0, SC_KS = 64 * SC_QSTR, SC_VS = 2 * 64 * SC_QSTR, SC_SP = SC_VS + 64 * SC_VSTR, SC_QCX = SC_SP + 64 * SC_VSTR, SC_VEC = SC_QCX + 16384;
constexpr int V_A2 = 0, V_C2 = 64, V_WI = 128, V_EM = 192, V_WS = 256, V_QN = 320, V_RS = 384  , V_NV = 640, V_MISC = 896;
constexpr int SC_END = SC_VEC + 904 * 4;
static_assert(SC_END <= 131072, "scan LDS");
struct ScanT { const bf16_t *Q, *K, *VT; bf16_t* OG; const float *IG, *LF; };
DI float scan_add(float v, int lane) {
#pragma unroll
    for (int o = 1; o < 64; o <<= 1) { const float t = __shfl_up(v, o); if (lane >= o) v += t; }
    return v;
}
DI float scan_max(float v, int lane) {
#pragma unroll
    for (int o = 1; o < 64; o <<= 1) { const float t = __shfl_up(v, o); if (lane >= o) v = fmaxf(v, t); }
    return v;
}
DI void scan_item(LAS unsigned char* lds, const ScanT& T, int b, int h, int sl) {
    const int tid = tidx(), w = __builtin_amdgcn_readfirstlane(tid >> 6), lane = tid & 63, g = w >> 2, c = w & 3, l15 = lane & 15, q = lane >> 4;
    const int tok0 = b * S;
    LAS float* vec = (LAS float*)(lds + SC_VEC);
    f32x4 Cacc[8];
#pragma unroll
    for (int i = 0; i < 8; ++i) Cacc[i] = (f32x4){0.f, 0.f, 0.f, 0.f};
    float nreg = 0.f, mrun = 0.f;
    if (tid < 256) vec[V_NV + tid] = 0.f;
    u32x4 sQ[4], sK[4], sV;
    const int vd = tid >> 3, vch = tid & 7;
    const bf16_t* gQ = T.Q + (size_t)tok0 * 1024 + 256 * h;
    const bf16_t* gK = T.K + (size_t)tok0 * 1024 + 256 * h;
    const bf16_t* gV = T.VT + ((size_t)(b * 2048 + 512 * h + 64 * sl + vd)) * S + 8 * vch;
#define SC_LOAD(ci) do { _Pragma("unroll") for (int i = 0; i < 4; ++i) { const int e = tid + i * NTHR, row = e >> 5, ch = e & 31; \
        sQ[i] = *(const u32x4*)(gQ + (size_t)((ci) * 64 + row) * 1024 + 8 * ch); sK[i] = *(const u32x4*)(gK + (size_t)((ci) * 64 + row) * 1024 + 8 * ch); } \
        sV = *(const u32x4*)(gV + (ci) * 64); } while (0)
    SC_LOAD(0);
    for (int ci = 0; ci < S / 64; ++ci) {
#pragma unroll
        for (int i = 0; i < 4; ++i) { const int e = tid + i * NTHR, row = e >> 5, ch = e & 31; *(LAS u32x4*)(lds + SC_QS + row * SC_QSTR + 16 * ch) = sQ[i]; *(LAS u32x4*)(lds + SC_KS + row * SC_QSTR + 16 * ch) = sK[i]; }
        *(LAS u32x2*)(lds + SC_VS + vd * SC_VSTR + 16 * vch) = (u32x2){sV.x, sV.y}; *(LAS u32x2*)(lds + SC_VS + vd * SC_VSTR + 16 * vch + 8) = (u32x2){sV.z, sV.w};
        if (w == 0) {
            const size_t gi = (size_t)(tok0 + ci * 64 + lane) * 4 + h;
            const float lfv = T.LF[gi], igv = T.IG[gi];
            const float bb = scan_add(lfv, lane), cc = igv - bb, pm = scan_max(cc, lane);
            const float mt = fmaxf(bb + mrun, bb + pm);
            const float blast = __shfl(bb, 63), cmax = __shfl(pm, 63);
            const float mnew = fmaxf(blast + mrun, blast + cmax);
            vec[V_A2 + lane] = (bb - mt) * LOG2E; vec[V_C2 + lane] = cc * LOG2E; vec[V_WI + lane] = __expf(bb + mrun - mt); vec[V_EM + lane] = __expf(-mt);
            vec[V_WS + lane] = __expf(blast + cc - mnew);
            if (lane == 0) vec[V_MISC] = __expf(blast + mrun - mnew);
            mrun = mnew;
        }
        __syncthreads();
        if (ci + 1 < S / 64) SC_LOAD(ci + 1);
        {
            const int sb = w >> 1;
#pragma unroll
            for (int tt = 0; tt < 2; ++tt) {
                const int tb = 2 * (w & 1) + tt;
                if (sb <= tb) {
                    f32x4 a4 = (f32x4){0.f, 0.f, 0.f, 0.f};
#pragma unroll
                    for (int ks = 0; ks < 8; ++ks) {
                        const bf16x8 ka = *(const LAS bf16x8*)(lds + SC_KS + (16 * sb + l15) * SC_QSTR + 64 * ks + 16 * q);
                        const bf16x8 qb2 = *(const LAS bf16x8*)(lds + SC_QS + (16 * tb + l15) * SC_QSTR + 64 * ks + 16 * q);
                        a4 = MFMA16(ka, qb2, a4);
                    }
                    const int t = 16 * tb + l15, s0 = 16 * sb + 4 * q; const float a2 = vec[V_A2 + t]; const f32x4 c2 = *(const LAS f32x4*)(vec + V_C2 + s0);
                    float rsum = 0.f;
#pragma unroll
                    for (int r2 = 0; r2 < 4; ++r2) { const float wgt = (s0 + r2 <= t) ? ex2(a2 + c2[r2]) : 0.f; a4[r2] *= wgt; rsum += a4[r2]; }
                    u32x2 pw; pw.x = pk2(a4[0], a4[1]); pw.y = pk2(a4[2], a4[3]);
                    *(LAS u32x2*)(lds + SC_SP + t * SC_VSTR + s0 * 2) = pw;
                    rsum = red_fq(rsum); if (q == 0) vec[V_RS + 64 * sb + t] = rsum;
                } else {
                    const int t = 16 * tb + l15, s0 = 16 * sb + 4 * q;
                    *(LAS u32x2*)(lds + SC_SP + t * SC_VSTR + s0 * 2) = (u32x2){0u, 0u};
                    if (q == 0) vec[V_RS + 64 * sb + t] = 0.f;
                }
            }
        }
        f32x4 qc[4];
        {
            bf16x8 cf[4];
#pragma unroll
            for (int ks = 0; ks < 4; ++ks) { u32x4 cw; cw.x = pk2(Cacc[2 * ks][0], Cacc[2 * ks][1]); cw.y = pk2(Cacc[2 * ks][2], Cacc[2 * ks][3]); cw.z = pk2(Cacc[2 * ks + 1][0], Cacc[2 * ks + 1][1]); cw.w = pk2(Cacc[2 * ks + 1][2], Cacc[2 * ks + 1][3]); cf[ks] = __builtin_bit_cast(bf16x8, cw); }
#pragma unroll
            for (int tb = 0; tb < 4; ++tb) {
                qc[tb] = (f32x4){0.f, 0.f, 0.f, 0.f};
#pragma unroll
                for (int ks = 0; ks < 4; ++ks) {
                    const LAS unsigned char* qp = lds + SC_QS + (16 * tb + l15) * SC_QSTR + (128 * g + 32 * ks + 4 * q) * 2;
                    const bf16x8 qa = cat4(*(const LAS s16x4*)qp, *(const LAS s16x4*)(qp + 32));
                    qc[tb] = MFMA16(qa, cf[ks], qc[tb]);
                }
            }
            LAS f32x4* qx = (LAS f32x4*)(lds + SC_QCX) + (w * 2) * 64 + lane;
            qx[0] = g ? qc[0] : qc[2]; qx[64] = g ? qc[1] : qc[3];
        }
        {
            const int t = tid >> 3, part = tid & 7; float a = 0.f;
#pragma unroll
            for (int i = 0; i < 4; ++i) { f32x4 x0, x1; unpk8(*(const LAS u32x4*)(lds + SC_QS + t * SC_QSTR + 64 * part + 16 * i), x0, x1);
                const f32x4 n0 = *(const LAS f32x4*)(vec + V_NV + 32 * part + 8 * i), n1 = *(const LAS f32x4*)(vec + V_NV + 32 * part + 8 * i + 4);
                a += (x0[0] * n0[0] + x0[1] * n0[1]) + (x0[2] * n0[2] + x0[3] * n0[3]) + (x1[0] * n1[0] + x1[1] * n1[1]) + (x1[2] * n1[2] + x1[3] * n1[3]); }
            a += __shfl_xor(a, 1); a += __shfl_xor(a, 2); a += __shfl_xor(a, 4);
            if (part == 0) vec[V_QN + t] = a;
        }
        __syncthreads();
        bf16x8 vf[2];
#pragma unroll
        for (int ks = 0; ks < 2; ++ks) { const LAS unsigned char* vp = lds + SC_VS + (16 * c + l15) * SC_VSTR + 64 * ks + 16 * q; vf[ks] = cat4(*(const LAS s16x4*)vp, *(const LAS s16x4*)(vp + 8)); }
        {
            const LAS f32x4* px = (const LAS f32x4*)(lds + SC_QCX) + ((w ^ 4) * 2) * 64 + lane;
#pragma unroll
            for (int tt = 0; tt < 2; ++tt) {
                const int tb = 2 * g + tt;
                f32x4 sv = (f32x4){0.f, 0.f, 0.f, 0.f};
#pragma unroll
                for (int ks = 0; ks < 2; ++ks) { const LAS unsigned char* sp = lds + SC_SP + (16 * tb + l15) * SC_VSTR + 64 * ks + 16 * q; const bf16x8 sa = cat4(*(const LAS s16x4*)sp, *(const LAS s16x4*)(sp + 8)); sv = MFMA16(sa, vf[ks], sv); }
                const f32x4 qct = (g ? qc[2 + tt] : qc[tt]) + px[64 * tt];
                const int t0 = 16 * tb + 4 * q;
                const f32x4 wi = *(const LAS f32x4*)(vec + V_WI + t0), em = *(const LAS f32x4*)(vec + V_EM + t0), qn = *(const LAS f32x4*)(vec + V_QN + t0),
                    rs = (*(const LAS f32x4*)(vec + V_RS + t0) + *(const LAS f32x4*)(vec + V_RS + 64 + t0)) + (*(const LAS f32x4*)(vec + V_RS + 128 + t0) + *(const LAS f32x4*)(vec + V_RS + 192 + t0));
#pragma unroll
                for (int r2 = 0; r2 < 4; ++r2) {
                    const float num = wi[r2] * qct[r2] + sv[r2], den = wi[r2] * qn[r2] + rs[r2];
                    const float hv = num / fmaxf(fabsf(den), em[r2]);
                    bf16_t* op = T.OG + (size_t)(tok0 + ci * 64 + t0 + r2) * 2048 + 512 * h + 64 * sl + 16 * c + l15;
                    *op = (bf16_t)(pk2(hv * bf1(*op), 0.f) & 0xffff);
                }
            }
        }
        {
            const float decay = vec[V_MISC];
            bf16x8 vw[2];
#pragma unroll
            for (int ks = 0; ks < 2; ++ks) {
                const f32x4 w0 = *(const LAS f32x4*)(vec + V_WS + 32 * ks + 8 * q), w1 = *(const LAS f32x4*)(vec + V_WS + 32 * ks + 8 * q + 4);
                f32x4 x0, x1; unpk8(__builtin_bit_cast(u32x4, vf[ks]), x0, x1); vw[ks] = __builtin_bit_cast(bf16x8, pk8(x0 * w0, x1 * w1));
            }
#pragma unroll
            for (int i = 0; i < 8; ++i) {
                Cacc[i] *= decay;
#pragma unroll
                for (int ks = 0; ks < 2; ++ks) {
                    LAS unsigned char* kp = lds + SC_KS + (32 * ks + 8 * q + (l15 >> 2)) * SC_QSTR + (128 * g + 16 * i + 4 * (lane & 3)) * 2;
                    const s16x4 lo = __builtin_amdgcn_ds_read_tr16_b64_v4i16((LAS s16x4*)kp), hi = __builtin_amdgcn_ds_read_tr16_b64_v4i16((LAS s16x4*)(kp + 4 * SC_QSTR));
                    Cacc[i] = MFMA16(cat4(lo, hi), vw[ks], Cacc[i]);
                }
            }
            if (tid < 256) {
                float a = 0.f;
#pragma unroll 8
                for (int s = 0; s < 64; ++s) a += vec[V_WS + s] * bf1(*(const LAS bf16_t*)(lds + SC_KS + s * SC_QSTR + 2 * tid));
                nreg = decay * nreg + a; vec[V_NV + tid] = nreg;
            }
        }
        __syncthreads();
    }
#undef SC_LOAD
}
DI void scan_phase(LAS unsigned char* lds, const ScanT& T, int cu) {
    const int xcd = cu & 7, idx = cu >> 3, bh = xcd * 4 + (idx >> 3), sl = idx & 7;
    scan_item(lds, T, bh >> 2, bh & 3, sl);
}

DI void final_phase(float* x, const u64* ssq, const float* g, int gw, int NGW, int lane) {
    for (int m = gw; m < M; m += NGW) {
        const float rs = ssq_rstd(ssq + m, 1.f / 1024.f);
        f32x4* xr = (f32x4*)(x + (size_t)m * D) + lane;
#pragma unroll
        for (int j = 0; j < 4; ++j) { const f32x4 gv = ((const f32x4*)g)[lane + 64 * j]; xr[64 * j] = xr[64 * j] * rs * gv; }
    }
}
constexpr int LDS_BYTES = 147456, MISC_OFF = 131072;
constexpr int PH_PER_LAYER = 6, PH_FINAL = 1 + 4 * PH_PER_LAYER, PH_REFRESH = 100;
#ifndef PHM
#define PHM 0xFFFF
#endif
#define PH_ON(b) ((PHM >> (b)) & 1)
typedef const __attribute__((address_space(4))) Args* KArgs;
DI KArgs kargs() { KArgs p = (KArgs)__builtin_amdgcn_kernarg_segment_ptr(); asm volatile("" : "+s"(p)); return p; }

__global__ void __launch_bounds__(NTHR, 2) fwd(Args a_) {
    extern __shared__ __attribute__((aligned(16))) unsigned char lds_[];
    LAS unsigned char* lds = (LAS unsigned char*)lds_;
    const int cu = blockIdx.x, G = gridDim.x;
#define TID_DEFS const int tid = tidx(), w = __builtin_amdgcn_readfirstlane(tid >> 6), lane = tid & 63; (void)w; (void)lane
#define GW (cu * 8 + w)
#define NGW (G * 8)
#define GT (cu * NTHR + tid)
#define NGT (G * NTHR)
    const int lo = a_.ph_lo, hi = a_.ph_hi;
    volatile LAS unsigned* misc = (volatile LAS unsigned*)(lds + MISC_OFF);
    { TID_DEFS; if (tid < 32) misc[tid] = 0u; }
    __syncthreads();
    const bool multi = (hi - lo) > 1;
    XcdBarrier bar; bar.bar = nullptr; bar.x = 0; bar.st = misc + 8;
    if (multi) bar = xcd_barrier_post((unsigned*)(kargs()->ws + WS_CTL), misc + 8);
#define IN(k) (lo <= (k) && (k) < hi)
#define SEAM(k) do { if (multi && (k) + 1 < hi) { XcdBarrier b2 = bar; b2.bar = (unsigned*)(kargs()->ws + WS_CTL); xcd_barrier(b2); } } while (0)

    if (lo >= PH_REFRESH) {
        TID_DEFS; KArgs A = kargs(); const int i = lo - PH_REFRESH; rows_to_bf16_ssq(A->out, (bf16_t*)(A->ws + WS_XBA), ssq_arr(A->ws, SSQ_X + i), GW, NGW, lane); return;
    }
    if (IN(0)) {
        TID_DEFS; KArgs A = kargs(); unsigned char* ws = A->ws;
        rows_to_bf16_ssq(A->in[I_X], (bf16_t*)(ws + WS_XBA), ssq_arr(ws, SSQ_X), GW, NGW, lane);
        rope_tables((const int*)A->in[I_POS], (float*)(ws + WS_CS), (float*)(ws + WS_SN), GT, NGT);
        SEAM(0);
    }
#pragma unroll 1
    for (int i = 0; i < 4; ++i) {
        const int kind = i % 3, j = i / 3, base = 1 + PH_PER_LAYER * i;
        if (hi <= base || lo >= base + PH_PER_LAYER) continue;
        if (IN(base + 0) && PH_ON(0)) {
            TID_DEFS; KArgs A = kargs(); unsigned char* ws = A->ws;
            LAS float* scr = (LAS float*)lds;
            const float* normg = A->in[I_NORMG] + (size_t)i * D;
            bf16_t* wmix = (bf16_t*)(ws + WS_WMIX);
            prep_run1(PrepTask{A->in[I_PLE_GATE] + (size_t)i * D * D, D, nullptr, D, D, PM_ID, (bf16_t*)(ws + WS_WPLE)}, scr, cu, G);
            prep_run1(PrepTask{A->in[I_PLE_PROJ] + (size_t)i * 256 * D, D, nullptr, 256, D, PM_ID, (bf16_t*)(ws + WS_WPLE + 2 * MiB)}, scr, cu, G);
            if (kind == 0) {
                prep_run1(PrepTask{A->in[I_MLA_WIN] + (size_t)j * D * 1696, 1696, normg, D, 1792, PM_MLA_IN, wmix}, scr, cu, G);
                prep_run1(PrepTask{A->in[I_MLA_WQB] + (size_t)j * 384 * 1536, 1536, A->in[I_MLA_QN] + j * 384, 384, 1536, PM_MLA_QB, (bf16_t*)(ws + WS_WMIX + WM_QB)}, scr, cu, G);
                prep_run1(PrepTask{A->in[I_MLA_WKVB] + (size_t)j * 256 * 2048, 2048, A->in[I_MLA_KVN] + j * 256, 256, 2048, PM_MLA_KVB, (bf16_t*)(ws + WS_WMIX + WM_KVB)}, scr, cu, G);
                prep_run1(PrepTask{A->in[I_MLA_WOUT] + (size_t)j * D * D, D, nullptr, D, D, PM_ID, (bf16_t*)(ws + WS_WMIX + WM_OUT_MLA)}, scr, cu, G);
            } else if (kind == 1) {
                prep_run1(PrepTask{A->in[I_CONV_WIN] + (size_t)j * D * 4096, 4096, normg, D, 4096, PM_CONV_IN, wmix}, scr, cu, G);
                prep_run1(PrepTask{A->in[I_CONV_WOUT] + (size_t)j * D * D, D, nullptr, D, D, PM_ID, (bf16_t*)(ws + WS_WMIX + WM_OUT_CONV)}, scr, cu, G);
            } else {
                prep_run1(PrepTask{A->in[I_L_WIN] + (size_t)j * D * 8200, 8200, normg, D, 8192, PM_LSTM_IN, wmix}, scr, cu, G);
                prep_run1(PrepTask{A->in[I_L_WOUT] + (size_t)j * 2048 * D, D, nullptr, 2048, D, PM_ID, (bf16_t*)(ws + WS_WMIX + WM_OUT_LSTM)}, scr, cu, G);
                gw8_prep(A->in[I_L_WIN] + (size_t)j * D * 8200, normg, (float*)(ws + WS_GW8), GT, NGT);
            }
            if (kind != 2) p_to_bf16(A->in[I_P] + (size_t)i * M * 256, (bf16_t*)(ws + WS_BIG + A_PB), GT, NGT);
        }
        if (IN(base + 0)) SEAM(base + 0);
        if (IN(base + 1)) {
            if (kind == 0 && PH_ON(1)) {
                unsigned char* ws = kargs()->ws;
                pg8::Gemm g{(bf16_t*)(ws + WS_XBA), (bf16_t*)(ws + WS_WMIX), M, 1792, opaque(D)}; pg8::StaticOrder So; So.init(M, 1792, G, cu);
                EpiA1 E{ws, i, j};
                pg8::gemm_phase<EpiA1, pg8::StaticOrder, true, true>(lds, g, So, E);
            } else if (kind == 1 && PH_ON(2)) {
                unsigned char* ws = kargs()->ws;
                pg8::Gemm g{(bf16_t*)(ws + WS_XBA), (bf16_t*)(ws + WS_WMIX), M, 4096, opaque(D)}; pg8::StaticOrder So; So.init(M, 4096, G, cu);
                EpiC1 E{ws, i};
                pg8::gemm_phase<EpiC1, pg8::StaticOrder, true, true>(lds, g, So, E);
            } else if (kind == 2 && PH_ON(3)) {
                { TID_DEFS; KArgs A = kargs(); unsigned char* ws = A->ws;
                  gates_phase((bf16_t*)(ws + WS_XBA), ssq_arr(ws, SSQ_X + i), (const float*)(ws + WS_GW8), A->in[I_L_BG] + j * 8, (float*)(ws + WS_IG), (float*)(ws + WS_LF), GW, NGW, lane); }
                unsigned char* ws = kargs()->ws;
                pg8::Gemm g{(bf16_t*)(ws + WS_XBA), (bf16_t*)(ws + WS_WMIX), M, 8192, opaque(D)}; pg8::StaticOrder So; So.init(M, 8192, G, cu);
                EpiL1 E{ws, i};
                pg8::gemm_phase<EpiL1, pg8::StaticOrder, true, true>(lds, g, So, E);
            }
            SEAM(base + 1);
        }
        if (IN(base + 2) && kind != 2) {
            if (kind == 0 && PH_ON(4)) {
                { unsigned char* ws = kargs()->ws;
                  pg8::Gemm g{(bf16_t*)(ws + WS_BIG + A_CQ), (bf16_t*)(ws + WS_WMIX + WM_QB), M, 1536, opaque(384)}; pg8::StaticOrder So; So.init(M, 1536, G, cu);
                  EpiQ E{ws, j};
                  pg8::gemm_phase<EpiQ, pg8::StaticOrder, true, true>(lds, g, So, E); }
                { unsigned char* ws = kargs()->ws;
                  pg8::Gemm g{(bf16_t*)(ws + WS_BIG + A_CKV), (bf16_t*)(ws + WS_WMIX + WM_KVB), M, 2048, opaque(256)}; pg8::StaticOrder So; So.init(M, 2048, G, G - 1 - cu);
                  EpiKV E{ws, j};
                  pg8::gemm_phase<EpiKV, pg8::StaticOrder, true, true>(lds, g, So, E); }
            } else if (kind == 1 && PH_ON(5)) {
                TID_DEFS; KArgs A = kargs(); unsigned char* ws = A->ws;
                conv_phase((const bf16_t*)(ws + WS_BIG + C_CH), (bf16_t*)(ws + WS_BIG + C_BZ), A->in[I_CONV_W] + (size_t)j * 3 * 1024, GT, NGT);
            }
            SEAM(base + 2);
        }
        if (IN(base + 3) && kind != 1) {
            if (kind == 0 && PH_ON(6)) {
                unsigned char* big = kargs()->ws + WS_BIG;
                AttnT T{(bf16_t*)(big + A_Q), (bf16_t*)(big + A_KN), (bf16_t*)(big + A_KR), (bf16_t*)(big + A_VT), (bf16_t*)(big + A_SZ)};
                attn_phase(lds, T, cu);
            } else if (kind == 2 && PH_ON(7)) {
                { unsigned char* ws = kargs()->ws; unsigned char* big = ws + WS_BIG;
                  ScanT T{(bf16_t*)(big + L_Q), (bf16_t*)(big + L_K), (bf16_t*)(big + L_VT), (bf16_t*)(big + L_OG), (float*)(ws + WS_IG), (float*)(ws + WS_LF)};
                  scan_phase(lds, T, cu); }
                TID_DEFS; KArgs A = kargs();
                p_to_bf16(A->in[I_P] + (size_t)i * M * 256, (bf16_t*)(A->ws + WS_XBA), GT, NGT);
            }
            SEAM(base + 3);
        }
        if (IN(base + 4)) {
            const size_t xbb_off = kind == 0 ? A_XBB : kind == 1 ? C_XBB : L_XBB, pp_off = kind == 0 ? A_PP : kind == 1 ? C_PP : L_PP;
            if (PH_ON(8)) { KArgs A = kargs(); unsigned char* ws = A->ws;
              const size_t oin = kind == 0 ? A_SZ : kind == 1 ? C_BZ : L_OG, wout = kind == 2 ? WM_OUT_LSTM : WM_OUT_MLA;
              pg8::Gemm g{(bf16_t*)(ws + WS_BIG + oin), (bf16_t*)(ws + WS_WMIX + wout), M, D, opaque(kind == 2 ? 2048 : 1024)}; pg8::StaticOrder So; So.init(M, D, G, cu);
              EpiOut E{ws, i == 0 ? A->in[I_X] : A->out, A->out, xbb_off, i};
              pg8::gemm_phase<EpiOut, pg8::StaticOrder, true, true>(lds, g, So, E); }
            if (PH_ON(9)) { unsigned char* ws = kargs()->ws;
              pg8::Gemm g{kind == 2 ? (bf16_t*)(ws + WS_XBA) : (bf16_t*)(ws + WS_BIG + A_PB), (bf16_t*)(ws + WS_WPLE + 2 * MiB), M, D, opaque(256)}; pg8::StaticOrder So; So.init(M, D, G, cu);
              EpiPP E{ws, pp_off};
              pg8::gemm_phase<EpiPP, pg8::StaticOrder, true, true>(lds, g, So, E); }
            SEAM(base + 4);
        }
        if (IN(base + 5)) {
            if (PH_ON(10)) { KArgs A = kargs(); unsigned char* ws = A->ws;
              const size_t xbb_off = kind == 0 ? A_XBB : kind == 1 ? C_XBB : L_XBB, pp_off = kind == 0 ? A_PP : kind == 1 ? C_PP : L_PP;
              pg8::Gemm g{(bf16_t*)(ws + WS_BIG + xbb_off), (bf16_t*)(ws + WS_WPLE), M, D, opaque(D)}; pg8::StaticOrder So; So.init(M, D, G, cu);
              EpiPle E{ws, A->out, pp_off, i};
              pg8::gemm_phase<EpiPle, pg8::StaticOrder, true, true>(lds, g, So, E); }
            SEAM(base + 5);
        }
    }
    if (IN(PH_FINAL)) { TID_DEFS; KArgs A = kargs(); final_phase(A->out, ssq_arr(A->ws, SSQ_X + 4), A->in[I_FNORM], GW, NGW, lane); }
#undef IN
#undef SEAM
}
}
#ifndef FAST_LAYERS
#define FAST_LAYERS 15
#endif
#ifndef ONE_LAUNCH
#define ONE_LAUNCH 1
#endif

extern "C" void kernel_launch(void* const* d_in, const int* in_sizes, int n_in, void* d_out, int out_size, void* d_ws, size_t ws_size, hipStream_t stream) {
    static int grid = 0;
    if (grid == 0) {
        int dev = 0, cus = 0;
        if (n_in != 19 || ws_size < fk::WS_END || out_size != fk::M * fk::D) { fprintf(stderr, "kernel_launch: unexpected shapes (n_in %d, ws %zu, out %d)\n", n_in, ws_size, out_size); grid = -1; return; }
        if (hipGetDevice(&dev) != hipSuccess || hipDeviceGetAttribute(&cus, hipDeviceAttributeMultiprocessorCount, dev) != hipSuccess) { grid = -1; return; }
        if (hipFuncSetAttribute((const void*)fk::fwd, hipFuncAttributeMaxDynamicSharedMemorySize, fk::LDS_BYTES) != hipSuccess) { fprintf(stderr, "kernel_launch: hipFuncSetAttribute failed\n"); grid = -1; return; }
        int per_cu = 0;
        if (hipOccupancyMaxActiveBlocksPerMultiprocessor(&per_cu, (const void*)fk::fwd, fk::NTHR, fk::LDS_BYTES) != hipSuccess || per_cu < 1) { fprintf(stderr, "kernel_launch: occupancy query says %d\n", per_cu); }
        (void)hipGetLastError();
        grid = cus;
        if (grid != 256) fprintf(stderr, "kernel_launch: %d CUs (built for 256)\n", grid);
    }
    if (grid < 0) return;
    (void)hipMemsetAsync(d_ws, 0, fk::ZERO_BYTES, stream);
    fk::Args a{};
    for (int i = 0; i < 19; ++i) a.in[i] = (const float*)d_in[i];
    a.out = (float*)d_out; a.ws = (unsigned char*)d_ws;
#define LAUNCH(lo_, hi_) do { a.ph_lo = (lo_); a.ph_hi = (hi_); hipLaunchKernelGGL(fk::fwd, dim3(grid), dim3(fk::NTHR), fk::LDS_BYTES, stream, a); } while (0)
#if ONE_LAUNCH && (FAST_LAYERS == 15)
    LAUNCH(0, fk::PH_FINAL + 1);
#else
    nv::In in;
    in.x = (const float*)d_in[0]; in.p = (const float*)d_in[1]; in.pos = (const int*)d_in[2]; in.norm_g = (const float*)d_in[3];
    in.mla_w_in = (const float*)d_in[4]; in.mla_q_norm = (const float*)d_in[5]; in.mla_w_q_b = (const float*)d_in[6];
    in.mla_kv_norm = (const float*)d_in[7]; in.mla_w_kv_b = (const float*)d_in[8]; in.mla_w_out = (const float*)d_in[9];
    in.conv_w_in = (const float*)d_in[10]; in.conv_w = (const float*)d_in[11]; in.conv_w_out = (const float*)d_in[12];
    in.mlstm_w_in = (const float*)d_in[13]; in.mlstm_b_gates = (const float*)d_in[14]; in.mlstm_w_out = (const float*)d_in[15];
    in.ple_proj = (const float*)d_in[16]; in.ple_gate = (const float*)d_in[17]; in.final_norm = (const float*)d_in[18];
    float* nws = (float*)((char*)d_ws + 2 * fk::MiB);
    LAUNCH(0, 1);
    for (int i = 0; i < 4; ++i) {
        if ((FAST_LAYERS >> i) & 1) {
            if (i > 0 && !((FAST_LAYERS >> (i - 1)) & 1)) LAUNCH(fk::PH_REFRESH + i, fk::PH_REFRESH + i + 1);
            for (int s = 0; s < fk::PH_PER_LAYER; ++s) LAUNCH(1 + fk::PH_PER_LAYER * i + s, 1 + fk::PH_PER_LAYER * i + s + 1);
        } else {
            nv::layer(in, (float*)d_out, nws, stream, i, i == 0);
        }
    }
    if ((FAST_LAYERS >> 3) & 1) LAUNCH(fk::PH_FINAL, fk::PH_FINAL + 1);
    else nv::final_norm(in, (float*)d_out, stream);
#endif
#undef LAUNCH
}
```

```cpp
#include <hip/hip_runtime.h>
#include <cstdio>
#include <cstdint>
#include <math.h>
#define LAS __attribute__((address_space(3)))
#define GAS __attribute__((address_space(1)))
#define FAST_LAYERS 15
#define ONE_LAUNCH 1
namespace pg8 {
#define PG8_LAS __attribute__((address_space(3)))
typedef unsigned short bf16_t;
typedef short bf16x8 __attribute__((ext_vector_type(8)));
typedef float f32x4 __attribute__((ext_vector_type(4)));
typedef unsigned u32x4 __attribute__((ext_vector_type(4)));
constexpr int BM = 256, BK = 64, HALF = 128, HTB = HALF * BK * 2  , STAGE_BYTES = 8 * HTB, NXCD = 8, WGM = 8;

__host__ __device__ __forceinline__ int lds_byte(int r, int c) { const int st = (r >> 4) * 2 + (c >> 5), rr = r & 15, cc = c & 31, ob = rr * 64 + cc * 2; return st * 1024 + (ob ^ (((ob >> 9) & 1) << 5)); }
__host__ __device__ __forceinline__ void stage_rc(int b, int& R, int& C) { const int st = b / 1024, sb = b % 1024, swz = sb ^ (((sb >> 9) & 1) << 5); R = (st >> 1) * 16 + swz / 64; C = (st & 1) * 32 + (swz % 64) / 2; }
__host__ __device__ __forceinline__ int perm32(int rho) { const int n = rho >> 4, i = rho & 15; return 8 * (i >> 2) + 4 * n + (i & 3); }

struct Unit { int pm, pn; };
struct Gemm { const bf16_t* A; const bf16_t* Bt; int M, N, K; };

struct StaticOrder {
    int nM, nN, nwg, G, c;
    __host__ __device__ void init(int M, int N, int G_, int c_) { nM = M / BM; nN = N / BM; nwg = nM * nN; G = G_; c = c_; }
    __host__ __device__ bool next(int i, Unit& u) const {
        const long L = (long)i * G + c; if (L >= nwg) return false;
        int wgid = (int)L; { const int q = nwg / NXCD, r = nwg % NXCD, xcd = wgid % NXCD, off = wgid / NXCD; wgid = (xcd < r ? xcd * (q + 1) : r * (q + 1) + (xcd - r) * q) + off; }
        const int nig = WGM * nN, gid = wgid / nig, fm = gid * WGM, gsz = (nM - fm) < WGM ? (nM - fm) : WGM;
        u.pm = fm + ((wgid % nig) % gsz); u.pn = (wgid % nig) / gsz; return true;
    }
    __device__ __forceinline__ void a_ready(const Unit&) const {}
    __device__ __forceinline__ void done(const Unit&) const {}
};

template <class Epi, class Sched, bool ALIGN_EPI = false, bool SP2 = false>
__device__ __forceinline__ void gemm_phase(PG8_LAS unsigned char* lds, const Gemm g, const Sched& S, const Epi& E) {
    int tid_ = threadIdx.x; asm volatile("" : "+v"(tid_));
    const int tid = tid_, wid = __builtin_amdgcn_readfirstlane(tid >> 6), lane = tid & 63, wr = wid >> 2, wc = wid & 3, fr = lane & 15, fq = lane >> 4;
    const int K = g.K, nt = K / BK;
    unsigned voffA[2], voffB[2];
#pragma unroll
    for (int i = 0; i < 2; ++i) { int R, C; stage_rc(tid * 16 + i * 8192, R, C); const int Rb = Epi::PERM ? ((R & ~31) + perm32(R & 31)) : R;
        voffA[i] = (unsigned)(R * K + C) * 2u; voffB[i] = (unsigned)(Rb * K + C) * 2u; }
    const size_t kstep = (size_t)(BK * 2);
    const size_t hstep = (size_t)HALF * K * 2;
    const size_t tstep = 2 * hstep;
    const unsigned ldsw = (unsigned)wid * 1024u;
    const int aoff = lds_byte(wr * 64 + fr, fq * 8), boff = lds_byte(wc * 32 + fr, fq * 8);
#define PG8_SA(b, h) (((b) * 2 + (h)) * HTB)
#define PG8_SB(b, h) ((4 + (b) * 2 + (h)) * HTB)
#define PG8_STAGE(bufoff, gbase, voff) do { _Pragma("unroll") for (int _i = 0; _i < 2; ++_i) \
        __builtin_amdgcn_global_load_lds((const unsigned*)((const char*)(gbase) + (voff)[_i]), (PG8_LAS unsigned*)(lds + (bufoff) + ldsw + _i * 8192), 16, 0, 0); } while (0)
#define PG8_LDA(dst, b, h) do { _Pragma("unroll") for (int m = 0; m < 4; ++m) _Pragma("unroll") for (int k = 0; k < 2; ++k) dst[m][k] = *(const PG8_LAS bf16x8*)(lds + PG8_SA(b, h) + aoff + m * 2048 + k * 1024); } while (0)
#define PG8_LDB(dst, b, h) do { _Pragma("unroll") for (int n = 0; n < 2; ++n) _Pragma("unroll") for (int k = 0; k < 2; ++k) dst[n][k] = *(const PG8_LAS bf16x8*)(lds + PG8_SB(b, h) + boff + n * 2048 + k * 1024); } while (0)
#define PG8_MMA(ai, bj, At, Bt) do { __builtin_amdgcn_s_setprio(1); _Pragma("unroll") for (int m = 0; m < 4; ++m) _Pragma("unroll") for (int n = 0; n < 2; ++n) _Pragma("unroll") for (int k = 0; k < 2; ++k) \
        acc[ai][bj][m][n] = __builtin_amdgcn_mfma_f32_16x16x32_bf16(Bt[n][k], At[m][k], acc[ai][bj][m][n], 0, 0, 0); __builtin_amdgcn_s_setprio(0); } while (0)
#define PG8_WAIT_V(n) asm volatile("s_waitcnt vmcnt(" #n ")" ::: "memory")
#define PG8_WAIT_L(n) asm volatile("s_waitcnt lgkmcnt(" #n ")" ::: "memory")
#define PG8_BAR __builtin_amdgcn_s_barrier()
#define PG8_SCHED __builtin_amdgcn_sched_barrier(0)
    Unit cur, nxt; int ui = 0;
    if (!S.next(0, cur)) return;
    f32x4 acc[2][2][4][2];
#pragma unroll
    for (int a = 0; a < 2; ++a)
#pragma unroll
        for (int b = 0; b < 2; ++b)
#pragma unroll
            for (int m = 0; m < 4; ++m)
#pragma unroll
                for (int n = 0; n < 2; ++n) acc[a][b][m][n] = (f32x4){0.f, 0.f, 0.f, 0.f};
    bf16x8 At[4][2], B0[2][2], B1[2][2];
    const char* cA = (const char*)g.A + (size_t)cur.pm * tstep; const char* cB = (const char*)g.Bt + (size_t)cur.pn * tstep;
    S.a_ready(cur);
    if constexpr (SP2) {
        PG8_STAGE(PG8_SB(0, 0), cB, voffB); PG8_STAGE(PG8_SB(0, 1), cB + hstep, voffB); PG8_STAGE(PG8_SA(0, 0), cA, voffA); PG8_STAGE(PG8_SA(0, 1), cA + hstep, voffA);
        if (wr == 1) PG8_BAR;
        PG8_WAIT_V(2); PG8_BAR;
        PG8_STAGE(PG8_SB(1, 0), cB + kstep, voffB); PG8_STAGE(PG8_SA(1, 0), cA + kstep, voffA); PG8_STAGE(PG8_SB(1, 1), cB + hstep + kstep, voffB);
        PG8_WAIT_V(6); PG8_BAR;
    } else {
        PG8_STAGE(PG8_SB(0, 0), cB, voffB); PG8_STAGE(PG8_SA(0, 0), cA, voffA); PG8_STAGE(PG8_SB(0, 1), cB + hstep, voffB); PG8_STAGE(PG8_SA(0, 1), cA + hstep, voffA);
        if (wr == 1) PG8_BAR;
        PG8_WAIT_V(4); PG8_BAR;
        PG8_STAGE(PG8_SB(1, 0), cB + kstep, voffB); PG8_STAGE(PG8_SA(1, 0), cA + kstep, voffA); PG8_STAGE(PG8_SB(1, 1), cB + hstep + kstep, voffB);
        PG8_WAIT_V(6); PG8_BAR;
    }
    for (;;) {
        const bool has_next = S.next(ui + 1, nxt);
        const char* nA = has_next ? (const char*)g.A + (size_t)nxt.pm * tstep : cA; const char* nB = has_next ? (const char*)g.Bt + (size_t)nxt.pn * tstep : cB;
        for (int t = 0; t < nt; t += 2) {
            const bool last = (t == nt - 2);
            const char* a1 = cA + (size_t)(t + 1) * kstep;
            const char* a2 = last ? nA : cA + (size_t)(t + 2) * kstep; const char* b2 = last ? nB : cB + (size_t)(t + 2) * kstep;
            const char* a3 = a2 + kstep; const char* b3 = b2 + kstep;
            if (last && has_next) S.a_ready(nxt);
            if constexpr (SP2) {
            PG8_LDB(B0, 0, 0); PG8_LDB(B1, 0, 1); PG8_SCHED; PG8_LDA(At, 0, 0); PG8_STAGE(PG8_SA(1, 1), a1 + hstep, voffA);
            PG8_WAIT_V(8); PG8_WAIT_L(0); PG8_BAR; PG8_MMA(0, 0, At, B0); PG8_MMA(0, 1, At, B1); PG8_BAR; PG8_SCHED;
            PG8_LDA(At, 0, 1); PG8_STAGE(PG8_SB(0, 0), b2, voffB); PG8_STAGE(PG8_SB(0, 1), b2 + hstep, voffB); PG8_STAGE(PG8_SA(0, 0), a2, voffA);
            PG8_WAIT_V(8); PG8_WAIT_L(0); PG8_BAR; PG8_MMA(1, 0, At, B0); PG8_MMA(1, 1, At, B1); PG8_BAR; PG8_SCHED;
            PG8_LDB(B0, 1, 0); PG8_LDB(B1, 1, 1); PG8_SCHED; PG8_LDA(At, 1, 0); PG8_STAGE(PG8_SA(0, 1), a2 + hstep, voffA);
            PG8_WAIT_V(8); PG8_WAIT_L(0); PG8_BAR; PG8_MMA(0, 0, At, B0); PG8_MMA(0, 1, At, B1); PG8_BAR; PG8_SCHED;
            PG8_LDA(At, 1, 1); PG8_STAGE(PG8_SB(1, 0), b3, voffB); PG8_STAGE(PG8_SB(1, 1), b3 + hstep, voffB); PG8_STAGE(PG8_SA(1, 0), a3, voffA);
            PG8_WAIT_V(8); PG8_WAIT_L(0); PG8_BAR; PG8_MMA(1, 0, At, B0); PG8_MMA(1, 1, At, B1); PG8_BAR; PG8_SCHED;
            } else {
            PG8_LDB(B0, 0, 0); PG8_SCHED; PG8_LDA(At, 0, 0); PG8_STAGE(PG8_SA(1, 1), a1 + hstep, voffA);
            PG8_WAIT_L(8); PG8_BAR; PG8_WAIT_L(0); PG8_MMA(0, 0, At, B0); PG8_BAR; PG8_SCHED;
            PG8_LDB(B1, 0, 1); PG8_STAGE(PG8_SB(0, 0), b2, voffB);
            PG8_BAR; PG8_WAIT_L(0); PG8_MMA(0, 1, At, B1); PG8_BAR;
            PG8_LDA(At, 0, 1); PG8_STAGE(PG8_SA(0, 0), a2, voffA);
            PG8_BAR; PG8_WAIT_L(0); PG8_MMA(1, 0, At, B0); PG8_BAR; PG8_SCHED;
            PG8_STAGE(PG8_SB(0, 1), b2 + hstep, voffB);
            PG8_WAIT_V(6); PG8_BAR; PG8_MMA(1, 1, At, B1); PG8_BAR;
            PG8_LDB(B0, 1, 0); PG8_SCHED; PG8_LDA(At, 1, 0); PG8_STAGE(PG8_SA(0, 1), a2 + hstep, voffA);
            PG8_WAIT_L(8); PG8_BAR; PG8_WAIT_L(0); PG8_MMA(0, 0, At, B0); PG8_BAR; PG8_SCHED;
            PG8_LDB(B1, 1, 1); PG8_STAGE(PG8_SB(1, 0), b3, voffB);
            PG8_BAR; PG8_WAIT_L(0); PG8_MMA(0, 1, At, B1); PG8_BAR;
            PG8_LDA(At, 1, 1); PG8_STAGE(PG8_SA(1, 0), a3, voffA);
            PG8_BAR; PG8_WAIT_L(0); PG8_MMA(1, 0, At, B0); PG8_BAR; PG8_SCHED;
            PG8_STAGE(PG8_SB(1, 1), b3 + hstep, voffB);
            PG8_WAIT_V(6); PG8_BAR; PG8_MMA(1, 1, At, B1); PG8_BAR;
            }
        }
        if constexpr (ALIGN_EPI) { if (wr == 0) PG8_BAR; }
        if constexpr (!Epi::AFTER_DRAIN) { E(acc, cur, wr, wc, fr, fq); S.done(cur); }
        if (!has_next) break;
#pragma unroll
        for (int a = 0; a < 2; ++a)
#pragma unroll
            for (int b = 0; b < 2; ++b)
#pragma unroll
                for (int m = 0; m < 4; ++m)
#pragma unroll
                    for (int n = 0; n < 2; ++n) acc[a][b][m][n] = (f32x4){0.f, 0.f, 0.f, 0.f};
        cur = nxt; cA = nA; cB = nB; ++ui;
        if constexpr (ALIGN_EPI) { if (wr == 1) PG8_BAR; }
    }
    PG8_WAIT_V(0);
    if constexpr (!ALIGN_EPI) { if (wr == 0) PG8_BAR; }
    PG8_BAR;
    if constexpr (Epi::AFTER_DRAIN) { E.fused(acc, cur, wr, wc, fr, fq, lds, wid, lane); S.done(cur); }
#undef PG8_SA
#undef PG8_SB
#undef PG8_STAGE
#undef PG8_LDA
#undef PG8_LDB
#undef PG8_MMA
#undef PG8_WAIT_V
#undef PG8_WAIT_L
#undef PG8_BAR
#undef PG8_SCHED
}
}
#define XB_TMO      128
#define XB_XCNT(j)  (256  + 64 * (j))
#define XB_XSUB(j)  (1280 + 64 * (j))
#define XB_XGEN(j)  (2304 + 64 * (j))
#define XB_TOP      3328
#define XB_TOPGEN   3392
#define XCD_BAR_WORDS 3456
#define XB_SPIN_CAP (1u << 18)

__device__ __forceinline__ unsigned xb_ld(unsigned* p)              { return __hip_atomic_load(p, __ATOMIC_RELAXED, __HIP_MEMORY_SCOPE_AGENT); }
__device__ __forceinline__ unsigned xb_add(unsigned* p, unsigned v) { return __hip_atomic_fetch_add(p, v, __ATOMIC_RELAXED, __HIP_MEMORY_SCOPE_AGENT); }
__device__ __forceinline__ unsigned xb_xcc_id() { return (unsigned)__builtin_amdgcn_s_getreg((3 << 11) | 20) & 0xFu; }
#define XB_SPIN(cond, bar) do { unsigned _sp = 0; while (cond) { __builtin_amdgcn_s_sleep(1); \
    if ((++_sp & 255u) == 0u) { if (xb_ld(&(bar)[XB_TMO])) break; if (_sp > XB_SPIN_CAP) { atomicAdd(&(bar)[XB_TMO], 1u); break; } } } } while (0)

struct XcdBarrier {
    unsigned* bar; unsigned x;
    volatile LAS unsigned* st;
};

__device__ __forceinline__ XcdBarrier xcd_barrier_post(unsigned* bar, volatile LAS unsigned* st) {
    XcdBarrier b; b.bar = bar; b.x = xb_xcc_id(); b.st = st;
    if (threadIdx.x == 0) (void)xb_add(&bar[XB_XCNT(b.x)], 1u);
    return b;
}
__device__ __forceinline__ void xcd_barrier_complete(unsigned* bar, unsigned x, unsigned& nloc, unsigned& nx) {
    const unsigned G = gridDim.x * gridDim.y * gridDim.z;
    unsigned sum, cnt, mine, sp = 0u;
    for (;;) {
        sum = 0u; cnt = 0u; mine = 0u;
#pragma unroll
        for (unsigned j = 0; j < 16; ++j) { const unsigned c = xb_ld(&bar[XB_XCNT(j)]); sum += c; cnt += (c > 0u) ? 1u : 0u; mine = (j == x) ? c : mine; }
        if (sum == G) break;
        __builtin_amdgcn_s_sleep(1);
        if ((++sp & 255u) == 0u) { if (xb_ld(&bar[XB_TMO])) break; if (sp > XB_SPIN_CAP) { atomicAdd(&bar[XB_TMO], 1u); break; } }
    }
    nloc = mine > 0u ? mine : 1u; nx = cnt > 0u ? cnt : 1u;
}

__device__ __forceinline__ void xcd_barrier(const XcdBarrier& b) {
    asm volatile("s_waitcnt vmcnt(0)" ::: "memory");
    __syncthreads();
    if (threadIdx.x == 0) {
        unsigned* bar = b.bar;
        __builtin_amdgcn_s_waitcnt(0);
        unsigned nloc = b.st[0], nx = b.st[1];
        if (nloc == 0u) { xcd_barrier_complete(bar, b.x, nloc, nx); b.st[0] = nloc; b.st[1] = nx; }
        const unsigned old = xb_add(&bar[XB_XSUB(b.x)], 1u);
        const unsigned gen = old / nloc;
        if (old + 1u == (gen + 1u) * nloc) {
            __builtin_amdgcn_fence(__ATOMIC_RELEASE, "agent");
            asm volatile("s_waitcnt vmcnt(0)" ::: "memory");
            const unsigned og = xb_add(&bar[XB_TOP], 1u);
            const unsigned tg = og / nx;
            if (og + 1u == (tg + 1u) * nx) xb_add(&bar[XB_TOPGEN], 1u);
            else XB_SPIN(xb_ld(&bar[XB_TOPGEN]) == tg, bar);
            __builtin_amdgcn_fence(__ATOMIC_ACQUIRE, "agent");
            xb_add(&bar[XB_XGEN(b.x)], 1u);
            asm volatile("s_waitcnt vmcnt(0)" ::: "memory");
        } else {
            XB_SPIN(xb_ld(&bar[XB_XGEN(b.x)]) == gen, bar);
            __builtin_amdgcn_fence(__ATOMIC_ACQUIRE, "agent");
            asm volatile("s_waitcnt vmcnt(0)" ::: "memory");
        }
    }
    __syncthreads();
}
namespace fk {
using pg8::bf16_t; using pg8::bf16x8; using pg8::f32x4; using pg8::u32x4; using pg8::Unit;
typedef float f32x16 __attribute__((ext_vector_type(16)));
typedef float f32x2 __attribute__((ext_vector_type(2)));
typedef __bf16 bf16x2_t __attribute__((ext_vector_type(2)));
typedef short s16x4 __attribute__((ext_vector_type(4)));
typedef unsigned u32x2 __attribute__((ext_vector_type(2)));
#define DI __device__ __forceinline__

constexpr int NB = 8, S = 2048, M = NB * S, D = 1024;
constexpr float EPS = 1e-6f, LOG2E = 1.4426950408889634f;
constexpr int NTHR = 512;

DI int tidx() { int t = threadIdx.x; asm volatile("" : "+v"(t)); return t; }
DI unsigned pk2(float lo, float hi) { f32x2 v = {lo, hi}; return __builtin_bit_cast(unsigned, __builtin_convertvector(v, bf16x2_t)); }
DI float bflo(unsigned u) { return __uint_as_float(u << 16); }
DI float bfhi(unsigned u) { return __uint_as_float(u & 0xffff0000u); }
DI float bf1(unsigned short b) { return __uint_as_float((unsigned)b << 16); }
DI float sigm(float x) { return 1.f / (1.f + __expf(-x)); }
DI float silu(float x) { return x * sigm(x); }
DI float ex2(float x) { return __builtin_amdgcn_exp2f(x); }
DI u32x4 pk8(const f32x4& a, const f32x4& b) { u32x4 w; w.x = pk2(a[0], a[1]); w.y = pk2(a[2], a[3]); w.z = pk2(b[0], b[1]); w.w = pk2(b[2], b[3]); return w; }
DI void unpk8(u32x4 w, f32x4& a, f32x4& b) { a[0] = bflo(w.x); a[1] = bfhi(w.x); a[2] = bflo(w.y); a[3] = bfhi(w.y); b[0] = bflo(w.z); b[1] = bfhi(w.z); b[2] = bflo(w.w); b[3] = bfhi(w.w); }

constexpr size_t KiB = 1024, MiB = 1u << 20;
constexpr size_t WS_CTL = 0;
constexpr size_t WS_SSQ = 64 * KiB;
constexpr int SSQ_X = 0  , SSQ_1 = 5  , SSQ_Q = 9  , SSQ_KV = 11  ;
constexpr size_t ZERO_BYTES = 1792 * KiB;
constexpr size_t WS_GW8 = 1792 * KiB;
constexpr size_t WS_WMIX = 2 * MiB;
constexpr size_t WS_WPLE = 23 * MiB;
constexpr size_t WS_XBA = 26 * MiB;
constexpr size_t WS_BIG = 58 * MiB;
constexpr size_t WS_CS = WS_BIG + 192 * MiB, WS_SN = WS_CS + 1 * MiB, WS_IG = WS_SN + 1 * MiB, WS_LF = WS_IG + 256 * KiB;
constexpr size_t WS_END = 256 * MiB;
static_assert(WS_LF + 256 * KiB <= WS_END, "ws map");
constexpr size_t WM_IN = 0, WM_QB = 4 * MiB, WM_KVB = 6 * MiB, WM_OUT_MLA = 8 * MiB, WM_OUT_CONV = 8 * MiB, WM_OUT_LSTM = 16 * MiB;
constexpr size_t A_SZ = 0, A_Q = 32 * MiB, A_KN = 80 * MiB, A_VT = 112 * MiB, A_CQ = 144 * MiB, A_CKV = 156 * MiB, A_KR = 164 * MiB, A_XBB = 32 * MiB, A_PP = 80 * MiB, A_PB = 166 * MiB;
constexpr size_t C_CH = 0, C_BZ = 32 * MiB, C_XBB = 64 * MiB, C_PP = 96 * MiB, C_PB = 166 * MiB;
constexpr size_t L_Q = 0, L_K = 32 * MiB, L_VT = 64 * MiB, L_OG = 128 * MiB, L_XBB = 0, L_PP = 64 * MiB;

struct Args { const float* in[19]; float* out; unsigned char* ws; int ph_lo, ph_hi; };
enum { I_X = 0, I_P, I_POS, I_NORMG, I_MLA_WIN, I_MLA_QN, I_MLA_WQB, I_MLA_KVN, I_MLA_WKVB, I_MLA_WOUT, I_CONV_WIN, I_CONV_W, I_CONV_WOUT, I_L_WIN, I_L_BG, I_L_WOUT, I_PLE_PROJ, I_PLE_GATE, I_FNORM };

enum { PM_ID = 0, PM_MLA_IN, PM_MLA_QB, PM_MLA_KVB, PM_CONV_IN, PM_LSTM_IN };
DI int prep_src(int mode, int n, float& sc) {
    sc = 1.f;
    switch (mode) {
    case PM_MLA_IN: { if (n < 1024) return 672 + n; if (n < 1408) return n - 1024; if (n < 1664) return 384 + (n - 1408); if (n < 1696) { const int jj = n - 1664; return 640 + (jj >> 1) + 16 * (jj & 1); } return -1; }
    case PM_MLA_QB: { sc = 0.10206207261596577f * LOG2E; const int hd = n / 96, d = n % 96; if (d < 64) return n; const int jj = d - 64; return 96 * hd + 64 + (jj >> 1) + 16 * (jj & 1); }
    case PM_MLA_KVB: { if (n < 1024) return 128 * (n >> 6) + (n & 63); const int n2 = n - 1024; return 128 * (n2 >> 6) + 64 + (n2 & 63); }
    case PM_CONV_IN: { const int pn = n >> 8, bj = (n >> 7) & 1, i = n & 127; if (pn < 8) return (bj ? 2048 : 1024) + 128 * pn + i; return (bj ? 3072 : 0) + 128 * (pn - 8) + i; }
    case PM_LSTM_IN: { if (n < 4096) { if (n >= 1024 && n < 2048) sc = 0.0625f; return n; } const int n2 = n - 4096, pn = n2 >> 8, bj = (n2 >> 7) & 1, i = n2 & 127; return (bj ? 6144 : 4096) + 128 * pn + i; }
    default: return n;
    }
}
struct PrepTask { const float* W; int ldw; const float* gk; int K, Nst, mode; bf16_t* out; };
DI void prep_tile(const PrepTask& t, int tile, LAS float* scr) {
    const int tid = tidx(), nkb = t.K >> 7, nb = tile / nkb, kb = tile % nkb, n0 = nb << 6, k0 = kb << 7;
    const int nn = tid & 63, kq = tid >> 6;
    float sc; const int src = prep_src(t.mode, n0 + nn, sc);
    float v[16];
#pragma unroll
    for (int i = 0; i < 16; ++i) { const int kk = kq + 8 * i; v[i] = (src >= 0) ? t.W[(size_t)(k0 + kk) * t.ldw + src] : 0.f; }
#pragma unroll
    for (int i = 0; i < 16; ++i) { const int kk = kq + 8 * i; float x = v[i] * sc; if (t.gk) x *= t.gk[k0 + kk]; scr[nn * 129 + kk] = x; }
    __syncthreads();
#pragma unroll
    for (int h2 = 0; h2 < 2; ++h2) { const int e = tid + h2 * NTHR, n2 = e >> 4, c = e & 15; const LAS float* sp = scr + n2 * 129 + 8 * c;
      u32x4 o; o.x = pk2(sp[0], sp[1]); o.y = pk2(sp[2], sp[3]); o.z = pk2(sp[4], sp[5]); o.w = pk2(sp[6], sp[7]);
      *(u32x4*)(t.out + (size_t)(n0 + n2) * t.K + k0 + 8 * c) = o; }
    __syncthreads();
}
DI void prep_run1(const PrepTask& t, LAS float* scr, int cu, int G) {
    const int total = (t.Nst >> 6) * (t.K >> 7);
#pragma unroll 1
    for (int it = cu; it < total; it += G) prep_tile(t, it, scr);
}

DI float wave_sum(float v) {
#pragma unroll
    for (int o = 1; o < 64; o <<= 1) v += __shfl_xor(v, o);
    return v;
}
DI void rows_to_bf16_ssq(const float* x, bf16_t* xb, unsigned long long* ssq, int gw, int NGW, int lane) {
    for (int m = gw; m < M; m += 2 * NGW) {
        const int m2 = m + NGW; const bool two = m2 < M;
        const f32x4* xr = (const f32x4*)(x + (size_t)m * D) + lane; const f32x4* xr2 = (const f32x4*)(x + (size_t)(two ? m2 : m) * D) + lane;
        f32x4 v[4], v2[4];
#pragma unroll
        for (int j = 0; j < 4; ++j) { v[j] = xr[64 * j]; v2[j] = xr2[64 * j]; }
        float s = 0.f, s2 = 0.f;
        u32x2* o8 = (u32x2*)(xb + (size_t)m * D) + lane; u32x2* o82 = (u32x2*)(xb + (size_t)m2 * D) + lane;
#pragma unroll
        for (int j = 0; j < 4; ++j) {
            s += (v[j][0] * v[j][0] + v[j][1] * v[j][1]) + (v[j][2] * v[j][2] + v[j][3] * v[j][3]); u32x2 w; w.x = pk2(v[j][0], v[j][1]); w.y = pk2(v[j][2], v[j][3]); o8[64 * j] = w;
            s2 += (v2[j][0] * v2[j][0] + v2[j][1] * v2[j][1]) + (v2[j][2] * v2[j][2] + v2[j][3] * v2[j][3]); if (two) { u32x2 w2; w2.x = pk2(v2[j][0], v2[j][1]); w2.y = pk2(v2[j][2], v2[j][3]); o82[64 * j] = w2; }
        }
        s = wave_sum(s); s2 = wave_sum(s2);
        if (lane == 0) { ssq[m] = (unsigned long long)(s * 16777216.f); if (two) ssq[m2] = (unsigned long long)(s2 * 16777216.f); }
    }
}
DI void p_to_bf16(const float* p, bf16_t* pb, int gt, int NGT) {
    constexpr size_t N8 = (size_t)M * 256 / 8;
    for (size_t i = gt; i < N8; i += (size_t)4 * NGT) {
        f32x4 a[4], b[4];
#pragma unroll
        for (int k = 0; k < 4; ++k) { const size_t e = i + (size_t)k * NGT; if (e < N8) { a[k] = ((const f32x4*)p)[2 * e]; b[k] = ((const f32x4*)p)[2 * e + 1]; } }
#pragma unroll
        for (int k = 0; k < 4; ++k) { const size_t e = i + (size_t)k * NGT; if (e < N8) ((u32x4*)pb)[e] = pk8(a[k], b[k]); }
    }
}
DI void rope_tables(const int* pos, float* cs, float* sn, int gt, int NGT) {
    for (int i = gt; i < M * 16; i += NGT) {
        const int t = i >> 4, j = i & 15;
        const float inv = powf(10000.0f, -(float)(2 * j) / 32.0f);
        const float ang = (float)pos[t] * inv;
        double rev = (double)ang * 0.15915494309189533577; rev -= rint(rev);
        const float fr = (float)rev;
        cs[i] = __builtin_amdgcn_cosf(fr); sn[i] = __builtin_amdgcn_sinf(fr);
    }
}

#define EPI_ROW(u, ai, m) ((u).pm * 256 + (ai) * 128 + wr * 64 + (m) * 16 + fr)
#define EPI_LOOP_AM _Pragma("unroll") for (int ai = 0; ai < 2; ++ai) _Pragma("unroll") for (int m = 0; m < 4; ++m)
typedef const f32x4 (&AccRef)[2][2][4][2];
#ifndef NT_STORES
#define NT_STORES 0
#endif
DI void st16(bf16_t* p, const u32x4& v) { if (NT_STORES) __builtin_nontemporal_store(v, (u32x4*)p); else *(u32x4*)p = v; }
DI float sq8(const f32x4& a, const f32x4& b) { return (a[0] * a[0] + a[1] * a[1]) + (a[2] * a[2] + a[3] * a[3]) + (b[0] * b[0] + b[1] * b[1]) + (b[2] * b[2] + b[3] * b[3]); }
DI float red_fq(float s) { s += __shfl_xor(s, 16); s += __shfl_xor(s, 32); return s; }
DI void rope8(f32x4& a, f32x4& b, const float* cs, const float* sn, int row, int p0) {
    const f32x4 c = *(const f32x4*)(cs + (size_t)row * 16 + p0), s = *(const f32x4*)(sn + (size_t)row * 16 + p0);
    const f32x4 a0 = a, b0 = b;
    a[0] = a0[0] * c[0] - a0[1] * s[0]; a[1] = a0[0] * s[0] + a0[1] * c[0];
    a[2] = a0[2] * c[1] - a0[3] * s[1]; a[3] = a0[2] * s[1] + a0[3] * c[1];
    b[0] = b0[0] * c[2] - b0[1] * s[2]; b[1] = b0[0] * s[2] + b0[1] * c[2];
    b[2] = b0[2] * c[3] - b0[3] * s[3]; b[3] = b0[2] * s[3] + b0[3] * c[3];
}

DI int opaque(int v) { asm volatile("" : "+s"(v)); return v; }
template <class T> DI T* launder(T* p) { asm volatile("" : "+s"(p)); return p; }
typedef unsigned long long u64;
constexpr float SSQ_SCALE = 16777216.f, SSQ_INV = 1.f / 16777216.f;
DI u64* ssq_arr(unsigned char* ws, int idx) { return (u64*)(ws + WS_SSQ) + (size_t)idx * M; }
DI void ssq_add(u64* p, float s) { atomicAdd(p, (u64)(s * SSQ_SCALE)); }
DI float ssq_rstd(const u64* p, float invn) { return rsqrtf((float)(*p) * SSQ_INV * invn + EPS); }

#define EPI_RS8(rsarr, ssqp, invn) float rsarr[2][4]; { u64 t_[2][4]; _Pragma("unroll") for (int ai = 0; ai < 2; ++ai) _Pragma("unroll") for (int m = 0; m < 4; ++m) t_[ai][m] = (ssqp)[EPI_ROW(u, ai, m)]; \
    _Pragma("unroll") for (int ai = 0; ai < 2; ++ai) _Pragma("unroll") for (int m = 0; m < 4; ++m) rsarr[ai][m] = rsqrtf((float)t_[ai][m] * SSQ_INV * (invn) + EPS); }

struct EpiA1 {
    static constexpr bool PERM = true, AFTER_DRAIN = false;
    unsigned char* ws; int i, j;
    DI void operator()(AccRef acc, const Unit& u, int wr, int wc, int fr, int fq) const {
        unsigned char* w = launder(ws); unsigned char* big = w + WS_BIG;
        const u64* ssq_x = ssq_arr(w, SSQ_X + i); u64* ssq_q = ssq_arr(w, SSQ_Q + j); u64* ssq_kv = ssq_arr(w, SSQ_KV + j);
        bf16_t *SZ = (bf16_t*)(big + A_SZ), *CQ = (bf16_t*)(big + A_CQ), *CKV = (bf16_t*)(big + A_CKV), *KR = (bf16_t*)(big + A_KR);
        const float *CS = (const float*)(w + WS_CS), *SN = (const float*)(w + WS_SN);
        EPI_RS8(rsv, ssq_x, 1.f / 1024.f);
        EPI_LOOP_AM {
            const int row = EPI_ROW(u, ai, m); const float rs = rsv[ai][m];
            float sq = 0.f, skv = 0.f; bool hq = false, hkv = false;
#pragma unroll
            for (int bj = 0; bj < 2; ++bj) {
                f32x4 v0 = acc[ai][bj][m][0] * rs, v1 = acc[ai][bj][m][1] * rs;
                if (u.pn < 4) {
                    const int col = u.pn * 256 + bj * 128 + wc * 32 + 8 * fq;
#pragma unroll
                    for (int jj = 0; jj < 4; ++jj) { v0[jj] = silu(v0[jj]); v1[jj] = silu(v1[jj]); }
                    st16(SZ + (size_t)row * 1024 + col, pk8(v0, v1));
                } else {
                    const int c = (u.pn - 4) * 256 + bj * 128 + wc * 32 + 8 * fq;
                    if (c < 384) { st16(CQ + (size_t)row * 384 + c, pk8(v0, v1)); sq += sq8(v0, v1); hq = true; }
                    else if (c < 640) { st16(CKV + (size_t)row * 256 + (c - 384), pk8(v0, v1)); skv += sq8(v0, v1); hkv = true; }
                    else if (c < 672) { const int jj0 = c - 640; rope8(v0, v1, CS, SN, row, jj0 >> 1); st16(KR + (size_t)row * 32 + jj0, pk8(v0, v1)); }
                }
            }
            if (u.pn >= 4) {
                sq = red_fq(sq); skv = red_fq(skv);
                if (fq == 0 && hq) ssq_add(ssq_q + row, sq);
                if (fq == 0 && hkv) ssq_add(ssq_kv + row, skv);
            }
        }
    }
};
struct EpiQ {
    static constexpr bool PERM = true, AFTER_DRAIN = false;
    unsigned char* ws; int j;
    DI void operator()(AccRef acc, const Unit& u, int wr, int wc, int fr, int fq) const {
        unsigned char* w = launder(ws); const u64* ssq_q = ssq_arr(w, SSQ_Q + j); bf16_t* Q = (bf16_t*)(w + WS_BIG + A_Q);
        const float *CS = (const float*)(w + WS_CS), *SN = (const float*)(w + WS_SN);
        EPI_RS8(rsv, ssq_q, 1.f / 384.f);
        EPI_LOOP_AM {
            const int row = EPI_ROW(u, ai, m); const float rs = rsv[ai][m];
#pragma unroll
            for (int bj = 0; bj < 2; ++bj) {
                const int col = u.pn * 256 + bj * 128 + wc * 32 + 8 * fq, d = col % 96;
                f32x4 v0 = acc[ai][bj][m][0] * rs, v1 = acc[ai][bj][m][1] * rs;
                if (d >= 64) rope8(v0, v1, CS, SN, row, (d - 64) >> 1);
                st16(Q + (size_t)row * 1536 + col, pk8(v0, v1));
            }
        }
    }
};
struct EpiKV {
    static constexpr bool PERM = true, AFTER_DRAIN = false;
    unsigned char* ws; int j;
    DI void operator()(AccRef acc, const Unit& u, int wr, int wc, int fr, int fq) const {
        unsigned char* w = launder(ws); const u64* ssq_kv = ssq_arr(w, SSQ_KV + j); bf16_t* O = (bf16_t*)(w + WS_BIG + (u.pn < 4 ? A_KN : A_VT));
        EPI_RS8(rsv, ssq_kv, 1.f / 256.f);
        EPI_LOOP_AM {
            const int row = EPI_ROW(u, ai, m); const float rs = rsv[ai][m];
#pragma unroll
            for (int bj = 0; bj < 2; ++bj) {
                const int col = (u.pn & 3) * 256 + bj * 128 + wc * 32 + 8 * fq;
                st16(O + (size_t)row * 1024 + col, pk8(acc[ai][bj][m][0] * rs, acc[ai][bj][m][1] * rs));
            }
        }
    }
};
struct EpiOut {
    static constexpr bool PERM = true, AFTER_DRAIN = false;
    unsigned char* ws; size_t xbb_off; int i;
    DI void operator()(AccRef acc, const Unit& u, int wr, int wc, int fr, int fq) const {
        unsigned char* w = launder(ws); u64* ssq = ssq_arr(w, SSQ_1 + i); bf16_t* XB = (bf16_t*)(w + WS_BIG + xbb_off); const bf16_t* xin = (const bf16_t*)(w + WS_XBA);
        const size_t cb = (size_t)u.pn * 256 + wc * 32 + 8 * fq;
        u32x4 cur[2], nxt[2];
#define EO_LOAD(dst, it) do { const size_t o_ = (size_t)EPI_ROW(u, (it) >> 2, (it) & 3) * 1024 + cb; dst[0] = *(const u32x4*)(xin + o_); dst[1] = *(const u32x4*)(xin + o_ + 128); } while (0)
        EO_LOAD(cur, 0);
#pragma unroll
        for (int it = 0; it < 8; ++it) {
            const int ai = it >> 2, m = it & 3;
            if (it < 7) EO_LOAD(nxt, it + 1);
            const int row = EPI_ROW(u, ai, m); float sq = 0.f;
#pragma unroll
            for (int bj = 0; bj < 2; ++bj) {
                const size_t off = (size_t)row * 1024 + cb + bj * 128;
                f32x4 x0, x1; unpk8(cur[bj], x0, x1);
                const f32x4 y0 = x0 + acc[ai][bj][m][0], y1 = x1 + acc[ai][bj][m][1];
                *(u32x4*)(XB + off) = pk8(y0, y1); sq += sq8(y0, y1);
            }
            sq = red_fq(sq); if (fq == 0) ssq_add(ssq + row, sq);
            cur[0] = nxt[0]; cur[1] = nxt[1];
        }
#undef EO_LOAD
    }
};
struct EpiPP {
    static constexpr bool PERM = true, AFTER_DRAIN = false;
    bf16_t* pp;
    DI void operator()(AccRef acc, const Unit& u, int wr, int wc, int fr, int fq) const {
        bf16_t* PP = launder(pp);
        EPI_LOOP_AM { const int row = EPI_ROW(u, ai, m);
#pragma unroll
            for (int bj = 0; bj < 2; ++bj) { const size_t off = (size_t)row * 1024 + u.pn * 256 + bj * 128 + wc * 32 + 8 * fq; *(u32x4*)(PP + off) = pk8(acc[ai][bj][m][0], acc[ai][bj][m][1]); } }
    }
};
struct EpiPle {
    static constexpr bool PERM = true, AFTER_DRAIN = false;
    unsigned char* ws; const bf16_t* pp; size_t xbb_off; int i;
    DI void operator()(AccRef acc, const Unit& u, int wr, int wc, int fr, int fq) const {
        unsigned char* w = launder(ws); const u64* ssq1 = ssq_arr(w, SSQ_1 + i); u64* ssq = ssq_arr(w, SSQ_X + i + 1);
        const bf16_t* PP = launder(pp); const bf16_t* X1 = (const bf16_t*)(w + WS_BIG + xbb_off); bf16_t* XB = (bf16_t*)(w + WS_XBA);
        const size_t cb = (size_t)u.pn * 256 + wc * 32 + 8 * fq;
        EPI_RS8(rsv, ssq1, 1.f / 1024.f);
        u32x4 cur[2], nxt[2], pc[2], pn2[2];
#define EP_LOAD(dst, pd, it) do { const size_t o_ = (size_t)EPI_ROW(u, (it) >> 2, (it) & 3) * 1024 + cb; dst[0] = *(const u32x4*)(X1 + o_); dst[1] = *(const u32x4*)(X1 + o_ + 128); \
            pd[0] = *(const u32x4*)(PP + o_); pd[1] = *(const u32x4*)(PP + o_ + 128); } while (0)
        EP_LOAD(cur, pc, 0);
#pragma unroll
        for (int it = 0; it < 8; ++it) {
            const int ai = it >> 2, m = it & 3;
            if (it < 7) EP_LOAD(nxt, pn2, it + 1);
            const int row = EPI_ROW(u, ai, m); const float rs = rsv[ai][m]; float sq = 0.f;
#pragma unroll
            for (int bj = 0; bj < 2; ++bj) {
                const size_t off = (size_t)row * 1024 + cb + bj * 128;
                f32x4 p0, p1, y0, y1; unpk8(pc[bj], p0, p1); unpk8(cur[bj], y0, y1);
#pragma unroll
                for (int jj = 0; jj < 4; ++jj) { y0[jj] += sigm(acc[ai][bj][m][0][jj] * rs) * p0[jj]; y1[jj] += sigm(acc[ai][bj][m][1][jj] * rs) * p1[jj]; }
                *(u32x4*)(XB + off) = pk8(y0, y1); sq += sq8(y0, y1);
            }
            sq = red_fq(sq); if (fq == 0) ssq_add(ssq + row, sq);
#pragma unroll
            for (int bj = 0; bj < 2; ++bj) { cur[bj] = nxt[bj]; pc[bj] = pn2[bj]; }
        }
#undef EP_LOAD
    }
};
struct EpiPleLast {
    static constexpr bool PERM = true, AFTER_DRAIN = true;
    unsigned char* ws; float* out; const float* gfin; const bf16_t* pp; size_t xbb_off; int i; unsigned xcc; volatile LAS unsigned* st;
    DI void fused(f32x4 (&acc)[2][2][4][2], const Unit& u, int wr, int wc, int fr, int fq, LAS unsigned char* lds, int wid, int lane) const {
        unsigned char* w = launder(ws); const u64* ssq1 = ssq_arr(w, SSQ_1 + i); u64* ssq = ssq_arr(w, SSQ_X + i + 1);
        const bf16_t* PP = launder(pp); const bf16_t* X1 = (const bf16_t*)(w + WS_BIG + xbb_off);
        const size_t cb = (size_t)u.pn * 256 + wc * 32 + 8 * fq;
        {
            EPI_RS8(rsv, ssq1, 1.f / 1024.f);
#pragma unroll
            for (int it = 0; it < 8; ++it) {
                const int ai = it >> 2, m = it & 3; const int row = EPI_ROW(u, ai, m); const float rs = rsv[ai][m]; float sq = 0.f;
#pragma unroll
                for (int bj = 0; bj < 2; ++bj) {
                    const size_t off = (size_t)row * 1024 + cb + bj * 128;
                    f32x4 p0, p1, y0, y1; unpk8(*(const u32x4*)(PP + off), p0, p1); unpk8(*(const u32x4*)(X1 + off), y0, y1);
#pragma unroll
                    for (int jj = 0; jj < 4; ++jj) { y0[jj] += sigm(acc[ai][bj][m][0][jj] * rs) * p0[jj]; y1[jj] += sigm(acc[ai][bj][m][1][jj] * rs) * p1[jj]; }
                    acc[ai][bj][m][0] = y0; acc[ai][bj][m][1] = y1; sq += sq8(y0, y1);
                }
                sq = red_fq(sq); if (fq == 0) ssq_add(ssq + row, sq);
            }
        }
        { XcdBarrier b; b.bar = (unsigned*)(launder(ws) + WS_CTL); b.x = xcc; b.st = st; xcd_barrier(b); }
        {
            const u64* ssqf = ssq_arr(launder(ws), SSQ_X + i + 1);
            EPI_RS8(rsf, ssqf, 1.f / 1024.f);
#pragma unroll
            for (int bj = 0; bj < 2; ++bj) {
                const f32x4 g0 = *(const f32x4*)(gfin + cb + bj * 128), g1 = *(const f32x4*)(gfin + cb + bj * 128 + 4);
                EPI_LOOP_AM { const size_t off = (size_t)EPI_ROW(u, ai, m) * 1024 + cb + bj * 128; const float rs = rsf[ai][m];
                    *(f32x4*)(out + off) = acc[ai][bj][m][0] * rs * g0; *(f32x4*)(out + off + 4) = acc[ai][bj][m][1] * rs * g1; }
            }
        }
    }
};
struct EpiC1 {
    static constexpr bool PERM = true, AFTER_DRAIN = false;
    unsigned char* ws; int i; int dry;
    DI void operator()(AccRef acc, const Unit& u, int wr, int wc, int fr, int fq) const {
        if (dry == 1) { asm volatile("" :: "v"(acc[0][0][0][0][0]), "v"(acc[1][1][3][1][3])); return; }
        unsigned char* w = launder(ws); const u64* ssq_x = ssq_arr(w, SSQ_X + i); bf16_t *CH = (bf16_t*)(w + WS_BIG + C_CH), *BZ = (bf16_t*)(w + WS_BIG + C_BZ);
        EPI_RS8(rsv, ssq_x, 1.f / 1024.f);
        EPI_LOOP_AM {
            const int row = EPI_ROW(u, ai, m); const float rs = rsv[ai][m];
            const size_t off = (size_t)row * 1024 + (u.pn & 7) * 128 + wc * 32 + 8 * fq;
            f32x4 r0, r1;
            if (u.pn < 8) { r0 = (acc[ai][0][m][0] * rs) * (acc[ai][1][m][0] * rs); r1 = (acc[ai][0][m][1] * rs) * (acc[ai][1][m][1] * rs); { const u32x4 o_ = pk8(r0, r1); if (dry == 2) asm volatile("" :: "v"(o_)); else st16(CH + off, o_); } }
            else {
#pragma unroll
                for (int jj = 0; jj < 4; ++jj) { r0[jj] = (acc[ai][0][m][0][jj] * rs) * silu(acc[ai][1][m][0][jj] * rs); r1[jj] = (acc[ai][0][m][1][jj] * rs) * silu(acc[ai][1][m][1][jj] * rs); }
                { const u32x4 o_ = pk8(r0, r1); if (dry == 2) asm volatile("" :: "v"(o_)); else st16(BZ + off, o_); }
            }
        }
    }
};
struct EpiL1 {
    static constexpr bool PERM = true, AFTER_DRAIN = false;
    unsigned char* ws; int i;
    DI void operator()(AccRef acc, const Unit& u, int wr, int wc, int fr, int fq) const {
        unsigned char* w = launder(ws); const u64* ssq_x = ssq_arr(w, SSQ_X + i); unsigned char* big = w + WS_BIG;
        EPI_RS8(rsv, ssq_x, 1.f / 1024.f);
        if (u.pn < 16) {
            bf16_t* O; int ld, c0;
            if (u.pn < 4) { O = (bf16_t*)(big + L_Q); ld = 1024; c0 = u.pn * 256; } else if (u.pn < 8) { O = (bf16_t*)(big + L_K); ld = 1024; c0 = (u.pn - 4) * 256; } else { O = (bf16_t*)(big + L_VT); ld = 2048; c0 = (u.pn - 8) * 256; }
            EPI_LOOP_AM {
                const int row = EPI_ROW(u, ai, m); const float rs = rsv[ai][m];
#pragma unroll
                for (int bj = 0; bj < 2; ++bj) st16(O + (size_t)row * ld + c0 + bj * 128 + wc * 32 + 8 * fq, pk8(acc[ai][bj][m][0] * rs, acc[ai][bj][m][1] * rs));
            }
        } else {
            bf16_t* OG = (bf16_t*)(big + L_OG);
            EPI_LOOP_AM {
                const int row = EPI_ROW(u, ai, m); const float rs = rsv[ai][m];
                const size_t off = (size_t)row * 2048 + (u.pn - 16) * 128 + wc * 32 + 8 * fq; f32x4 r0, r1;
#pragma unroll
                for (int jj = 0; jj < 4; ++jj) { r0[jj] = sigm(acc[ai][0][m][0][jj] * rs) * silu(acc[ai][1][m][0][jj] * rs); r1[jj] = sigm(acc[ai][0][m][1][jj] * rs) * silu(acc[ai][1][m][1][jj] * rs); }
                st16(OG + off, pk8(r0, r1));
            }
        }
    }
};
constexpr int AT_KSTR = 208, AT_VSTR = 192, AT_KB = 64 * AT_KSTR, AT_VB = 64 * AT_VSTR;
#define MFMA32(a, b, c) __builtin_amdgcn_mfma_f32_32x32x16_bf16((a), (b), (c), 0, 0, 0)
#define MFMA16(a, b, c) __builtin_amdgcn_mfma_f32_16x16x32_bf16((a), (b), (c), 0, 0, 0)
DI bf16x8 cat4(s16x4 lo, s16x4 hi) { return __builtin_shufflevector(lo, hi, 0, 1, 2, 3, 4, 5, 6, 7); }

struct AttnT { const bf16_t *Q, *KN, *KR, *VT; bf16_t* SZOG; };
#ifndef DIAG_NOLOAD
#define DIAG_NOLOAD 0
#endif
struct AttnStage { u32x4 k, r, v; };
DI void attn_unit(LAS unsigned char* lds, const AttnT& T, int b, int h, int qb, int dry) {
    const int tid = tidx(), w = __builtin_amdgcn_readfirstlane(tid >> 6), lane = tid & 63, r = lane & 31, hh = lane >> 5;
    const int tok0 = b * S, row0 = tok0 + qb * 256 + 32 * w;
    bf16x8 qf[6];
#pragma unroll
    for (int ks = 0; ks < 6; ++ks) qf[ks] = *(const bf16x8*)(T.Q + (size_t)(row0 + r) * 1536 + 96 * h + 16 * ks + 8 * hh);
    f32x16 O0, O1;
#pragma unroll
    for (int i = 0; i < 16; ++i) { O0[i] = 0.f; O1[i] = 0.f; }
    float mrun = -1e30f, lrun = 0.f;
    const int ntiles = 4 * qb + 4, myvis = 4 * qb + (w >> 1);
    const int kkey = tid >> 3, kch = tid & 7, rkey = tid >> 2, rch = tid & 3;
    const bf16_t* gK = T.KN + (size_t)(tok0 + kkey) * 1024 + 64 * h + 8 * kch;
    const bf16_t* gR = T.KR + (size_t)(tok0 + rkey) * 32 + 8 * rch;
    const bf16_t* gV = T.VT + (size_t)(tok0 + kkey) * 1024 + 64 * h + 8 * kch;
    const int lK = kkey * AT_KSTR + 16 * kch, lR = rkey * AT_KSTR + 128 + 16 * rch, lV = kkey * AT_VSTR + 16 * kch;
    const int krd = r * AT_KSTR + 16 * hh;
    const int vrd = (4 * hh + ((lane & 15) >> 2)) * AT_VSTR + (16 * ((lane >> 4) & 1) + 4 * (lane & 3)) * 2;
#define AT_LOADK(st, kt) do { if (DIAG_NOLOAD && dry) break; (st).k = *(const u32x4*)(gK + (size_t)(kt) * 64 * 1024); if (tid < 256) (st).r = *(const u32x4*)(gR + (size_t)(kt) * 64 * 32); } while (0)
#define AT_LOADV(st, kt) do { if (DIAG_NOLOAD && dry) break; (st).v = *(const u32x4*)(gV + (size_t)(kt) * 64 * 1024); } while (0)
#define AT_WRITEK(st, buf) do { LAS unsigned char* kb_ = lds + (buf) * AT_KB; *(LAS u32x4*)(kb_ + lK) = (st).k; if (tid < 256) *(LAS u32x4*)(kb_ + lR) = (st).r; } while (0)
#define AT_WRITEV(st, buf) do { *(LAS u32x4*)(lds + 2 * AT_KB + (buf) * AT_VB + lV) = (st).v; } while (0)
#define AT_QK1(sX, buf, blk) do { const LAS unsigned char* kb = lds + (buf) * AT_KB + krd + (blk) * 32 * AT_KSTR; \
        _Pragma("unroll") for (int i = 0; i < 16; ++i) sX[i] = 0.f; \
        _Pragma("unroll") for (int ks = 0; ks < 6; ++ks) sX = MFMA32(*(const LAS bf16x8*)(kb + 32 * ks), qf[ks], sX); } while (0)
#define AT_QK(sA, sB, buf) do { AT_QK1(sA, buf, 0); AT_QK1(sB, buf, 1); } while (0)
#define AT_MAX(s0, s1) \
        float mx = fmaxf(s0[0], s1[0]); \
        _Pragma("unroll") for (int i = 1; i < 16; ++i) mx = fmaxf(mx, fmaxf(s0[i], s1[i])); \
        mx = fmaxf(mx, __shfl_xor(mx, 32)); \
        const float mnew = fmaxf(mrun, mx), alpha = ex2(mrun - mnew); mrun = mnew;
#define AT_EXP(s0, s1) do { float ps = 0.f; \
        _Pragma("unroll") for (int i = 0; i < 16; ++i) { s0[i] = ex2(s0[i] - mrun); s1[i] = ex2(s1[i] - mrun); ps += s0[i] + s1[i]; } \
        lrun = lrun * alpha + ps; \
        _Pragma("unroll") for (int i = 0; i < 16; ++i) { O0[i] *= alpha; O1[i] *= alpha; } } while (0)
#define AT_PV(s0, s1, buf) do { LAS unsigned char* vb = lds + 2 * AT_KB + (buf) * AT_VB + vrd; \
        _Pragma("unroll") for (int kb2 = 0; kb2 < 2; ++kb2) _Pragma("unroll") for (int s = 0; s < 2; ++s) { \
            const f32x16& sx = kb2 ? s1 : s0; \
            u32x4 pw; pw.x = pk2(sx[8 * s + 0], sx[8 * s + 1]); pw.y = pk2(sx[8 * s + 2], sx[8 * s + 3]); pw.z = pk2(sx[8 * s + 4], sx[8 * s + 5]); pw.w = pk2(sx[8 * s + 6], sx[8 * s + 7]); \
            const bf16x8 pf = __builtin_bit_cast(bf16x8, pw); \
            LAS unsigned char* vp = vb + (32 * kb2 + 16 * s) * AT_VSTR; \
            const bf16x8 v0 = cat4(__builtin_amdgcn_ds_read_tr16_b64_v4i16((LAS s16x4*)vp), __builtin_amdgcn_ds_read_tr16_b64_v4i16((LAS s16x4*)(vp + 8 * AT_VSTR))); \
            const bf16x8 v1 = cat4(__builtin_amdgcn_ds_read_tr16_b64_v4i16((LAS s16x4*)(vp + 64)), __builtin_amdgcn_ds_read_tr16_b64_v4i16((LAS s16x4*)(vp + 64 + 8 * AT_VSTR))); \
            O0 = MFMA32(v0, pf, O0); O1 = MFMA32(v1, pf, O1); } } while (0)
#define AT_SOFTMAX_PV(s0, s1, buf) do { AT_MAX(s0, s1); AT_EXP(s0, s1); AT_PV(s0, s1, buf); } while (0)
#define AT_FUSED(c0, c1, n0, n1, bufK, bufV) do { AT_QK1(n0, bufK, 0); AT_MAX(c0, c1); __builtin_amdgcn_sched_barrier(0); \
        AT_QK1(n1, bufK, 1); AT_EXP(c0, c1); __builtin_amdgcn_sched_barrier(0); AT_PV(c0, c1, bufV); } while (0)
    AttnStage RA, RB;
    f32x16 a0, a1, b0, b1;
    AT_LOADK(RA, 0); AT_LOADV(RA, 0); AT_LOADK(RB, 1);
    AT_WRITEK(RA, 0); AT_WRITEV(RA, 0); AT_WRITEK(RB, 1);
    AT_LOADK(RA, 2); AT_LOADV(RA, 1);
    __syncthreads();
    AT_QK(a0, a1, 0);
    const int nmain = 4 * qb, jv = w >> 1;
    int t = 0;
#pragma unroll 1
    for (; t < nmain; t += 2) {
        AT_LOADK(RB, t + 3); AT_LOADV(RB, t + 2);
        AT_FUSED(a0, a1, b0, b1, 1, 0);
        AT_WRITEK(RA, 0); AT_WRITEV(RA, 1);
        __syncthreads();
        AT_LOADK(RA, t + 4); AT_LOADV(RA, t + 3);
        AT_FUSED(b0, b1, a0, a1, 0, 1);
        AT_WRITEK(RB, 1); AT_WRITEV(RB, 0);
        __syncthreads();
    }
    AT_LOADK(RB, t + 3); AT_LOADV(RB, t + 2);
    if (jv >= 1) AT_QK(b0, b1, 1);
    AT_SOFTMAX_PV(a0, a1, 0);
    AT_WRITEK(RA, 0); AT_WRITEV(RA, 1);
    __syncthreads();
    AT_LOADV(RA, t + 3);
    if (jv >= 2) AT_QK(a0, a1, 0);
    if (jv >= 1) AT_SOFTMAX_PV(b0, b1, 1);
    AT_WRITEK(RB, 1); AT_WRITEV(RB, 0);
    __syncthreads();
    if (jv >= 3) AT_QK(b0, b1, 1);
    if (jv >= 2) AT_SOFTMAX_PV(a0, a1, 0);
    AT_WRITEV(RA, 1);
    __syncthreads();
    if (jv >= 3) AT_SOFTMAX_PV(b0, b1, 1);
    __syncthreads();
#undef AT_LOADK
#undef AT_LOADV
#undef AT_WRITEK
#undef AT_WRITEV
#undef AT_QK
#undef AT_SOFTMAX_PV
#undef AT_QK1
#undef AT_MAX
#undef AT_EXP
#undef AT_PV
#undef AT_FUSED
    const float linv = 1.f / (lrun + __shfl_xor(lrun, 32));
    bf16_t* op = T.SZOG + (size_t)(row0 + r) * 1024 + 64 * h + 4 * hh;
#pragma unroll
    for (int db = 0; db < 2; ++db)
#pragma unroll
        for (int g4 = 0; g4 < 4; ++g4) {
            const f32x16& ox = db ? O1 : O0; bf16_t* p = op + 32 * db + 8 * g4;
            const u32x2 z = *(const u32x2*)p; u32x2 o;
            o.x = pk2(ox[4 * g4 + 0] * linv * bflo(z.x), ox[4 * g4 + 1] * linv * bfhi(z.x)); o.y = pk2(ox[4 * g4 + 2] * linv * bflo(z.y), ox[4 * g4 + 3] * linv * bfhi(z.y));
            if (!dry) *(u32x2*)p = o;
        }
}
DI void attn_phase(LAS unsigned char* lds, const AttnT& T, int cu, int dry) {
    const int bh = (cu & 7) + 8 * (cu >> 4), half = (cu >> 3) & 1, b = bh >> 4, h = bh & 15;
#pragma unroll 1
    for (int ui = 0; ui < 4; ++ui) attn_unit(lds, T, b, h, ((half ? 0x2516 : 0x3407) >> (4 * ui)) & 0xF, dry);
}

DI void conv_phase(const bf16_t* CH, bf16_t* BZ, const float* cw, int gt, int NGT, int dry) {
    for (int it = gt; it < (M / 8) * 128; it += NGT) {
        const int c8 = (it & 127) * 8, m0 = (it >> 7) * 8, t0 = m0 & (S - 1);
        const f32x4 w0a = *(const f32x4*)(cw + c8), w0b = *(const f32x4*)(cw + c8 + 4), w1a = *(const f32x4*)(cw + 1024 + c8), w1b = *(const f32x4*)(cw + 1024 + c8 + 4), w2a = *(const f32x4*)(cw + 2048 + c8), w2b = *(const f32x4*)(cw + 2048 + c8 + 4);
        u32x4 ch[10], bz[8];
#pragma unroll
        for (int r = 0; r < 10; ++r) { const int m = m0 - 2 + r; ch[r] = (r >= 2 || t0 > 0) ? *(const u32x4*)(CH + (size_t)m * 1024 + c8) : (u32x4){0u, 0u, 0u, 0u}; }
#pragma unroll
        for (int r = 0; r < 8; ++r) bz[r] = *(const u32x4*)(BZ + (size_t)(m0 + r) * 1024 + c8);
        f32x4 pa, pb, qa, qb;
        unpk8(ch[0], pa, pb); unpk8(ch[1], qa, qb);
#pragma unroll
        for (int r = 0; r < 8; ++r) {
            f32x4 ca, cb, ba, bb; unpk8(ch[r + 2], ca, cb); unpk8(bz[r], ba, bb);
            const f32x4 ya = w0a * pa + w1a * qa + w2a * ca, yb = w0b * pb + w1b * qb + w2b * cb;
            const u32x4 ov = pk8(ba * ya, bb * yb); if (!dry) *(u32x4*)(BZ + (size_t)(m0 + r) * 1024 + c8) = ov;
            pa = qa; pb = qb; qa = ca; qb = cb;
        }
    }
}

DI void gates_phase(const bf16_t* XB, const u64* ssq_x, const float* Wg8, const float* bg, float* IG, float* LF, int gw, int NGW, int lane) {
    f32x4 wv[8][2][2];
#pragma unroll
    for (int j = 0; j < 8; ++j)
#pragma unroll
        for (int half = 0; half < 2; ++half) { const int k0 = half * 512 + lane * 8; wv[j][half][0] = *(const f32x4*)(Wg8 + j * 1024 + k0); wv[j][half][1] = *(const f32x4*)(Wg8 + j * 1024 + k0 + 4); }
    float bgv[8];
#pragma unroll
    for (int j = 0; j < 8; ++j) bgv[j] = bg[j];
    for (int m = gw; m < M; m += NGW) {
        float acc[8];
#pragma unroll
        for (int j = 0; j < 8; ++j) acc[j] = 0.f;
        const u32x4 xw0 = *(const u32x4*)(XB + (size_t)m * 1024 + lane * 8), xw1 = *(const u32x4*)(XB + (size_t)m * 1024 + 512 + lane * 8);
#pragma unroll
        for (int half = 0; half < 2; ++half) {
            f32x4 xa, xb2; unpk8(half ? xw1 : xw0, xa, xb2);
#pragma unroll
            for (int j = 0; j < 8; ++j) { const f32x4 wa = wv[j][half][0], wb = wv[j][half][1];
                acc[j] += (xa[0] * wa[0] + xa[1] * wa[1]) + (xa[2] * wa[2] + xa[3] * wa[3]) + (xb2[0] * wb[0] + xb2[1] * wb[1]) + (xb2[2] * wb[2] + xb2[3] * wb[3]); }
        }
        const float rs = ssq_rstd(ssq_x + m, 1.f / 1024.f);
#pragma unroll
        for (int j = 0; j < 8; ++j) acc[j] = wave_sum(acc[j]) * rs + bgv[j];
        if (lane == 0) {
            *(f32x4*)(IG + (size_t)m * 4) = (f32x4){acc[0], acc[1], acc[2], acc[3]};
            f32x4 lf;
#pragma unroll
            for (int j = 0; j < 4; ++j) { const float x = acc[4 + j]; lf[j] = fminf(x, 0.f) - log1pf(__expf(-fabsf(x))); }
            *(f32x4*)(LF + (size_t)m * 4) = lf;
        }
    }
}
DI void gw8_prep(const float* w_in, const float* g, float* Wg8, int gt, int NGT) {
    for (int i = gt; i < 8 * 1024; i += NGT) { const int j = i >> 10, k = i & 1023; Wg8[i] = w_in[(size_t)k * 8200 + 8192 + j] * g[k]; }
}

constexpr int SC_QSTR = 528, SC_VSTR = 136  , SC_VVSTR = 144  ;
constexpr int SC_QS = 0, SC_KS = 64 * SC_QSTR, SC_VS = 2 * 64 * SC_QSTR, SC_SP = SC_VS + 64 * SC_VVSTR, SC_QCX = SC_SP + 64 * SC_VSTR, SC_GT = SC_QCX + 16384, SC_VEC = SC_GT + 3 * 32 * 64 * 4 + 512, SC_OT = SC_VEC + 832 * 4;
constexpr int G_B = 0, G_CC = 2048, G_PM = 4096, G_SC = 6144;
constexpr int V_QNP = 0  , V_RS = 512  , V_WS = 768;
constexpr int SC_END = SC_OT + 64 * SC_VVSTR;
struct ScanT { const bf16_t *Q, *K, *VT; bf16_t* OG; const float *IG, *LF; };
DI float scan_add(float v, int lane) {
#pragma unroll
    for (int o = 1; o < 64; o <<= 1) { const float t = __shfl_up(v, o); if (lane >= o) v += t; }
    return v;
}
DI float scan_max(float v, int lane) {
#pragma unroll
    for (int o = 1; o < 64; o <<= 1) { const float t = __shfl_up(v, o); if (lane >= o) v = fmaxf(v, t); }
    return v;
}
DI void scan_item(LAS unsigned char* lds, const ScanT& T, int b, int h, int sl, int dry) {
    const int tid0 = tidx(), w = __builtin_amdgcn_readfirstlane(tid0 >> 6), g = w >> 2, c = w & 3;
    int tid = tid0, lane = tid & 63, l15 = lane & 15, q = lane >> 4;
    const int tok0 = b * S;
    LAS float* vec = (LAS float*)(lds + SC_VEC);
    LAS float* gt = (LAS float*)(lds + SC_GT);
    f32x4 Cacc[8];
#pragma unroll
    for (int i = 0; i < 8; ++i) Cacc[i] = (f32x4){0.f, 0.f, 0.f, 0.f};
    f32x4 nacc[2] = {(f32x4){0.f, 0.f, 0.f, 0.f}, (f32x4){0.f, 0.f, 0.f, 0.f}};
    u32x4 sQ[4], sK[4], sV;
    const int vd = tid >> 3, vch = tid & 7;
    const bf16_t* gQ = T.Q + (size_t)tok0 * 1024 + 256 * h;
    const bf16_t* gK = T.K + (size_t)tok0 * 1024 + 256 * h;
    const bf16_t* gV = T.VT + (size_t)(tok0 + vd) * 2048 + 512 * h + 64 * sl + 8 * vch;
#define SC_LOAD(ci) do { _Pragma("unroll") for (int i = 0; i < 4; ++i) { const int e = tid + i * NTHR, row = e >> 5, ch = e & 31; \
        sQ[i] = *(const u32x4*)(gQ + (size_t)((ci) * 64 + row) * 1024 + 8 * ch); sK[i] = *(const u32x4*)(gK + (size_t)((ci) * 64 + row) * 1024 + 8 * ch); } \
        sV = *(const u32x4*)(gV + (size_t)(ci) * 64 * 2048); } while (0)
    u32x4 sOG;
    bf16_t* gOG = T.OG + (size_t)(tok0 + vd) * 2048 + 512 * h + 64 * sl + 8 * vch;
#define SC_LOADOG(ci) do { sOG = *(const u32x4*)(gOG + (size_t)(ci) * 64 * 2048); } while (0)
    SC_LOAD(0); SC_LOADOG(0);
    {
        float lfv[4], igv[4];
#pragma unroll
        for (int k = 0; k < 4; ++k) { const size_t gi = (size_t)(tok0 + (w + 8 * k) * 64 + lane) * 4 + h; lfv[k] = T.LF[gi]; igv[k] = T.IG[gi]; }
#pragma unroll
        for (int k = 0; k < 4; ++k) {
            const int ck = w + 8 * k; const float bb = scan_add(lfv[k], lane), cc = igv[k] - bb, pm = scan_max(cc, lane);
            gt[G_B + ck * 64 + lane] = bb; gt[G_CC + ck * 64 + lane] = cc; gt[G_PM + ck * 64 + lane] = pm;
            if (lane == 63) { gt[G_SC + ck * 4 + 0] = bb; gt[G_SC + ck * 4 + 1] = pm; }
        }
        __syncthreads();
        if (tid == 0) { float m = 0.f;
#pragma unroll 1
            for (int ck = 0; ck < 32; ++ck) { const float bl = gt[G_SC + ck * 4], cm = gt[G_SC + ck * 4 + 1]; gt[G_SC + ck * 4 + 2] = m; m = fmaxf(bl + m, bl + cm); gt[G_SC + ck * 4 + 3] = m; } }
        __syncthreads();
    }
    for (int ci = 0; ci < S / 64; ++ci) {
        tid = tid0; asm volatile("" : "+v"(tid)); lane = tid & 63; l15 = lane & 15; q = lane >> 4;
#pragma unroll
        for (int i = 0; i < 4; ++i) { const int e = tid + i * NTHR, row = e >> 5, ch = e & 31; *(LAS u32x4*)(lds + SC_QS + row * SC_QSTR + 16 * ch) = sQ[i]; *(LAS u32x4*)(lds + SC_KS + row * SC_QSTR + 16 * ch) = sK[i]; }
        *(LAS u32x4*)(lds + SC_VS + vd * SC_VVSTR + 16 * vch) = sV;
        if (ci > 0 && !dry) *(u32x4*)(gOG + (size_t)(ci - 1) * 64 * 2048) = *(const LAS u32x4*)(lds + SC_OT + vd * SC_VVSTR + 16 * vch);
        *(LAS u32x4*)(lds + SC_OT + vd * SC_VVSTR + 16 * vch) = sOG;
        const f32x4 scal = *(const LAS f32x4*)(gt + G_SC + ci * 4);
        const float m_c = scal[2], blast = scal[0], mnew = scal[3];
        const LAS float* gB = gt + G_B + ci * 64; const LAS float* gC = gt + G_CC + ci * 64; const LAS float* gP = gt + G_PM + ci * 64;
        __syncthreads();
        if (ci + 1 < S / 64) SC_LOAD(ci + 1);
        {
            const int sb = w >> 1;
#pragma unroll
            for (int tt = 0; tt < 2; ++tt) {
                const int tb = 2 * (w & 1) + tt;
                const int t = 16 * tb + l15, s0 = 16 * sb + 4 * q;
                if (sb <= tb) {
                    f32x4 a4 = (f32x4){0.f, 0.f, 0.f, 0.f};
#pragma unroll
                    for (int ks = 0; ks < 8; ++ks) {
                        const bf16x8 ka = *(const LAS bf16x8*)(lds + SC_KS + (16 * sb + l15) * SC_QSTR + 64 * ks + 16 * q);
                        const bf16x8 qb2 = *(const LAS bf16x8*)(lds + SC_QS + (16 * tb + l15) * SC_QSTR + 64 * ks + 16 * q);
                        a4 = MFMA16(ka, qb2, a4);
                    }
                    const float a2 = -fmaxf(m_c, gP[t]) * LOG2E; const f32x4 c2 = *(const LAS f32x4*)(gC + s0);
                    float rsum = 0.f;
#pragma unroll
                    for (int r2 = 0; r2 < 4; ++r2) { const float wgt = (s0 + r2 <= t) ? ex2(a2 + c2[r2] * LOG2E) : 0.f; a4[r2] *= wgt; rsum += a4[r2]; }
                    u32x2 pw; pw.x = pk2(a4[0], a4[1]); pw.y = pk2(a4[2], a4[3]);
                    *(LAS u32x2*)(lds + SC_SP + t * SC_VSTR + s0 * 2) = pw;
                    rsum = red_fq(rsum); if (q == 0) vec[V_RS + 64 * sb + t] = rsum;
                } else {
                    *(LAS u32x2*)(lds + SC_SP + t * SC_VSTR + s0 * 2) = (u32x2){0u, 0u};
                    if (q == 0) vec[V_RS + 64 * sb + t] = 0.f;
                }
            }
        }
        f32x4 qc[4];
        {
            bf16x8 cf[4]; f32x4 qnp[4];
            u32x4 nw; nw.x = pk2(nacc[0][0], nacc[0][1]); nw.y = pk2(nacc[0][2], nacc[0][3]); nw.z = pk2(nacc[1][0], nacc[1][1]); nw.w = pk2(nacc[1][2], nacc[1][3]);
            const bf16x8 nf = __builtin_bit_cast(bf16x8, nw);
#pragma unroll
            for (int ks = 0; ks < 4; ++ks) { u32x4 cw; cw.x = pk2(Cacc[2 * ks][0], Cacc[2 * ks][1]); cw.y = pk2(Cacc[2 * ks][2], Cacc[2 * ks][3]); cw.z = pk2(Cacc[2 * ks + 1][0], Cacc[2 * ks + 1][1]); cw.w = pk2(Cacc[2 * ks + 1][2], Cacc[2 * ks + 1][3]); cf[ks] = __builtin_bit_cast(bf16x8, cw); }
#pragma unroll
            for (int tb = 0; tb < 4; ++tb) {
                qc[tb] = (f32x4){0.f, 0.f, 0.f, 0.f}; qnp[tb] = (f32x4){0.f, 0.f, 0.f, 0.f};
#pragma unroll
                for (int ks = 0; ks < 4; ++ks) {
                    const LAS unsigned char* qp = lds + SC_QS + (16 * tb + l15) * SC_QSTR + (128 * g + 32 * ks + 4 * q) * 2;
                    const bf16x8 qa = cat4(*(const LAS s16x4*)qp, *(const LAS s16x4*)(qp + 32));
                    qc[tb] = MFMA16(qa, cf[ks], qc[tb]);
                    if (ks == c) qnp[tb] = MFMA16(qa, nf, qnp[tb]);
                }
            }
            if (l15 == 0) {
#pragma unroll
                for (int tb = 0; tb < 4; ++tb) *(LAS f32x4*)(vec + V_QNP + w * 64 + 16 * tb + 4 * q) = qnp[tb];
            }
            LAS f32x4* qx = (LAS f32x4*)(lds + SC_QCX) + (w * 2) * 64 + lane;
            qx[0] = g ? qc[0] : qc[2]; qx[64] = g ? qc[1] : qc[3];
        }
        if (tid < 64) vec[V_WS + tid] = __expf(blast + gC[tid] - mnew);
        __syncthreads();
        bf16x8 vf[2];
#pragma unroll
        for (int ks = 0; ks < 2; ++ks) { LAS unsigned char* vp = lds + SC_VS + (32 * ks + 8 * q + (l15 >> 2)) * SC_VVSTR + (16 * c + 4 * (lane & 3)) * 2;
            vf[ks] = cat4(__builtin_amdgcn_ds_read_tr16_b64_v4i16((LAS s16x4*)vp), __builtin_amdgcn_ds_read_tr16_b64_v4i16((LAS s16x4*)(vp + 4 * SC_VVSTR))); }
        {
            const LAS f32x4* px = (const LAS f32x4*)(lds + SC_QCX) + ((w ^ 4) * 2) * 64 + lane;
#pragma unroll
            for (int tt = 0; tt < 2; ++tt) {
                const int tb = 2 * g + tt;
                f32x4 sv = (f32x4){0.f, 0.f, 0.f, 0.f};
#pragma unroll
                for (int ks = 0; ks < 2; ++ks) { const LAS unsigned char* sp = lds + SC_SP + (16 * tb + l15) * SC_VSTR + 64 * ks + 16 * q; const bf16x8 sa = cat4(*(const LAS s16x4*)sp, *(const LAS s16x4*)(sp + 8)); sv = MFMA16(sa, vf[ks], sv); }
                const f32x4 qct = (g ? qc[2 + tt] : qc[tt]) + px[64 * tt];
                const int t0 = 16 * tb + 4 * q;
                const f32x4 pmv = *(const LAS f32x4*)(gP + t0), bv = *(const LAS f32x4*)(gB + t0), qn = ((*(const LAS f32x4*)(vec + V_QNP + t0) + *(const LAS f32x4*)(vec + V_QNP + 64 + t0)) + (*(const LAS f32x4*)(vec + V_QNP + 128 + t0) + *(const LAS f32x4*)(vec + V_QNP + 192 + t0)))
                        + ((*(const LAS f32x4*)(vec + V_QNP + 256 + t0) + *(const LAS f32x4*)(vec + V_QNP + 320 + t0)) + (*(const LAS f32x4*)(vec + V_QNP + 384 + t0) + *(const LAS f32x4*)(vec + V_QNP + 448 + t0))),
                    rs = (*(const LAS f32x4*)(vec + V_RS + t0) + *(const LAS f32x4*)(vec + V_RS + 64 + t0)) + (*(const LAS f32x4*)(vec + V_RS + 128 + t0) + *(const LAS f32x4*)(vec + V_RS + 192 + t0));
#pragma unroll
                for (int r2 = 0; r2 < 4; ++r2) {
                    const float mxv = fmaxf(m_c, pmv[r2]), wi = __expf(m_c - mxv), em = __expf(-bv[r2] - mxv);
                    const float num = wi * qct[r2] + sv[r2], den = wi * qn[r2] + rs[r2];
                    const float hv = num / fmaxf(fabsf(den), em);
                    LAS bf16_t* op = (LAS bf16_t*)(lds + SC_OT + (t0 + r2) * SC_VVSTR) + 16 * c + l15;
                    *op = (bf16_t)(pk2(hv * bf1(*op), 0.f) & 0xffff);
                }
            }
        }
        if (ci + 1 < S / 64) SC_LOADOG(ci + 1);
        {
            const float decay = __expf(blast + m_c - mnew);
            bf16x8 vw[2], wsf[2];
#pragma unroll
            for (int ks = 0; ks < 2; ++ks) {
                const f32x4 w0 = *(const LAS f32x4*)(vec + V_WS + 32 * ks + 8 * q), w1 = *(const LAS f32x4*)(vec + V_WS + 32 * ks + 8 * q + 4);
                f32x4 x0, x1; unpk8(__builtin_bit_cast(u32x4, vf[ks]), x0, x1); vw[ks] = __builtin_bit_cast(bf16x8, pk8(x0 * w0, x1 * w1));
                const u32x4 wz = pk8(w0, w1); wsf[ks] = __builtin_bit_cast(bf16x8, l15 == 0 ? wz : (u32x4){0u, 0u, 0u, 0u});
            }
#pragma unroll
            for (int i = 0; i < 8; ++i) {
                if ((i & 1) == 0) __builtin_amdgcn_sched_barrier(0);
                Cacc[i] *= decay;
#pragma unroll
                for (int ks = 0; ks < 2; ++ks) {
                    LAS unsigned char* kp = lds + SC_KS + (32 * ks + 8 * q + (l15 >> 2)) * SC_QSTR + (128 * g + 16 * i + 4 * (lane & 3)) * 2;
                    const s16x4 lo = __builtin_amdgcn_ds_read_tr16_b64_v4i16((LAS s16x4*)kp), hi = __builtin_amdgcn_ds_read_tr16_b64_v4i16((LAS s16x4*)(kp + 4 * SC_QSTR));
                    Cacc[i] = MFMA16(cat4(lo, hi), vw[ks], Cacc[i]);
                }
            }
#pragma unroll
            for (int ib = 0; ib < 2; ++ib) {
                nacc[ib] *= decay;
#pragma unroll
                for (int ks = 0; ks < 2; ++ks) {
                    LAS unsigned char* kp = lds + SC_KS + (32 * ks + 8 * q + (l15 >> 2)) * SC_QSTR + (128 * g + 16 * (2 * c + ib) + 4 * (lane & 3)) * 2;
                    const s16x4 lo = __builtin_amdgcn_ds_read_tr16_b64_v4i16((LAS s16x4*)kp), hi = __builtin_amdgcn_ds_read_tr16_b64_v4i16((LAS s16x4*)(kp + 4 * SC_QSTR));
                    nacc[ib] = MFMA16(cat4(lo, hi), wsf[ks], nacc[ib]);
                }
            }
        }
        __syncthreads();
    }
    if (!dry) *(u32x4*)(gOG + (size_t)(S / 64 - 1) * 64 * 2048) = *(const LAS u32x4*)(lds + SC_OT + vd * SC_VVSTR + 16 * vch);
    __syncthreads();
#undef SC_LOAD
#undef SC_LOADOG
}
DI void scan_phase(LAS unsigned char* lds, const ScanT& T, int cu, int dry) {
    const int xcd = cu & 7, idx = cu >> 3, bh = xcd * 4 + (idx >> 3), sl = idx & 7;
    scan_item(lds, T, bh >> 2, bh & 3, sl, dry);
}

DI void final_phase(const bf16_t* xb, float* out, const u64* ssq, const float* g, int gw, int NGW, int lane) {
    for (int m = gw; m < M; m += NGW) {
        const float rs = ssq_rstd(ssq + m, 1.f / 1024.f);
#pragma unroll
        for (int j = 0; j < 2; ++j) {
            const int c0 = (lane + 64 * j) * 8; f32x4 a, b; unpk8(*(const u32x4*)(xb + (size_t)m * D + c0), a, b);
            *(f32x4*)(out + (size_t)m * D + c0) = a * rs * *(const f32x4*)(g + c0); *(f32x4*)(out + (size_t)m * D + c0 + 4) = b * rs * *(const f32x4*)(g + c0 + 4);
        }
    }
}
constexpr int LDS_BYTES = 147456, MISC_OFF = 146944;
static_assert(SC_END <= MISC_OFF && 2 * AT_KB + 2 * AT_VB <= MISC_OFF, "LDS map");
constexpr int PH_PER_LAYER = 6, PH_FINAL = 1 + 4 * PH_PER_LAYER, PH_REFRESH = 100;
#ifndef GEMM_ALIGN
#define GEMM_ALIGN true
#endif
#ifndef GEMM_SP2
#define GEMM_SP2 true
#endif
#ifndef C1_DRYMODE
#define C1_DRYMODE 1
#endif
#ifndef BAR_TWICE
#define BAR_TWICE 0
#endif
#ifndef STAGGER
#define STAGGER 0
#endif
#define STAGGER_SLEEP() do { if (STAGGER) { for (int s_ = 0; s_ < (int)(((cu >> 3) & 3) * STAGGER); ++s_) __builtin_amdgcn_s_sleep(32); } } while (0)
#ifndef PP_HOLES
#define PP_HOLES 1
#endif
#ifndef PHM
#define PHM 0xFFFF
#endif
#define PH_ON(b) ((PHM >> (b)) & 1)
#ifndef REPEAT
#define REPEAT 0
#endif
#define REP_LOOP(b) for (int rep_ = opaque((REPEAT >> (b)) & 1); rep_ >= 0; --rep_)
typedef const __attribute__((address_space(4))) Args* KArgs;
DI KArgs kargs() { KArgs p = (KArgs)__builtin_amdgcn_kernarg_segment_ptr(); asm volatile("" : "+s"(p)); return p; }

#define TID_DEFS const int tid = tidx(), w = __builtin_amdgcn_readfirstlane(tid >> 6), lane = tid & 63; (void)w; (void)lane
DI void prep_mixer(LAS unsigned char* lds, int i, int cu, int G) {
    TID_DEFS; KArgs A = kargs(); unsigned char* ws = A->ws; LAS float* scr = (LAS float*)lds;
    const int kind = i % 3, j = i / 3;
    const float* normg = A->in[I_NORMG] + (size_t)i * D; bf16_t* wmix = (bf16_t*)(ws + WS_WMIX);
    if (kind == 0) {
        constexpr int n0 = 28 * 8, n1 = 24 * 3, n2 = 32 * 2, n3 = 16 * 8;
#pragma unroll 1
        for (int it = cu; it < n0 + n1 + n2 + n3; it += G) {
            if (it < n0) prep_tile(PrepTask{A->in[I_MLA_WIN] + (size_t)j * D * 1696, 1696, normg, D, 1792, PM_MLA_IN, wmix}, it, scr);
            else if (it < n0 + n1) prep_tile(PrepTask{A->in[I_MLA_WQB] + (size_t)j * 384 * 1536, 1536, A->in[I_MLA_QN] + j * 384, 384, 1536, PM_MLA_QB, (bf16_t*)(ws + WS_WMIX + WM_QB)}, it - n0, scr);
            else if (it < n0 + n1 + n2) prep_tile(PrepTask{A->in[I_MLA_WKVB] + (size_t)j * 256 * 2048, 2048, A->in[I_MLA_KVN] + j * 256, 256, 2048, PM_MLA_KVB, (bf16_t*)(ws + WS_WMIX + WM_KVB)}, it - n0 - n1, scr);
            else prep_tile(PrepTask{A->in[I_MLA_WOUT] + (size_t)j * D * D, D, nullptr, D, D, PM_ID, (bf16_t*)(ws + WS_WMIX + WM_OUT_MLA)}, it - n0 - n1 - n2, scr);
        }
    } else if (kind == 1) {
        constexpr int n0 = 64 * 8, n1 = 16 * 8;
#pragma unroll 1
        for (int it = cu; it < n0 + n1; it += G) {
            if (it < n0) prep_tile(PrepTask{A->in[I_CONV_WIN] + (size_t)j * D * 4096, 4096, normg, D, 4096, PM_CONV_IN, wmix}, it, scr);
            else prep_tile(PrepTask{A->in[I_CONV_WOUT] + (size_t)j * D * D, D, nullptr, D, D, PM_ID, (bf16_t*)(ws + WS_WMIX + WM_OUT_CONV)}, it - n0, scr);
        }
    } else {
        constexpr int n0 = 128 * 8, n1 = 16 * 16;
#pragma unroll 1
        for (int it = cu; it < n0 + n1; it += G) {
            if (it < n0) prep_tile(PrepTask{A->in[I_L_WIN] + (size_t)j * D * 8200, 8200, normg, D, 8192, PM_LSTM_IN, wmix}, it, scr);
            else prep_tile(PrepTask{A->in[I_L_WOUT] + (size_t)j * 2048 * D, D, nullptr, 2048, D, PM_ID, (bf16_t*)(ws + WS_WMIX + WM_OUT_LSTM)}, it - n0, scr);
        }
        gw8_prep(A->in[I_L_WIN] + (size_t)j * D * 8200, normg, (float*)(ws + WS_GW8), cu * NTHR + tid, G * NTHR);
    }
    if (kind != 2) p_to_bf16(A->in[I_P] + (size_t)i * M * 256, (bf16_t*)(ws + WS_BIG + A_PB), cu * NTHR + tid, G * NTHR);
#pragma unroll 1
    for (int it = cu; it < 16 * 2; it += G) prep_tile(PrepTask{A->in[I_PLE_PROJ] + (size_t)i * 256 * D, D, nullptr, 256, D, PM_ID, (bf16_t*)(ws + WS_WPLE + 2 * MiB)}, it, scr);
}
DI void prep_ple(LAS unsigned char* lds, int i, int cu, int G) {
    KArgs A = kargs(); unsigned char* ws = A->ws; LAS float* scr = (LAS float*)lds;
#pragma unroll 1
    for (int it = cu; it < 16 * 8; it += G) prep_tile(PrepTask{A->in[I_PLE_GATE] + (size_t)i * D * D, D, nullptr, D, D, PM_ID, (bf16_t*)(ws + WS_WPLE)}, it, scr);
}

__global__ void __launch_bounds__(NTHR, 2) fwd(Args a_) {
    extern __shared__ __attribute__((aligned(16))) unsigned char lds_[];
    LAS unsigned char* lds = (LAS unsigned char*)lds_;
    const int cu = blockIdx.x, G = gridDim.x;
#define GW (cu * 8 + w)
#define NGW (G * 8)
#define GT (cu * NTHR + tid)
#define NGT (G * NTHR)
    const int lo = a_.ph_lo, hi = a_.ph_hi;
    volatile LAS unsigned* misc = (volatile LAS unsigned*)(lds + MISC_OFF);
    { TID_DEFS; if (tid < 32) misc[tid] = 0u; }
    __syncthreads();
    const bool multi = (hi - lo) > 1;
    XcdBarrier bar; bar.bar = nullptr; bar.x = 0; bar.st = misc + 8;
    if (multi) bar = xcd_barrier_post((unsigned*)(kargs()->ws + WS_CTL), misc + 8);
#define IN(k) (lo <= (k) && (k) < hi)
#ifdef TIMELINE
#define STAMP(idx) do { if (blockIdx.x == 0 && threadIdx.x == 0) ((unsigned long long*)(kargs()->ws + WS_CTL + 32 * KiB))[(idx)] = __builtin_amdgcn_s_memrealtime(); } while (0)
#else
#define STAMP(idx) do { } while (0)
#endif
#define SEAM(k) do { if (multi && (k) + 1 < hi) { XcdBarrier b2 = bar; b2.bar = (unsigned*)(kargs()->ws + WS_CTL); xcd_barrier(b2); if (BAR_TWICE) xcd_barrier(b2); } STAMP((k) + 1); } while (0)

    STAMP(0);
    if (lo >= PH_REFRESH) {
        TID_DEFS; KArgs A = kargs(); const int i = lo - PH_REFRESH; rows_to_bf16_ssq(A->out, (bf16_t*)(A->ws + WS_XBA), ssq_arr(A->ws, SSQ_X + i), GW, NGW, lane); return;
    }
    if (IN(0)) {
        REP_LOOP(11) { TID_DEFS; KArgs A = kargs(); unsigned char* ws = A->ws; rows_to_bf16_ssq(A->in[I_X], (bf16_t*)(ws + WS_XBA), ssq_arr(ws, SSQ_X), GW, NGW, lane); }
        REP_LOOP(12) { TID_DEFS; KArgs A = kargs(); unsigned char* ws = A->ws; rope_tables((const int*)A->in[I_POS], (float*)(ws + WS_CS), (float*)(ws + WS_SN), GT, NGT); }
        REP_LOOP(13) prep_mixer(lds, 0, cu, G);
    }
    if (IN(0)) SEAM(0);
#pragma unroll 1
    for (int i = 0; i < 4; ++i) {
        const int kind = i % 3, j = i / 3, base = 1 + PH_PER_LAYER * i;
        if (hi <= base || lo >= base + PH_PER_LAYER) continue;
        if (IN(base + 1)) {
            REP_LOOP(0) prep_ple(lds, i, cu, G);
            if (kind == 0 && PH_ON(1)) {
                unsigned char* ws = kargs()->ws;
                pg8::Gemm g{(bf16_t*)(ws + WS_XBA), (bf16_t*)(ws + WS_WMIX), M, 1792, opaque(D)}; pg8::StaticOrder So; So.init(M, 1792, G, cu);
                EpiA1 E{ws, i, j}; STAGGER_SLEEP();
                pg8::gemm_phase<EpiA1, pg8::StaticOrder, GEMM_ALIGN, GEMM_SP2>(lds, g, So, E);
                if (PP_HOLES && G == 256 && cu >= 192) {
                    KArgs A2 = kargs(); unsigned char* ws2 = A2->ws;
                    pg8::Gemm g2{(bf16_t*)(ws2 + WS_BIG + A_PB), (bf16_t*)(ws2 + WS_WPLE + 2 * MiB), M, D, opaque(256)}; pg8::StaticOrder So2; So2.init(M, D, 64, cu - 192);
                    EpiPP E2{(bf16_t*)A2->out};
                    pg8::gemm_phase<EpiPP, pg8::StaticOrder, GEMM_ALIGN, GEMM_SP2>(lds, g2, So2, E2);
                }
            } else if (kind == 1 && PH_ON(2)) REP_LOOP(2) {
                unsigned char* ws = kargs()->ws;
                pg8::Gemm g{(bf16_t*)(ws + WS_XBA), (bf16_t*)(ws + WS_WMIX), M, 4096, opaque(D)}; pg8::StaticOrder So; So.init(M, 4096, G, cu);
                EpiC1 E{ws, i, rep_ * C1_DRYMODE}; STAGGER_SLEEP();
                pg8::gemm_phase<EpiC1, pg8::StaticOrder, GEMM_ALIGN, GEMM_SP2>(lds, g, So, E);
            } else if (kind == 2 && PH_ON(3)) REP_LOOP(3) {
                { TID_DEFS; KArgs A = kargs(); unsigned char* ws = A->ws;
                  gates_phase((bf16_t*)(ws + WS_XBA), ssq_arr(ws, SSQ_X + i), (const float*)(ws + WS_GW8), A->in[I_L_BG] + j * 8, (float*)(ws + WS_IG), (float*)(ws + WS_LF), GW, NGW, lane); }
                unsigned char* ws = kargs()->ws;
                pg8::Gemm g{(bf16_t*)(ws + WS_XBA), (bf16_t*)(ws + WS_WMIX), M, 8192, opaque(D)}; pg8::StaticOrder So; So.init(M, 8192, G, cu);
                EpiL1 E{ws, i}; STAGGER_SLEEP();
                pg8::gemm_phase<EpiL1, pg8::StaticOrder, GEMM_ALIGN, GEMM_SP2>(lds, g, So, E);
            }
            SEAM(base + 1);
        }
        if (IN(base + 2) && kind != 2) {
            if (kind == 0 && PH_ON(4)) REP_LOOP(4) {
                { unsigned char* ws = kargs()->ws;
                  pg8::Gemm g{(bf16_t*)(ws + WS_BIG + A_CQ), (bf16_t*)(ws + WS_WMIX + WM_QB), M, 1536, opaque(384)}; pg8::StaticOrder So; So.init(M, 1536, G, cu);
                  EpiQ E{ws, j};
                  pg8::gemm_phase<EpiQ, pg8::StaticOrder, GEMM_ALIGN, GEMM_SP2>(lds, g, So, E); }
                { unsigned char* ws = kargs()->ws;
                  pg8::Gemm g{(bf16_t*)(ws + WS_BIG + A_CKV), (bf16_t*)(ws + WS_WMIX + WM_KVB), M, 2048, opaque(256)}; pg8::StaticOrder So; So.init(M, 2048, G, G - 1 - cu);
                  EpiKV E{ws, j};
                  pg8::gemm_phase<EpiKV, pg8::StaticOrder, GEMM_ALIGN, GEMM_SP2>(lds, g, So, E); }
            } else if (kind == 1 && PH_ON(5)) REP_LOOP(5) {
                TID_DEFS; KArgs A = kargs(); unsigned char* ws = A->ws;
                conv_phase((const bf16_t*)(ws + WS_BIG + C_CH), (bf16_t*)(ws + WS_BIG + C_BZ), A->in[I_CONV_W] + (size_t)j * 3 * 1024, GT, NGT, rep_);
            }
            SEAM(base + 2);
        }
        if (IN(base + 3) && kind != 1) {
            if (kind == 0 && PH_ON(6)) REP_LOOP(6) {
                unsigned char* big = kargs()->ws + WS_BIG;
                AttnT T{(bf16_t*)(big + A_Q), (bf16_t*)(big + A_KN), (bf16_t*)(big + A_KR), (bf16_t*)(big + A_VT), (bf16_t*)(big + A_SZ)};
                attn_phase(lds, T, cu, rep_);
            } else if (kind == 2 && PH_ON(7)) {
                { unsigned char* ws = kargs()->ws; unsigned char* big = ws + WS_BIG;
                  ScanT T{(bf16_t*)(big + L_Q), (bf16_t*)(big + L_K), (bf16_t*)(big + L_VT), (bf16_t*)(big + L_OG), (float*)(ws + WS_IG), (float*)(ws + WS_LF)};
                  REP_LOOP(7) scan_phase(lds, T, cu, rep_); }
                TID_DEFS; KArgs A = kargs();
                p_to_bf16(A->in[I_P] + (size_t)i * M * 256, (bf16_t*)A->out, GT, NGT);
            }
            SEAM(base + 3);
        }
        if (IN(base + 4)) {
            const size_t xbb_off = kind == 0 ? A_XBB : kind == 1 ? C_XBB : L_XBB, pp_off = kind == 0 ? A_PP : kind == 1 ? C_PP : L_PP;
            if (PH_ON(8)) { KArgs A = kargs(); unsigned char* ws = A->ws;
              const size_t oin = kind == 0 ? A_SZ : kind == 1 ? C_BZ : L_OG, wout = kind == 2 ? WM_OUT_LSTM : WM_OUT_MLA;
              pg8::Gemm g{(bf16_t*)(ws + WS_BIG + oin), (bf16_t*)(ws + WS_WMIX + wout), M, D, opaque(kind == 2 ? 2048 : 1024)}; pg8::StaticOrder So; So.init(M, D, G, cu);
              EpiOut E{ws, xbb_off, i};
              pg8::gemm_phase<EpiOut, pg8::StaticOrder, GEMM_ALIGN, GEMM_SP2>(lds, g, So, E); }
            if (PH_ON(9) && !(PP_HOLES && kind == 0 && G == 256)) REP_LOOP(9) { KArgs A = kargs(); unsigned char* ws = A->ws;
              pg8::Gemm g{kind == 2 ? (bf16_t*)A->out : (bf16_t*)(ws + WS_BIG + A_PB), (bf16_t*)(ws + WS_WPLE + 2 * MiB), M, D, opaque(256)}; pg8::StaticOrder So; So.init(M, D, G, cu);
              EpiPP E{(bf16_t*)(ws + WS_BIG + pp_off)};
              pg8::gemm_phase<EpiPP, pg8::StaticOrder, GEMM_ALIGN, GEMM_SP2>(lds, g, So, E); }
            SEAM(base + 4);
        }
        if (IN(base + 5)) {
            if (PH_ON(10)) { KArgs A = kargs(); unsigned char* ws = A->ws;
              const size_t xbb_off = kind == 0 ? A_XBB : kind == 1 ? C_XBB : L_XBB, pp_off = kind == 0 ? A_PP : kind == 1 ? C_PP : L_PP;
              const bf16_t* ppp = (PP_HOLES && kind == 0 && G == 256) ? (const bf16_t*)A->out : (const bf16_t*)(ws + WS_BIG + pp_off);
              pg8::Gemm g{(bf16_t*)(ws + WS_BIG + xbb_off), (bf16_t*)(ws + WS_WPLE), M, D, opaque(D)}; pg8::StaticOrder So; So.init(M, D, G, cu);
              if (i == 3 && multi && G == 256 && hi > PH_FINAL) {
                  EpiPleLast E{ws, A->out, A->in[I_FNORM], ppp, xbb_off, i, bar.x, bar.st};
                  pg8::gemm_phase<EpiPleLast, pg8::StaticOrder, false, GEMM_SP2>(lds, g, So, E);
              } else {
                  EpiPle E{ws, ppp, xbb_off, i};
                  pg8::gemm_phase<EpiPle, pg8::StaticOrder, GEMM_ALIGN, GEMM_SP2>(lds, g, So, E); } }
            if (i < 3) REP_LOOP(1) prep_mixer(lds, i + 1, cu, G);
            if (!(i == 3 && multi && G == 256 && hi > PH_FINAL)) SEAM(base + 5);
        }
    }
    if (IN(PH_FINAL) && !(multi && G == 256 && lo <= PH_FINAL - 1)) { TID_DEFS; KArgs A = kargs(); final_phase((const bf16_t*)(A->ws + WS_XBA), A->out, ssq_arr(A->ws, SSQ_X + 4), A->in[I_FNORM], GW, NGW, lane); }
#ifdef TIMELINE
    {
        SEAM(PH_FINAL);
        TID_DEFS; KArgs A = kargs(); const unsigned long long* ts = (const unsigned long long*)(A->ws + WS_CTL + 32 * KiB);
        const float dA = (float)(ts[TS_A1] - ts[TS_A0]) * 0.01f, dB = (float)(ts[TS_B1] - ts[TS_B0]) * 0.01f;
        const float c = sqrtf(dA);
        for (size_t e = GT; e < (size_t)M * D; e += NGT) A->out[e] = (e == 0) ? 60.f + dB : c;
    }
#endif
#undef IN
#undef SEAM
}
}
#ifndef FAST_LAYERS
#define FAST_LAYERS 15
#endif
#ifndef ONE_LAUNCH
#define ONE_LAUNCH 1
#endif

extern "C" void kernel_launch(void* const* d_in, const int* in_sizes, int n_in, void* d_out, int out_size, void* d_ws, size_t ws_size, hipStream_t stream) {
    static int grid = 0;
    if (grid == 0) {
        int dev = 0, cus = 0;
        if (n_in != 19 || ws_size < fk::WS_END || out_size != fk::M * fk::D) { fprintf(stderr, "kernel_launch: unexpected shapes (n_in %d, ws %zu, out %d)\n", n_in, ws_size, out_size); grid = -1; return; }
        if (hipGetDevice(&dev) != hipSuccess || hipDeviceGetAttribute(&cus, hipDeviceAttributeMultiprocessorCount, dev) != hipSuccess) { grid = -1; return; }
        if (hipFuncSetAttribute((const void*)fk::fwd, hipFuncAttributeMaxDynamicSharedMemorySize, fk::LDS_BYTES) != hipSuccess) { fprintf(stderr, "kernel_launch: hipFuncSetAttribute failed\n"); grid = -1; return; }
        int per_cu = 0;
        if (hipOccupancyMaxActiveBlocksPerMultiprocessor(&per_cu, (const void*)fk::fwd, fk::NTHR, fk::LDS_BYTES) != hipSuccess || per_cu < 1) { fprintf(stderr, "kernel_launch: occupancy query says %d\n", per_cu); }
        (void)hipGetLastError();
        grid = cus;
        if (grid != 256) fprintf(stderr, "kernel_launch: %d CUs (built for 256)\n", grid);
    }
    if (grid < 0) return;
    (void)hipMemsetAsync(d_ws, 0, fk::ZERO_BYTES, stream);
    fk::Args a{};
    for (int i = 0; i < 19; ++i) a.in[i] = (const float*)d_in[i];
    a.out = (float*)d_out; a.ws = (unsigned char*)d_ws;
#define LAUNCH(lo_, hi_) do { a.ph_lo = (lo_); a.ph_hi = (hi_); hipLaunchKernelGGL(fk::fwd, dim3(grid), dim3(fk::NTHR), fk::LDS_BYTES, stream, a); } while (0)
#if ONE_LAUNCH && (FAST_LAYERS == 15)
#ifdef TIMELINE
    LAUNCH(0, fk::PH_FINAL + 2);
#else
    LAUNCH(0, fk::PH_FINAL + 1);
#endif
#else
    nv::In in;
    in.x = (const float*)d_in[0]; in.p = (const float*)d_in[1]; in.pos = (const int*)d_in[2]; in.norm_g = (const float*)d_in[3];
    in.mla_w_in = (const float*)d_in[4]; in.mla_q_norm = (const float*)d_in[5]; in.mla_w_q_b = (const float*)d_in[6];
    in.mla_kv_norm = (const float*)d_in[7]; in.mla_w_kv_b = (const float*)d_in[8]; in.mla_w_out = (const float*)d_in[9];
    in.conv_w_in = (const float*)d_in[10]; in.conv_w = (const float*)d_in[11]; in.conv_w_out = (const float*)d_in[12];
    in.mlstm_w_in = (const float*)d_in[13]; in.mlstm_b_gates = (const float*)d_in[14]; in.mlstm_w_out = (const float*)d_in[15];
    in.ple_proj = (const float*)d_in[16]; in.ple_gate = (const float*)d_in[17]; in.final_norm = (const float*)d_in[18];
    float* nws = (float*)((char*)d_ws + 2 * fk::MiB);
    LAUNCH(0, 1);
    for (int i = 0; i < 4; ++i) {
        if ((FAST_LAYERS >> i) & 1) {
            if (i > 0 && !((FAST_LAYERS >> (i - 1)) & 1)) LAUNCH(fk::PH_REFRESH + i, fk::PH_REFRESH + i + 1);
            for (int s = 0; s < fk::PH_PER_LAYER; ++s) LAUNCH(1 + fk::PH_PER_LAYER * i + s, 1 + fk::PH_PER_LAYER * i + s + 1);
        } else {
            nv::layer(in, (float*)d_out, nws, stream, i, i == 0);
        }
    }
    if ((FAST_LAYERS >> 3) & 1) LAUNCH(fk::PH_FINAL, fk::PH_FINAL + 1);
    else nv::final_norm(in, (float*)d_out, stream);
#endif
#undef LAUNCH
}
```

```cpp
#include <hip/hip_runtime.h>
#include <cstdio>
#include <cstdint>
#include <math.h>
#define LAS __attribute__((address_space(3)))
#define GAS __attribute__((address_space(1)))
#define FAST_LAYERS 15
#define ONE_LAUNCH 1
namespace pg8 {
#define PG8_LAS __attribute__((address_space(3)))
typedef unsigned short bf16_t;
typedef short bf16x8 __attribute__((ext_vector_type(8)));
typedef float f32x4 __attribute__((ext_vector_type(4)));
typedef unsigned u32x4 __attribute__((ext_vector_type(4)));
constexpr int BM = 256, BK = 64, HALF = 128, HTB = HALF * BK * 2  , STAGE_BYTES = 8 * HTB, NXCD = 8, WGM = 8;

__host__ __device__ __forceinline__ int lds_byte(int r, int c) { const int st = (r >> 4) * 2 + (c >> 5), rr = r & 15, cc = c & 31, ob = rr * 64 + cc * 2; return st * 1024 + (ob ^ (((ob >> 9) & 1) << 5)); }
__host__ __device__ __forceinline__ void stage_rc(int b, int& R, int& C) { const int st = b / 1024, sb = b % 1024, swz = sb ^ (((sb >> 9) & 1) << 5); R = (st >> 1) * 16 + swz / 64; C = (st & 1) * 32 + (swz % 64) / 2; }
__host__ __device__ __forceinline__ int perm32(int rho) { const int n = rho >> 4, i = rho & 15; return 8 * (i >> 2) + 4 * n + (i & 3); }

struct Unit { int pm, pn; };
struct Gemm { const bf16_t* A; const bf16_t* Bt; int M, N, K; };

struct StaticOrder {
    int nM, nN, nwg, G, c;
    __host__ __device__ void init(int M, int N, int G_, int c_) { nM = M / BM; nN = N / BM; nwg = nM * nN; G = G_; c = c_; }
    __host__ __device__ bool next(int i, Unit& u) const {
        const long L = (long)i * G + c; if (L >= nwg) return false;
        int wgid = (int)L; { const int q = nwg / NXCD, r = nwg % NXCD, xcd = wgid % NXCD, off = wgid / NXCD; wgid = (xcd < r ? xcd * (q + 1) : r * (q + 1) + (xcd - r) * q) + off; }
        const int nig = WGM * nN, gid = wgid / nig, fm = gid * WGM, gsz = (nM - fm) < WGM ? (nM - fm) : WGM;
        u.pm = fm + ((wgid % nig) % gsz); u.pn = (wgid % nig) / gsz; return true;
    }
    __device__ __forceinline__ void a_ready(const Unit&) const {}
    __device__ __forceinline__ void done(const Unit&) const {}
};

template <class Epi, class Sched, bool ALIGN_EPI = false, bool SP2 = false>
__device__ __forceinline__ void gemm_phase(PG8_LAS unsigned char* lds, const Gemm g, const Sched& S, const Epi& E) {
    int tid_ = threadIdx.x; asm volatile("" : "+v"(tid_));
    const int tid = tid_, wid = __builtin_amdgcn_readfirstlane(tid >> 6), lane = tid & 63, wr = wid >> 2, wc = wid & 3, fr = lane & 15, fq = lane >> 4;
    const int K = g.K, nt = K / BK;
    unsigned voffA[2], voffB[2];
#pragma unroll
    for (int i = 0; i < 2; ++i) { int R, C; stage_rc(tid * 16 + i * 8192, R, C); const int Rb = Epi::PERM ? ((R & ~31) + perm32(R & 31)) : R;
        voffA[i] = (unsigned)(R * K + C) * 2u; voffB[i] = (unsigned)(Rb * K + C) * 2u; }
    const size_t kstep = (size_t)(BK * 2);
    const size_t hstep = (size_t)HALF * K * 2;
    const size_t tstep = 2 * hstep;
    const unsigned ldsw = (unsigned)wid * 1024u;
    const int aoff = lds_byte(wr * 64 + fr, fq * 8), boff = lds_byte(wc * 32 + fr, fq * 8);
#define PG8_SA(b, h) (((b) * 2 + (h)) * HTB)
#define PG8_SB(b, h) ((4 + (b) * 2 + (h)) * HTB)
#define PG8_STAGE(bufoff, gbase, voff) do { _Pragma("unroll") for (int _i = 0; _i < 2; ++_i) \
        __builtin_amdgcn_global_load_lds((const unsigned*)((const char*)(gbase) + (voff)[_i]), (PG8_LAS unsigned*)(lds + (bufoff) + ldsw + _i * 8192), 16, 0, 0); } while (0)
#define PG8_LDA(dst, b, h) do { _Pragma("unroll") for (int m = 0; m < 4; ++m) _Pragma("unroll") for (int k = 0; k < 2; ++k) dst[m][k] = *(const PG8_LAS bf16x8*)(lds + PG8_SA(b, h) + aoff + m * 2048 + k * 1024); } while (0)
#define PG8_LDB(dst, b, h) do { _Pragma("unroll") for (int n = 0; n < 2; ++n) _Pragma("unroll") for (int k = 0; k < 2; ++k) dst[n][k] = *(const PG8_LAS bf16x8*)(lds + PG8_SB(b, h) + boff + n * 2048 + k * 1024); } while (0)
#define PG8_MMA(ai, bj, At, Bt) do { __builtin_amdgcn_s_setprio(1); _Pragma("unroll") for (int m = 0; m < 4; ++m) _Pragma("unroll") for (int n = 0; n < 2; ++n) _Pragma("unroll") for (int k = 0; k < 2; ++k) \
        acc[ai][bj][m][n] = __builtin_amdgcn_mfma_f32_16x16x32_bf16(Bt[n][k], At[m][k], acc[ai][bj][m][n], 0, 0, 0); __builtin_amdgcn_s_setprio(0); } while (0)
#define PG8_WAIT_V(n) asm volatile("s_waitcnt vmcnt(" #n ")" ::: "memory")
#define PG8_WAIT_L(n) asm volatile("s_waitcnt lgkmcnt(" #n ")" ::: "memory")
#define PG8_BAR __builtin_amdgcn_s_barrier()
#define PG8_SCHED __builtin_amdgcn_sched_barrier(0)
    Unit cur, nxt; int ui = 0;
    if (!S.next(0, cur)) return;
    f32x4 acc[2][2][4][2];
#pragma unroll
    for (int a = 0; a < 2; ++a)
#pragma unroll
        for (int b = 0; b < 2; ++b)
#pragma unroll
            for (int m = 0; m < 4; ++m)
#pragma unroll
                for (int n = 0; n < 2; ++n) acc[a][b][m][n] = (f32x4){0.f, 0.f, 0.f, 0.f};
    bf16x8 At[4][2], B0[2][2], B1[2][2];
    const char* cA = (const char*)g.A + (size_t)cur.pm * tstep; const char* cB = (const char*)g.Bt + (size_t)cur.pn * tstep;
    S.a_ready(cur);
    if constexpr (SP2) {
        PG8_STAGE(PG8_SB(0, 0), cB, voffB); PG8_STAGE(PG8_SB(0, 1), cB + hstep, voffB); PG8_STAGE(PG8_SA(0, 0), cA, voffA); PG8_STAGE(PG8_SA(0, 1), cA + hstep, voffA);
        if (wr == 1) PG8_BAR;
        PG8_WAIT_V(2); PG8_BAR;
        PG8_STAGE(PG8_SB(1, 0), cB + kstep, voffB); PG8_STAGE(PG8_SA(1, 0), cA + kstep, voffA); PG8_STAGE(PG8_SB(1, 1), cB + hstep + kstep, voffB);
        PG8_WAIT_V(6); PG8_BAR;
    } else {
        PG8_STAGE(PG8_SB(0, 0), cB, voffB); PG8_STAGE(PG8_SA(0, 0), cA, voffA); PG8_STAGE(PG8_SB(0, 1), cB + hstep, voffB); PG8_STAGE(PG8_SA(0, 1), cA + hstep, voffA);
        if (wr == 1) PG8_BAR;
        PG8_WAIT_V(4); PG8_BAR;
        PG8_STAGE(PG8_SB(1, 0), cB + kstep, voffB); PG8_STAGE(PG8_SA(1, 0), cA + kstep, voffA); PG8_STAGE(PG8_SB(1, 1), cB + hstep + kstep, voffB);
        PG8_WAIT_V(6); PG8_BAR;
    }
    for (;;) {
        const bool has_next = S.next(ui + 1, nxt);
        const char* nA = has_next ? (const char*)g.A + (size_t)nxt.pm * tstep : cA; const char* nB = has_next ? (const char*)g.Bt + (size_t)nxt.pn * tstep : cB;
        for (int t = 0; t < nt; t += 2) {
            const bool last = (t == nt - 2);
            const char* a1 = cA + (size_t)(t + 1) * kstep;
            const char* a2 = last ? nA : cA + (size_t)(t + 2) * kstep; const char* b2 = last ? nB : cB + (size_t)(t + 2) * kstep;
            const char* a3 = a2 + kstep; const char* b3 = b2 + kstep;
            if (last && has_next) S.a_ready(nxt);
            if constexpr (SP2) {
            PG8_LDB(B0, 0, 0); PG8_LDB(B1, 0, 1); PG8_SCHED; PG8_LDA(At, 0, 0); PG8_STAGE(PG8_SA(1, 1), a1 + hstep, voffA);
            PG8_WAIT_V(8); PG8_WAIT_L(0); PG8_BAR; PG8_MMA(0, 0, At, B0); PG8_MMA(0, 1, At, B1); PG8_BAR; PG8_SCHED;
            PG8_LDA(At, 0, 1); PG8_STAGE(PG8_SB(0, 0), b2, voffB); PG8_STAGE(PG8_SB(0, 1), b2 + hstep, voffB); PG8_STAGE(PG8_SA(0, 0), a2, voffA);
            PG8_WAIT_V(8); PG8_WAIT_L(0); PG8_BAR; PG8_MMA(1, 0, At, B0); PG8_MMA(1, 1, At, B1); PG8_BAR; PG8_SCHED;
            PG8_LDB(B0, 1, 0); PG8_LDB(B1, 1, 1); PG8_SCHED; PG8_LDA(At, 1, 0); PG8_STAGE(PG8_SA(0, 1), a2 + hstep, voffA);
            PG8_WAIT_V(8); PG8_WAIT_L(0); PG8_BAR; PG8_MMA(0, 0, At, B0); PG8_MMA(0, 1, At, B1); PG8_BAR; PG8_SCHED;
            PG8_LDA(At, 1, 1); PG8_STAGE(PG8_SB(1, 0), b3, voffB); PG8_STAGE(PG8_SB(1, 1), b3 + hstep, voffB); PG8_STAGE(PG8_SA(1, 0), a3, voffA);
            PG8_WAIT_V(8); PG8_WAIT_L(0); PG8_BAR; PG8_MMA(1, 0, At, B0); PG8_MMA(1, 1, At, B1); PG8_BAR; PG8_SCHED;
            } else {
            PG8_LDB(B0, 0, 0); PG8_SCHED; PG8_LDA(At, 0, 0); PG8_STAGE(PG8_SA(1, 1), a1 + hstep, voffA);
            PG8_WAIT_L(8); PG8_BAR; PG8_WAIT_L(0); PG8_MMA(0, 0, At, B0); PG8_BAR; PG8_SCHED;
            PG8_LDB(B1, 0, 1); PG8_STAGE(PG8_SB(0, 0), b2, voffB);
            PG8_BAR; PG8_WAIT_L(0); PG8_MMA(0, 1, At, B1); PG8_BAR;
            PG8_LDA(At, 0, 1); PG8_STAGE(PG8_SA(0, 0), a2, voffA);
            PG8_BAR; PG8_WAIT_L(0); PG8_MMA(1, 0, At, B0); PG8_BAR; PG8_SCHED;
            PG8_STAGE(PG8_SB(0, 1), b2 + hstep, voffB);
            PG8_WAIT_V(6); PG8_BAR; PG8_MMA(1, 1, At, B1); PG8_BAR;
            PG8_LDB(B0, 1, 0); PG8_SCHED; PG8_LDA(At, 1, 0); PG8_STAGE(PG8_SA(0, 1), a2 + hstep, voffA);
            PG8_WAIT_L(8); PG8_BAR; PG8_WAIT_L(0); PG8_MMA(0, 0, At, B0); PG8_BAR; PG8_SCHED;
            PG8_LDB(B1, 1, 1); PG8_STAGE(PG8_SB(1, 0), b3, voffB);
            PG8_BAR; PG8_WAIT_L(0); PG8_MMA(0, 1, At, B1); PG8_BAR;
            PG8_LDA(At, 1, 1); PG8_STAGE(PG8_SA(1, 0), a3, voffA);
            PG8_BAR; PG8_WAIT_L(0); PG8_MMA(1, 0, At, B0); PG8_BAR; PG8_SCHED;
            PG8_STAGE(PG8_SB(1, 1), b3 + hstep, voffB);
            PG8_WAIT_V(6); PG8_BAR; PG8_MMA(1, 1, At, B1); PG8_BAR;
            }
        }
        if constexpr (ALIGN_EPI) { if (wr == 0) PG8_BAR; }
        if constexpr (!Epi::AFTER_DRAIN) { E(acc, cur, wr, wc, fr, fq); S.done(cur); }
        if (!has_next) break;
#pragma unroll
        for (int a = 0; a < 2; ++a)
#pragma unroll
            for (int b = 0; b < 2; ++b)
#pragma unroll
                for (int m = 0; m < 4; ++m)
#pragma unroll
                    for (int n = 0; n < 2; ++n) acc[a][b][m][n] = (f32x4){0.f, 0.f, 0.f, 0.f};
        cur = nxt; cA = nA; cB = nB; ++ui;
        if constexpr (ALIGN_EPI) { if (wr == 1) PG8_BAR; }
    }
    PG8_WAIT_V(0);
    if constexpr (!ALIGN_EPI) { if (wr == 0) PG8_BAR; }
    PG8_BAR;
    if constexpr (Epi::AFTER_DRAIN) { E.fused(acc, cur, wr, wc, fr, fq, lds, wid, lane); S.done(cur); }
#undef PG8_SA
#undef PG8_SB
#undef PG8_STAGE
#undef PG8_LDA
#undef PG8_LDB
#undef PG8_MMA
#undef PG8_WAIT_V
#undef PG8_WAIT_L
#undef PG8_BAR
#undef PG8_SCHED
}
}
#define XB_TMO      128
#define XB_XCNT(j)  (256  + 64 * (j))
#define XB_XSUB(j)  (1280 + 64 * (j))
#define XB_XGEN(j)  (2304 + 64 * (j))
#define XB_TOP      3328
#define XB_TOPGEN   3392
#define XCD_BAR_WORDS 3456
#define XB_SPIN_CAP (1u << 18)

__device__ __forceinline__ unsigned xb_ld(unsigned* p)              { return __hip_atomic_load(p, __ATOMIC_RELAXED, __HIP_MEMORY_SCOPE_AGENT); }
__device__ __forceinline__ unsigned xb_add(unsigned* p, unsigned v) { return __hip_atomic_fetch_add(p, v, __ATOMIC_RELAXED, __HIP_MEMORY_SCOPE_AGENT); }
__device__ __forceinline__ unsigned xb_xcc_id() { return (unsigned)__builtin_amdgcn_s_getreg((3 << 11) | 20) & 0xFu; }
#define XB_SPIN(cond, bar) do { unsigned _sp = 0; while (cond) { __builtin_amdgcn_s_sleep(1); \
    if ((++_sp & 255u) == 0u) { if (xb_ld(&(bar)[XB_TMO])) break; if (_sp > XB_SPIN_CAP) { atomicAdd(&(bar)[XB_TMO], 1u); break; } } } } while (0)

struct XcdBarrier {
    unsigned* bar; unsigned x;
    volatile LAS unsigned* st;
};

__device__ __forceinline__ XcdBarrier xcd_barrier_post(unsigned* bar, volatile LAS unsigned* st) {
    XcdBarrier b; b.bar = bar; b.x = xb_xcc_id(); b.st = st;
    if (threadIdx.x == 0) (void)xb_add(&bar[XB_XCNT(b.x)], 1u);
    return b;
}
__device__ __forceinline__ void xcd_barrier_complete(unsigned* bar, unsigned x, unsigned& nloc, unsigned& nx) {
    const unsigned G = gridDim.x * gridDim.y * gridDim.z;
    unsigned sum, cnt, mine, sp = 0u;
    for (;;) {
        sum = 0u; cnt = 0u; mine = 0u;
#pragma unroll
        for (unsigned j = 0; j < 16; ++j) { const unsigned c = xb_ld(&bar[XB_XCNT(j)]); sum += c; cnt += (c > 0u) ? 1u : 0u; mine = (j == x) ? c : mine; }
        if (sum == G) break;
        __builtin_amdgcn_s_sleep(1);
        if ((++sp & 255u) == 0u) { if (xb_ld(&bar[XB_TMO])) break; if (sp > XB_SPIN_CAP) { atomicAdd(&bar[XB_TMO], 1u); break; } }
    }
    nloc = mine > 0u ? mine : 1u; nx = cnt > 0u ? cnt : 1u;
}

__device__ __forceinline__ void xcd_barrier(const XcdBarrier& b) {
    asm volatile("s_waitcnt vmcnt(0)" ::: "memory");
    __syncthreads();
    if (threadIdx.x == 0) {
        unsigned* bar = b.bar;
        __builtin_amdgcn_s_waitcnt(0);
        unsigned nloc = b.st[0], nx = b.st[1];
        if (nloc == 0u) { xcd_barrier_complete(bar, b.x, nloc, nx); b.st[0] = nloc; b.st[1] = nx; }
        const unsigned old = xb_add(&bar[XB_XSUB(b.x)], 1u);
        const unsigned gen = old / nloc;
        if (old + 1u == (gen + 1u) * nloc) {
            __builtin_amdgcn_fence(__ATOMIC_RELEASE, "agent");
            asm volatile("s_waitcnt vmcnt(0)" ::: "memory");
            const unsigned og = xb_add(&bar[XB_TOP], 1u);
            const unsigned tg = og / nx;
            if (og + 1u == (tg + 1u) * nx) xb_add(&bar[XB_TOPGEN], 1u);
            else XB_SPIN(xb_ld(&bar[XB_TOPGEN]) == tg, bar);
            __builtin_amdgcn_fence(__ATOMIC_ACQUIRE, "agent");
            xb_add(&bar[XB_XGEN(b.x)], 1u);
            asm volatile("s_waitcnt vmcnt(0)" ::: "memory");
        } else {
            XB_SPIN(xb_ld(&bar[XB_XGEN(b.x)]) == gen, bar);
            __builtin_amdgcn_fence(__ATOMIC_ACQUIRE, "agent");
            asm volatile("s_waitcnt vmcnt(0)" ::: "memory");
        }
    }
    __syncthreads();
}
namespace fk {
using pg8::bf16_t; using pg8::bf16x8; using pg8::f32x4; using pg8::u32x4; using pg8::Unit;
typedef float f32x16 __attribute__((ext_vector_type(16)));
typedef float f32x2 __attribute__((ext_vector_type(2)));
typedef __bf16 bf16x2_t __attribute__((ext_vector_type(2)));
typedef short s16x4 __attribute__((ext_vector_type(4)));
typedef unsigned u32x2 __attribute__((ext_vector_type(2)));
#define DI __device__ __forceinline__

constexpr int NB = 8, S = 2048, M = NB * S, D = 1024;
constexpr float EPS = 1e-6f, LOG2E = 1.4426950408889634f;
constexpr int NTHR = 512;

DI int tidx() { int t = threadIdx.x; asm volatile("" : "+v"(t)); return t; }
DI unsigned pk2(float lo, float hi) { f32x2 v = {lo, hi}; return __builtin_bit_cast(unsigned, __builtin_convertvector(v, bf16x2_t)); }
DI float bflo(unsigned u) { return __uint_as_float(u << 16); }
DI float bfhi(unsigned u) { return __uint_as_float(u & 0xffff0000u); }
DI float bf1(unsigned short b) { return __uint_as_float((unsigned)b << 16); }
DI float sigm(float x) { return 1.f / (1.f + __expf(-x)); }
DI float silu(float x) { return x * sigm(x); }
DI float ex2(float x) { return __builtin_amdgcn_exp2f(x); }
DI u32x4 pk8(const f32x4& a, const f32x4& b) { u32x4 w; w.x = pk2(a[0], a[1]); w.y = pk2(a[2], a[3]); w.z = pk2(b[0], b[1]); w.w = pk2(b[2], b[3]); return w; }
DI void unpk8(u32x4 w, f32x4& a, f32x4& b) { a[0] = bflo(w.x); a[1] = bfhi(w.x); a[2] = bflo(w.y); a[3] = bfhi(w.y); b[0] = bflo(w.z); b[1] = bfhi(w.z); b[2] = bflo(w.w); b[3] = bfhi(w.w); }

constexpr size_t KiB = 1024, MiB = 1u << 20;
constexpr size_t WS_CTL = 0;
constexpr size_t WS_SSQ = 64 * KiB;
constexpr int SSQ_X = 0  , SSQ_1 = 5  , SSQ_Q = 9  , SSQ_KV = 11  ;
constexpr size_t ZERO_BYTES = 1792 * KiB;
constexpr size_t WS_GW8 = 1792 * KiB;
constexpr size_t WS_WMIX = 2 * MiB;
constexpr size_t WS_WPLE = 23 * MiB;
constexpr size_t WS_XBA = 26 * MiB;
constexpr size_t WS_BIG = 58 * MiB;
constexpr size_t WS_CS = WS_BIG + 192 * MiB, WS_SN = WS_CS + 1 * MiB, WS_IG = WS_SN + 1 * MiB, WS_LF = WS_IG + 256 * KiB;
constexpr size_t WS_END = 256 * MiB;
static_assert(WS_LF + 256 * KiB <= WS_END, "ws map");
constexpr size_t WM_IN = 0, WM_QB = 4 * MiB, WM_KVB = 6 * MiB, WM_OUT_MLA = 8 * MiB, WM_OUT_CONV = 8 * MiB, WM_OUT_LSTM = 16 * MiB;
constexpr size_t A_SZ = 0, A_Q = 32 * MiB, A_KN = 80 * MiB, A_VT = 112 * MiB, A_CQ = 144 * MiB, A_CKV = 156 * MiB, A_KR = 164 * MiB, A_XBB = 32 * MiB, A_PP = 80 * MiB, A_PB = 166 * MiB;
constexpr size_t C_CH = 0, C_BZ = 32 * MiB, C_XBB = 64 * MiB, C_PP = 96 * MiB, C_PB = 166 * MiB;
constexpr size_t L_Q = 0, L_K = 32 * MiB, L_VT = 64 * MiB, L_OG = 128 * MiB, L_XBB = 0, L_PP = 64 * MiB;

struct Args { const float* in[19]; float* out; unsigned char* ws; int ph_lo, ph_hi; };
enum { I_X = 0, I_P, I_POS, I_NORMG, I_MLA_WIN, I_MLA_QN, I_MLA_WQB, I_MLA_KVN, I_MLA_WKVB, I_MLA_WOUT, I_CONV_WIN, I_CONV_W, I_CONV_WOUT, I_L_WIN, I_L_BG, I_L_WOUT, I_PLE_PROJ, I_PLE_GATE, I_FNORM };

enum { PM_ID = 0, PM_MLA_IN, PM_MLA_QB, PM_MLA_KVB, PM_CONV_IN, PM_LSTM_IN };
DI int prep_src(int mode, int n, float& sc) {
    sc = 1.f;
    switch (mode) {
    case PM_MLA_IN: { if (n < 1024) return 672 + n; if (n < 1408) return n - 1024; if (n < 1664) return 384 + (n - 1408); if (n < 1696) { const int jj = n - 1664; return 640 + (jj >> 1) + 16 * (jj & 1); } return -1; }
    case PM_MLA_QB: { sc = 0.10206207261596577f * LOG2E; const int hd = n / 96, d = n % 96; if (d < 64) return n; const int jj = d - 64; return 96 * hd + 64 + (jj >> 1) + 16 * (jj & 1); }
    case PM_MLA_KVB: { if (n < 1024) return 128 * (n >> 6) + (n & 63); const int n2 = n - 1024; return 128 * (n2 >> 6) + 64 + (n2 & 63); }
    case PM_CONV_IN: { const int pn = n >> 8, bj = (n >> 7) & 1, i = n & 127; if (pn < 8) return (bj ? 2048 : 1024) + 128 * pn + i; return (bj ? 3072 : 0) + 128 * (pn - 8) + i; }
    case PM_LSTM_IN: { if (n < 4096) { if (n >= 1024 && n < 2048) sc = 0.0625f; return n; } const int n2 = n - 4096, pn = n2 >> 8, bj = (n2 >> 7) & 1, i = n2 & 127; return (bj ? 6144 : 4096) + 128 * pn + i; }
    default: return n;
    }
}
struct PrepTask { const float* W; int ldw; const float* gk; int K, Nst, mode; bf16_t* out; };
DI void prep_tile(const PrepTask& t, int tile, LAS float* scr) {
    const int tid = tidx(), nkb = t.K >> 7, nb = tile / nkb, kb = tile % nkb, n0 = nb << 6, k0 = kb << 7;
    const int nn = tid & 63, kq = tid >> 6;
    float sc; const int src = prep_src(t.mode, n0 + nn, sc);
    float v[16];
#pragma unroll
    for (int i = 0; i < 16; ++i) { const int kk = kq + 8 * i; v[i] = (src >= 0) ? t.W[(size_t)(k0 + kk) * t.ldw + src] : 0.f; }
#pragma unroll
    for (int i = 0; i < 16; ++i) { const int kk = kq + 8 * i; float x = v[i] * sc; if (t.gk) x *= t.gk[k0 + kk]; scr[nn * 129 + kk] = x; }
    __syncthreads();
#pragma unroll
    for (int h2 = 0; h2 < 2; ++h2) { const int e = tid + h2 * NTHR, n2 = e >> 4, c = e & 15; const LAS float* sp = scr + n2 * 129 + 8 * c;
      u32x4 o; o.x = pk2(sp[0], sp[1]); o.y = pk2(sp[2], sp[3]); o.z = pk2(sp[4], sp[5]); o.w = pk2(sp[6], sp[7]);
      *(u32x4*)(t.out + (size_t)(n0 + n2) * t.K + k0 + 8 * c) = o; }
    __syncthreads();
}
DI void prep_run1(const PrepTask& t, LAS float* scr, int cu, int G) {
    const int total = (t.Nst >> 6) * (t.K >> 7);
#pragma unroll 1
    for (int it = cu; it < total; it += G) prep_tile(t, it, scr);
}

DI float wave_sum(float v) {
#pragma unroll
    for (int o = 1; o < 64; o <<= 1) v += __shfl_xor(v, o);
    return v;
}
DI void rows_to_bf16_ssq(const float* x, bf16_t* xb, unsigned long long* ssq, int gw, int NGW, int lane) {
    for (int m = gw; m < M; m += 2 * NGW) {
        const int m2 = m + NGW; const bool two = m2 < M;
        const f32x4* xr = (const f32x4*)(x + (size_t)m * D) + lane; const f32x4* xr2 = (const f32x4*)(x + (size_t)(two ? m2 : m) * D) + lane;
        f32x4 v[4], v2[4];
#pragma unroll
        for (int j = 0; j < 4; ++j) { v[j] = xr[64 * j]; v2[j] = xr2[64 * j]; }
        float s = 0.f, s2 = 0.f;
        u32x2* o8 = (u32x2*)(xb + (size_t)m * D) + lane; u32x2* o82 = (u32x2*)(xb + (size_t)m2 * D) + lane;
#pragma unroll
        for (int j = 0; j < 4; ++j) {
            s += (v[j][0] * v[j][0] + v[j][1] * v[j][1]) + (v[j][2] * v[j][2] + v[j][3] * v[j][3]); u32x2 w; w.x = pk2(v[j][0], v[j][1]); w.y = pk2(v[j][2], v[j][3]); o8[64 * j] = w;
            s2 += (v2[j][0] * v2[j][0] + v2[j][1] * v2[j][1]) + (v2[j][2] * v2[j][2] + v2[j][3] * v2[j][3]); if (two) { u32x2 w2; w2.x = pk2(v2[j][0], v2[j][1]); w2.y = pk2(v2[j][2], v2[j][3]); o82[64 * j] = w2; }
        }
        s = wave_sum(s); s2 = wave_sum(s2);
        if (lane == 0) { ssq[m] = (unsigned long long)(s * 16777216.f); if (two) ssq[m2] = (unsigned long long)(s2 * 16777216.f); }
    }
}
DI void p_to_bf16(const float* p, bf16_t* pb, int gt, int NGT) {
    constexpr size_t N8 = (size_t)M * 256 / 8;
    for (size_t i = gt; i < N8; i += (size_t)4 * NGT) {
        f32x4 a[4], b[4];
#pragma unroll
        for (int k = 0; k < 4; ++k) { const size_t e = i + (size_t)k * NGT; if (e < N8) { a[k] = ((const f32x4*)p)[2 * e]; b[k] = ((const f32x4*)p)[2 * e + 1]; } }
#pragma unroll
        for (int k = 0; k < 4; ++k) { const size_t e = i + (size_t)k * NGT; if (e < N8) ((u32x4*)pb)[e] = pk8(a[k], b[k]); }
    }
}
DI void rope_tables(const int* pos, float* cs, float* sn, int gt, int NGT) {
    for (int i = gt; i < M * 16; i += NGT) {
        const int t = i >> 4, j = i & 15;
        const float inv = powf(10000.0f, -(float)(2 * j) / 32.0f);
        const float ang = (float)pos[t] * inv;
        double rev = (double)ang * 0.15915494309189533577; rev -= rint(rev);
        const float fr = (float)rev;
        cs[i] = __builtin_amdgcn_cosf(fr); sn[i] = __builtin_amdgcn_sinf(fr);
    }
}

#define EPI_ROW(u, ai, m) ((u).pm * 256 + (ai) * 128 + wr * 64 + (m) * 16 + fr)
#define EPI_LOOP_AM _Pragma("unroll") for (int ai = 0; ai < 2; ++ai) _Pragma("unroll") for (int m = 0; m < 4; ++m)
typedef const f32x4 (&AccRef)[2][2][4][2];
#ifndef NT_STORES
#define NT_STORES 0
#endif
#ifndef SC1_STORES
#define SC1_STORES 0
#endif
DI void st16(const void* base, bf16_t* p, const u32x4& v) {
    if (SC1_STORES) __builtin_amdgcn_raw_buffer_store_b128(v, __builtin_amdgcn_make_buffer_rsrc((void*)base, 0, 0xFFFFFFFFu, 0x00020000), (unsigned)((const char*)p - (const char*)base), 0, 16);
    else if (NT_STORES) __builtin_nontemporal_store(v, (u32x4*)p); else *(u32x4*)p = v; }
DI float sq8(const f32x4& a, const f32x4& b) { return (a[0] * a[0] + a[1] * a[1]) + (a[2] * a[2] + a[3] * a[3]) + (b[0] * b[0] + b[1] * b[1]) + (b[2] * b[2] + b[3] * b[3]); }
DI float red_fq(float s) { s += __shfl_xor(s, 16); s += __shfl_xor(s, 32); return s; }
DI void rope8(f32x4& a, f32x4& b, const float* cs, const float* sn, int row, int p0) {
    const f32x4 c = *(const f32x4*)(cs + (size_t)row * 16 + p0), s = *(const f32x4*)(sn + (size_t)row * 16 + p0);
    const f32x4 a0 = a, b0 = b;
    a[0] = a0[0] * c[0] - a0[1] * s[0]; a[1] = a0[0] * s[0] + a0[1] * c[0];
    a[2] = a0[2] * c[1] - a0[3] * s[1]; a[3] = a0[2] * s[1] + a0[3] * c[1];
    b[0] = b0[0] * c[2] - b0[1] * s[2]; b[1] = b0[0] * s[2] + b0[1] * c[2];
    b[2] = b0[2] * c[3] - b0[3] * s[3]; b[3] = b0[2] * s[3] + b0[3] * c[3];
}

DI int opaque(int v) { asm volatile("" : "+s"(v)); return v; }
template <class T> DI T* launder(T* p) { asm volatile("" : "+s"(p)); return p; }
typedef unsigned long long u64;
constexpr float SSQ_SCALE = 16777216.f, SSQ_INV = 1.f / 16777216.f;
DI u64* ssq_arr(unsigned char* ws, int idx) { return (u64*)(ws + WS_SSQ) + (size_t)idx * M; }
DI void ssq_add(u64* p, float s) { atomicAdd(p, (u64)(s * SSQ_SCALE)); }
DI float ssq_rstd(const u64* p, float invn) { return rsqrtf((float)(*p) * SSQ_INV * invn + EPS); }

#define EPI_RS8(rsarr, ssqp, invn) float rsarr[2][4]; { u64 t_[2][4]; _Pragma("unroll") for (int ai = 0; ai < 2; ++ai) _Pragma("unroll") for (int m = 0; m < 4; ++m) t_[ai][m] = (ssqp)[EPI_ROW(u, ai, m)]; \
    _Pragma("unroll") for (int ai = 0; ai < 2; ++ai) _Pragma("unroll") for (int m = 0; m < 4; ++m) rsarr[ai][m] = rsqrtf((float)t_[ai][m] * SSQ_INV * (invn) + EPS); }

struct EpiA1 {
    static constexpr bool PERM = true, AFTER_DRAIN = false;
    unsigned char* ws; int i, j;
    DI void operator()(AccRef acc, const Unit& u, int wr, int wc, int fr, int fq) const {
        unsigned char* w = launder(ws); unsigned char* big = w + WS_BIG;
        const u64* ssq_x = ssq_arr(w, SSQ_X + i); u64* ssq_q = ssq_arr(w, SSQ_Q + j); u64* ssq_kv = ssq_arr(w, SSQ_KV + j);
        bf16_t *SZ = (bf16_t*)(big + A_SZ), *CQ = (bf16_t*)(big + A_CQ), *CKV = (bf16_t*)(big + A_CKV), *KR = (bf16_t*)(big + A_KR);
        const float *CS = (const float*)(w + WS_CS), *SN = (const float*)(w + WS_SN);
        EPI_RS8(rsv, ssq_x, 1.f / 1024.f);
        EPI_LOOP_AM {
            const int row = EPI_ROW(u, ai, m); const float rs = rsv[ai][m];
            float sq = 0.f, skv = 0.f; bool hq = false, hkv = false;
#pragma unroll
            for (int bj = 0; bj < 2; ++bj) {
                f32x4 v0 = acc[ai][bj][m][0] * rs, v1 = acc[ai][bj][m][1] * rs;
                if (u.pn < 4) {
                    const int col = u.pn * 256 + bj * 128 + wc * 32 + 8 * fq;
#pragma unroll
                    for (int jj = 0; jj < 4; ++jj) { v0[jj] = silu(v0[jj]); v1[jj] = silu(v1[jj]); }
                    st16(w, SZ + (size_t)row * 1024 + col, pk8(v0, v1));
                } else {
                    const int c = (u.pn - 4) * 256 + bj * 128 + wc * 32 + 8 * fq;
                    if (c < 384) { st16(w, CQ + (size_t)row * 384 + c, pk8(v0, v1)); sq += sq8(v0, v1); hq = true; }
                    else if (c < 640) { st16(w, CKV + (size_t)row * 256 + (c - 384), pk8(v0, v1)); skv += sq8(v0, v1); hkv = true; }
                    else if (c < 672) { const int jj0 = c - 640; rope8(v0, v1, CS, SN, row, jj0 >> 1); st16(w, KR + (size_t)row * 32 + jj0, pk8(v0, v1)); }
                }
            }
            if (u.pn >= 4) {
                sq = red_fq(sq); skv = red_fq(skv);
                if (fq == 0 && hq) ssq_add(ssq_q + row, sq);
                if (fq == 0 && hkv) ssq_add(ssq_kv + row, skv);
            }
        }
    }
};
struct EpiQ {
    static constexpr bool PERM = true, AFTER_DRAIN = false;
    unsigned char* ws; int j;
    DI void operator()(AccRef acc, const Unit& u, int wr, int wc, int fr, int fq) const {
        unsigned char* w = launder(ws); const u64* ssq_q = ssq_arr(w, SSQ_Q + j); bf16_t* Q = (bf16_t*)(w + WS_BIG + A_Q);
        const float *CS = (const float*)(w + WS_CS), *SN = (const float*)(w + WS_SN);
        EPI_RS8(rsv, ssq_q, 1.f / 384.f);
        EPI_LOOP_AM {
            const int row = EPI_ROW(u, ai, m); const float rs = rsv[ai][m];
#pragma unroll
            for (int bj = 0; bj < 2; ++bj) {
                const int col = u.pn * 256 + bj * 128 + wc * 32 + 8 * fq, d = col % 96;
                f32x4 v0 = acc[ai][bj][m][0] * rs, v1 = acc[ai][bj][m][1] * rs;
                if (d >= 64) rope8(v0, v1, CS, SN, row, (d - 64) >> 1);
                st16(w, Q + (size_t)row * 1536 + col, pk8(v0, v1));
            }
        }
    }
};
struct EpiKV {
    static constexpr bool PERM = true, AFTER_DRAIN = false;
    unsigned char* ws; int j;
    DI void operator()(AccRef acc, const Unit& u, int wr, int wc, int fr, int fq) const {
        unsigned char* w = launder(ws); const u64* ssq_kv = ssq_arr(w, SSQ_KV + j); bf16_t* O = (bf16_t*)(w + WS_BIG + (u.pn < 4 ? A_KN : A_VT));
        EPI_RS8(rsv, ssq_kv, 1.f / 256.f);
        EPI_LOOP_AM {
            const int row = EPI_ROW(u, ai, m); const float rs = rsv[ai][m];
#pragma unroll
            for (int bj = 0; bj < 2; ++bj) {
                const int col = (u.pn & 3) * 256 + bj * 128 + wc * 32 + 8 * fq;
                st16(w, O + (size_t)row * 1024 + col, pk8(acc[ai][bj][m][0] * rs, acc[ai][bj][m][1] * rs));
            }
        }
    }
};
struct EpiOut {
    static constexpr bool PERM = true, AFTER_DRAIN = false;
    unsigned char* ws; size_t xbb_off; int i;
    DI void operator()(AccRef acc, const Unit& u, int wr, int wc, int fr, int fq) const {
        unsigned char* w = launder(ws); u64* ssq = ssq_arr(w, SSQ_1 + i); bf16_t* XB = (bf16_t*)(w + WS_BIG + xbb_off); const bf16_t* xin = (const bf16_t*)(w + WS_XBA);
        const size_t cb = (size_t)u.pn * 256 + wc * 32 + 8 * fq;
        u32x4 cur[2], nxt[2];
#define EO_LOAD(dst, it) do { const size_t o_ = (size_t)EPI_ROW(u, (it) >> 2, (it) & 3) * 1024 + cb; dst[0] = *(const u32x4*)(xin + o_); dst[1] = *(const u32x4*)(xin + o_ + 128); } while (0)
        EO_LOAD(cur, 0);
#pragma unroll
        for (int it = 0; it < 8; ++it) {
            const int ai = it >> 2, m = it & 3;
            if (it < 7) EO_LOAD(nxt, it + 1);
            const int row = EPI_ROW(u, ai, m); float sq = 0.f;
#pragma unroll
            for (int bj = 0; bj < 2; ++bj) {
                const size_t off = (size_t)row * 1024 + cb + bj * 128;
                f32x4 x0, x1; unpk8(cur[bj], x0, x1);
                const f32x4 y0 = x0 + acc[ai][bj][m][0], y1 = x1 + acc[ai][bj][m][1];
                st16(w, XB + off, pk8(y0, y1)); sq += sq8(y0, y1);
            }
            sq = red_fq(sq); if (fq == 0) ssq_add(ssq + row, sq);
            cur[0] = nxt[0]; cur[1] = nxt[1];
        }
#undef EO_LOAD
    }
};
struct EpiPP {
    static constexpr bool PERM = true, AFTER_DRAIN = false;
    bf16_t* pp;
    DI void operator()(AccRef acc, const Unit& u, int wr, int wc, int fr, int fq) const {
        bf16_t* PP = launder(pp);
        EPI_LOOP_AM { const int row = EPI_ROW(u, ai, m);
#pragma unroll
            for (int bj = 0; bj < 2; ++bj) { const size_t off = (size_t)row * 1024 + u.pn * 256 + bj * 128 + wc * 32 + 8 * fq; st16(PP, PP + off, pk8(acc[ai][bj][m][0], acc[ai][bj][m][1])); } }
    }
};
struct EpiPle {
    static constexpr bool PERM = true, AFTER_DRAIN = false;
    unsigned char* ws; const bf16_t* pp; size_t xbb_off; int i;
    DI void operator()(AccRef acc, const Unit& u, int wr, int wc, int fr, int fq) const {
        unsigned char* w = launder(ws); const u64* ssq1 = ssq_arr(w, SSQ_1 + i); u64* ssq = ssq_arr(w, SSQ_X + i + 1);
        const bf16_t* PP = launder(pp); const bf16_t* X1 = (const bf16_t*)(w + WS_BIG + xbb_off); bf16_t* XB = (bf16_t*)(w + WS_XBA);
        const size_t cb = (size_t)u.pn * 256 + wc * 32 + 8 * fq;
        EPI_RS8(rsv, ssq1, 1.f / 1024.f);
        u32x4 cur[2], nxt[2], pc[2], pn2[2];
#define EP_LOAD(dst, pd, it) do { const size_t o_ = (size_t)EPI_ROW(u, (it) >> 2, (it) & 3) * 1024 + cb; dst[0] = *(const u32x4*)(X1 + o_); dst[1] = *(const u32x4*)(X1 + o_ + 128); \
            pd[0] = *(const u32x4*)(PP + o_); pd[1] = *(const u32x4*)(PP + o_ + 128); } while (0)
        EP_LOAD(cur, pc, 0);
#pragma unroll
        for (int it = 0; it < 8; ++it) {
            const int ai = it >> 2, m = it & 3;
            if (it < 7) EP_LOAD(nxt, pn2, it + 1);
            const int row = EPI_ROW(u, ai, m); const float rs = rsv[ai][m]; float sq = 0.f;
#pragma unroll
            for (int bj = 0; bj < 2; ++bj) {
                const size_t off = (size_t)row * 1024 + cb + bj * 128;
                f32x4 p0, p1, y0, y1; unpk8(pc[bj], p0, p1); unpk8(cur[bj], y0, y1);
#pragma unroll
                for (int jj = 0; jj < 4; ++jj) { y0[jj] += sigm(acc[ai][bj][m][0][jj] * rs) * p0[jj]; y1[jj] += sigm(acc[ai][bj][m][1][jj] * rs) * p1[jj]; }
                st16(w, XB + off, pk8(y0, y1)); sq += sq8(y0, y1);
            }
            sq = red_fq(sq); if (fq == 0) ssq_add(ssq + row, sq);
#pragma unroll
            for (int bj = 0; bj < 2; ++bj) { cur[bj] = nxt[bj]; pc[bj] = pn2[bj]; }
        }
#undef EP_LOAD
    }
};
struct EpiPleLast {
    static constexpr bool PERM = true, AFTER_DRAIN = true;
    unsigned char* ws; float* out; const float* gfin; const bf16_t* pp; size_t xbb_off; int i; unsigned xcc; volatile LAS unsigned* st;
    DI void fused(f32x4 (&acc)[2][2][4][2], const Unit& u, int wr, int wc, int fr, int fq, LAS unsigned char* lds, int wid, int lane) const {
        unsigned char* w = launder(ws); const u64* ssq1 = ssq_arr(w, SSQ_1 + i); u64* ssq = ssq_arr(w, SSQ_X + i + 1);
        const bf16_t* PP = launder(pp); const bf16_t* X1 = (const bf16_t*)(w + WS_BIG + xbb_off);
        const size_t cb = (size_t)u.pn * 256 + wc * 32 + 8 * fq;
        {
            EPI_RS8(rsv, ssq1, 1.f / 1024.f);
#pragma unroll
            for (int it = 0; it < 8; ++it) {
                const int ai = it >> 2, m = it & 3; const int row = EPI_ROW(u, ai, m); const float rs = rsv[ai][m]; float sq = 0.f;
#pragma unroll
                for (int bj = 0; bj < 2; ++bj) {
                    const size_t off = (size_t)row * 1024 + cb + bj * 128;
                    f32x4 p0, p1, y0, y1; unpk8(*(const u32x4*)(PP + off), p0, p1); unpk8(*(const u32x4*)(X1 + off), y0, y1);
#pragma unroll
                    for (int jj = 0; jj < 4; ++jj) { y0[jj] += sigm(acc[ai][bj][m][0][jj] * rs) * p0[jj]; y1[jj] += sigm(acc[ai][bj][m][1][jj] * rs) * p1[jj]; }
                    acc[ai][bj][m][0] = y0; acc[ai][bj][m][1] = y1; sq += sq8(y0, y1);
                }
                sq = red_fq(sq); if (fq == 0) ssq_add(ssq + row, sq);
            }
        }
        { XcdBarrier b; b.bar = (unsigned*)(launder(ws) + WS_CTL); b.x = xcc; b.st = st; xcd_barrier(b); }
        {
            const u64* ssqf = ssq_arr(launder(ws), SSQ_X + i + 1);
            EPI_RS8(rsf, ssqf, 1.f / 1024.f);
#pragma unroll
            for (int bj = 0; bj < 2; ++bj) {
                const f32x4 g0 = *(const f32x4*)(gfin + cb + bj * 128), g1 = *(const f32x4*)(gfin + cb + bj * 128 + 4);
                EPI_LOOP_AM { const size_t off = (size_t)EPI_ROW(u, ai, m) * 1024 + cb + bj * 128; const float rs = rsf[ai][m];
                    *(f32x4*)(out + off) = acc[ai][bj][m][0] * rs * g0; *(f32x4*)(out + off + 4) = acc[ai][bj][m][1] * rs * g1; }
            }
        }
    }
};
struct EpiC1 {
    static constexpr bool PERM = true, AFTER_DRAIN = false;
    unsigned char* ws; int i; int dry;
    DI void operator()(AccRef acc, const Unit& u, int wr, int wc, int fr, int fq) const {
        if (dry == 1) { asm volatile("" :: "v"(acc[0][0][0][0][0]), "v"(acc[1][1][3][1][3])); return; }
        unsigned char* w = launder(ws); const u64* ssq_x = ssq_arr(w, SSQ_X + i); bf16_t *CH = (bf16_t*)(w + WS_BIG + C_CH), *BZ = (bf16_t*)(w + WS_BIG + C_BZ);
        EPI_RS8(rsv, ssq_x, 1.f / 1024.f);
        EPI_LOOP_AM {
            const int row = EPI_ROW(u, ai, m); const float rs = rsv[ai][m];
            const size_t off = (size_t)row * 1024 + (u.pn & 7) * 128 + wc * 32 + 8 * fq;
            f32x4 r0, r1;
            if (u.pn < 8) { r0 = (acc[ai][0][m][0] * rs) * (acc[ai][1][m][0] * rs); r1 = (acc[ai][0][m][1] * rs) * (acc[ai][1][m][1] * rs); { const u32x4 o_ = pk8(r0, r1); if (dry == 2) asm volatile("" :: "v"(o_)); else st16(w, CH + off, o_); } }
            else {
#pragma unroll
                for (int jj = 0; jj < 4; ++jj) { r0[jj] = (acc[ai][0][m][0][jj] * rs) * silu(acc[ai][1][m][0][jj] * rs); r1[jj] = (acc[ai][0][m][1][jj] * rs) * silu(acc[ai][1][m][1][jj] * rs); }
                { const u32x4 o_ = pk8(r0, r1); if (dry == 2) asm volatile("" :: "v"(o_)); else st16(w, BZ + off, o_); }
            }
        }
    }
};
struct EpiL1 {
    static constexpr bool PERM = true, AFTER_DRAIN = false;
    unsigned char* ws; int i;
    DI void operator()(AccRef acc, const Unit& u, int wr, int wc, int fr, int fq) const {
        unsigned char* w = launder(ws); const u64* ssq_x = ssq_arr(w, SSQ_X + i); unsigned char* big = w + WS_BIG;
        EPI_RS8(rsv, ssq_x, 1.f / 1024.f);
        if (u.pn < 16) {
            bf16_t* O; int ld, c0;
            if (u.pn < 4) { O = (bf16_t*)(big + L_Q); ld = 1024; c0 = u.pn * 256; } else if (u.pn < 8) { O = (bf16_t*)(big + L_K); ld = 1024; c0 = (u.pn - 4) * 256; } else { O = (bf16_t*)(big + L_VT); ld = 2048; c0 = (u.pn - 8) * 256; }
            EPI_LOOP_AM {
                const int row = EPI_ROW(u, ai, m); const float rs = rsv[ai][m];
#pragma unroll
                for (int bj = 0; bj < 2; ++bj) st16(w, O + (size_t)row * ld + c0 + bj * 128 + wc * 32 + 8 * fq, pk8(acc[ai][bj][m][0] * rs, acc[ai][bj][m][1] * rs));
            }
        } else {
            bf16_t* OG = (bf16_t*)(big + L_OG);
            EPI_LOOP_AM {
                const int row = EPI_ROW(u, ai, m); const float rs = rsv[ai][m];
                const size_t off = (size_t)row * 2048 + (u.pn - 16) * 128 + wc * 32 + 8 * fq; f32x4 r0, r1;
#pragma unroll
                for (int jj = 0; jj < 4; ++jj) { r0[jj] = sigm(acc[ai][0][m][0][jj] * rs) * silu(acc[ai][1][m][0][jj] * rs); r1[jj] = sigm(acc[ai][0][m][1][jj] * rs) * silu(acc[ai][1][m][1][jj] * rs); }
                st16(w, OG + off, pk8(r0, r1));
            }
        }
    }
};
constexpr int AT_KSTR = 208, AT_VSTR = 192, AT_KB = 64 * AT_KSTR, AT_VB = 64 * AT_VSTR;
#define MFMA32(a, b, c) __builtin_amdgcn_mfma_f32_32x32x16_bf16((a), (b), (c), 0, 0, 0)
#define MFMA16(a, b, c) __builtin_amdgcn_mfma_f32_16x16x32_bf16((a), (b), (c), 0, 0, 0)
DI float max3f(float a, float b, float c) { float r; asm("v_max3_f32 %0, %1, %2, %3" : "=v"(r) : "v"(a), "v"(b), "v"(c)); return r; }
DI bf16x8 cat4(s16x4 lo, s16x4 hi) { return __builtin_shufflevector(lo, hi, 0, 1, 2, 3, 4, 5, 6, 7); }

struct AttnT { const bf16_t *Q, *KN, *KR, *VT; bf16_t* SZOG; };
#ifndef DIAG_NOLOAD
#define DIAG_NOLOAD 0
#endif
struct AttnStage { u32x4 k, r, v; };
DI void attn_unit(LAS unsigned char* lds, const AttnT& T, int b, int h, int qb, int dry) {
    const int tid = tidx(), w = __builtin_amdgcn_readfirstlane(tid >> 6), lane = tid & 63, r = lane & 31, hh = lane >> 5;
    const int tok0 = b * S, row0 = tok0 + qb * 256 + 32 * w;
    bf16x8 qf[6];
#pragma unroll
    for (int ks = 0; ks < 6; ++ks) qf[ks] = *(const bf16x8*)(T.Q + (size_t)(row0 + r) * 1536 + 96 * h + 16 * ks + 8 * hh);
    f32x16 O0, O1;
#pragma unroll
    for (int i = 0; i < 16; ++i) { O0[i] = 0.f; O1[i] = 0.f; }
    float mrun = -1e30f, lrun = 0.f;
    const int ntiles = 4 * qb + 4, myvis = 4 * qb + (w >> 1);
    const int kkey = tid >> 3, kch = tid & 7, rkey = tid >> 2, rch = tid & 3;
    const bf16_t* gK = T.KN + (size_t)(tok0 + kkey) * 1024 + 64 * h + 8 * kch;
    const bf16_t* gR = T.KR + (size_t)(tok0 + rkey) * 32 + 8 * rch;
    const bf16_t* gV = T.VT + (size_t)(tok0 + kkey) * 1024 + 64 * h + 8 * kch;
    const int lK = kkey * AT_KSTR + 16 * kch, lR = rkey * AT_KSTR + 128 + 16 * rch, lV = kkey * AT_VSTR + 16 * kch;
    const int krd = r * AT_KSTR + 16 * hh;
    const int vrd = (4 * hh + ((lane & 15) >> 2)) * AT_VSTR + (16 * ((lane >> 4) & 1) + 4 * (lane & 3)) * 2;
#define AT_LOADK(st, kt) do { if (DIAG_NOLOAD && dry) break; (st).k = *(const u32x4*)(gK + (size_t)(kt) * 64 * 1024); if (tid < 256) (st).r = *(const u32x4*)(gR + (size_t)(kt) * 64 * 32); } while (0)
#define AT_LOADV(st, kt) do { if (DIAG_NOLOAD && dry) break; (st).v = *(const u32x4*)(gV + (size_t)(kt) * 64 * 1024); } while (0)
#define AT_WRITEK(st, buf) do { LAS unsigned char* kb_ = lds + (buf) * AT_KB; *(LAS u32x4*)(kb_ + lK) = (st).k; if (tid < 256) *(LAS u32x4*)(kb_ + lR) = (st).r; } while (0)
#define AT_WRITEV(st, buf) do { *(LAS u32x4*)(lds + 2 * AT_KB + (buf) * AT_VB + lV) = (st).v; } while (0)
#define AT_QK1(sX, buf, blk) do { const LAS unsigned char* kb = lds + (buf) * AT_KB + krd + (blk) * 32 * AT_KSTR; \
        _Pragma("unroll") for (int i = 0; i < 16; ++i) sX[i] = 0.f; \
        _Pragma("unroll") for (int ks = 0; ks < 6; ++ks) sX = MFMA32(*(const LAS bf16x8*)(kb + 32 * ks), qf[ks], sX); } while (0)
#define AT_QK(sA, sB, buf) do { AT_QK1(sA, buf, 0); AT_QK1(sB, buf, 1); } while (0)
#define AT_MAX(s0, s1) \
          \
        asm volatile("s_nop 7\n\ts_nop 7\n\ts_nop 7" : "+v"(s0[0]), "+v"(s1[0])); \
        float mx = max3f(s0[0], s1[0], mrun); \
        _Pragma("unroll") for (int i = 1; i < 16; ++i) mx = max3f(mx, s0[i], s1[i]); \
        const float mnew = max3f(mx, __shfl_xor(mx, 32), mx), alpha = ex2(mrun - mnew); mrun = mnew;
#define AT_EXP(s0, s1) do { float ps = 0.f; \
        _Pragma("unroll") for (int i = 0; i < 16; ++i) { s0[i] = ex2(s0[i] - mrun); s1[i] = ex2(s1[i] - mrun); ps += s0[i] + s1[i]; } \
        lrun = lrun * alpha + ps; \
        _Pragma("unroll") for (int i = 0; i < 16; ++i) { O0[i] *= alpha; O1[i] *= alpha; } } while (0)
#define AT_PV(s0, s1, buf) do { LAS unsigned char* vb = lds + 2 * AT_KB + (buf) * AT_VB + vrd; \
        _Pragma("unroll") for (int kb2 = 0; kb2 < 2; ++kb2) _Pragma("unroll") for (int s = 0; s < 2; ++s) { \
            const f32x16& sx = kb2 ? s1 : s0; \
            u32x4 pw; pw.x = pk2(sx[8 * s + 0], sx[8 * s + 1]); pw.y = pk2(sx[8 * s + 2], sx[8 * s + 3]); pw.z = pk2(sx[8 * s + 4], sx[8 * s + 5]); pw.w = pk2(sx[8 * s + 6], sx[8 * s + 7]); \
            const bf16x8 pf = __builtin_bit_cast(bf16x8, pw); \
            LAS unsigned char* vp = vb + (32 * kb2 + 16 * s) * AT_VSTR; \
            const bf16x8 v0 = cat4(__builtin_amdgcn_ds_read_tr16_b64_v4i16((LAS s16x4*)vp), __builtin_amdgcn_ds_read_tr16_b64_v4i16((LAS s16x4*)(vp + 8 * AT_VSTR))); \
            const bf16x8 v1 = cat4(__builtin_amdgcn_ds_read_tr16_b64_v4i16((LAS s16x4*)(vp + 64)), __builtin_amdgcn_ds_read_tr16_b64_v4i16((LAS s16x4*)(vp + 64 + 8 * AT_VSTR))); \
            O0 = MFMA32(v0, pf, O0); O1 = MFMA32(v1, pf, O1); } } while (0)
#define AT_SOFTMAX_PV(s0, s1, buf) do { AT_MAX(s0, s1); AT_EXP(s0, s1); AT_PV(s0, s1, buf); } while (0)
#define AT_FUSED(c0, c1, n0, n1, bufK, bufV) do { AT_QK1(n0, bufK, 0); AT_MAX(c0, c1); __builtin_amdgcn_sched_barrier(0); \
        AT_QK1(n1, bufK, 1); AT_EXP(c0, c1); __builtin_amdgcn_sched_barrier(0); AT_PV(c0, c1, bufV); } while (0)
    AttnStage RA, RB;
    f32x16 a0, a1, b0, b1;
    AT_LOADK(RA, 0); AT_LOADV(RA, 0); AT_LOADK(RB, 1);
    AT_WRITEK(RA, 0); AT_WRITEV(RA, 0); AT_WRITEK(RB, 1);
    AT_LOADK(RA, 2); AT_LOADV(RA, 1);
    __syncthreads();
    AT_QK(a0, a1, 0);
    const int nmain = 4 * qb, jv = w >> 1;
    int t = 0;
#pragma unroll 1
    for (; t < nmain; t += 2) {
        AT_LOADK(RB, t + 3); AT_LOADV(RB, t + 2);
        AT_FUSED(a0, a1, b0, b1, 1, 0);
        AT_WRITEK(RA, 0); AT_WRITEV(RA, 1);
        __syncthreads();
        AT_LOADK(RA, t + 4); AT_LOADV(RA, t + 3);
        AT_FUSED(b0, b1, a0, a1, 0, 1);
        AT_WRITEK(RB, 1); AT_WRITEV(RB, 0);
        __syncthreads();
    }
    AT_LOADK(RB, t + 3); AT_LOADV(RB, t + 2);
    if (jv >= 1) AT_QK(b0, b1, 1);
    AT_SOFTMAX_PV(a0, a1, 0);
    AT_WRITEK(RA, 0); AT_WRITEV(RA, 1);
    __syncthreads();
    AT_LOADV(RA, t + 3);
    if (jv >= 2) AT_QK(a0, a1, 0);
    if (jv >= 1) AT_SOFTMAX_PV(b0, b1, 1);
    AT_WRITEK(RB, 1); AT_WRITEV(RB, 0);
    __syncthreads();
    if (jv >= 3) AT_QK(b0, b1, 1);
    if (jv >= 2) AT_SOFTMAX_PV(a0, a1, 0);
    AT_WRITEV(RA, 1);
    __syncthreads();
    if (jv >= 3) AT_SOFTMAX_PV(b0, b1, 1);
    __syncthreads();
#undef AT_LOADK
#undef AT_LOADV
#undef AT_WRITEK
#undef AT_WRITEV
#undef AT_QK
#undef AT_SOFTMAX_PV
#undef AT_QK1
#undef AT_MAX
#undef AT_EXP
#undef AT_PV
#undef AT_FUSED
    const float linv = 1.f / (lrun + __shfl_xor(lrun, 32));
    bf16_t* op = T.SZOG + (size_t)(row0 + r) * 1024 + 64 * h + 4 * hh;
#pragma unroll
    for (int db = 0; db < 2; ++db)
#pragma unroll
        for (int g4 = 0; g4 < 4; ++g4) {
            const f32x16& ox = db ? O1 : O0; bf16_t* p = op + 32 * db + 8 * g4;
            const u32x2 z = *(const u32x2*)p; u32x2 o;
            o.x = pk2(ox[4 * g4 + 0] * linv * bflo(z.x), ox[4 * g4 + 1] * linv * bfhi(z.x)); o.y = pk2(ox[4 * g4 + 2] * linv * bflo(z.y), ox[4 * g4 + 3] * linv * bfhi(z.y));
            if (!dry) *(u32x2*)p = o;
        }
}
DI void attn_phase(LAS unsigned char* lds, const AttnT& T, int cu, int dry) {
    const int bh = (cu & 7) + 8 * (cu >> 4), half = (cu >> 3) & 1, b = bh >> 4, h = bh & 15;
#pragma unroll 1
    for (int ui = 0; ui < 4; ++ui) attn_unit(lds, T, b, h, ((half ? 0x2516 : 0x3407) >> (4 * ui)) & 0xF, dry);
}

DI void conv_phase(const bf16_t* CH, bf16_t* BZ, const float* cw, int gt, int NGT, int dry) {
    for (int it = gt; it < (M / 8) * 128; it += NGT) {
        const int c8 = (it & 127) * 8, m0 = (it >> 7) * 8, t0 = m0 & (S - 1);
        const f32x4 w0a = *(const f32x4*)(cw + c8), w0b = *(const f32x4*)(cw + c8 + 4), w1a = *(const f32x4*)(cw + 1024 + c8), w1b = *(const f32x4*)(cw + 1024 + c8 + 4), w2a = *(const f32x4*)(cw + 2048 + c8), w2b = *(const f32x4*)(cw + 2048 + c8 + 4);
        u32x4 ch[10], bz[8];
#pragma unroll
        for (int r = 0; r < 10; ++r) { const int m = m0 - 2 + r; ch[r] = (r >= 2 || t0 > 0) ? *(const u32x4*)(CH + (size_t)m * 1024 + c8) : (u32x4){0u, 0u, 0u, 0u}; }
#pragma unroll
        for (int r = 0; r < 8; ++r) bz[r] = *(const u32x4*)(BZ + (size_t)(m0 + r) * 1024 + c8);
        f32x4 pa, pb, qa, qb;
        unpk8(ch[0], pa, pb); unpk8(ch[1], qa, qb);
#pragma unroll
        for (int r = 0; r < 8; ++r) {
            f32x4 ca, cb, ba, bb; unpk8(ch[r + 2], ca, cb); unpk8(bz[r], ba, bb);
            const f32x4 ya = w0a * pa + w1a * qa + w2a * ca, yb = w0b * pb + w1b * qb + w2b * cb;
            const u32x4 ov = pk8(ba * ya, bb * yb); if (!dry) *(u32x4*)(BZ + (size_t)(m0 + r) * 1024 + c8) = ov;
            pa = qa; pb = qb; qa = ca; qb = cb;
        }
    }
}

DI void gates_phase(const bf16_t* XB, const u64* ssq_x, const float* Wg8, const float* bg, float* IG, float* LF, int gw, int NGW, int lane) {
    f32x4 wv[8][2][2];
#pragma unroll
    for (int j = 0; j < 8; ++j)
#pragma unroll
        for (int half = 0; half < 2; ++half) { const int k0 = half * 512 + lane * 8; wv[j][half][0] = *(const f32x4*)(Wg8 + j * 1024 + k0); wv[j][half][1] = *(const f32x4*)(Wg8 + j * 1024 + k0 + 4); }
    float bgv[8];
#pragma unroll
    for (int j = 0; j < 8; ++j) bgv[j] = bg[j];
    for (int m = gw; m < M; m += NGW) {
        float acc[8];
#pragma unroll
        for (int j = 0; j < 8; ++j) acc[j] = 0.f;
        const u32x4 xw0 = *(const u32x4*)(XB + (size_t)m * 1024 + lane * 8), xw1 = *(const u32x4*)(XB + (size_t)m * 1024 + 512 + lane * 8);
#pragma unroll
        for (int half = 0; half < 2; ++half) {
            f32x4 xa, xb2; unpk8(half ? xw1 : xw0, xa, xb2);
#pragma unroll
            for (int j = 0; j < 8; ++j) { const f32x4 wa = wv[j][half][0], wb = wv[j][half][1];
                acc[j] += (xa[0] * wa[0] + xa[1] * wa[1]) + (xa[2] * wa[2] + xa[3] * wa[3]) + (xb2[0] * wb[0] + xb2[1] * wb[1]) + (xb2[2] * wb[2] + xb2[3] * wb[3]); }
        }
        const float rs = ssq_rstd(ssq_x + m, 1.f / 1024.f);
#pragma unroll
        for (int j = 0; j < 8; ++j) acc[j] = wave_sum(acc[j]) * rs + bgv[j];
        if (lane == 0) {
            *(f32x4*)(IG + (size_t)m * 4) = (f32x4){acc[0], acc[1], acc[2], acc[3]};
            f32x4 lf;
#pragma unroll
            for (int j = 0; j < 4; ++j) { const float x = acc[4 + j]; lf[j] = fminf(x, 0.f) - log1pf(__expf(-fabsf(x))); }
            *(f32x4*)(LF + (size_t)m * 4) = lf;
        }
    }
}
DI void gw8_prep(const float* w_in, const float* g, float* Wg8, int gt, int NGT) {
    for (int i = gt; i < 8 * 1024; i += NGT) { const int j = i >> 10, k = i & 1023; Wg8[i] = w_in[(size_t)k * 8200 + 8192 + j] * g[k]; }
}

constexpr int SC_QSTR = 528, SC_VSTR = 136  , SC_VVSTR = 144  ;
constexpr int SC_QS = 0, SC_KS = 64 * SC_QSTR, SC_VS = 2 * 64 * SC_QSTR, SC_SP = SC_VS + 64 * SC_VVSTR, SC_QCX = SC_SP + 64 * SC_VSTR, SC_GT = SC_QCX + 16384, SC_VEC = SC_GT + 3 * 32 * 64 * 4 + 512, SC_OT = SC_VEC + (832 + 512) * 4;
constexpr int G_B = 0, G_CC = 2048, G_PM = 4096, G_SC = 6144;
constexpr int V_QNP = 0  , V_RS = 512  , V_WS = 768, V_WH = 832  ;
constexpr int SC_END = SC_OT + 64 * SC_VVSTR;
struct ScanT { const bf16_t *Q, *K, *VT; bf16_t* OG; const float *IG, *LF; };
DI float scan_add(float v, int lane) {
#pragma unroll
    for (int o = 1; o < 64; o <<= 1) { const float t = __shfl_up(v, o); if (lane >= o) v += t; }
    return v;
}
DI float scan_max(float v, int lane) {
#pragma unroll
    for (int o = 1; o < 64; o <<= 1) { const float t = __shfl_up(v, o); if (lane >= o) v = fmaxf(v, t); }
    return v;
}
DI void scan_item(LAS unsigned char* lds, const ScanT& T, int b, int h, int sl, int dry) {
    const int tid0 = tidx(), w = __builtin_amdgcn_readfirstlane(tid0 >> 6), g = w >> 2, c = w & 3;
    int tid = tid0, lane = tid & 63, l15 = lane & 15, q = lane >> 4;
    const int tok0 = b * S;
    LAS float* vec = (LAS float*)(lds + SC_VEC);
    LAS float* gt = (LAS float*)(lds + SC_GT);
    f32x4 Cacc[8];
#pragma unroll
    for (int i = 0; i < 8; ++i) Cacc[i] = (f32x4){0.f, 0.f, 0.f, 0.f};
    f32x4 nacc[2] = {(f32x4){0.f, 0.f, 0.f, 0.f}, (f32x4){0.f, 0.f, 0.f, 0.f}};
    u32x4 sQ[4], sK[4], sV;
    const int vd = tid >> 3, vch = tid & 7;
    const bf16_t* gQ = T.Q + (size_t)tok0 * 1024 + 256 * h;
    const bf16_t* gK = T.K + (size_t)tok0 * 1024 + 256 * h;
    const bf16_t* gV = T.VT + (size_t)(tok0 + vd) * 2048 + 512 * h + 64 * sl + 8 * vch;
#define SC_LOAD(ci) do { _Pragma("unroll") for (int i = 0; i < 4; ++i) { const int e = tid + i * NTHR, row = e >> 5, ch = e & 31; \
        sQ[i] = *(const u32x4*)(gQ + (size_t)((ci) * 64 + row) * 1024 + 8 * ch); sK[i] = *(const u32x4*)(gK + (size_t)((ci) * 64 + row) * 1024 + 8 * ch); } \
        sV = *(const u32x4*)(gV + (size_t)(ci) * 64 * 2048); } while (0)
    u32x4 sOG;
    bf16_t* gOG = T.OG + (size_t)(tok0 + vd) * 2048 + 512 * h + 64 * sl + 8 * vch;
#define SC_LOADOG(ci) do { sOG = *(const u32x4*)(gOG + (size_t)(ci) * 64 * 2048); } while (0)
    SC_LOAD(0); SC_LOADOG(0);
    {
        float lfv[4], igv[4];
#pragma unroll
        for (int k = 0; k < 4; ++k) { const size_t gi = (size_t)(tok0 + (w + 8 * k) * 64 + lane) * 4 + h; lfv[k] = T.LF[gi]; igv[k] = T.IG[gi]; }
#pragma unroll
        for (int k = 0; k < 4; ++k) {
            const int ck = w + 8 * k; const float bb = scan_add(lfv[k], lane), cc = igv[k] - bb, pm = scan_max(cc, lane);
            gt[G_B + ck * 64 + lane] = bb; gt[G_CC + ck * 64 + lane] = cc; gt[G_PM + ck * 64 + lane] = pm;
            if (lane == 63) { gt[G_SC + ck * 4 + 0] = bb; gt[G_SC + ck * 4 + 1] = pm; }
        }
        __syncthreads();
        if (tid == 0) { float m = 0.f;
#pragma unroll 1
            for (int ck = 0; ck < 32; ++ck) { const float bl = gt[G_SC + ck * 4], cm = gt[G_SC + ck * 4 + 1]; gt[G_SC + ck * 4 + 2] = m; m = fmaxf(bl + m, bl + cm); gt[G_SC + ck * 4 + 3] = m; } }
        __syncthreads();
    }
    for (int ci = 0; ci < S / 64; ++ci) {
        tid = tid0; asm volatile("" : "+v"(tid)); lane = tid & 63; l15 = lane & 15; q = lane >> 4;
#pragma unroll
        for (int i = 0; i < 4; ++i) { const int e = tid + i * NTHR, row = e >> 5, ch = e & 31; *(LAS u32x4*)(lds + SC_QS + row * SC_QSTR + 16 * ch) = sQ[i]; *(LAS u32x4*)(lds + SC_KS + row * SC_QSTR + 16 * ch) = sK[i]; }
        *(LAS u32x4*)(lds + SC_VS + vd * SC_VVSTR + 16 * vch) = sV;
        if (ci > 0 && !dry) *(u32x4*)(gOG + (size_t)(ci - 1) * 64 * 2048) = *(const LAS u32x4*)(lds + SC_OT + vd * SC_VVSTR + 16 * vch);
        *(LAS u32x4*)(lds + SC_OT + vd * SC_VVSTR + 16 * vch) = sOG;
        const f32x4 scal = *(const LAS f32x4*)(gt + G_SC + ci * 4);
        const float m_c = scal[2], blast = scal[0], mnew = scal[3];
        const LAS float* gB = gt + G_B + ci * 64; const LAS float* gC = gt + G_CC + ci * 64; const LAS float* gP = gt + G_PM + ci * 64;
        __syncthreads();
        if (ci + 1 < S / 64) SC_LOAD(ci + 1);
        {
            const int sb = w >> 1;
#pragma unroll
            for (int tt = 0; tt < 2; ++tt) {
                const int tb = 2 * (w & 1) + tt;
                const int t = 16 * tb + l15, s0 = 16 * sb + 4 * q;
                if (sb <= tb) {
                    f32x4 a4 = (f32x4){0.f, 0.f, 0.f, 0.f};
#pragma unroll
                    for (int ks = 0; ks < 8; ++ks) {
                        const bf16x8 ka = *(const LAS bf16x8*)(lds + SC_KS + (16 * sb + l15) * SC_QSTR + 64 * ks + 16 * q);
                        const bf16x8 qb2 = *(const LAS bf16x8*)(lds + SC_QS + (16 * tb + l15) * SC_QSTR + 64 * ks + 16 * q);
                        a4 = MFMA16(ka, qb2, a4);
                    }
                    const float a2 = -fmaxf(m_c, gP[t]) * LOG2E; const f32x4 c2 = *(const LAS f32x4*)(gC + s0);
                    float rsum = 0.f;
#pragma unroll
                    for (int r2 = 0; r2 < 4; ++r2) { const float wgt = (s0 + r2 <= t) ? ex2(a2 + c2[r2] * LOG2E) : 0.f; a4[r2] *= wgt; rsum += a4[r2]; }
                    u32x2 pw; pw.x = pk2(a4[0], a4[1]); pw.y = pk2(a4[2], a4[3]);
                    *(LAS u32x2*)(lds + SC_SP + t * SC_VSTR + s0 * 2) = pw;
                    rsum = red_fq(rsum); if (q == 0) vec[V_RS + 64 * sb + t] = rsum;
                } else {
                    *(LAS u32x2*)(lds + SC_SP + t * SC_VSTR + s0 * 2) = (u32x2){0u, 0u};
                    if (q == 0) vec[V_RS + 64 * sb + t] = 0.f;
                }
            }
        }
        f32x4 qc[4];
        {
            bf16x8 cf[4]; f32x4 qnp[4];
            u32x4 nw; nw.x = pk2(nacc[0][0], nacc[0][1]); nw.y = pk2(nacc[0][2], nacc[0][3]); nw.z = pk2(nacc[1][0], nacc[1][1]); nw.w = pk2(nacc[1][2], nacc[1][3]);
            const bf16x8 nf = __builtin_bit_cast(bf16x8, nw);
#pragma unroll
            for (int ks = 0; ks < 4; ++ks) { u32x4 cw; cw.x = pk2(Cacc[2 * ks][0], Cacc[2 * ks][1]); cw.y = pk2(Cacc[2 * ks][2], Cacc[2 * ks][3]); cw.z = pk2(Cacc[2 * ks + 1][0], Cacc[2 * ks + 1][1]); cw.w = pk2(Cacc[2 * ks + 1][2], Cacc[2 * ks + 1][3]); cf[ks] = __builtin_bit_cast(bf16x8, cw); }
#pragma unroll
            for (int tb = 0; tb < 4; ++tb) {
                qc[tb] = (f32x4){0.f, 0.f, 0.f, 0.f}; qnp[tb] = (f32x4){0.f, 0.f, 0.f, 0.f};
#pragma unroll
                for (int ks = 0; ks < 4; ++ks) {
                    const LAS unsigned char* qp = lds + SC_QS + (16 * tb + l15) * SC_QSTR + (128 * g + 32 * ks + 4 * q) * 2;
                    const bf16x8 qa = cat4(*(const LAS s16x4*)qp, *(const LAS s16x4*)(qp + 32));
                    qc[tb] = MFMA16(qa, cf[ks], qc[tb]);
                    if (ks == c) qnp[tb] = MFMA16(qa, nf, qnp[tb]);
                }
            }
            if (l15 == 0) {
#pragma unroll
                for (int tb = 0; tb < 4; ++tb) *(LAS f32x4*)(vec + V_QNP + w * 64 + 16 * tb + 4 * q) = qnp[tb];
            }
            LAS f32x4* qx = (LAS f32x4*)(lds + SC_QCX) + (w * 2) * 64 + lane;
            qx[0] = g ? qc[0] : qc[2]; qx[64] = g ? qc[1] : qc[3];
        }
        if (tid < 64) vec[V_WS + tid] = __expf(blast + gC[tid] - mnew);
        __syncthreads();
        bf16x8 vf[2];
#pragma unroll
        for (int ks = 0; ks < 2; ++ks) { LAS unsigned char* vp = lds + SC_VS + (32 * ks + 8 * q + (l15 >> 2)) * SC_VVSTR + (16 * c + 4 * (lane & 3)) * 2;
            vf[ks] = cat4(__builtin_amdgcn_ds_read_tr16_b64_v4i16((LAS s16x4*)vp), __builtin_amdgcn_ds_read_tr16_b64_v4i16((LAS s16x4*)(vp + 4 * SC_VVSTR))); }
        {
            LAS float* wh = vec + V_WH + w * 64;
            if (lane < 32) {
                const int t = 32 * g + lane; float qn = 0.f, rs = 0.f;
#pragma unroll
                for (int k = 0; k < 8; ++k) qn += vec[V_QNP + 64 * k + t];
#pragma unroll
                for (int k = 0; k < 4; ++k) rs += vec[V_RS + 64 * k + t];
                const float mxv = fmaxf(m_c, gP[t]), wi = __expf(m_c - mxv), em = __expf(-gB[t] - mxv);
                wh[lane] = wi; wh[32 + lane] = __builtin_amdgcn_rcpf(fmaxf(fabsf(wi * qn + rs), em));
            }
            const LAS f32x4* px = (const LAS f32x4*)(lds + SC_QCX) + ((w ^ 4) * 2) * 64 + lane;
#define SC_FIN(tt, QCV) do { const int tb = 2 * g + (tt); \
                f32x4 sv = (f32x4){0.f, 0.f, 0.f, 0.f}; \
                _Pragma("unroll") for (int ks = 0; ks < 2; ++ks) { const LAS unsigned char* sp = lds + SC_SP + (16 * tb + l15) * SC_VSTR + 64 * ks + 16 * q; const bf16x8 sa = cat4(*(const LAS s16x4*)sp, *(const LAS s16x4*)(sp + 8)); sv = MFMA16(sa, vf[ks], sv); } \
                const f32x4 qct = (QCV) + px[64 * (tt)]; \
                const f32x4 wiv = *(const LAS f32x4*)(wh + 16 * (tt) + 4 * q), hiv = *(const LAS f32x4*)(wh + 32 + 16 * (tt) + 4 * q); \
                _Pragma("unroll") for (int r2 = 0; r2 < 4; ++r2) { \
                    const float hv = (wiv[r2] * qct[r2] + sv[r2]) * hiv[r2]; \
                    LAS bf16_t* op = (LAS bf16_t*)(lds + SC_OT + (16 * tb + 4 * q + r2) * SC_VVSTR) + 16 * c + l15; \
                    *op = (bf16_t)(pk2(hv * bf1(*op), 0.f) & 0xffff); } } while (0)
            if (g) { SC_FIN(0, qc[2]); SC_FIN(1, qc[3]); } else { SC_FIN(0, qc[0]); SC_FIN(1, qc[1]); }
#undef SC_FIN
        }
        if (ci + 1 < S / 64) SC_LOADOG(ci + 1);
        {
            const float decay = __expf(blast + m_c - mnew);
            bf16x8 vw[2], wsf[2];
#pragma unroll
            for (int ks = 0; ks < 2; ++ks) {
                const f32x4 w0 = *(const LAS f32x4*)(vec + V_WS + 32 * ks + 8 * q), w1 = *(const LAS f32x4*)(vec + V_WS + 32 * ks + 8 * q + 4);
                f32x4 x0, x1; unpk8(__builtin_bit_cast(u32x4, vf[ks]), x0, x1); vw[ks] = __builtin_bit_cast(bf16x8, pk8(x0 * w0, x1 * w1));
                const u32x4 wz = pk8(w0, w1); wsf[ks] = __builtin_bit_cast(bf16x8, l15 == 0 ? wz : (u32x4){0u, 0u, 0u, 0u});
            }
#pragma unroll
            for (int i = 0; i < 8; ++i) {
                if ((i & 1) == 0) __builtin_amdgcn_sched_barrier(0);
                Cacc[i] *= decay;
#pragma unroll
                for (int ks = 0; ks < 2; ++ks) {
                    LAS unsigned char* kp = lds + SC_KS + (32 * ks + 8 * q + (l15 >> 2)) * SC_QSTR + (128 * g + 16 * i + 4 * (lane & 3)) * 2;
                    const s16x4 lo = __builtin_amdgcn_ds_read_tr16_b64_v4i16((LAS s16x4*)kp), hi = __builtin_amdgcn_ds_read_tr16_b64_v4i16((LAS s16x4*)(kp + 4 * SC_QSTR));
                    Cacc[i] = MFMA16(cat4(lo, hi), vw[ks], Cacc[i]);
                }
            }
#pragma unroll
            for (int ib = 0; ib < 2; ++ib) {
                nacc[ib] *= decay;
#pragma unroll
                for (int ks = 0; ks < 2; ++ks) {
                    LAS unsigned char* kp = lds + SC_KS + (32 * ks + 8 * q + (l15 >> 2)) * SC_QSTR + (128 * g + 16 * (2 * c + ib) + 4 * (lane & 3)) * 2;
                    const s16x4 lo = __builtin_amdgcn_ds_read_tr16_b64_v4i16((LAS s16x4*)kp), hi = __builtin_amdgcn_ds_read_tr16_b64_v4i16((LAS s16x4*)(kp + 4 * SC_QSTR));
                    nacc[ib] = MFMA16(cat4(lo, hi), wsf[ks], nacc[ib]);
                }
            }
        }
        __syncthreads();
    }
    if (!dry) *(u32x4*)(gOG + (size_t)(S / 64 - 1) * 64 * 2048) = *(const LAS u32x4*)(lds + SC_OT + vd * SC_VVSTR + 16 * vch);
    __syncthreads();
#undef SC_LOAD
#undef SC_LOADOG
}
DI void scan_phase(LAS unsigned char* lds, const ScanT& T, int cu, int dry) {
    const int xcd = cu & 7, idx = cu >> 3, bh = xcd * 4 + (idx >> 3), sl = idx & 7;
    scan_item(lds, T, bh >> 2, bh & 3, sl, dry);
}

DI void final_phase(const bf16_t* xb, float* out, const u64* ssq, const float* g, int gw, int NGW, int lane) {
    for (int m = gw; m < M; m += NGW) {
        const float rs = ssq_rstd(ssq + m, 1.f / 1024.f);
#pragma unroll
        for (int j = 0; j < 2; ++j) {
            const int c0 = (lane + 64 * j) * 8; f32x4 a, b; unpk8(*(const u32x4*)(xb + (size_t)m * D + c0), a, b);
            *(f32x4*)(out + (size_t)m * D + c0) = a * rs * *(const f32x4*)(g + c0); *(f32x4*)(out + (size_t)m * D + c0 + 4) = b * rs * *(const f32x4*)(g + c0 + 4);
        }
    }
}
constexpr int LDS_BYTES = 147456, MISC_OFF = 146944;
static_assert(SC_END <= MISC_OFF && 2 * AT_KB + 2 * AT_VB <= MISC_OFF, "LDS map");
constexpr int PH_PER_LAYER = 6, PH_FINAL = 1 + 4 * PH_PER_LAYER, PH_REFRESH = 100;
#ifndef GEMM_ALIGN
#define GEMM_ALIGN true
#endif
#ifndef GEMM_SP2
#define GEMM_SP2 true
#endif
#ifndef C1_DRYMODE
#define C1_DRYMODE 1
#endif
#ifndef BAR_TWICE
#define BAR_TWICE 0
#endif
#ifndef STAGGER
#define STAGGER 0
#endif
#define STAGGER_SLEEP() do { if (STAGGER) { for (int s_ = 0; s_ < (int)(((cu >> 3) & 3) * STAGGER); ++s_) __builtin_amdgcn_s_sleep(32); } } while (0)
#ifndef PP_HOLES
#define PP_HOLES 1
#endif
#ifndef PHM
#define PHM 0xFFFF
#endif
#define PH_ON(b) ((PHM >> (b)) & 1)
#ifndef REPEAT
#define REPEAT 0
#endif
#ifndef REPEAT_AFTER
#define REPEAT_AFTER 0
#endif
#if REPEAT_AFTER
#define REP_LOOP(b) for (int rep_ = 0, nrep_ = opaque((REPEAT >> (b)) & 1); rep_ <= nrep_; ++rep_)
#else
#define REP_LOOP(b) for (int rep_ = opaque((REPEAT >> (b)) & 1); rep_ >= 0; --rep_)
#endif
typedef const __attribute__((address_space(4))) Args* KArgs;
DI KArgs kargs() { KArgs p = (KArgs)__builtin_amdgcn_kernarg_segment_ptr(); asm volatile("" : "+s"(p)); return p; }

#define TID_DEFS const int tid = tidx(), w = __builtin_amdgcn_readfirstlane(tid >> 6), lane = tid & 63; (void)w; (void)lane
DI void prep_mixer(LAS unsigned char* lds, int i, int cu, int G) {
    TID_DEFS; KArgs A = kargs(); unsigned char* ws = A->ws; LAS float* scr = (LAS float*)lds;
    const int kind = i % 3, j = i / 3;
    const float* normg = A->in[I_NORMG] + (size_t)i * D; bf16_t* wmix = (bf16_t*)(ws + WS_WMIX);
    if (kind == 0) {
        constexpr int n0 = 28 * 8, n1 = 24 * 3, n2 = 32 * 2, n3 = 16 * 8;
#pragma unroll 1
        for (int it = cu; it < n0 + n1 + n2 + n3; it += G) {
            if (it < n0) prep_tile(PrepTask{A->in[I_MLA_WIN] + (size_t)j * D * 1696, 1696, normg, D, 1792, PM_MLA_IN, wmix}, it, scr);
            else if (it < n0 + n1) prep_tile(PrepTask{A->in[I_MLA_WQB] + (size_t)j * 384 * 1536, 1536, A->in[I_MLA_QN] + j * 384, 384, 1536, PM_MLA_QB, (bf16_t*)(ws + WS_WMIX + WM_QB)}, it - n0, scr);
            else if (it < n0 + n1 + n2) prep_tile(PrepTask{A->in[I_MLA_WKVB] + (size_t)j * 256 * 2048, 2048, A->in[I_MLA_KVN] + j * 256, 256, 2048, PM_MLA_KVB, (bf16_t*)(ws + WS_WMIX + WM_KVB)}, it - n0 - n1, scr);
            else prep_tile(PrepTask{A->in[I_MLA_WOUT] + (size_t)j * D * D, D, nullptr, D, D, PM_ID, (bf16_t*)(ws + WS_WMIX + WM_OUT_MLA)}, it - n0 - n1 - n2, scr);
        }
    } else if (kind == 1) {
        constexpr int n0 = 64 * 8, n1 = 16 * 8;
#pragma unroll 1
        for (int it = cu; it < n0 + n1; it += G) {
            if (it < n0) prep_tile(PrepTask{A->in[I_CONV_WIN] + (size_t)j * D * 4096, 4096, normg, D, 4096, PM_CONV_IN, wmix}, it, scr);
            else prep_tile(PrepTask{A->in[I_CONV_WOUT] + (size_t)j * D * D, D, nullptr, D, D, PM_ID, (bf16_t*)(ws + WS_WMIX + WM_OUT_CONV)}, it - n0, scr);
        }
    } else {
        constexpr int n0 = 128 * 8, n1 = 16 * 16;
#pragma unroll 1
        for (int it = cu; it < n0 + n1; it += G) {
            if (it < n0) prep_tile(PrepTask{A->in[I_L_WIN] + (size_t)j * D * 8200, 8200, normg, D, 8192, PM_LSTM_IN, wmix}, it, scr);
            else prep_tile(PrepTask{A->in[I_L_WOUT] + (size_t)j * 2048 * D, D, nullptr, 2048, D, PM_ID, (bf16_t*)(ws + WS_WMIX + WM_OUT_LSTM)}, it - n0, scr);
        }
        gw8_prep(A->in[I_L_WIN] + (size_t)j * D * 8200, normg, (float*)(ws + WS_GW8), cu * NTHR + tid, G * NTHR);
    }
    if (kind != 2) p_to_bf16(A->in[I_P] + (size_t)i * M * 256, (bf16_t*)(ws + WS_BIG + A_PB), cu * NTHR + tid, G * NTHR);
#pragma unroll 1
    for (int it = cu; it < 16 * 2; it += G) prep_tile(PrepTask{A->in[I_PLE_PROJ] + (size_t)i * 256 * D, D, nullptr, 256, D, PM_ID, (bf16_t*)(ws + WS_WPLE + 2 * MiB)}, it, scr);
}
DI void prep_ple(LAS unsigned char* lds, int i, int cu, int G) {
    KArgs A = kargs(); unsigned char* ws = A->ws; LAS float* scr = (LAS float*)lds;
#pragma unroll 1
    for (int it = cu; it < 16 * 8; it += G) prep_tile(PrepTask{A->in[I_PLE_GATE] + (size_t)i * D * D, D, nullptr, D, D, PM_ID, (bf16_t*)(ws + WS_WPLE)}, it, scr);
}

__global__ void __launch_bounds__(NTHR, 2) fwd(Args a_) {
    extern __shared__ __attribute__((aligned(16))) unsigned char lds_[];
    LAS unsigned char* lds = (LAS unsigned char*)lds_;
    const int cu = blockIdx.x, G = gridDim.x;
#define GW (cu * 8 + w)
#define NGW (G * 8)
#define GT (cu * NTHR + tid)
#define NGT (G * NTHR)
    const int lo = a_.ph_lo, hi = a_.ph_hi;
    volatile LAS unsigned* misc = (volatile LAS unsigned*)(lds + MISC_OFF);
    { TID_DEFS; if (tid < 32) misc[tid] = 0u; }
    __syncthreads();
    const bool multi = (hi - lo) > 1;
    XcdBarrier bar; bar.bar = nullptr; bar.x = 0; bar.st = misc + 8;
    if (multi) bar = xcd_barrier_post((unsigned*)(kargs()->ws + WS_CTL), misc + 8);
#define IN(k) (lo <= (k) && (k) < hi)
#ifdef TIMELINE
#define STAMP(idx) do { if (blockIdx.x == 0 && threadIdx.x == 0) ((unsigned long long*)(kargs()->ws + WS_CTL + 32 * KiB))[(idx)] = __builtin_amdgcn_s_memrealtime(); } while (0)
#else
#define STAMP(idx) do { } while (0)
#endif
#define SEAM(k) do { if (multi && (k) + 1 < hi) { XcdBarrier b2 = bar; b2.bar = (unsigned*)(kargs()->ws + WS_CTL); xcd_barrier(b2); if (BAR_TWICE) xcd_barrier(b2); } STAMP((k) + 1); } while (0)

    STAMP(0);
    if (lo >= PH_REFRESH) {
        TID_DEFS; KArgs A = kargs(); const int i = lo - PH_REFRESH; rows_to_bf16_ssq(A->out, (bf16_t*)(A->ws + WS_XBA), ssq_arr(A->ws, SSQ_X + i), GW, NGW, lane); return;
    }
    if (IN(0)) {
        REP_LOOP(11) { TID_DEFS; KArgs A = kargs(); unsigned char* ws = A->ws; rows_to_bf16_ssq(A->in[I_X], (bf16_t*)(ws + WS_XBA), ssq_arr(ws, SSQ_X), GW, NGW, lane); }
        REP_LOOP(12) { TID_DEFS; KArgs A = kargs(); unsigned char* ws = A->ws; rope_tables((const int*)A->in[I_POS], (float*)(ws + WS_CS), (float*)(ws + WS_SN), GT, NGT); }
        REP_LOOP(13) prep_mixer(lds, 0, cu, G);
    }
    if (IN(0)) SEAM(0);
#pragma unroll 1
    for (int i = 0; i < 4; ++i) {
        const int kind = i % 3, j = i / 3, base = 1 + PH_PER_LAYER * i;
        if (hi <= base || lo >= base + PH_PER_LAYER) continue;
        if (IN(base + 1)) {
            REP_LOOP(0) prep_ple(lds, i, cu, G);
            if (kind == 0 && PH_ON(1)) {
                unsigned char* ws = kargs()->ws;
                pg8::Gemm g{(bf16_t*)(ws + WS_XBA), (bf16_t*)(ws + WS_WMIX), M, 1792, opaque(D)}; pg8::StaticOrder So; So.init(M, 1792, G, cu);
                EpiA1 E{ws, i, j}; STAGGER_SLEEP();
                pg8::gemm_phase<EpiA1, pg8::StaticOrder, GEMM_ALIGN, GEMM_SP2>(lds, g, So, E);
                if (PP_HOLES && G == 256 && cu >= 192) {
                    KArgs A2 = kargs(); unsigned char* ws2 = A2->ws;
                    pg8::Gemm g2{(bf16_t*)(ws2 + WS_BIG + A_PB), (bf16_t*)(ws2 + WS_WPLE + 2 * MiB), M, D, opaque(256)}; pg8::StaticOrder So2; So2.init(M, D, 64, cu - 192);
                    EpiPP E2{(bf16_t*)A2->out};
                    pg8::gemm_phase<EpiPP, pg8::StaticOrder, GEMM_ALIGN, GEMM_SP2>(lds, g2, So2, E2);
                }
            } else if (kind == 1 && PH_ON(2)) REP_LOOP(2) {
                unsigned char* ws = kargs()->ws;
                pg8::Gemm g{(bf16_t*)(ws + WS_XBA), (bf16_t*)(ws + WS_WMIX), M, 4096, opaque(D)}; pg8::StaticOrder So; So.init(M, 4096, G, cu);
                EpiC1 E{ws, i, rep_ * C1_DRYMODE}; STAGGER_SLEEP();
                pg8::gemm_phase<EpiC1, pg8::StaticOrder, GEMM_ALIGN, GEMM_SP2>(lds, g, So, E);
            } else if (kind == 2 && PH_ON(3)) REP_LOOP(3) {
                { TID_DEFS; KArgs A = kargs(); unsigned char* ws = A->ws;
                  gates_phase((bf16_t*)(ws + WS_XBA), ssq_arr(ws, SSQ_X + i), (const float*)(ws + WS_GW8), A->in[I_L_BG] + j * 8, (float*)(ws + WS_IG), (float*)(ws + WS_LF), GW, NGW, lane); }
                unsigned char* ws = kargs()->ws;
                pg8::Gemm g{(bf16_t*)(ws + WS_XBA), (bf16_t*)(ws + WS_WMIX), M, 8192, opaque(D)}; pg8::StaticOrder So; So.init(M, 8192, G, cu);
                EpiL1 E{ws, i}; STAGGER_SLEEP();
                pg8::gemm_phase<EpiL1, pg8::StaticOrder, GEMM_ALIGN, GEMM_SP2>(lds, g, So, E);
            }
            SEAM(base + 1);
        }
        if (IN(base + 2) && kind != 2) {
            if (kind == 0 && PH_ON(4)) REP_LOOP(4) {
                { unsigned char* ws = kargs()->ws;
                  pg8::Gemm g{(bf16_t*)(ws + WS_BIG + A_CQ), (bf16_t*)(ws + WS_WMIX + WM_QB), M, 1536, opaque(384)}; pg8::StaticOrder So; So.init(M, 1536, G, cu);
                  EpiQ E{ws, j};
                  pg8::gemm_phase<EpiQ, pg8::StaticOrder, GEMM_ALIGN, GEMM_SP2>(lds, g, So, E); }
                { unsigned char* ws = kargs()->ws;
                  pg8::Gemm g{(bf16_t*)(ws + WS_BIG + A_CKV), (bf16_t*)(ws + WS_WMIX + WM_KVB), M, 2048, opaque(256)}; pg8::StaticOrder So; So.init(M, 2048, G, G - 1 - cu);
                  EpiKV E{ws, j};
                  pg8::gemm_phase<EpiKV, pg8::StaticOrder, GEMM_ALIGN, GEMM_SP2>(lds, g, So, E); }
            } else if (kind == 1 && PH_ON(5)) REP_LOOP(5) {
                TID_DEFS; KArgs A = kargs(); unsigned char* ws = A->ws;
                conv_phase((const bf16_t*)(ws + WS_BIG + C_CH), (bf16_t*)(ws + WS_BIG + C_BZ), A->in[I_CONV_W] + (size_t)j * 3 * 1024, GT, NGT, rep_);
            }
            SEAM(base + 2);
        }
        if (IN(base + 3) && kind != 1) {
            if (kind == 0 && PH_ON(6)) REP_LOOP(6) {
                unsigned char* big = kargs()->ws + WS_BIG;
                AttnT T{(bf16_t*)(big + A_Q), (bf16_t*)(big + A_KN), (bf16_t*)(big + A_KR), (bf16_t*)(big + A_VT), (bf16_t*)(big + A_SZ)};
                attn_phase(lds, T, cu, rep_);
            } else if (kind == 2 && PH_ON(7)) {
                { unsigned char* ws = kargs()->ws; unsigned char* big = ws + WS_BIG;
                  ScanT T{(bf16_t*)(big + L_Q), (bf16_t*)(big + L_K), (bf16_t*)(big + L_VT), (bf16_t*)(big + L_OG), (float*)(ws + WS_IG), (float*)(ws + WS_LF)};
                  REP_LOOP(7) scan_phase(lds, T, cu, rep_); }
                TID_DEFS; KArgs A = kargs();
                p_to_bf16(A->in[I_P] + (size_t)i * M * 256, (bf16_t*)A->out, GT, NGT);
            }
            SEAM(base + 3);
        }
        if (IN(base + 4)) {
            const size_t xbb_off = kind == 0 ? A_XBB : kind == 1 ? C_XBB : L_XBB, pp_off = kind == 0 ? A_PP : kind == 1 ? C_PP : L_PP;
            if (PH_ON(8)) { KArgs A = kargs(); unsigned char* ws = A->ws;
              const size_t oin = kind == 0 ? A_SZ : kind == 1 ? C_BZ : L_OG, wout = kind == 2 ? WM_OUT_LSTM : WM_OUT_MLA;
              pg8::Gemm g{(bf16_t*)(ws + WS_BIG + oin), (bf16_t*)(ws + WS_WMIX + wout), M, D, opaque(kind == 2 ? 2048 : 1024)}; pg8::StaticOrder So; So.init(M, D, G, cu);
              EpiOut E{ws, xbb_off, i};
              pg8::gemm_phase<EpiOut, pg8::StaticOrder, GEMM_ALIGN, GEMM_SP2>(lds, g, So, E); }
            if (PH_ON(9) && !(PP_HOLES && kind == 0 && G == 256)) REP_LOOP(9) { KArgs A = kargs(); unsigned char* ws = A->ws;
              pg8::Gemm g{kind == 2 ? (bf16_t*)A->out : (bf16_t*)(ws + WS_BIG + A_PB), (bf16_t*)(ws + WS_WPLE + 2 * MiB), M, D, opaque(256)}; pg8::StaticOrder So; So.init(M, D, G, cu);
              EpiPP E{(bf16_t*)(ws + WS_BIG + pp_off)};
              pg8::gemm_phase<EpiPP, pg8::StaticOrder, GEMM_ALIGN, GEMM_SP2>(lds, g, So, E); }
            SEAM(base + 4);
        }
        if (IN(base + 5)) {
            if (PH_ON(10)) { KArgs A = kargs(); unsigned char* ws = A->ws;
              const size_t xbb_off = kind == 0 ? A_XBB : kind == 1 ? C_XBB : L_XBB, pp_off = kind == 0 ? A_PP : kind == 1 ? C_PP : L_PP;
              const bf16_t* ppp = (PP_HOLES && kind == 0 && G == 256) ? (const bf16_t*)A->out : (const bf16_t*)(ws + WS_BIG + pp_off);
              pg8::Gemm g{(bf16_t*)(ws + WS_BIG + xbb_off), (bf16_t*)(ws + WS_WPLE), M, D, opaque(D)}; pg8::StaticOrder So; So.init(M, D, G, cu);
              if (i == 3 && multi && G == 256 && hi > PH_FINAL) {
                  EpiPleLast E{ws, A->out, A->in[I_FNORM], ppp, xbb_off, i, bar.x, bar.st};
                  pg8::gemm_phase<EpiPleLast, pg8::StaticOrder, false, GEMM_SP2>(lds, g, So, E);
              } else {
                  EpiPle E{ws, ppp, xbb_off, i};
                  pg8::gemm_phase<EpiPle, pg8::StaticOrder, GEMM_ALIGN, GEMM_SP2>(lds, g, So, E); } }
            if (i < 3) REP_LOOP(1) prep_mixer(lds, i + 1, cu, G);
            if (!(i == 3 && multi && G == 256 && hi > PH_FINAL)) SEAM(base + 5);
        }
    }
    if (IN(PH_FINAL) && !(multi && G == 256 && lo <= PH_FINAL - 1)) { TID_DEFS; KArgs A = kargs(); final_phase((const bf16_t*)(A->ws + WS_XBA), A->out, ssq_arr(A->ws, SSQ_X + 4), A->in[I_FNORM], GW, NGW, lane); }
#ifdef TIMELINE
    {
        SEAM(PH_FINAL);
        TID_DEFS; KArgs A = kargs(); const unsigned long long* ts = (const unsigned long long*)(A->ws + WS_CTL + 32 * KiB);
        const float dA = (float)(ts[TS_A1] - ts[TS_A0]) * 0.01f, dB = (float)(ts[TS_B1] - ts[TS_B0]) * 0.01f;
        const float c = sqrtf(dA);
        for (size_t e = GT; e < (size_t)M * D; e += NGT) A->out[e] = (e == 0) ? 60.f + dB : c;
    }
#endif
#undef IN
#undef SEAM
}
}
#ifndef FAST_LAYERS
#define FAST_LAYERS 15
#endif
#ifndef ONE_LAUNCH
#define ONE_LAUNCH 1
#endif

extern "C" void kernel_launch(void* const* d_in, const int* in_sizes, int n_in, void* d_out, int out_size, void* d_ws, size_t ws_size, hipStream_t stream) {
    static int grid = 0;
    if (grid == 0) {
        int dev = 0, cus = 0;
        if (n_in != 19 || ws_size < fk::WS_END || out_size != fk::M * fk::D) { fprintf(stderr, "kernel_launch: unexpected shapes (n_in %d, ws %zu, out %d)\n", n_in, ws_size, out_size); grid = -1; return; }
        if (hipGetDevice(&dev) != hipSuccess || hipDeviceGetAttribute(&cus, hipDeviceAttributeMultiprocessorCount, dev) != hipSuccess) { grid = -1; return; }
        if (hipFuncSetAttribute((const void*)fk::fwd, hipFuncAttributeMaxDynamicSharedMemorySize, fk::LDS_BYTES) != hipSuccess) { fprintf(stderr, "kernel_launch: hipFuncSetAttribute failed\n"); grid = -1; return; }
        int per_cu = 0;
        if (hipOccupancyMaxActiveBlocksPerMultiprocessor(&per_cu, (const void*)fk::fwd, fk::NTHR, fk::LDS_BYTES) != hipSuccess || per_cu < 1) { fprintf(stderr, "kernel_launch: occupancy query says %d\n", per_cu); }
        (void)hipGetLastError();
        grid = cus;
        if (grid != 256) fprintf(stderr, "kernel_launch: %d CUs (built for 256)\n", grid);
    }
    if (grid < 0) return;
    (void)hipMemsetAsync(d_ws, 0, fk::ZERO_BYTES, stream);
    fk::Args a{};
    for (int i = 0; i < 19; ++i) a.in[i] = (const float*)d_in[i];
    a.out = (float*)d_out; a.ws = (unsigned char*)d_ws;
#define LAUNCH(lo_, hi_) do { a.ph_lo = (lo_); a.ph_hi = (hi_); hipLaunchKernelGGL(fk::fwd, dim3(grid), dim3(fk::NTHR), fk::LDS_BYTES, stream, a); } while (0)
#if ONE_LAUNCH && (FAST_LAYERS == 15)
#ifdef TIMELINE
    LAUNCH(0, fk::PH_FINAL + 2);
#else
    LAUNCH(0, fk::PH_FINAL + 1);
#endif
#else
    nv::In in;
    in.x = (const float*)d_in[0]; in.p = (const float*)d_in[1]; in.pos = (const int*)d_in[2]; in.norm_g = (const float*)d_in[3];
    in.mla_w_in = (const float*)d_in[4]; in.mla_q_norm = (const float*)d_in[5]; in.mla_w_q_b = (const float*)d_in[6];
    in.mla_kv_norm = (const float*)d_in[7]; in.mla_w_kv_b = (const float*)d_in[8]; in.mla_w_out = (const float*)d_in[9];
    in.conv_w_in = (const float*)d_in[10]; in.conv_w = (const float*)d_in[11]; in.conv_w_out = (const float*)d_in[12];
    in.mlstm_w_in = (const float*)d_in[13]; in.mlstm_b_gates = (const float*)d_in[14]; in.mlstm_w_out = (const float*)d_in[15];
    in.ple_proj = (const float*)d_in[16]; in.ple_gate = (const float*)d_in[17]; in.final_norm = (const float*)d_in[18];
    float* nws = (float*)((char*)d_ws + 2 * fk::MiB);
    LAUNCH(0, 1);
    for (int i = 0; i < 4; ++i) {
        if ((FAST_LAYERS >> i) & 1) {
            if (i > 0 && !((FAST_LAYERS >> (i - 1)) & 1)) LAUNCH(fk::PH_REFRESH + i, fk::PH_REFRESH + i + 1);
            for (int s = 0; s < fk::PH_PER_LAYER; ++s) LAUNCH(1 + fk::PH_PER_LAYER * i + s, 1 + fk::PH_PER_LAYER * i + s + 1);
        } else {
            nv::layer(in, (float*)d_out, nws, stream, i, i == 0);
        }
    }
    if ((FAST_LAYERS >> 3) & 1) LAUNCH(fk::PH_FINAL, fk::PH_FINAL + 1);
    else nv::final_norm(in, (float*)d_out, stream);
#endif
#undef LAUNCH
}
```

```cpp
#include <hip/hip_runtime.h>
#include <cstdio>
#include <cstdint>
#include <math.h>
#define LAS __attribute__((address_space(3)))
#define GAS __attribute__((address_space(1)))
#define FAST_LAYERS 15
#define ONE_LAUNCH 1
namespace pg8 {
#define PG8_LAS __attribute__((address_space(3)))
typedef unsigned short bf16_t;
typedef short bf16x8 __attribute__((ext_vector_type(8)));
typedef float f32x4 __attribute__((ext_vector_type(4)));
typedef unsigned u32x4 __attribute__((ext_vector_type(4)));
constexpr int BM = 256, BK = 64, HALF = 128, HTB = HALF * BK * 2  , STAGE_BYTES = 8 * HTB, NXCD = 8, WGM = 8;

__host__ __device__ __forceinline__ int lds_byte(int r, int c) { const int st = (r >> 4) * 2 + (c >> 5), rr = r & 15, cc = c & 31, ob = rr * 64 + cc * 2; return st * 1024 + (ob ^ (((ob >> 9) & 1) << 5)); }
__host__ __device__ __forceinline__ void stage_rc(int b, int& R, int& C) { const int st = b / 1024, sb = b % 1024, swz = sb ^ (((sb >> 9) & 1) << 5); R = (st >> 1) * 16 + swz / 64; C = (st & 1) * 32 + (swz % 64) / 2; }
__host__ __device__ __forceinline__ int perm32(int rho) { const int n = rho >> 4, i = rho & 15; return 8 * (i >> 2) + 4 * n + (i & 3); }

struct Unit { int pm, pn; };
struct Gemm { const bf16_t* A; const bf16_t* Bt; int M, N, K; };

struct StaticOrder {
    int nM, nN, nwg, G, c;
    __host__ __device__ void init(int M, int N, int G_, int c_) { nM = M / BM; nN = N / BM; nwg = nM * nN; G = G_; c = c_; }
    __host__ __device__ bool next(int i, Unit& u) const {
        const long L = (long)i * G + c; if (L >= nwg) return false;
        int wgid = (int)L; { const int q = nwg / NXCD, r = nwg % NXCD, xcd = wgid % NXCD, off = wgid / NXCD; wgid = (xcd < r ? xcd * (q + 1) : r * (q + 1) + (xcd - r) * q) + off; }
        const int nig = WGM * nN, gid = wgid / nig, fm = gid * WGM, gsz = (nM - fm) < WGM ? (nM - fm) : WGM;
        u.pm = fm + ((wgid % nig) % gsz); u.pn = (wgid % nig) / gsz; return true;
    }
    __device__ __forceinline__ void a_ready(const Unit&) const {}
    __device__ __forceinline__ void done(const Unit&) const {}
};

template <class Epi, class Sched, bool ALIGN_EPI = false, bool SP2 = false>
__device__ __forceinline__ void gemm_phase(PG8_LAS unsigned char* lds, const Gemm g, const Sched& S, const Epi& E) {
    int tid_ = threadIdx.x; asm volatile("" : "+v"(tid_));
    const int tid = tid_, wid = __builtin_amdgcn_readfirstlane(tid >> 6), lane = tid & 63, wr = wid >> 2, wc = wid & 3, fr = lane & 15, fq = lane >> 4;
    const int K = g.K, nt = K / BK;
    unsigned voffA[2], voffB[2];
#pragma unroll
    for (int i = 0; i < 2; ++i) { int R, C; stage_rc(tid * 16 + i * 8192, R, C); const int Rb = Epi::PERM ? ((R & ~31) + perm32(R & 31)) : R;
        voffA[i] = (unsigned)(R * K + C) * 2u; voffB[i] = (unsigned)(Rb * K + C) * 2u; }
    const size_t kstep = (size_t)(BK * 2);
    const size_t hstep = (size_t)HALF * K * 2;
    const size_t tstep = 2 * hstep;
    const unsigned ldsw = (unsigned)wid * 1024u;
    const int aoff = lds_byte(wr * 64 + fr, fq * 8), boff = lds_byte(wc * 32 + fr, fq * 8);
#define PG8_SA(b, h) (((b) * 2 + (h)) * HTB)
#define PG8_SB(b, h) ((4 + (b) * 2 + (h)) * HTB)
#define PG8_STAGE(bufoff, gbase, voff) do { _Pragma("unroll") for (int _i = 0; _i < 2; ++_i) \
        __builtin_amdgcn_global_load_lds((const unsigned*)((const char*)(gbase) + (voff)[_i]), (PG8_LAS unsigned*)(lds + (bufoff) + ldsw + _i * 8192), 16, 0, 0); } while (0)
#define PG8_LDA(dst, b, h) do { _Pragma("unroll") for (int m = 0; m < 4; ++m) _Pragma("unroll") for (int k = 0; k < 2; ++k) dst[m][k] = *(const PG8_LAS bf16x8*)(lds + PG8_SA(b, h) + aoff + m * 2048 + k * 1024); } while (0)
#define PG8_LDB(dst, b, h) do { _Pragma("unroll") for (int n = 0; n < 2; ++n) _Pragma("unroll") for (int k = 0; k < 2; ++k) dst[n][k] = *(const PG8_LAS bf16x8*)(lds + PG8_SB(b, h) + boff + n * 2048 + k * 1024); } while (0)
#define PG8_MMA(ai, bj, At, Bt) do { __builtin_amdgcn_s_setprio(1); _Pragma("unroll") for (int m = 0; m < 4; ++m) _Pragma("unroll") for (int n = 0; n < 2; ++n) _Pragma("unroll") for (int k = 0; k < 2; ++k) \
        acc[ai][bj][m][n] = __builtin_amdgcn_mfma_f32_16x16x32_bf16(Bt[n][k], At[m][k], acc[ai][bj][m][n], 0, 0, 0); __builtin_amdgcn_s_setprio(0); } while (0)
#define PG8_WAIT_V(n) asm volatile("s_waitcnt vmcnt(" #n ")" ::: "memory")
#define PG8_WAIT_L(n) asm volatile("s_waitcnt lgkmcnt(" #n ")" ::: "memory")
#define PG8_BAR __builtin_amdgcn_s_barrier()
#define PG8_SCHED __builtin_amdgcn_sched_barrier(0)
    Unit cur, nxt; int ui = 0;
    if (!S.next(0, cur)) return;
    f32x4 acc[2][2][4][2];
#pragma unroll
    for (int a = 0; a < 2; ++a)
#pragma unroll
        for (int b = 0; b < 2; ++b)
#pragma unroll
            for (int m = 0; m < 4; ++m)
#pragma unroll
                for (int n = 0; n < 2; ++n) acc[a][b][m][n] = (f32x4){0.f, 0.f, 0.f, 0.f};
    bf16x8 At[4][2], B0[2][2], B1[2][2];
    const char* cA = (const char*)g.A + (size_t)cur.pm * tstep; const char* cB = (const char*)g.Bt + (size_t)cur.pn * tstep;
    S.a_ready(cur);
    if constexpr (SP2) {
        PG8_STAGE(PG8_SB(0, 0), cB, voffB); PG8_STAGE(PG8_SB(0, 1), cB + hstep, voffB); PG8_STAGE(PG8_SA(0, 0), cA, voffA); PG8_STAGE(PG8_SA(0, 1), cA + hstep, voffA);
        if (wr == 1) PG8_BAR;
        PG8_WAIT_V(2); PG8_BAR;
        PG8_STAGE(PG8_SB(1, 0), cB + kstep, voffB); PG8_STAGE(PG8_SA(1, 0), cA + kstep, voffA); PG8_STAGE(PG8_SB(1, 1), cB + hstep + kstep, voffB);
        PG8_WAIT_V(6); PG8_BAR;
    } else {
        PG8_STAGE(PG8_SB(0, 0), cB, voffB); PG8_STAGE(PG8_SA(0, 0), cA, voffA); PG8_STAGE(PG8_SB(0, 1), cB + hstep, voffB); PG8_STAGE(PG8_SA(0, 1), cA + hstep, voffA);
        if (wr == 1) PG8_BAR;
        PG8_WAIT_V(4); PG8_BAR;
        PG8_STAGE(PG8_SB(1, 0), cB + kstep, voffB); PG8_STAGE(PG8_SA(1, 0), cA + kstep, voffA); PG8_STAGE(PG8_SB(1, 1), cB + hstep + kstep, voffB);
        PG8_WAIT_V(6); PG8_BAR;
    }
    for (;;) {
        const bool has_next = S.next(ui + 1, nxt);
        const char* nA = has_next ? (const char*)g.A + (size_t)nxt.pm * tstep : cA; const char* nB = has_next ? (const char*)g.Bt + (size_t)nxt.pn * tstep : cB;
        for (int t = 0; t < nt; t += 2) {
            const bool last = (t == nt - 2);
            const char* a1 = cA + (size_t)(t + 1) * kstep;
            const char* a2 = last ? nA : cA + (size_t)(t + 2) * kstep; const char* b2 = last ? nB : cB + (size_t)(t + 2) * kstep;
            const char* a3 = a2 + kstep; const char* b3 = b2 + kstep;
            if (last && has_next) S.a_ready(nxt);
            if constexpr (SP2) {
            PG8_LDB(B0, 0, 0); PG8_LDB(B1, 0, 1); PG8_SCHED; PG8_LDA(At, 0, 0); PG8_STAGE(PG8_SA(1, 1), a1 + hstep, voffA);
            PG8_WAIT_V(8); PG8_WAIT_L(0); PG8_BAR; PG8_MMA(0, 0, At, B0); PG8_MMA(0, 1, At, B1); PG8_BAR; PG8_SCHED;
            PG8_LDA(At, 0, 1); PG8_STAGE(PG8_SB(0, 0), b2, voffB); PG8_STAGE(PG8_SB(0, 1), b2 + hstep, voffB); PG8_STAGE(PG8_SA(0, 0), a2, voffA);
            PG8_WAIT_V(8); PG8_WAIT_L(0); PG8_BAR; PG8_MMA(1, 0, At, B0); PG8_MMA(1, 1, At, B1); PG8_BAR; PG8_SCHED;
            PG8_LDB(B0, 1, 0); PG8_LDB(B1, 1, 1); PG8_SCHED; PG8_LDA(At, 1, 0); PG8_STAGE(PG8_SA(0, 1), a2 + hstep, voffA);
            PG8_WAIT_V(8); PG8_WAIT_L(0); PG8_BAR; PG8_MMA(0, 0, At, B0); PG8_MMA(0, 1, At, B1); PG8_BAR; PG8_SCHED;
            PG8_LDA(At, 1, 1); PG8_STAGE(PG8_SB(1, 0), b3, voffB); PG8_STAGE(PG8_SB(1, 1), b3 + hstep, voffB); PG8_STAGE(PG8_SA(1, 0), a3, voffA);
            PG8_WAIT_V(8); PG8_WAIT_L(0); PG8_BAR; PG8_MMA(1, 0, At, B0); PG8_MMA(1, 1, At, B1); PG8_BAR; PG8_SCHED;
            } else {
            PG8_LDB(B0, 0, 0); PG8_SCHED; PG8_LDA(At, 0, 0); PG8_STAGE(PG8_SA(1, 1), a1 + hstep, voffA);
            PG8_WAIT_L(8); PG8_BAR; PG8_WAIT_L(0); PG8_MMA(0, 0, At, B0); PG8_BAR; PG8_SCHED;
            PG8_LDB(B1, 0, 1); PG8_STAGE(PG8_SB(0, 0), b2, voffB);
            PG8_BAR; PG8_WAIT_L(0); PG8_MMA(0, 1, At, B1); PG8_BAR;
            PG8_LDA(At, 0, 1); PG8_STAGE(PG8_SA(0, 0), a2, voffA);
            PG8_BAR; PG8_WAIT_L(0); PG8_MMA(1, 0, At, B0); PG8_BAR; PG8_SCHED;
            PG8_STAGE(PG8_SB(0, 1), b2 + hstep, voffB);
            PG8_WAIT_V(6); PG8_BAR; PG8_MMA(1, 1, At, B1); PG8_BAR;
            PG8_LDB(B0, 1, 0); PG8_SCHED; PG8_LDA(At, 1, 0); PG8_STAGE(PG8_SA(0, 1), a2 + hstep, voffA);
            PG8_WAIT_L(8); PG8_BAR; PG8_WAIT_L(0); PG8_MMA(0, 0, At, B0); PG8_BAR; PG8_SCHED;
            PG8_LDB(B1, 1, 1); PG8_STAGE(PG8_SB(1, 0), b3, voffB);
            PG8_BAR; PG8_WAIT_L(0); PG8_MMA(0, 1, At, B1); PG8_BAR;
            PG8_LDA(At, 1, 1); PG8_STAGE(PG8_SA(1, 0), a3, voffA);
            PG8_BAR; PG8_WAIT_L(0); PG8_MMA(1, 0, At, B0); PG8_BAR; PG8_SCHED;
            PG8_STAGE(PG8_SB(1, 1), b3 + hstep, voffB);
            PG8_WAIT_V(6); PG8_BAR; PG8_MMA(1, 1, At, B1); PG8_BAR;
            }
        }
        if constexpr (ALIGN_EPI) { if (wr == 0) PG8_BAR; }
        if constexpr (!Epi::AFTER_DRAIN) { E(acc, cur, wr, wc, fr, fq); S.done(cur); }
        if (!has_next) break;
#pragma unroll
        for (int a = 0; a < 2; ++a)
#pragma unroll
            for (int b = 0; b < 2; ++b)
#pragma unroll
                for (int m = 0; m < 4; ++m)
#pragma unroll
                    for (int n = 0; n < 2; ++n) acc[a][b][m][n] = (f32x4){0.f, 0.f, 0.f, 0.f};
        cur = nxt; cA = nA; cB = nB; ++ui;
        if constexpr (ALIGN_EPI) { if (wr == 1) PG8_BAR; }
    }
    PG8_WAIT_V(0);
    if constexpr (!ALIGN_EPI) { if (wr == 0) PG8_BAR; }
    PG8_BAR;
    if constexpr (Epi::AFTER_DRAIN) { E.fused(acc, cur, wr, wc, fr, fq, lds, wid, lane); S.done(cur); }
#undef PG8_SA
#undef PG8_SB
#undef PG8_STAGE
#undef PG8_LDA
#undef PG8_LDB
#undef PG8_MMA
#undef PG8_WAIT_V
#undef PG8_WAIT_L
#undef PG8_BAR
#undef PG8_SCHED
}
}
#define XB_TMO      128
#define XB_XCNT(j)  (256  + 64 * (j))
#define XB_XSUB(j)  (1280 + 64 * (j))
#define XB_XGEN(j)  (2304 + 64 * (j))
#define XB_TOP      3328
#define XB_TOPGEN   3392
#define XCD_BAR_WORDS 3456
#define XB_SPIN_CAP (1u << 18)

__device__ __forceinline__ unsigned xb_ld(unsigned* p)              { return __hip_atomic_load(p, __ATOMIC_RELAXED, __HIP_MEMORY_SCOPE_AGENT); }
__device__ __forceinline__ unsigned xb_add(unsigned* p, unsigned v) { return __hip_atomic_fetch_add(p, v, __ATOMIC_RELAXED, __HIP_MEMORY_SCOPE_AGENT); }
__device__ __forceinline__ unsigned xb_xcc_id() { return (unsigned)__builtin_amdgcn_s_getreg((3 << 11) | 20) & 0xFu; }
#define XB_SPIN(cond, bar) do { unsigned _sp = 0; while (cond) { __builtin_amdgcn_s_sleep(1); \
    if ((++_sp & 255u) == 0u) { if (xb_ld(&(bar)[XB_TMO])) break; if (_sp > XB_SPIN_CAP) { atomicAdd(&(bar)[XB_TMO], 1u); break; } } } } while (0)

struct XcdBarrier {
    unsigned* bar; unsigned x;
    volatile LAS unsigned* st;
};

__device__ __forceinline__ XcdBarrier xcd_barrier_post(unsigned* bar, volatile LAS unsigned* st) {
    XcdBarrier b; b.bar = bar; b.x = xb_xcc_id(); b.st = st;
    if (threadIdx.x == 0) (void)xb_add(&bar[XB_XCNT(b.x)], 1u);
    return b;
}
__device__ __forceinline__ void xcd_barrier_complete(unsigned* bar, unsigned x, unsigned& nloc, unsigned& nx) {
    const unsigned G = gridDim.x * gridDim.y * gridDim.z;
    unsigned sum, cnt, mine, sp = 0u;
    for (;;) {
        sum = 0u; cnt = 0u; mine = 0u;
#pragma unroll
        for (unsigned j = 0; j < 16; ++j) { const unsigned c = xb_ld(&bar[XB_XCNT(j)]); sum += c; cnt += (c > 0u) ? 1u : 0u; mine = (j == x) ? c : mine; }
        if (sum == G) break;
        __builtin_amdgcn_s_sleep(1);
        if ((++sp & 255u) == 0u) { if (xb_ld(&bar[XB_TMO])) break; if (sp > XB_SPIN_CAP) { atomicAdd(&bar[XB_TMO], 1u); break; } }
    }
    nloc = mine > 0u ? mine : 1u; nx = cnt > 0u ? cnt : 1u;
}

__device__ __forceinline__ void xcd_barrier(const XcdBarrier& b) {
    asm volatile("s_waitcnt vmcnt(0)" ::: "memory");
    __syncthreads();
    if (threadIdx.x == 0) {
        unsigned* bar = b.bar;
        __builtin_amdgcn_s_waitcnt(0);
        unsigned nloc = b.st[0], nx = b.st[1];
        if (nloc == 0u) { xcd_barrier_complete(bar, b.x, nloc, nx); b.st[0] = nloc; b.st[1] = nx; }
        const unsigned old = xb_add(&bar[XB_XSUB(b.x)], 1u);
        const unsigned gen = old / nloc;
        if (old + 1u == (gen + 1u) * nloc) {
            __builtin_amdgcn_fence(__ATOMIC_RELEASE, "agent");
            asm volatile("s_waitcnt vmcnt(0)" ::: "memory");
            const unsigned og = xb_add(&bar[XB_TOP], 1u);
            const unsigned tg = og / nx;
            if (og + 1u == (tg + 1u) * nx) xb_add(&bar[XB_TOPGEN], 1u);
            else XB_SPIN(xb_ld(&bar[XB_TOPGEN]) == tg, bar);
            __builtin_amdgcn_fence(__ATOMIC_ACQUIRE, "agent");
            xb_add(&bar[XB_XGEN(b.x)], 1u);
            asm volatile("s_waitcnt vmcnt(0)" ::: "memory");
        } else {
            XB_SPIN(xb_ld(&bar[XB_XGEN(b.x)]) == gen, bar);
            __builtin_amdgcn_fence(__ATOMIC_ACQUIRE, "agent");
            asm volatile("s_waitcnt vmcnt(0)" ::: "memory");
        }
    }
    __syncthreads();
}
namespace fk {
using pg8::bf16_t; using pg8::bf16x8; using pg8::f32x4; using pg8::u32x4; using pg8::Unit;
typedef float f32x16 __attribute__((ext_vector_type(16)));
typedef float f32x2 __attribute__((ext_vector_type(2)));
typedef __bf16 bf16x2_t __attribute__((ext_vector_type(2)));
typedef short s16x4 __attribute__((ext_vector_type(4)));
typedef unsigned u32x2 __attribute__((ext_vector_type(2)));
#define DI __device__ __forceinline__

constexpr int NB = 8, S = 2048, M = NB * S, D = 1024;
constexpr float EPS = 1e-6f, LOG2E = 1.4426950408889634f;
constexpr int NTHR = 512;

DI int tidx() { int t = threadIdx.x; asm volatile("" : "+v"(t)); return t; }
DI unsigned pk2(float lo, float hi) { f32x2 v = {lo, hi}; return __builtin_bit_cast(unsigned, __builtin_convertvector(v, bf16x2_t)); }
DI float bflo(unsigned u) { return __uint_as_float(u << 16); }
DI float bfhi(unsigned u) { return __uint_as_float(u & 0xffff0000u); }
DI float bf1(unsigned short b) { return __uint_as_float((unsigned)b << 16); }
DI float sigm(float x) { return 1.f / (1.f + __expf(-x)); }
DI float silu(float x) { return x * sigm(x); }
DI float ex2(float x) { return __builtin_amdgcn_exp2f(x); }
DI u32x4 pk8(const f32x4& a, const f32x4& b) { u32x4 w; w.x = pk2(a[0], a[1]); w.y = pk2(a[2], a[3]); w.z = pk2(b[0], b[1]); w.w = pk2(b[2], b[3]); return w; }
DI void unpk8(u32x4 w, f32x4& a, f32x4& b) { a[0] = bflo(w.x); a[1] = bfhi(w.x); a[2] = bflo(w.y); a[3] = bfhi(w.y); b[0] = bflo(w.z); b[1] = bfhi(w.z); b[2] = bflo(w.w); b[3] = bfhi(w.w); }

constexpr size_t KiB = 1024, MiB = 1u << 20;
constexpr size_t WS_CTL = 0;
constexpr size_t WS_SSQ = 64 * KiB;
constexpr int SSQ_X = 0  , SSQ_1 = 5  , SSQ_Q = 9  , SSQ_KV = 11  ;
constexpr size_t ZERO_BYTES = 1792 * KiB;
constexpr size_t WS_GW8 = 1792 * KiB;
constexpr size_t WS_WMIX = 2 * MiB;
constexpr size_t WS_WPLE = 23 * MiB;
constexpr size_t WS_XBA = 26 * MiB;
constexpr size_t WS_BIG = 58 * MiB;
constexpr size_t WS_CS = WS_BIG + 192 * MiB, WS_SN = WS_CS + 1 * MiB, WS_IG = WS_SN + 1 * MiB, WS_LF = WS_IG + 256 * KiB;
constexpr size_t WS_END = 256 * MiB;
static_assert(WS_LF + 256 * KiB <= WS_END, "ws map");
constexpr size_t WM_IN = 0, WM_QB = 4 * MiB, WM_KVB = 6 * MiB, WM_OUT_MLA = 8 * MiB, WM_OUT_CONV = 8 * MiB, WM_OUT_LSTM = 16 * MiB;
constexpr size_t A_SZ = 0, A_Q = 32 * MiB, A_KN = 80 * MiB, A_VT = 112 * MiB, A_CQ = 144 * MiB, A_CKV = 156 * MiB, A_KR = 164 * MiB, A_XBB = 32 * MiB, A_PP = 80 * MiB, A_PB = 166 * MiB;
constexpr size_t C_CH = 0, C_BZ = 32 * MiB, C_XBB = 64 * MiB, C_PP = 96 * MiB, C_PB = 166 * MiB;
constexpr size_t L_Q = 0, L_K = 32 * MiB, L_VT = 64 * MiB, L_OG = 128 * MiB, L_XBB = 0, L_PP = 64 * MiB;

struct Args { const float* in[19]; float* out; unsigned char* ws; int ph_lo, ph_hi; };
enum { I_X = 0, I_P, I_POS, I_NORMG, I_MLA_WIN, I_MLA_QN, I_MLA_WQB, I_MLA_KVN, I_MLA_WKVB, I_MLA_WOUT, I_CONV_WIN, I_CONV_W, I_CONV_WOUT, I_L_WIN, I_L_BG, I_L_WOUT, I_PLE_PROJ, I_PLE_GATE, I_FNORM };

enum { PM_ID = 0, PM_MLA_IN, PM_MLA_QB, PM_MLA_KVB, PM_CONV_IN, PM_LSTM_IN };
DI int prep_src(int mode, int n, float& sc) {
    sc = 1.f;
    switch (mode) {
    case PM_MLA_IN: { if (n < 1024) return 672 + n; if (n < 1408) return n - 1024; if (n < 1664) return 384 + (n - 1408); if (n < 1696) { const int jj = n - 1664; return 640 + (jj >> 1) + 16 * (jj & 1); } return -1; }
    case PM_MLA_QB: { sc = 0.10206207261596577f * LOG2E; const int hd = n / 96, d = n % 96; if (d < 64) return n; const int jj = d - 64; return 96 * hd + 64 + (jj >> 1) + 16 * (jj & 1); }
    case PM_MLA_KVB: { if (n < 1024) return 128 * (n >> 6) + (n & 63); const int n2 = n - 1024; return 128 * (n2 >> 6) + 64 + (n2 & 63); }
    case PM_CONV_IN: { const int pn = n >> 8, bj = (n >> 7) & 1, i = n & 127; if (pn < 8) return (bj ? 2048 : 1024) + 128 * pn + i; return (bj ? 3072 : 0) + 128 * (pn - 8) + i; }
    case PM_LSTM_IN: { if (n < 4096) { if (n >= 1024 && n < 2048) sc = 0.0625f; return n; } const int n2 = n - 4096, pn = n2 >> 8, bj = (n2 >> 7) & 1, i = n2 & 127; return (bj ? 6144 : 4096) + 128 * pn + i; }
    default: return n;
    }
}
struct PrepTask { const float* W; int ldw; const float* gk; int K, Nst, mode; bf16_t* out; };
DI void prep_tile(const PrepTask& t, int tile, LAS float* scr) {
    const int tid = tidx(), nkb = t.K >> 7, nb = tile / nkb, kb = tile % nkb, n0 = nb << 6, k0 = kb << 7;
    const int nn = tid & 63, kq = tid >> 6;
    float sc; const int src = prep_src(t.mode, n0 + nn, sc);
    float v[16];
#pragma unroll
    for (int i = 0; i < 16; ++i) { const int kk = kq + 8 * i; v[i] = (src >= 0) ? t.W[(size_t)(k0 + kk) * t.ldw + src] : 0.f; }
#pragma unroll
    for (int i = 0; i < 16; ++i) { const int kk = kq + 8 * i; float x = v[i] * sc; if (t.gk) x *= t.gk[k0 + kk]; scr[nn * 129 + kk] = x; }
    __syncthreads();
#pragma unroll
    for (int h2 = 0; h2 < 2; ++h2) { const int e = tid + h2 * NTHR, n2 = e >> 4, c = e & 15; const LAS float* sp = scr + n2 * 129 + 8 * c;
      u32x4 o; o.x = pk2(sp[0], sp[1]); o.y = pk2(sp[2], sp[3]); o.z = pk2(sp[4], sp[5]); o.w = pk2(sp[6], sp[7]);
      *(u32x4*)(t.out + (size_t)(n0 + n2) * t.K + k0 + 8 * c) = o; }
    __syncthreads();
}
DI void prep_run1(const PrepTask& t, LAS float* scr, int cu, int G) {
    const int total = (t.Nst >> 6) * (t.K >> 7);
#pragma unroll 1
    for (int it = cu; it < total; it += G) prep_tile(t, it, scr);
}

DI float wave_sum(float v) {
#pragma unroll
    for (int o = 1; o < 64; o <<= 1) v += __shfl_xor(v, o);
    return v;
}
DI void rows_to_bf16_ssq(const float* x, bf16_t* xb, unsigned long long* ssq, int gw, int NGW, int lane) {
    for (int m0 = gw; m0 < M; m0 += 4 * NGW) {
        f32x4 v[4][4];
#pragma unroll
        for (int r = 0; r < 4; ++r) { const int m = m0 + r * NGW; const f32x4* xr = (const f32x4*)(x + (size_t)(m < M ? m : m0) * D) + lane;
#pragma unroll
            for (int j = 0; j < 4; ++j) v[r][j] = xr[64 * j]; }
#pragma unroll
        for (int r = 0; r < 4; ++r) { const int m = m0 + r * NGW; if (m < M) {
            float s = 0.f; u32x2* o8 = (u32x2*)(xb + (size_t)m * D) + lane;
#pragma unroll
            for (int j = 0; j < 4; ++j) { s += (v[r][j][0] * v[r][j][0] + v[r][j][1] * v[r][j][1]) + (v[r][j][2] * v[r][j][2] + v[r][j][3] * v[r][j][3]); u32x2 w; w.x = pk2(v[r][j][0], v[r][j][1]); w.y = pk2(v[r][j][2], v[r][j][3]); o8[64 * j] = w; }
            s = wave_sum(s); if (lane == 0) ssq[m] = (unsigned long long)(s * 16777216.f); } }
    }
}
DI void p_to_bf16(const float* p, bf16_t* pb, int gt, int NGT) {
    constexpr size_t N8 = (size_t)M * 256 / 8;
    for (size_t i = gt; i < N8; i += (size_t)4 * NGT) {
        f32x4 a[4], b[4];
#pragma unroll
        for (int k = 0; k < 4; ++k) { const size_t e = i + (size_t)k * NGT; if (e < N8) { a[k] = ((const f32x4*)p)[2 * e]; b[k] = ((const f32x4*)p)[2 * e + 1]; } }
#pragma unroll
        for (int k = 0; k < 4; ++k) { const size_t e = i + (size_t)k * NGT; if (e < N8) ((u32x4*)pb)[e] = pk8(a[k], b[k]); }
    }
}
DI void rope_tables(const int* pos, float* cs, float* sn, int gt, int NGT) {
    for (int i = gt; i < M * 16; i += NGT) {
        const int t = i >> 4, j = i & 15;
        const float inv = powf(10000.0f, -(float)(2 * j) / 32.0f);
        const float ang = (float)pos[t] * inv;
        double rev = (double)ang * 0.15915494309189533577; rev -= rint(rev);
        const float fr = (float)rev;
        cs[i] = __builtin_amdgcn_cosf(fr); sn[i] = __builtin_amdgcn_sinf(fr);
    }
}

#define EPI_ROW(u, ai, m) ((u).pm * 256 + (ai) * 128 + wr * 64 + (m) * 16 + fr)
#define EPI_LOOP_AM _Pragma("unroll") for (int ai = 0; ai < 2; ++ai) _Pragma("unroll") for (int m = 0; m < 4; ++m)
typedef const f32x4 (&AccRef)[2][2][4][2];
#ifndef NT_STORES
#define NT_STORES 0
#endif
#ifndef SC1_STORES
#define SC1_STORES 0
#endif
DI void st16(const void* base, bf16_t* p, const u32x4& v) {
    if (SC1_STORES) __builtin_amdgcn_raw_buffer_store_b128(v, __builtin_amdgcn_make_buffer_rsrc((void*)base, 0, 0xFFFFFFFFu, 0x00020000), (unsigned)((const char*)p - (const char*)base), 0, 16);
    else if (NT_STORES) __builtin_nontemporal_store(v, (u32x4*)p); else *(u32x4*)p = v; }
DI float sq8(const f32x4& a, const f32x4& b) { return (a[0] * a[0] + a[1] * a[1]) + (a[2] * a[2] + a[3] * a[3]) + (b[0] * b[0] + b[1] * b[1]) + (b[2] * b[2] + b[3] * b[3]); }
DI float red_fq(float s) { s += __shfl_xor(s, 16); s += __shfl_xor(s, 32); return s; }
DI void rope8(f32x4& a, f32x4& b, const float* cs, const float* sn, int row, int p0) {
    const f32x4 c = *(const f32x4*)(cs + (size_t)row * 16 + p0), s = *(const f32x4*)(sn + (size_t)row * 16 + p0);
    const f32x4 a0 = a, b0 = b;
    a[0] = a0[0] * c[0] - a0[1] * s[0]; a[1] = a0[0] * s[0] + a0[1] * c[0];
    a[2] = a0[2] * c[1] - a0[3] * s[1]; a[3] = a0[2] * s[1] + a0[3] * c[1];
    b[0] = b0[0] * c[2] - b0[1] * s[2]; b[1] = b0[0] * s[2] + b0[1] * c[2];
    b[2] = b0[2] * c[3] - b0[3] * s[3]; b[3] = b0[2] * s[3] + b0[3] * c[3];
}

DI int opaque(int v) { asm volatile("" : "+s"(v)); return v; }
template <class T> DI T* launder(T* p) { asm volatile("" : "+s"(p)); return p; }
typedef unsigned long long u64;
constexpr float SSQ_SCALE = 16777216.f, SSQ_INV = 1.f / 16777216.f;
DI u64* ssq_arr(unsigned char* ws, int idx) { return (u64*)(ws + WS_SSQ) + (size_t)idx * M; }
DI void ssq_add(u64* p, float s) { atomicAdd(p, (u64)(s * SSQ_SCALE)); }
DI float ssq_rstd(const u64* p, float invn) { return rsqrtf((float)(*p) * SSQ_INV * invn + EPS); }

#define EPI_RS8(rsarr, ssqp, invn) float rsarr[2][4]; { u64 t_[2][4]; _Pragma("unroll") for (int ai = 0; ai < 2; ++ai) _Pragma("unroll") for (int m = 0; m < 4; ++m) t_[ai][m] = (ssqp)[EPI_ROW(u, ai, m)]; \
    _Pragma("unroll") for (int ai = 0; ai < 2; ++ai) _Pragma("unroll") for (int m = 0; m < 4; ++m) rsarr[ai][m] = rsqrtf((float)t_[ai][m] * SSQ_INV * (invn) + EPS); }

struct EpiA1 {
    static constexpr bool PERM = true, AFTER_DRAIN = false;
    unsigned char* ws; int i, j;
    DI void operator()(AccRef acc, const Unit& u, int wr, int wc, int fr, int fq) const {
        unsigned char* w = launder(ws); unsigned char* big = w + WS_BIG;
        const u64* ssq_x = ssq_arr(w, SSQ_X + i); u64* ssq_q = ssq_arr(w, SSQ_Q + j); u64* ssq_kv = ssq_arr(w, SSQ_KV + j);
        bf16_t *SZ = (bf16_t*)(big + A_SZ), *CQ = (bf16_t*)(big + A_CQ), *CKV = (bf16_t*)(big + A_CKV), *KR = (bf16_t*)(big + A_KR);
        const float *CS = (const float*)(w + WS_CS), *SN = (const float*)(w + WS_SN);
        EPI_RS8(rsv, ssq_x, 1.f / 1024.f);
        EPI_LOOP_AM {
            const int row = EPI_ROW(u, ai, m); const float rs = rsv[ai][m];
            float sq = 0.f, skv = 0.f; bool hq = false, hkv = false;
#pragma unroll
            for (int bj = 0; bj < 2; ++bj) {
                f32x4 v0 = acc[ai][bj][m][0] * rs, v1 = acc[ai][bj][m][1] * rs;
                if (u.pn < 4) {
                    const int col = u.pn * 256 + bj * 128 + wc * 32 + 8 * fq;
#pragma unroll
                    for (int jj = 0; jj < 4; ++jj) { v0[jj] = silu(v0[jj]); v1[jj] = silu(v1[jj]); }
                    st16(w, SZ + (size_t)row * 1024 + col, pk8(v0, v1));
                } else {
                    const int c = (u.pn - 4) * 256 + bj * 128 + wc * 32 + 8 * fq;
                    if (c < 384) { st16(w, CQ + (size_t)row * 384 + c, pk8(v0, v1)); sq += sq8(v0, v1); hq = true; }
                    else if (c < 640) { st16(w, CKV + (size_t)row * 256 + (c - 384), pk8(v0, v1)); skv += sq8(v0, v1); hkv = true; }
                    else if (c < 672) { const int jj0 = c - 640; rope8(v0, v1, CS, SN, row, jj0 >> 1); st16(w, KR + (size_t)row * 32 + jj0, pk8(v0, v1)); }
                }
            }
            if (u.pn >= 4) {
                sq = red_fq(sq); skv = red_fq(skv);
                if (fq == 0 && hq) ssq_add(ssq_q + row, sq);
                if (fq == 0 && hkv) ssq_add(ssq_kv + row, skv);
            }
        }
    }
};
struct EpiQ {
    static constexpr bool PERM = true, AFTER_DRAIN = false;
    unsigned char* ws; int j;
    DI void operator()(AccRef acc, const Unit& u, int wr, int wc, int fr, int fq) const {
        unsigned char* w = launder(ws); const u64* ssq_q = ssq_arr(w, SSQ_Q + j); bf16_t* Q = (bf16_t*)(w + WS_BIG + A_Q);
        const float *CS = (const float*)(w + WS_CS), *SN = (const float*)(w + WS_SN);
        EPI_RS8(rsv, ssq_q, 1.f / 384.f);
        EPI_LOOP_AM {
            const int row = EPI_ROW(u, ai, m); const float rs = rsv[ai][m];
#pragma unroll
            for (int bj = 0; bj < 2; ++bj) {
                const int col = u.pn * 256 + bj * 128 + wc * 32 + 8 * fq, d = col % 96;
                f32x4 v0 = acc[ai][bj][m][0] * rs, v1 = acc[ai][bj][m][1] * rs;
                if (d >= 64) rope8(v0, v1, CS, SN, row, (d - 64) >> 1);
                st16(w, Q + (size_t)row * 1536 + col, pk8(v0, v1));
            }
        }
    }
};
struct EpiKV {
    static constexpr bool PERM = true, AFTER_DRAIN = false;
    unsigned char* ws; int j;
    DI void operator()(AccRef acc, const Unit& u, int wr, int wc, int fr, int fq) const {
        unsigned char* w = launder(ws); const u64* ssq_kv = ssq_arr(w, SSQ_KV + j); bf16_t* O = (bf16_t*)(w + WS_BIG + (u.pn < 4 ? A_KN : A_VT));
        EPI_RS8(rsv, ssq_kv, 1.f / 256.f);
        EPI_LOOP_AM {
            const int row = EPI_ROW(u, ai, m); const float rs = rsv[ai][m];
#pragma unroll
            for (int bj = 0; bj < 2; ++bj) {
                const int col = (u.pn & 3) * 256 + bj * 128 + wc * 32 + 8 * fq;
                st16(w, O + (size_t)row * 1024 + col, pk8(acc[ai][bj][m][0] * rs, acc[ai][bj][m][1] * rs));
            }
        }
    }
};
struct EpiOut {
    static constexpr bool PERM = true, AFTER_DRAIN = false;
    unsigned char* ws; size_t xbb_off; int i;
    DI void operator()(AccRef acc, const Unit& u, int wr, int wc, int fr, int fq) const {
        unsigned char* w = launder(ws); u64* ssq = ssq_arr(w, SSQ_1 + i); bf16_t* XB = (bf16_t*)(w + WS_BIG + xbb_off); const bf16_t* xin = (const bf16_t*)(w + WS_XBA);
        const size_t cb = (size_t)u.pn * 256 + wc * 32 + 8 * fq;
        u32x4 cur[2], nxt[2];
#define EO_LOAD(dst, it) do { const size_t o_ = (size_t)EPI_ROW(u, (it) >> 2, (it) & 3) * 1024 + cb; dst[0] = *(const u32x4*)(xin + o_); dst[1] = *(const u32x4*)(xin + o_ + 128); } while (0)
        EO_LOAD(cur, 0);
#pragma unroll
        for (int it = 0; it < 8; ++it) {
            const int ai = it >> 2, m = it & 3;
            if (it < 7) EO_LOAD(nxt, it + 1);
            const int row = EPI_ROW(u, ai, m); float sq = 0.f;
#pragma unroll
            for (int bj = 0; bj < 2; ++bj) {
                const size_t off = (size_t)row * 1024 + cb + bj * 128;
                f32x4 x0, x1; unpk8(cur[bj], x0, x1);
                const f32x4 y0 = x0 + acc[ai][bj][m][0], y1 = x1 + acc[ai][bj][m][1];
                st16(w, XB + off, pk8(y0, y1)); sq += sq8(y0, y1);
            }
            sq = red_fq(sq); if (fq == 0) ssq_add(ssq + row, sq);
            cur[0] = nxt[0]; cur[1] = nxt[1];
        }
#undef EO_LOAD
    }
};
struct EpiPP {
    static constexpr bool PERM = true, AFTER_DRAIN = false;
    bf16_t* pp;
    DI void operator()(AccRef acc, const Unit& u, int wr, int wc, int fr, int fq) const {
        bf16_t* PP = launder(pp);
        EPI_LOOP_AM { const int row = EPI_ROW(u, ai, m);
#pragma unroll
            for (int bj = 0; bj < 2; ++bj) { const size_t off = (size_t)row * 1024 + u.pn * 256 + bj * 128 + wc * 32 + 8 * fq; st16(PP, PP + off, pk8(acc[ai][bj][m][0], acc[ai][bj][m][1])); } }
    }
};
struct EpiPle {
    static constexpr bool PERM = true, AFTER_DRAIN = false;
    unsigned char* ws; const bf16_t* pp; size_t xbb_off; int i;
    DI void operator()(AccRef acc, const Unit& u, int wr, int wc, int fr, int fq) const {
        unsigned char* w = launder(ws); const u64* ssq1 = ssq_arr(w, SSQ_1 + i); u64* ssq = ssq_arr(w, SSQ_X + i + 1);
        const bf16_t* PP = launder(pp); const bf16_t* X1 = (const bf16_t*)(w + WS_BIG + xbb_off); bf16_t* XB = (bf16_t*)(w + WS_XBA);
        const size_t cb = (size_t)u.pn * 256 + wc * 32 + 8 * fq;
        EPI_RS8(rsv, ssq1, 1.f / 1024.f);
        u32x4 cur[2], nxt[2], pc[2], pn2[2];
#define EP_LOAD(dst, pd, it) do { const size_t o_ = (size_t)EPI_ROW(u, (it) >> 2, (it) & 3) * 1024 + cb; dst[0] = *(const u32x4*)(X1 + o_); dst[1] = *(const u32x4*)(X1 + o_ + 128); \
            pd[0] = *(const u32x4*)(PP + o_); pd[1] = *(const u32x4*)(PP + o_ + 128); } while (0)
        EP_LOAD(cur, pc, 0);
#pragma unroll
        for (int it = 0; it < 8; ++it) {
            const int ai = it >> 2, m = it & 3;
            if (it < 7) EP_LOAD(nxt, pn2, it + 1);
            const int row = EPI_ROW(u, ai, m); const float rs = rsv[ai][m]; float sq = 0.f;
#pragma unroll
            for (int bj = 0; bj < 2; ++bj) {
                const size_t off = (size_t)row * 1024 + cb + bj * 128;
                f32x4 p0, p1, y0, y1; unpk8(pc[bj], p0, p1); unpk8(cur[bj], y0, y1);
#pragma unroll
                for (int jj = 0; jj < 4; ++jj) { y0[jj] += sigm(acc[ai][bj][m][0][jj] * rs) * p0[jj]; y1[jj] += sigm(acc[ai][bj][m][1][jj] * rs) * p1[jj]; }
                st16(w, XB + off, pk8(y0, y1)); sq += sq8(y0, y1);
            }
            sq = red_fq(sq); if (fq == 0) ssq_add(ssq + row, sq);
#pragma unroll
            for (int bj = 0; bj < 2; ++bj) { cur[bj] = nxt[bj]; pc[bj] = pn2[bj]; }
        }
#undef EP_LOAD
    }
};
struct EpiPleLast {
    static constexpr bool PERM = true, AFTER_DRAIN = true;
    unsigned char* ws; float* out; const float* gfin; const bf16_t* pp; size_t xbb_off; int i; unsigned xcc; volatile LAS unsigned* st;
    DI void fused(f32x4 (&acc)[2][2][4][2], const Unit& u, int wr, int wc, int fr, int fq, LAS unsigned char* lds, int wid, int lane) const {
        unsigned char* w = launder(ws); const u64* ssq1 = ssq_arr(w, SSQ_1 + i); u64* ssq = ssq_arr(w, SSQ_X + i + 1);
        const bf16_t* PP = launder(pp); const bf16_t* X1 = (const bf16_t*)(w + WS_BIG + xbb_off);
        const size_t cb = (size_t)u.pn * 256 + wc * 32 + 8 * fq;
        {
            EPI_RS8(rsv, ssq1, 1.f / 1024.f);
#pragma unroll
            for (int it = 0; it < 8; ++it) {
                const int ai = it >> 2, m = it & 3; const int row = EPI_ROW(u, ai, m); const float rs = rsv[ai][m]; float sq = 0.f;
#pragma unroll
                for (int bj = 0; bj < 2; ++bj) {
                    const size_t off = (size_t)row * 1024 + cb + bj * 128;
                    f32x4 p0, p1, y0, y1; unpk8(*(const u32x4*)(PP + off), p0, p1); unpk8(*(const u32x4*)(X1 + off), y0, y1);
#pragma unroll
                    for (int jj = 0; jj < 4; ++jj) { y0[jj] += sigm(acc[ai][bj][m][0][jj] * rs) * p0[jj]; y1[jj] += sigm(acc[ai][bj][m][1][jj] * rs) * p1[jj]; }
                    acc[ai][bj][m][0] = y0; acc[ai][bj][m][1] = y1; sq += sq8(y0, y1);
                }
                sq = red_fq(sq); if (fq == 0) ssq_add(ssq + row, sq);
            }
        }
        { XcdBarrier b; b.bar = (unsigned*)(launder(ws) + WS_CTL); b.x = xcc; b.st = st; xcd_barrier(b); }
        {
            const u64* ssqf = ssq_arr(launder(ws), SSQ_X + i + 1);
            EPI_RS8(rsf, ssqf, 1.f / 1024.f);
#pragma unroll
            for (int bj = 0; bj < 2; ++bj) {
                const f32x4 g0 = *(const f32x4*)(gfin + cb + bj * 128), g1 = *(const f32x4*)(gfin + cb + bj * 128 + 4);
                EPI_LOOP_AM { const size_t off = (size_t)EPI_ROW(u, ai, m) * 1024 + cb + bj * 128; const float rs = rsf[ai][m];
                    *(f32x4*)(out + off) = acc[ai][bj][m][0] * rs * g0; *(f32x4*)(out + off + 4) = acc[ai][bj][m][1] * rs * g1; }
            }
        }
    }
};
struct EpiC1 {
    static constexpr bool PERM = true, AFTER_DRAIN = false;
    unsigned char* ws; int i; int dry;
    DI void operator()(AccRef acc, const Unit& u, int wr, int wc, int fr, int fq) const {
        if (dry == 1) { asm volatile("" :: "v"(acc[0][0][0][0][0]), "v"(acc[1][1][3][1][3])); return; }
        unsigned char* w = launder(ws); const u64* ssq_x = ssq_arr(w, SSQ_X + i); bf16_t *CH = (bf16_t*)(w + WS_BIG + C_CH), *BZ = (bf16_t*)(w + WS_BIG + C_BZ);
        EPI_RS8(rsv, ssq_x, 1.f / 1024.f);
        EPI_LOOP_AM {
            const int row = EPI_ROW(u, ai, m); const float rs = rsv[ai][m];
            const size_t off = (size_t)row * 1024 + (u.pn & 7) * 128 + wc * 32 + 8 * fq;
            f32x4 r0, r1;
            if (u.pn < 8) { r0 = (acc[ai][0][m][0] * rs) * (acc[ai][1][m][0] * rs); r1 = (acc[ai][0][m][1] * rs) * (acc[ai][1][m][1] * rs); { const u32x4 o_ = pk8(r0, r1); if (dry == 2) asm volatile("" :: "v"(o_)); else st16(w, CH + off, o_); } }
            else {
#pragma unroll
                for (int jj = 0; jj < 4; ++jj) { r0[jj] = (acc[ai][0][m][0][jj] * rs) * silu(acc[ai][1][m][0][jj] * rs); r1[jj] = (acc[ai][0][m][1][jj] * rs) * silu(acc[ai][1][m][1][jj] * rs); }
                { const u32x4 o_ = pk8(r0, r1); if (dry == 2) asm volatile("" :: "v"(o_)); else st16(w, BZ + off, o_); }
            }
        }
    }
};
struct EpiL1 {
    static constexpr bool PERM = true, AFTER_DRAIN = false;
    unsigned char* ws; int i;
    DI void operator()(AccRef acc, const Unit& u, int wr, int wc, int fr, int fq) const {
        unsigned char* w = launder(ws); const u64* ssq_x = ssq_arr(w, SSQ_X + i); unsigned char* big = w + WS_BIG;
        EPI_RS8(rsv, ssq_x, 1.f / 1024.f);
        if (u.pn < 16) {
            bf16_t* O; int ld, c0;
            if (u.pn < 4) { O = (bf16_t*)(big + L_Q); ld = 1024; c0 = u.pn * 256; } else if (u.pn < 8) { O = (bf16_t*)(big + L_K); ld = 1024; c0 = (u.pn - 4) * 256; } else { O = (bf16_t*)(big + L_VT); ld = 2048; c0 = (u.pn - 8) * 256; }
            EPI_LOOP_AM {
                const int row = EPI_ROW(u, ai, m); const float rs = rsv[ai][m];
#pragma unroll
                for (int bj = 0; bj < 2; ++bj) st16(w, O + (size_t)row * ld + c0 + bj * 128 + wc * 32 + 8 * fq, pk8(acc[ai][bj][m][0] * rs, acc[ai][bj][m][1] * rs));
            }
        } else {
            bf16_t* OG = (bf16_t*)(big + L_OG);
            EPI_LOOP_AM {
                const int row = EPI_ROW(u, ai, m); const float rs = rsv[ai][m];
                const size_t off = (size_t)row * 2048 + (u.pn - 16) * 128 + wc * 32 + 8 * fq; f32x4 r0, r1;
#pragma unroll
                for (int jj = 0; jj < 4; ++jj) { r0[jj] = sigm(acc[ai][0][m][0][jj] * rs) * silu(acc[ai][1][m][0][jj] * rs); r1[jj] = sigm(acc[ai][0][m][1][jj] * rs) * silu(acc[ai][1][m][1][jj] * rs); }
                st16(w, OG + off, pk8(r0, r1));
            }
        }
    }
};
constexpr int AT_KSTR = 208, AT_VSTR = 192, AT_KB = 64 * AT_KSTR, AT_VB = 64 * AT_VSTR;
#define MFMA32(a, b, c) __builtin_amdgcn_mfma_f32_32x32x16_bf16((a), (b), (c), 0, 0, 0)
#define MFMA16(a, b, c) __builtin_amdgcn_mfma_f32_16x16x32_bf16((a), (b), (c), 0, 0, 0)
DI float max3f(float a, float b, float c) { float r; asm("v_max3_f32 %0, %1, %2, %3" : "=v"(r) : "v"(a), "v"(b), "v"(c)); return r; }
DI bf16x8 cat4(s16x4 lo, s16x4 hi) { return __builtin_shufflevector(lo, hi, 0, 1, 2, 3, 4, 5, 6, 7); }

struct AttnT { const bf16_t *Q, *KN, *KR, *VT; bf16_t* SZOG; };
#ifndef DIAG_NOLOAD
#define DIAG_NOLOAD 0
#endif
struct AttnStage { u32x4 k, r, v; };
DI void attn_unit(LAS unsigned char* lds, const AttnT& T, int b, int h, int qb, int dry) {
    const int tid = tidx(), w = __builtin_amdgcn_readfirstlane(tid >> 6), lane = tid & 63, r = lane & 31, hh = lane >> 5;
    const int tok0 = b * S, row0 = tok0 + qb * 256 + 32 * w;
    bf16x8 qf[6];
#pragma unroll
    for (int ks = 0; ks < 6; ++ks) qf[ks] = *(const bf16x8*)(T.Q + (size_t)(row0 + r) * 1536 + 96 * h + 16 * ks + 8 * hh);
    f32x16 O0, O1;
#pragma unroll
    for (int i = 0; i < 16; ++i) { O0[i] = 0.f; O1[i] = 0.f; }
    float mrun = -1e30f, lrun = 0.f;
    const int ntiles = 4 * qb + 4, myvis = 4 * qb + (w >> 1);
    const int kkey = tid >> 3, kch = tid & 7, rkey = tid >> 2, rch = tid & 3;
    const bf16_t* gK = T.KN + (size_t)(tok0 + kkey) * 1024 + 64 * h + 8 * kch;
    const bf16_t* gR = T.KR + (size_t)(tok0 + rkey) * 32 + 8 * rch;
    const bf16_t* gV = T.VT + (size_t)(tok0 + kkey) * 1024 + 64 * h + 8 * kch;
    const int lK = kkey * AT_KSTR + 16 * kch, lR = rkey * AT_KSTR + 128 + 16 * rch, lV = kkey * AT_VSTR + 16 * kch;
    const int krd = r * AT_KSTR + 16 * hh;
    const int vrd = (4 * hh + ((lane & 15) >> 2)) * AT_VSTR + (16 * ((lane >> 4) & 1) + 4 * (lane & 3)) * 2;
#define AT_LOADK(st, kt) do { if (DIAG_NOLOAD && dry) break; (st).k = *(const u32x4*)(gK + (size_t)(kt) * 64 * 1024); if (tid < 256) (st).r = *(const u32x4*)(gR + (size_t)(kt) * 64 * 32); } while (0)
#define AT_LOADV(st, kt) do { if (DIAG_NOLOAD && dry) break; (st).v = *(const u32x4*)(gV + (size_t)(kt) * 64 * 1024); } while (0)
#define AT_WRITEK(st, buf) do { LAS unsigned char* kb_ = lds + (buf) * AT_KB; *(LAS u32x4*)(kb_ + lK) = (st).k; if (tid < 256) *(LAS u32x4*)(kb_ + lR) = (st).r; } while (0)
#define AT_WRITEV(st, buf) do { *(LAS u32x4*)(lds + 2 * AT_KB + (buf) * AT_VB + lV) = (st).v; } while (0)
#define AT_QK1(sX, buf, blk) do { const LAS unsigned char* kb = lds + (buf) * AT_KB + krd + (blk) * 32 * AT_KSTR; \
        _Pragma("unroll") for (int i = 0; i < 16; ++i) sX[i] = 0.f; \
        _Pragma("unroll") for (int ks = 0; ks < 6; ++ks) sX = MFMA32(*(const LAS bf16x8*)(kb + 32 * ks), qf[ks], sX); } while (0)
#define AT_QK(sA, sB, buf) do { AT_QK1(sA, buf, 0); AT_QK1(sB, buf, 1); } while (0)
#define AT_MAX(s0, s1) \
          \
        asm volatile("s_nop 7\n\ts_nop 7\n\ts_nop 7" : "+v"(s0[0]), "+v"(s1[0])); \
        float mx = max3f(s0[0], s1[0], mrun); \
        _Pragma("unroll") for (int i = 1; i < 16; ++i) mx = max3f(mx, s0[i], s1[i]); \
        const float mnew = max3f(mx, __shfl_xor(mx, 32), mx), alpha = ex2(mrun - mnew); mrun = mnew;
#define AT_EXP(s0, s1) do { float ps = 0.f; \
        _Pragma("unroll") for (int i = 0; i < 16; ++i) { s0[i] = ex2(s0[i] - mrun); s1[i] = ex2(s1[i] - mrun); ps += s0[i] + s1[i]; } \
        lrun = lrun * alpha + ps; \
        _Pragma("unroll") for (int i = 0; i < 16; ++i) { O0[i] *= alpha; O1[i] *= alpha; } } while (0)
#define AT_PV(s0, s1, buf) do { LAS unsigned char* vb = lds + 2 * AT_KB + (buf) * AT_VB + vrd; \
        _Pragma("unroll") for (int kb2 = 0; kb2 < 2; ++kb2) _Pragma("unroll") for (int s = 0; s < 2; ++s) { \
            const f32x16& sx = kb2 ? s1 : s0; \
            u32x4 pw; pw.x = pk2(sx[8 * s + 0], sx[8 * s + 1]); pw.y = pk2(sx[8 * s + 2], sx[8 * s + 3]); pw.z = pk2(sx[8 * s + 4], sx[8 * s + 5]); pw.w = pk2(sx[8 * s + 6], sx[8 * s + 7]); \
            const bf16x8 pf = __builtin_bit_cast(bf16x8, pw); \
            LAS unsigned char* vp = vb + (32 * kb2 + 16 * s) * AT_VSTR; \
            const bf16x8 v0 = cat4(__builtin_amdgcn_ds_read_tr16_b64_v4i16((LAS s16x4*)vp), __builtin_amdgcn_ds_read_tr16_b64_v4i16((LAS s16x4*)(vp + 8 * AT_VSTR))); \
            const bf16x8 v1 = cat4(__builtin_amdgcn_ds_read_tr16_b64_v4i16((LAS s16x4*)(vp + 64)), __builtin_amdgcn_ds_read_tr16_b64_v4i16((LAS s16x4*)(vp + 64 + 8 * AT_VSTR))); \
            O0 = MFMA32(v0, pf, O0); O1 = MFMA32(v1, pf, O1); } } while (0)
#define AT_SOFTMAX_PV(s0, s1, buf) do { AT_MAX(s0, s1); AT_EXP(s0, s1); AT_PV(s0, s1, buf); } while (0)
#define AT_FUSED(c0, c1, n0, n1, bufK, bufV) do { AT_QK1(n0, bufK, 0); AT_MAX(c0, c1); __builtin_amdgcn_sched_barrier(0); \
        AT_QK1(n1, bufK, 1); AT_EXP(c0, c1); __builtin_amdgcn_sched_barrier(0); AT_PV(c0, c1, bufV); } while (0)
    AttnStage RA, RB;
    f32x16 a0, a1, b0, b1;
    AT_LOADK(RA, 0); AT_LOADV(RA, 0); AT_LOADK(RB, 1);
    AT_WRITEK(RA, 0); AT_WRITEV(RA, 0); AT_WRITEK(RB, 1);
    AT_LOADK(RA, 2); AT_LOADV(RA, 1);
    __syncthreads();
    AT_QK(a0, a1, 0);
    const int nmain = 4 * qb, jv = w >> 1;
    int t = 0;
#pragma unroll 1
    for (; t < nmain; t += 2) {
        AT_LOADK(RB, t + 3); AT_LOADV(RB, t + 2);
        AT_FUSED(a0, a1, b0, b1, 1, 0);
        AT_WRITEK(RA, 0); AT_WRITEV(RA, 1);
        __syncthreads();
        AT_LOADK(RA, t + 4); AT_LOADV(RA, t + 3);
        AT_FUSED(b0, b1, a0, a1, 0, 1);
        AT_WRITEK(RB, 1); AT_WRITEV(RB, 0);
        __syncthreads();
    }
    AT_LOADK(RB, t + 3); AT_LOADV(RB, t + 2);
    if (jv >= 1) AT_QK(b0, b1, 1);
    AT_SOFTMAX_PV(a0, a1, 0);
    AT_WRITEK(RA, 0); AT_WRITEV(RA, 1);
    __syncthreads();
    AT_LOADV(RA, t + 3);
    if (jv >= 2) AT_QK(a0, a1, 0);
    if (jv >= 1) AT_SOFTMAX_PV(b0, b1, 1);
    AT_WRITEK(RB, 1); AT_WRITEV(RB, 0);
    __syncthreads();
    if (jv >= 3) AT_QK(b0, b1, 1);
    if (jv >= 2) AT_SOFTMAX_PV(a0, a1, 0);
    AT_WRITEV(RA, 1);
    __syncthreads();
    if (jv >= 3) AT_SOFTMAX_PV(b0, b1, 1);
    __syncthreads();
#undef AT_LOADK
#undef AT_LOADV
#undef AT_WRITEK
#undef AT_WRITEV
#undef AT_QK
#undef AT_SOFTMAX_PV
#undef AT_QK1
#undef AT_MAX
#undef AT_EXP
#undef AT_PV
#undef AT_FUSED
    const float linv = 1.f / (lrun + __shfl_xor(lrun, 32));
    bf16_t* op = T.SZOG + (size_t)(row0 + r) * 1024 + 64 * h + 4 * hh;
#pragma unroll
    for (int db = 0; db < 2; ++db)
#pragma unroll
        for (int g4 = 0; g4 < 4; ++g4) {
            const f32x16& ox = db ? O1 : O0; bf16_t* p = op + 32 * db + 8 * g4;
            const u32x2 z = *(const u32x2*)p; u32x2 o;
            o.x = pk2(ox[4 * g4 + 0] * linv * bflo(z.x), ox[4 * g4 + 1] * linv * bfhi(z.x)); o.y = pk2(ox[4 * g4 + 2] * linv * bflo(z.y), ox[4 * g4 + 3] * linv * bfhi(z.y));
            if (!dry) *(u32x2*)p = o;
        }
}
DI void attn_phase(LAS unsigned char* lds, const AttnT& T, int cu, int dry) {
    const int bh = (cu & 7) + 8 * (cu >> 4), half = (cu >> 3) & 1, b = bh >> 4, h = bh & 15;
#pragma unroll 1
    for (int ui = 0; ui < 4; ++ui) attn_unit(lds, T, b, h, ((half ? 0x2516 : 0x3407) >> (4 * ui)) & 0xF, dry);
}

DI void conv_phase(const bf16_t* CH, bf16_t* BZ, const float* cw, int gt, int NGT, int dry) {
    for (int it = gt; it < (M / 8) * 128; it += NGT) {
        const int c8 = (it & 127) * 8, m0 = (it >> 7) * 8, t0 = m0 & (S - 1);
        const f32x4 w0a = *(const f32x4*)(cw + c8), w0b = *(const f32x4*)(cw + c8 + 4), w1a = *(const f32x4*)(cw + 1024 + c8), w1b = *(const f32x4*)(cw + 1024 + c8 + 4), w2a = *(const f32x4*)(cw + 2048 + c8), w2b = *(const f32x4*)(cw + 2048 + c8 + 4);
        u32x4 ch[10], bz[8];
#pragma unroll
        for (int r = 0; r < 10; ++r) { const int m = m0 - 2 + r; ch[r] = (r >= 2 || t0 > 0) ? *(const u32x4*)(CH + (size_t)m * 1024 + c8) : (u32x4){0u, 0u, 0u, 0u}; }
#pragma unroll
        for (int r = 0; r < 8; ++r) bz[r] = *(const u32x4*)(BZ + (size_t)(m0 + r) * 1024 + c8);
        f32x4 pa, pb, qa, qb;
        unpk8(ch[0], pa, pb); unpk8(ch[1], qa, qb);
#pragma unroll
        for (int r = 0; r < 8; ++r) {
            f32x4 ca, cb, ba, bb; unpk8(ch[r + 2], ca, cb); unpk8(bz[r], ba, bb);
            const f32x4 ya = w0a * pa + w1a * qa + w2a * ca, yb = w0b * pb + w1b * qb + w2b * cb;
            const u32x4 ov = pk8(ba * ya, bb * yb); if (!dry) *(u32x4*)(BZ + (size_t)(m0 + r) * 1024 + c8) = ov;
            pa = qa; pb = qb; qa = ca; qb = cb;
        }
    }
}

DI void gates_phase(const bf16_t* XB, const u64* ssq_x, const float* Wg8, const float* bg, float* IG, float* LF, int gw, int NGW, int lane) {
    f32x4 wv[8][2][2];
#pragma unroll
    for (int j = 0; j < 8; ++j)
#pragma unroll
        for (int half = 0; half < 2; ++half) { const int k0 = half * 512 + lane * 8; wv[j][half][0] = *(const f32x4*)(Wg8 + j * 1024 + k0); wv[j][half][1] = *(const f32x4*)(Wg8 + j * 1024 + k0 + 4); }
    float bgv[8];
#pragma unroll
    for (int j = 0; j < 8; ++j) bgv[j] = bg[j];
    for (int m = gw; m < M; m += NGW) {
        float acc[8];
#pragma unroll
        for (int j = 0; j < 8; ++j) acc[j] = 0.f;
        const u32x4 xw0 = *(const u32x4*)(XB + (size_t)m * 1024 + lane * 8), xw1 = *(const u32x4*)(XB + (size_t)m * 1024 + 512 + lane * 8);
#pragma unroll
        for (int half = 0; half < 2; ++half) {
            f32x4 xa, xb2; unpk8(half ? xw1 : xw0, xa, xb2);
#pragma unroll
            for (int j = 0; j < 8; ++j) { const f32x4 wa = wv[j][half][0], wb = wv[j][half][1];
                acc[j] += (xa[0] * wa[0] + xa[1] * wa[1]) + (xa[2] * wa[2] + xa[3] * wa[3]) + (xb2[0] * wb[0] + xb2[1] * wb[1]) + (xb2[2] * wb[2] + xb2[3] * wb[3]); }
        }
        const float rs = ssq_rstd(ssq_x + m, 1.f / 1024.f);
#pragma unroll
        for (int j = 0; j < 8; ++j) acc[j] = wave_sum(acc[j]) * rs + bgv[j];
        if (lane == 0) {
            *(f32x4*)(IG + (size_t)m * 4) = (f32x4){acc[0], acc[1], acc[2], acc[3]};
            f32x4 lf;
#pragma unroll
            for (int j = 0; j < 4; ++j) { const float x = acc[4 + j]; lf[j] = fminf(x, 0.f) - log1pf(__expf(-fabsf(x))); }
            *(f32x4*)(LF + (size_t)m * 4) = lf;
        }
    }
}
DI void gw8_prep(const float* w_in, const float* g, float* Wg8, int gt, int NGT) {
    for (int i = gt; i < 8 * 1024; i += NGT) { const int j = i >> 10, k = i & 1023; Wg8[i] = w_in[(size_t)k * 8200 + 8192 + j] * g[k]; }
}

constexpr int SC_QSTR = 528, SC_VSTR = 136  , SC_VVSTR = 144  ;
constexpr int SC_QS = 0, SC_KS = 64 * SC_QSTR, SC_VS = 2 * 64 * SC_QSTR, SC_SP = SC_VS + 64 * SC_VVSTR, SC_QCX = SC_SP + 64 * SC_VSTR, SC_GT = SC_QCX + 16384, SC_VEC = SC_GT + 3 * 32 * 64 * 4 + 512, SC_OT = SC_VEC + (832 + 512) * 4;
constexpr int G_B = 0, G_CC = 2048, G_PM = 4096, G_SC = 6144;
constexpr int V_QNP = 0  , V_RS = 512  , V_WS = 768, V_WH = 832  ;
constexpr int SC_END = SC_OT + 64 * SC_VVSTR;
struct ScanT { const bf16_t *Q, *K, *VT; bf16_t* OG; const float *IG, *LF; };
DI float scan_add(float v, int lane) {
#pragma unroll
    for (int o = 1; o < 64; o <<= 1) { const float t = __shfl_up(v, o); if (lane >= o) v += t; }
    return v;
}
DI float scan_max(float v, int lane) {
#pragma unroll
    for (int o = 1; o < 64; o <<= 1) { const float t = __shfl_up(v, o); if (lane >= o) v = fmaxf(v, t); }
    return v;
}
DI void scan_item(LAS unsigned char* lds, const ScanT& T, int b, int h, int sl, int dry) {
    const int tid0 = tidx(), w = __builtin_amdgcn_readfirstlane(tid0 >> 6), g = w >> 2, c = w & 3;
    int tid = tid0, lane = tid & 63, l15 = lane & 15, q = lane >> 4;
    const int tok0 = b * S;
    LAS float* vec = (LAS float*)(lds + SC_VEC);
    LAS float* gt = (LAS float*)(lds + SC_GT);
    f32x4 Cacc[8];
#pragma unroll
    for (int i = 0; i < 8; ++i) Cacc[i] = (f32x4){0.f, 0.f, 0.f, 0.f};
    f32x4 nacc[2] = {(f32x4){0.f, 0.f, 0.f, 0.f}, (f32x4){0.f, 0.f, 0.f, 0.f}};
    u32x4 sQ[4], sK[4], sV;
    const int vd = tid >> 3, vch = tid & 7;
    const bf16_t* gQ = T.Q + (size_t)tok0 * 1024 + 256 * h;
    const bf16_t* gK = T.K + (size_t)tok0 * 1024 + 256 * h;
    const bf16_t* gV = T.VT + (size_t)(tok0 + vd) * 2048 + 512 * h + 64 * sl + 8 * vch;
#define SC_LOAD(ci) do { _Pragma("unroll") for (int i = 0; i < 4; ++i) { const int e = tid + i * NTHR, row = e >> 5, ch = e & 31; \
        sQ[i] = *(const u32x4*)(gQ + (size_t)((ci) * 64 + row) * 1024 + 8 * ch); sK[i] = *(const u32x4*)(gK + (size_t)((ci) * 64 + row) * 1024 + 8 * ch); } \
        sV = *(const u32x4*)(gV + (size_t)(ci) * 64 * 2048); } while (0)
    u32x4 sOG;
    bf16_t* gOG = T.OG + (size_t)(tok0 + vd) * 2048 + 512 * h + 64 * sl + 8 * vch;
#define SC_LOADOG(ci) do { sOG = *(const u32x4*)(gOG + (size_t)(ci) * 64 * 2048); } while (0)
    SC_LOAD(0); SC_LOADOG(0);
    {
        float lfv[4], igv[4];
#pragma unroll
        for (int k = 0; k < 4; ++k) { const size_t gi = (size_t)(tok0 + (w + 8 * k) * 64 + lane) * 4 + h; lfv[k] = T.LF[gi]; igv[k] = T.IG[gi]; }
#pragma unroll
        for (int k = 0; k < 4; ++k) {
            const int ck = w + 8 * k; const float bb = scan_add(lfv[k], lane), cc = igv[k] - bb, pm = scan_max(cc, lane);
            gt[G_B + ck * 64 + lane] = bb; gt[G_CC + ck * 64 + lane] = cc; gt[G_PM + ck * 64 + lane] = pm;
            if (lane == 63) { gt[G_SC + ck * 4 + 0] = bb; gt[G_SC + ck * 4 + 1] = pm; }
        }
        __syncthreads();
        if (tid == 0) { float m = 0.f;
#pragma unroll 1
            for (int ck = 0; ck < 32; ++ck) { const float bl = gt[G_SC + ck * 4], cm = gt[G_SC + ck * 4 + 1]; gt[G_SC + ck * 4 + 2] = m; m = fmaxf(bl + m, bl + cm); gt[G_SC + ck * 4 + 3] = m; } }
        __syncthreads();
    }
    for (int ci = 0; ci < S / 64; ++ci) {
        tid = tid0; asm volatile("" : "+v"(tid)); lane = tid & 63; l15 = lane & 15; q = lane >> 4;
#pragma unroll
        for (int i = 0; i < 4; ++i) { const int e = tid + i * NTHR, row = e >> 5, ch = e & 31; *(LAS u32x4*)(lds + SC_QS + row * SC_QSTR + 16 * ch) = sQ[i]; *(LAS u32x4*)(lds + SC_KS + row * SC_QSTR + 16 * ch) = sK[i]; }
        *(LAS u32x4*)(lds + SC_VS + vd * SC_VVSTR + 16 * vch) = sV;
        if (ci > 0 && !dry) *(u32x4*)(gOG + (size_t)(ci - 1) * 64 * 2048) = *(const LAS u32x4*)(lds + SC_OT + vd * SC_VVSTR + 16 * vch);
        *(LAS u32x4*)(lds + SC_OT + vd * SC_VVSTR + 16 * vch) = sOG;
        const f32x4 scal = *(const LAS f32x4*)(gt + G_SC + ci * 4);
        const float m_c = scal[2], blast = scal[0], mnew = scal[3];
        const LAS float* gB = gt + G_B + ci * 64; const LAS float* gC = gt + G_CC + ci * 64; const LAS float* gP = gt + G_PM + ci * 64;
        __syncthreads();
        if (ci + 1 < S / 64) SC_LOAD(ci + 1);
        {
            const int sb = w >> 1;
#pragma unroll
            for (int tt = 0; tt < 2; ++tt) {
                const int tb = 2 * (w & 1) + tt;
                const int t = 16 * tb + l15, s0 = 16 * sb + 4 * q;
                if (sb <= tb) {
                    f32x4 a4 = (f32x4){0.f, 0.f, 0.f, 0.f};
#pragma unroll
                    for (int ks = 0; ks < 8; ++ks) {
                        const bf16x8 ka = *(const LAS bf16x8*)(lds + SC_KS + (16 * sb + l15) * SC_QSTR + 64 * ks + 16 * q);
                        const bf16x8 qb2 = *(const LAS bf16x8*)(lds + SC_QS + (16 * tb + l15) * SC_QSTR + 64 * ks + 16 * q);
                        a4 = MFMA16(ka, qb2, a4);
                    }
                    const float a2 = -fmaxf(m_c, gP[t]) * LOG2E; const f32x4 c2 = *(const LAS f32x4*)(gC + s0);
                    float rsum = 0.f;
#pragma unroll
                    for (int r2 = 0; r2 < 4; ++r2) { const float wgt = (s0 + r2 <= t) ? ex2(a2 + c2[r2] * LOG2E) : 0.f; a4[r2] *= wgt; rsum += a4[r2]; }
                    u32x2 pw; pw.x = pk2(a4[0], a4[1]); pw.y = pk2(a4[2], a4[3]);
                    *(LAS u32x2*)(lds + SC_SP + t * SC_VSTR + s0 * 2) = pw;
                    rsum = red_fq(rsum); if (q == 0) vec[V_RS + 64 * sb + t] = rsum;
                } else {
                    *(LAS u32x2*)(lds + SC_SP + t * SC_VSTR + s0 * 2) = (u32x2){0u, 0u};
                    if (q == 0) vec[V_RS + 64 * sb + t] = 0.f;
                }
            }
        }
        f32x4 qc[4];
        {
            bf16x8 cf[4]; f32x4 qnp[4];
            u32x4 nw; nw.x = pk2(nacc[0][0], nacc[0][1]); nw.y = pk2(nacc[0][2], nacc[0][3]); nw.z = pk2(nacc[1][0], nacc[1][1]); nw.w = pk2(nacc[1][2], nacc[1][3]);
            const bf16x8 nf = __builtin_bit_cast(bf16x8, nw);
#pragma unroll
            for (int ks = 0; ks < 4; ++ks) { u32x4 cw; cw.x = pk2(Cacc[2 * ks][0], Cacc[2 * ks][1]); cw.y = pk2(Cacc[2 * ks][2], Cacc[2 * ks][3]); cw.z = pk2(Cacc[2 * ks + 1][0], Cacc[2 * ks + 1][1]); cw.w = pk2(Cacc[2 * ks + 1][2], Cacc[2 * ks + 1][3]); cf[ks] = __builtin_bit_cast(bf16x8, cw); }
#pragma unroll
            for (int tb = 0; tb < 4; ++tb) {
                qc[tb] = (f32x4){0.f, 0.f, 0.f, 0.f}; qnp[tb] = (f32x4){0.f, 0.f, 0.f, 0.f};
#pragma unroll
                for (int ks = 0; ks < 4; ++ks) {
                    const LAS unsigned char* qp = lds + SC_QS + (16 * tb + l15) * SC_QSTR + (128 * g + 32 * ks + 4 * q) * 2;
                    const bf16x8 qa = cat4(*(const LAS s16x4*)qp, *(const LAS s16x4*)(qp + 32));
                    qc[tb] = MFMA16(cf[ks], qa, qc[tb]);
                    if (ks == c) qnp[tb] = MFMA16(nf, qa, qnp[tb]);
                }
            }
            if (q == 0) {
#pragma unroll
                for (int tb = 0; tb < 4; ++tb) vec[V_QNP + w * 64 + 16 * tb + l15] = qnp[tb][0];
            }
            LAS f32x4* qx = (LAS f32x4*)(lds + SC_QCX) + (w * 2) * 64 + lane;
            qx[0] = g ? qc[0] : qc[2]; qx[64] = g ? qc[1] : qc[3];
        }
        if (tid < 64) vec[V_WS + tid] = __expf(blast + gC[tid] - mnew);
        __syncthreads();
        bf16x8 vf[2];
#pragma unroll
        for (int ks = 0; ks < 2; ++ks) { LAS unsigned char* vp = lds + SC_VS + (32 * ks + 8 * q + (l15 >> 2)) * SC_VVSTR + (16 * c + 4 * (lane & 3)) * 2;
            vf[ks] = cat4(__builtin_amdgcn_ds_read_tr16_b64_v4i16((LAS s16x4*)vp), __builtin_amdgcn_ds_read_tr16_b64_v4i16((LAS s16x4*)(vp + 4 * SC_VVSTR))); }
        {
            LAS float* wh = vec + V_WH + w * 64;
            if (lane < 32) {
                const int t = 32 * g + lane; float qn = 0.f, rs = 0.f;
#pragma unroll
                for (int k = 0; k < 8; ++k) qn += vec[V_QNP + 64 * k + t];
#pragma unroll
                for (int k = 0; k < 4; ++k) rs += vec[V_RS + 64 * k + t];
                const float mxv = fmaxf(m_c, gP[t]), wi = __expf(m_c - mxv), em = __expf(-gB[t] - mxv);
                wh[lane] = wi; wh[32 + lane] = __builtin_amdgcn_rcpf(fmaxf(fabsf(wi * qn + rs), em));
            }
            const LAS f32x4* px = (const LAS f32x4*)(lds + SC_QCX) + ((w ^ 4) * 2) * 64 + lane;
#define SC_FIN(tt, QCV) do { const int tb = 2 * g + (tt); \
                f32x4 sv = (f32x4){0.f, 0.f, 0.f, 0.f}; \
                _Pragma("unroll") for (int ks = 0; ks < 2; ++ks) { const LAS unsigned char* sp = lds + SC_SP + (16 * tb + l15) * SC_VSTR + 64 * ks + 16 * q; const bf16x8 sa = cat4(*(const LAS s16x4*)sp, *(const LAS s16x4*)(sp + 8)); sv = MFMA16(vf[ks], sa, sv); } \
                const f32x4 qct = (QCV) + px[64 * (tt)]; \
                const float wi = wh[16 * (tt) + l15], hi_ = wh[32 + 16 * (tt) + l15]; \
                LAS u32x2* op = (LAS u32x2*)(lds + SC_OT + (16 * tb + l15) * SC_VVSTR + (16 * c + 4 * q) * 2); const u32x2 ogw = *op; \
                u32x2 ow; ow.x = pk2((wi * qct[0] + sv[0]) * hi_ * bflo(ogw.x), (wi * qct[1] + sv[1]) * hi_ * bfhi(ogw.x)); ow.y = pk2((wi * qct[2] + sv[2]) * hi_ * bflo(ogw.y), (wi * qct[3] + sv[3]) * hi_ * bfhi(ogw.y)); \
                *op = ow; } while (0)
            if (g) { SC_FIN(0, qc[2]); SC_FIN(1, qc[3]); } else { SC_FIN(0, qc[0]); SC_FIN(1, qc[1]); }
#undef SC_FIN
        }
        if (ci + 1 < S / 64) SC_LOADOG(ci + 1);
        {
            const float decay = __expf(blast + m_c - mnew);
            bf16x8 vw[2], wsf[2];
#pragma unroll
            for (int ks = 0; ks < 2; ++ks) {
                const f32x4 w0 = *(const LAS f32x4*)(vec + V_WS + 32 * ks + 8 * q), w1 = *(const LAS f32x4*)(vec + V_WS + 32 * ks + 8 * q + 4);
                f32x4 x0, x1; unpk8(__builtin_bit_cast(u32x4, vf[ks]), x0, x1); vw[ks] = __builtin_bit_cast(bf16x8, pk8(x0 * w0, x1 * w1));
                const u32x4 wz = pk8(w0, w1); wsf[ks] = __builtin_bit_cast(bf16x8, l15 == 0 ? wz : (u32x4){0u, 0u, 0u, 0u});
            }
#pragma unroll
            for (int i = 0; i < 8; ++i) {
                if ((i & 1) == 0) __builtin_amdgcn_sched_barrier(0);
                Cacc[i] *= decay;
#pragma unroll
                for (int ks = 0; ks < 2; ++ks) {
                    LAS unsigned char* kp = lds + SC_KS + (32 * ks + 8 * q + (l15 >> 2)) * SC_QSTR + (128 * g + 16 * i + 4 * (lane & 3)) * 2;
                    const s16x4 lo = __builtin_amdgcn_ds_read_tr16_b64_v4i16((LAS s16x4*)kp), hi = __builtin_amdgcn_ds_read_tr16_b64_v4i16((LAS s16x4*)(kp + 4 * SC_QSTR));
                    Cacc[i] = MFMA16(cat4(lo, hi), vw[ks], Cacc[i]);
                }
            }
#pragma unroll
            for (int ib = 0; ib < 2; ++ib) {
                nacc[ib] *= decay;
#pragma unroll
                for (int ks = 0; ks < 2; ++ks) {
                    LAS unsigned char* kp = lds + SC_KS + (32 * ks + 8 * q + (l15 >> 2)) * SC_QSTR + (128 * g + 16 * (2 * c + ib) + 4 * (lane & 3)) * 2;
                    const s16x4 lo = __builtin_amdgcn_ds_read_tr16_b64_v4i16((LAS s16x4*)kp), hi = __builtin_amdgcn_ds_read_tr16_b64_v4i16((LAS s16x4*)(kp + 4 * SC_QSTR));
                    nacc[ib] = MFMA16(cat4(lo, hi), wsf[ks], nacc[ib]);
                }
            }
        }
        __syncthreads();
    }
    if (!dry) *(u32x4*)(gOG + (size_t)(S / 64 - 1) * 64 * 2048) = *(const LAS u32x4*)(lds + SC_OT + vd * SC_VVSTR + 16 * vch);
    __syncthreads();
#undef SC_LOAD
#undef SC_LOADOG
}
DI void scan_phase(LAS unsigned char* lds, const ScanT& T, int cu, int dry) {
    const int xcd = cu & 7, idx = cu >> 3, bh = xcd * 4 + (idx >> 3), sl = idx & 7;
    scan_item(lds, T, bh >> 2, bh & 3, sl, dry);
}

DI void final_phase(const bf16_t* xb, float* out, const u64* ssq, const float* g, int gw, int NGW, int lane) {
    for (int m = gw; m < M; m += NGW) {
        const float rs = ssq_rstd(ssq + m, 1.f / 1024.f);
#pragma unroll
        for (int j = 0; j < 2; ++j) {
            const int c0 = (lane + 64 * j) * 8; f32x4 a, b; unpk8(*(const u32x4*)(xb + (size_t)m * D + c0), a, b);
            *(f32x4*)(out + (size_t)m * D + c0) = a * rs * *(const f32x4*)(g + c0); *(f32x4*)(out + (size_t)m * D + c0 + 4) = b * rs * *(const f32x4*)(g + c0 + 4);
        }
    }
}
constexpr int LDS_BYTES = 147456, MISC_OFF = 146944;
static_assert(SC_END <= MISC_OFF && 2 * AT_KB + 2 * AT_VB <= MISC_OFF, "LDS map");
constexpr int PH_PER_LAYER = 6, PH_FINAL = 1 + 4 * PH_PER_LAYER, PH_REFRESH = 100;
#ifndef GEMM_ALIGN
#define GEMM_ALIGN true
#endif
#ifndef GEMM_SP2
#define GEMM_SP2 true
#endif
#ifndef C1_DRYMODE
#define C1_DRYMODE 1
#endif
#ifndef BAR_TWICE
#define BAR_TWICE 0
#endif
#ifndef STAGGER
#define STAGGER 0
#endif
#define STAGGER_SLEEP() do { if (STAGGER) { for (int s_ = 0; s_ < (int)(((cu >> 3) & 3) * STAGGER); ++s_) __builtin_amdgcn_s_sleep(32); } } while (0)
#ifndef PP_HOLES
#define PP_HOLES 0
#endif
#ifndef PHM
#define PHM 0xFFFF
#endif
#define PH_ON(b) ((PHM >> (b)) & 1)
#ifndef REPEAT
#define REPEAT 0
#endif
#ifndef REPEAT_AFTER
#define REPEAT_AFTER 0
#endif
#if REPEAT_AFTER
#define REP_LOOP(b) for (int rep_ = 0, nrep_ = opaque((REPEAT >> (b)) & 1); rep_ <= nrep_; ++rep_)
#else
#define REP_LOOP(b) for (int rep_ = opaque((REPEAT >> (b)) & 1); rep_ >= 0; --rep_)
#endif
typedef const __attribute__((address_space(4))) Args* KArgs;
DI KArgs kargs() { KArgs p = (KArgs)__builtin_amdgcn_kernarg_segment_ptr(); asm volatile("" : "+s"(p)); return p; }

#define TID_DEFS const int tid = tidx(), w = __builtin_amdgcn_readfirstlane(tid >> 6), lane = tid & 63; (void)w; (void)lane
DI void prep_mixer(LAS unsigned char* lds, int i, int cu, int G) {
    TID_DEFS; KArgs A = kargs(); unsigned char* ws = A->ws; LAS float* scr = (LAS float*)lds;
    const int kind = i % 3, j = i / 3;
    const float* normg = A->in[I_NORMG] + (size_t)i * D; bf16_t* wmix = (bf16_t*)(ws + WS_WMIX);
    if (kind == 0) {
        constexpr int n0 = 28 * 8, n1 = 24 * 3, n2 = 32 * 2, n3 = 16 * 8;
#pragma unroll 1
        for (int it = cu; it < n0 + n1 + n2 + n3; it += G) {
            if (it < n0) prep_tile(PrepTask{A->in[I_MLA_WIN] + (size_t)j * D * 1696, 1696, normg, D, 1792, PM_MLA_IN, wmix}, it, scr);
            else if (it < n0 + n1) prep_tile(PrepTask{A->in[I_MLA_WQB] + (size_t)j * 384 * 1536, 1536, A->in[I_MLA_QN] + j * 384, 384, 1536, PM_MLA_QB, (bf16_t*)(ws + WS_WMIX + WM_QB)}, it - n0, scr);
            else if (it < n0 + n1 + n2) prep_tile(PrepTask{A->in[I_MLA_WKVB] + (size_t)j * 256 * 2048, 2048, A->in[I_MLA_KVN] + j * 256, 256, 2048, PM_MLA_KVB, (bf16_t*)(ws + WS_WMIX + WM_KVB)}, it - n0 - n1, scr);
            else prep_tile(PrepTask{A->in[I_MLA_WOUT] + (size_t)j * D * D, D, nullptr, D, D, PM_ID, (bf16_t*)(ws + WS_WMIX + WM_OUT_MLA)}, it - n0 - n1 - n2, scr);
        }
    } else if (kind == 1) {
        constexpr int n0 = 64 * 8, n1 = 16 * 8;
#pragma unroll 1
        for (int it = cu; it < n0 + n1; it += G) {
            if (it < n0) prep_tile(PrepTask{A->in[I_CONV_WIN] + (size_t)j * D * 4096, 4096, normg, D, 4096, PM_CONV_IN, wmix}, it, scr);
            else prep_tile(PrepTask{A->in[I_CONV_WOUT] + (size_t)j * D * D, D, nullptr, D, D, PM_ID, (bf16_t*)(ws + WS_WMIX + WM_OUT_CONV)}, it - n0, scr);
        }
    } else {
        constexpr int n0 = 128 * 8, n1 = 16 * 16;
#pragma unroll 1
        for (int it = cu; it < n0 + n1; it += G) {
            if (it < n0) prep_tile(PrepTask{A->in[I_L_WIN] + (size_t)j * D * 8200, 8200, normg, D, 8192, PM_LSTM_IN, wmix}, it, scr);
            else prep_tile(PrepTask{A->in[I_L_WOUT] + (size_t)j * 2048 * D, D, nullptr, 2048, D, PM_ID, (bf16_t*)(ws + WS_WMIX + WM_OUT_LSTM)}, it - n0, scr);
        }
        gw8_prep(A->in[I_L_WIN] + (size_t)j * D * 8200, normg, (float*)(ws + WS_GW8), cu * NTHR + tid, G * NTHR);
    }
    if (kind != 2) p_to_bf16(A->in[I_P] + (size_t)i * M * 256, (bf16_t*)(ws + WS_BIG + A_PB), cu * NTHR + tid, G * NTHR);
#pragma unroll 1
    for (int it = cu; it < 16 * 2; it += G) prep_tile(PrepTask{A->in[I_PLE_PROJ] + (size_t)i * 256 * D, D, nullptr, 256, D, PM_ID, (bf16_t*)(ws + WS_WPLE + 2 * MiB)}, it, scr);
}
DI void prep_ple(LAS unsigned char* lds, int i, int cu, int G) {
    KArgs A = kargs(); unsigned char* ws = A->ws; LAS float* scr = (LAS float*)lds;
#pragma unroll 1
    for (int it = cu; it < 16 * 8; it += G) prep_tile(PrepTask{A->in[I_PLE_GATE] + (size_t)i * D * D, D, nullptr, D, D, PM_ID, (bf16_t*)(ws + WS_WPLE)}, it, scr);
}

__global__ void __launch_bounds__(NTHR, 2) fwd(Args a_) {
    extern __shared__ __attribute__((aligned(16))) unsigned char lds_[];
    LAS unsigned char* lds = (LAS unsigned char*)lds_;
    const int cu = blockIdx.x, G = gridDim.x;
#define GW (cu * 8 + w)
#define NGW (G * 8)
#define GT (cu * NTHR + tid)
#define NGT (G * NTHR)
    const int lo = a_.ph_lo, hi = a_.ph_hi;
    volatile LAS unsigned* misc = (volatile LAS unsigned*)(lds + MISC_OFF);
    { TID_DEFS; if (tid < 32) misc[tid] = 0u; }
    __syncthreads();
    const bool multi = (hi - lo) > 1;
    XcdBarrier bar; bar.bar = nullptr; bar.x = 0; bar.st = misc + 8;
    if (multi) bar = xcd_barrier_post((unsigned*)(kargs()->ws + WS_CTL), misc + 8);
#define IN(k) (lo <= (k) && (k) < hi)
#ifdef TIMELINE
#define STAMP(idx) do { if (blockIdx.x == 0 && threadIdx.x == 0) ((unsigned long long*)(kargs()->ws + WS_CTL + 32 * KiB))[(idx)] = __builtin_amdgcn_s_memrealtime(); } while (0)
#else
#define STAMP(idx) do { } while (0)
#endif
#define SEAM(k) do { if (multi && (k) + 1 < hi) { XcdBarrier b2 = bar; b2.bar = (unsigned*)(kargs()->ws + WS_CTL); xcd_barrier(b2); if (BAR_TWICE) xcd_barrier(b2); } STAMP((k) + 1); } while (0)

    STAMP(0);
    if (lo >= PH_REFRESH) {
        TID_DEFS; KArgs A = kargs(); const int i = lo - PH_REFRESH; rows_to_bf16_ssq(A->out, (bf16_t*)(A->ws + WS_XBA), ssq_arr(A->ws, SSQ_X + i), GW, NGW, lane); return;
    }
    if (IN(0)) {
        REP_LOOP(11) { TID_DEFS; KArgs A = kargs(); unsigned char* ws = A->ws; rows_to_bf16_ssq(A->in[I_X], (bf16_t*)(ws + WS_XBA), ssq_arr(ws, SSQ_X), GW, NGW, lane); }
        REP_LOOP(12) { TID_DEFS; KArgs A = kargs(); unsigned char* ws = A->ws; rope_tables((const int*)A->in[I_POS], (float*)(ws + WS_CS), (float*)(ws + WS_SN), GT, NGT); }
        REP_LOOP(13) prep_mixer(lds, 0, cu, G);
    }
    if (IN(0)) SEAM(0);
#pragma unroll 1
    for (int i = 0; i < 4; ++i) {
        const int kind = i % 3, j = i / 3, base = 1 + PH_PER_LAYER * i;
        if (hi <= base || lo >= base + PH_PER_LAYER) continue;
        if (IN(base + 1)) {
            REP_LOOP(0) prep_ple(lds, i, cu, G);
            if (kind == 0 && PH_ON(1)) {
                unsigned char* ws = kargs()->ws;
                pg8::Gemm g{(bf16_t*)(ws + WS_XBA), (bf16_t*)(ws + WS_WMIX), M, 1792, opaque(D)}; pg8::StaticOrder So; So.init(M, 1792, G, cu);
                EpiA1 E{ws, i, j}; STAGGER_SLEEP();
                pg8::gemm_phase<EpiA1, pg8::StaticOrder, GEMM_ALIGN, GEMM_SP2>(lds, g, So, E);
                if (PP_HOLES && G == 256 && cu >= 192) {
                    KArgs A2 = kargs(); unsigned char* ws2 = A2->ws;
                    pg8::Gemm g2{(bf16_t*)(ws2 + WS_BIG + A_PB), (bf16_t*)(ws2 + WS_WPLE + 2 * MiB), M, D, opaque(256)}; pg8::StaticOrder So2; So2.init(M, D, 64, cu - 192);
                    EpiPP E2{(bf16_t*)A2->out};
                    pg8::gemm_phase<EpiPP, pg8::StaticOrder, GEMM_ALIGN, GEMM_SP2>(lds, g2, So2, E2);
                }
            } else if (kind == 1 && PH_ON(2)) REP_LOOP(2) {
                unsigned char* ws = kargs()->ws;
                pg8::Gemm g{(bf16_t*)(ws + WS_XBA), (bf16_t*)(ws + WS_WMIX), M, 4096, opaque(D)}; pg8::StaticOrder So; So.init(M, 4096, G, cu);
                EpiC1 E{ws, i, rep_ * C1_DRYMODE}; STAGGER_SLEEP();
                pg8::gemm_phase<EpiC1, pg8::StaticOrder, GEMM_ALIGN, GEMM_SP2>(lds, g, So, E);
            } else if (kind == 2 && PH_ON(3)) REP_LOOP(3) {
                { TID_DEFS; KArgs A = kargs(); unsigned char* ws = A->ws;
                  gates_phase((bf16_t*)(ws + WS_XBA), ssq_arr(ws, SSQ_X + i), (const float*)(ws + WS_GW8), A->in[I_L_BG] + j * 8, (float*)(ws + WS_IG), (float*)(ws + WS_LF), GW, NGW, lane); }
                unsigned char* ws = kargs()->ws;
                pg8::Gemm g{(bf16_t*)(ws + WS_XBA), (bf16_t*)(ws + WS_WMIX), M, 8192, opaque(D)}; pg8::StaticOrder So; So.init(M, 8192, G, cu);
                EpiL1 E{ws, i}; STAGGER_SLEEP();
                pg8::gemm_phase<EpiL1, pg8::StaticOrder, GEMM_ALIGN, GEMM_SP2>(lds, g, So, E);
            }
            SEAM(base + 1);
        }
        if (IN(base + 2) && kind != 2) {
            if (kind == 0 && PH_ON(4)) REP_LOOP(4) {
                { unsigned char* ws = kargs()->ws;
                  pg8::Gemm g{(bf16_t*)(ws + WS_BIG + A_CQ), (bf16_t*)(ws + WS_WMIX + WM_QB), M, 1536, opaque(384)}; pg8::StaticOrder So; So.init(M, 1536, G, cu);
                  EpiQ E{ws, j};
                  pg8::gemm_phase<EpiQ, pg8::StaticOrder, GEMM_ALIGN, GEMM_SP2>(lds, g, So, E); }
                { unsigned char* ws = kargs()->ws;
                  pg8::Gemm g{(bf16_t*)(ws + WS_BIG + A_CKV), (bf16_t*)(ws + WS_WMIX + WM_KVB), M, 2048, opaque(256)}; pg8::StaticOrder So; So.init(M, 2048, G, G - 1 - cu);
                  EpiKV E{ws, j};
                  pg8::gemm_phase<EpiKV, pg8::StaticOrder, GEMM_ALIGN, GEMM_SP2>(lds, g, So, E); }
            } else if (kind == 1 && PH_ON(5)) REP_LOOP(5) {
                TID_DEFS; KArgs A = kargs(); unsigned char* ws = A->ws;
                conv_phase((const bf16_t*)(ws + WS_BIG + C_CH), (bf16_t*)(ws + WS_BIG + C_BZ), A->in[I_CONV_W] + (size_t)j * 3 * 1024, GT, NGT, rep_);
            }
            SEAM(base + 2);
        }
        if (IN(base + 3) && kind != 1) {
            if (kind == 0 && PH_ON(6)) REP_LOOP(6) {
                unsigned char* big = kargs()->ws + WS_BIG;
                AttnT T{(bf16_t*)(big + A_Q), (bf16_t*)(big + A_KN), (bf16_t*)(big + A_KR), (bf16_t*)(big + A_VT), (bf16_t*)(big + A_SZ)};
                attn_phase(lds, T, cu, rep_);
            } else if (kind == 2 && PH_ON(7)) {
                { unsigned char* ws = kargs()->ws; unsigned char* big = ws + WS_BIG;
                  ScanT T{(bf16_t*)(big + L_Q), (bf16_t*)(big + L_K), (bf16_t*)(big + L_VT), (bf16_t*)(big + L_OG), (float*)(ws + WS_IG), (float*)(ws + WS_LF)};
                  REP_LOOP(7) scan_phase(lds, T, cu, rep_); }
                TID_DEFS; KArgs A = kargs();
                p_to_bf16(A->in[I_P] + (size_t)i * M * 256, (bf16_t*)A->out, GT, NGT);
            }
            SEAM(base + 3);
        }
        if (IN(base + 4)) {
            const size_t xbb_off = kind == 0 ? A_XBB : kind == 1 ? C_XBB : L_XBB, pp_off = kind == 0 ? A_PP : kind == 1 ? C_PP : L_PP;
            if (PH_ON(8)) { KArgs A = kargs(); unsigned char* ws = A->ws;
              const size_t oin = kind == 0 ? A_SZ : kind == 1 ? C_BZ : L_OG, wout = kind == 2 ? WM_OUT_LSTM : WM_OUT_MLA;
              pg8::Gemm g{(bf16_t*)(ws + WS_BIG + oin), (bf16_t*)(ws + WS_WMIX + wout), M, D, opaque(kind == 2 ? 2048 : 1024)}; pg8::StaticOrder So; So.init(M, D, G, cu);
              EpiOut E{ws, xbb_off, i};
              pg8::gemm_phase<EpiOut, pg8::StaticOrder, GEMM_ALIGN, GEMM_SP2>(lds, g, So, E); }
            if (PH_ON(9) && !(PP_HOLES && kind == 0 && G == 256)) REP_LOOP(9) { KArgs A = kargs(); unsigned char* ws = A->ws;
              pg8::Gemm g{kind == 2 ? (bf16_t*)A->out : (bf16_t*)(ws + WS_BIG + A_PB), (bf16_t*)(ws + WS_WPLE + 2 * MiB), M, D, opaque(256)}; pg8::StaticOrder So; So.init(M, D, G, cu);
              EpiPP E{(bf16_t*)(ws + WS_BIG + pp_off)};
              pg8::gemm_phase<EpiPP, pg8::StaticOrder, GEMM_ALIGN, GEMM_SP2>(lds, g, So, E); }
            SEAM(base + 4);
        }
        if (IN(base + 5)) {
            if (PH_ON(10)) { KArgs A = kargs(); unsigned char* ws = A->ws;
              const size_t xbb_off = kind == 0 ? A_XBB : kind == 1 ? C_XBB : L_XBB, pp_off = kind == 0 ? A_PP : kind == 1 ? C_PP : L_PP;
              const bf16_t* ppp = (PP_HOLES && kind == 0 && G == 256) ? (const bf16_t*)A->out : (const bf16_t*)(ws + WS_BIG + pp_off);
              pg8::Gemm g{(bf16_t*)(ws + WS_BIG + xbb_off), (bf16_t*)(ws + WS_WPLE), M, D, opaque(D)}; pg8::StaticOrder So; So.init(M, D, G, cu);
              if (i == 3 && multi && G == 256 && hi > PH_FINAL) {
                  EpiPleLast E{ws, A->out, A->in[I_FNORM], ppp, xbb_off, i, bar.x, bar.st};
                  pg8::gemm_phase<EpiPleLast, pg8::StaticOrder, false, GEMM_SP2>(lds, g, So, E);
              } else {
                  EpiPle E{ws, ppp, xbb_off, i};
                  pg8::gemm_phase<EpiPle, pg8::StaticOrder, GEMM_ALIGN, GEMM_SP2>(lds, g, So, E); } }
            if (i < 3) REP_LOOP(1) prep_mixer(lds, i + 1, cu, G);
            if (!(i == 3 && multi && G == 256 && hi > PH_FINAL)) SEAM(base + 5);
        }
    }
    if (IN(PH_FINAL) && !(multi && G == 256 && lo <= PH_FINAL - 1)) { TID_DEFS; KArgs A = kargs(); final_phase((const bf16_t*)(A->ws + WS_XBA), A->out, ssq_arr(A->ws, SSQ_X + 4), A->in[I_FNORM], GW, NGW, lane); }
#ifdef TIMELINE
    {
        SEAM(PH_FINAL);
        TID_DEFS; KArgs A = kargs(); const unsigned long long* ts = (const unsigned long long*)(A->ws + WS_CTL + 32 * KiB);
        const float dA = (float)(ts[TS_A1] - ts[TS_A0]) * 0.01f, dB = (float)(ts[TS_B1] - ts[TS_B0]) * 0.01f;
        const float c = sqrtf(dA);
        for (size_t e = GT; e < (size_t)M * D; e += NGT) A->out[e] = (e == 0) ? 60.f + dB : c;
    }
#endif
#undef IN
#undef SEAM
}
}
#ifndef FAST_LAYERS
#define FAST_LAYERS 15
#endif
#ifndef ONE_LAUNCH
#define ONE_LAUNCH 1
#endif

extern "C" void kernel_launch(void* const* d_in, const int* in_sizes, int n_in, void* d_out, int out_size, void* d_ws, size_t ws_size, hipStream_t stream) {
    static int grid = 0;
    if (grid == 0) {
        int dev = 0, cus = 0;
        if (n_in != 19 || ws_size < fk::WS_END || out_size != fk::M * fk::D) { fprintf(stderr, "kernel_launch: unexpected shapes (n_in %d, ws %zu, out %d)\n", n_in, ws_size, out_size); grid = -1; return; }
        if (hipGetDevice(&dev) != hipSuccess || hipDeviceGetAttribute(&cus, hipDeviceAttributeMultiprocessorCount, dev) != hipSuccess) { grid = -1; return; }
        if (hipFuncSetAttribute((const void*)fk::fwd, hipFuncAttributeMaxDynamicSharedMemorySize, fk::LDS_BYTES) != hipSuccess) { fprintf(stderr, "kernel_launch: hipFuncSetAttribute failed\n"); grid = -1; return; }
        int per_cu = 0;
        if (hipOccupancyMaxActiveBlocksPerMultiprocessor(&per_cu, (const void*)fk::fwd, fk::NTHR, fk::LDS_BYTES) != hipSuccess || per_cu < 1) { fprintf(stderr, "kernel_launch: occupancy query says %d\n", per_cu); }
        (void)hipGetLastError();
        grid = cus;
        if (grid != 256) fprintf(stderr, "kernel_launch: %d CUs (built for 256)\n", grid);
    }
    if (grid < 0) return;
    (void)hipMemsetAsync(d_ws, 0, fk::ZERO_BYTES, stream);
    fk::Args a{};
    for (int i = 0; i < 19; ++i) a.in[i] = (const float*)d_in[i];
    a.out = (float*)d_out; a.ws = (unsigned char*)d_ws;
#define LAUNCH(lo_, hi_) do { a.ph_lo = (lo_); a.ph_hi = (hi_); hipLaunchKernelGGL(fk::fwd, dim3(grid), dim3(fk::NTHR), fk::LDS_BYTES, stream, a); } while (0)
#if ONE_LAUNCH && (FAST_LAYERS == 15)
#ifdef TIMELINE
    LAUNCH(0, fk::PH_FINAL + 2);
#else
    LAUNCH(0, fk::PH_FINAL + 1);
#endif
#else
    nv::In in;
    in.x = (const float*)d_in[0]; in.p = (const float*)d_in[1]; in.pos = (const int*)d_in[2]; in.norm_g = (const float*)d_in[3];
    in.mla_w_in = (const float*)d_in[4]; in.mla_q_norm = (const float*)d_in[5]; in.mla_w_q_b = (const float*)d_in[6];
    in.mla_kv_norm = (const float*)d_in[7]; in.mla_w_kv_b = (const float*)d_in[8]; in.mla_w_out = (const float*)d_in[9];
    in.conv_w_in = (const float*)d_in[10]; in.conv_w = (const float*)d_in[11]; in.conv_w_out = (const float*)d_in[12];
    in.mlstm_w_in = (const float*)d_in[13]; in.mlstm_b_gates = (const float*)d_in[14]; in.mlstm_w_out = (const float*)d_in[15];
    in.ple_proj = (const float*)d_in[16]; in.ple_gate = (const float*)d_in[17]; in.final_norm = (const float*)d_in[18];
    float* nws = (float*)((char*)d_ws + 2 * fk::MiB);
    LAUNCH(0, 1);
    for (int i = 0; i < 4; ++i) {
        if ((FAST_LAYERS >> i) & 1) {
            if (i > 0 && !((FAST_LAYERS >> (i - 1)) & 1)) LAUNCH(fk::PH_REFRESH + i, fk::PH_REFRESH + i + 1);
            for (int s = 0; s < fk::PH_PER_LAYER; ++s) LAUNCH(1 + fk::PH_PER_LAYER * i + s, 1 + fk::PH_PER_LAYER * i + s + 1);
        } else {
            nv::layer(in, (float*)d_out, nws, stream, i, i == 0);
        }
    }
    if ((FAST_LAYERS >> 3) & 1) LAUNCH(fk::PH_FINAL, fk::PH_FINAL + 1);
    else nv::final_norm(in, (float*)d_out, stream);
#endif
#undef LAUNCH
}
```

```cpp
#include <hip/hip_runtime.h>
#include <cstdio>
#include <cstdint>
#include <math.h>
#define LAS __attribute__((address_space(3)))
#define GAS __attribute__((address_space(1)))
#define FAST_LAYERS 15
#define ONE_LAUNCH 1
namespace pg8 {
#define PG8_LAS __attribute__((address_space(3)))
typedef unsigned short bf16_t;
typedef short bf16x8 __attribute__((ext_vector_type(8)));
typedef float f32x4 __attribute__((ext_vector_type(4)));
typedef unsigned u32x4 __attribute__((ext_vector_type(4)));
constexpr int BM = 256, BK = 64, HALF = 128, HTB = HALF * BK * 2  , STAGE_BYTES = 8 * HTB, NXCD = 8, WGM = 8;

__host__ __device__ __forceinline__ int lds_byte(int r, int c) { const int st = (r >> 4) * 2 + (c >> 5), rr = r & 15, cc = c & 31, ob = rr * 64 + cc * 2; return st * 1024 + (ob ^ (((ob >> 9) & 1) << 5)); }
__host__ __device__ __forceinline__ void stage_rc(int b, int& R, int& C) { const int st = b / 1024, sb = b % 1024, swz = sb ^ (((sb >> 9) & 1) << 5); R = (st >> 1) * 16 + swz / 64; C = (st & 1) * 32 + (swz % 64) / 2; }
__host__ __device__ __forceinline__ int perm32(int rho) { const int n = rho >> 4, i = rho & 15; return 8 * (i >> 2) + 4 * n + (i & 3); }

struct Unit { int pm, pn; };
struct Gemm { const bf16_t* A; const bf16_t* Bt; int M, N, K; };

struct StaticOrder {
    int nM, nN, nwg, G, c;
    __host__ __device__ void init(int M, int N, int G_, int c_) { nM = M / BM; nN = N / BM; nwg = nM * nN; G = G_; c = c_; }
    __host__ __device__ bool next(int i, Unit& u) const {
        const long L = (long)i * G + c; if (L >= nwg) return false;
        int wgid = (int)L; { const int q = nwg / NXCD, r = nwg % NXCD, xcd = wgid % NXCD, off = wgid / NXCD; wgid = (xcd < r ? xcd * (q + 1) : r * (q + 1) + (xcd - r) * q) + off; }
        const int nig = WGM * nN, gid = wgid / nig, fm = gid * WGM, gsz = (nM - fm) < WGM ? (nM - fm) : WGM;
        u.pm = fm + ((wgid % nig) % gsz); u.pn = (wgid % nig) / gsz; return true;
    }
    __device__ __forceinline__ void a_ready(const Unit&) const {}
    __device__ __forceinline__ void done(const Unit&) const {}
};

template <class Epi, class Sched, bool ALIGN_EPI = false, bool SP2 = false>
__device__ __forceinline__ void gemm_phase(PG8_LAS unsigned char* lds, const Gemm g, const Sched& S, const Epi& E) {
    int tid_ = threadIdx.x; asm volatile("" : "+v"(tid_));
    const int tid = tid_, wid = __builtin_amdgcn_readfirstlane(tid >> 6), lane = tid & 63, wr = wid >> 2, wc = wid & 3, fr = lane & 15, fq = lane >> 4;
    const int K = g.K, nt = K / BK;
    unsigned voffA[2], voffB[2];
#pragma unroll
    for (int i = 0; i < 2; ++i) { int R, C; stage_rc(tid * 16 + i * 8192, R, C); const int Rb = Epi::PERM ? ((R & ~31) + perm32(R & 31)) : R;
        voffA[i] = (unsigned)(R * K + C) * 2u; voffB[i] = (unsigned)(Rb * K + C) * 2u; }
    const size_t kstep = (size_t)(BK * 2);
    const size_t hstep = (size_t)HALF * K * 2;
    const size_t tstep = 2 * hstep;
    const unsigned ldsw = (unsigned)wid * 1024u;
    const int aoff = lds_byte(wr * 64 + fr, fq * 8), boff = lds_byte(wc * 32 + fr, fq * 8);
#define PG8_SA(b, h) (((b) * 2 + (h)) * HTB)
#define PG8_SB(b, h) ((4 + (b) * 2 + (h)) * HTB)
#define PG8_STAGE(bufoff, gbase, voff) do { _Pragma("unroll") for (int _i = 0; _i < 2; ++_i) \
        __builtin_amdgcn_global_load_lds((const unsigned*)((const char*)(gbase) + (voff)[_i]), (PG8_LAS unsigned*)(lds + (bufoff) + ldsw + _i * 8192), 16, 0, 0); } while (0)
#define PG8_LDA(dst, b, h) do { _Pragma("unroll") for (int m = 0; m < 4; ++m) _Pragma("unroll") for (int k = 0; k < 2; ++k) dst[m][k] = *(const PG8_LAS bf16x8*)(lds + PG8_SA(b, h) + aoff + m * 2048 + k * 1024); } while (0)
#define PG8_LDB(dst, b, h) do { _Pragma("unroll") for (int n = 0; n < 2; ++n) _Pragma("unroll") for (int k = 0; k < 2; ++k) dst[n][k] = *(const PG8_LAS bf16x8*)(lds + PG8_SB(b, h) + boff + n * 2048 + k * 1024); } while (0)
#define PG8_MMA(ai, bj, At, Bt) do { __builtin_amdgcn_s_setprio(1); _Pragma("unroll") for (int m = 0; m < 4; ++m) _Pragma("unroll") for (int n = 0; n < 2; ++n) _Pragma("unroll") for (int k = 0; k < 2; ++k) \
        acc[ai][bj][m][n] = __builtin_amdgcn_mfma_f32_16x16x32_bf16(Bt[n][k], At[m][k], acc[ai][bj][m][n], 0, 0, 0); __builtin_amdgcn_s_setprio(0); } while (0)
#define PG8_WAIT_V(n) asm volatile("s_waitcnt vmcnt(" #n ")" ::: "memory")
#define PG8_WAIT_L(n) asm volatile("s_waitcnt lgkmcnt(" #n ")" ::: "memory")
#define PG8_BAR __builtin_amdgcn_s_barrier()
#define PG8_SCHED __builtin_amdgcn_sched_barrier(0)
    Unit cur, nxt; int ui = 0;
    if (!S.next(0, cur)) return;
    f32x4 acc[2][2][4][2];
#pragma unroll
    for (int a = 0; a < 2; ++a)
#pragma unroll
        for (int b = 0; b < 2; ++b)
#pragma unroll
            for (int m = 0; m < 4; ++m)
#pragma unroll
                for (int n = 0; n < 2; ++n) acc[a][b][m][n] = (f32x4){0.f, 0.f, 0.f, 0.f};
    bf16x8 At[4][2], B0[2][2], B1[2][2];
    const char* cA = (const char*)g.A + (size_t)cur.pm * tstep; const char* cB = (const char*)g.Bt + (size_t)cur.pn * tstep;
    S.a_ready(cur);
    if constexpr (SP2) {
        PG8_STAGE(PG8_SB(0, 0), cB, voffB); PG8_STAGE(PG8_SB(0, 1), cB + hstep, voffB); PG8_STAGE(PG8_SA(0, 0), cA, voffA); PG8_STAGE(PG8_SA(0, 1), cA + hstep, voffA);
        if (wr == 1) PG8_BAR;
        PG8_WAIT_V(2); PG8_BAR;
        PG8_STAGE(PG8_SB(1, 0), cB + kstep, voffB); PG8_STAGE(PG8_SA(1, 0), cA + kstep, voffA); PG8_STAGE(PG8_SB(1, 1), cB + hstep + kstep, voffB);
        PG8_WAIT_V(6); PG8_BAR;
    } else {
        PG8_STAGE(PG8_SB(0, 0), cB, voffB); PG8_STAGE(PG8_SA(0, 0), cA, voffA); PG8_STAGE(PG8_SB(0, 1), cB + hstep, voffB); PG8_STAGE(PG8_SA(0, 1), cA + hstep, voffA);
        if (wr == 1) PG8_BAR;
        PG8_WAIT_V(4); PG8_BAR;
        PG8_STAGE(PG8_SB(1, 0), cB + kstep, voffB); PG8_STAGE(PG8_SA(1, 0), cA + kstep, voffA); PG8_STAGE(PG8_SB(1, 1), cB + hstep + kstep, voffB);
        PG8_WAIT_V(6); PG8_BAR;
    }
    for (;;) {
        const bool has_next = S.next(ui + 1, nxt);
        const char* nA = has_next ? (const char*)g.A + (size_t)nxt.pm * tstep : cA; const char* nB = has_next ? (const char*)g.Bt + (size_t)nxt.pn * tstep : cB;
        for (int t = 0; t < nt; t += 2) {
            const bool last = (t == nt - 2);
            const char* a1 = cA + (size_t)(t + 1) * kstep;
            const char* a2 = last ? nA : cA + (size_t)(t + 2) * kstep; const char* b2 = last ? nB : cB + (size_t)(t + 2) * kstep;
            const char* a3 = a2 + kstep; const char* b3 = b2 + kstep;
            if (last && has_next) S.a_ready(nxt);
            if constexpr (SP2) {
            PG8_LDB(B0, 0, 0); PG8_LDB(B1, 0, 1); PG8_SCHED; PG8_LDA(At, 0, 0); PG8_STAGE(PG8_SA(1, 1), a1 + hstep, voffA);
            PG8_WAIT_V(8); PG8_WAIT_L(0); PG8_BAR; PG8_MMA(0, 0, At, B0); PG8_MMA(0, 1, At, B1); PG8_BAR; PG8_SCHED;
            PG8_LDA(At, 0, 1); PG8_STAGE(PG8_SB(0, 0), b2, voffB); PG8_STAGE(PG8_SB(0, 1), b2 + hstep, voffB); PG8_STAGE(PG8_SA(0, 0), a2, voffA);
            PG8_WAIT_V(8); PG8_WAIT_L(0); PG8_BAR; PG8_MMA(1, 0, At, B0); PG8_MMA(1, 1, At, B1); PG8_BAR; PG8_SCHED;
            PG8_LDB(B0, 1, 0); PG8_LDB(B1, 1, 1); PG8_SCHED; PG8_LDA(At, 1, 0); PG8_STAGE(PG8_SA(0, 1), a2 + hstep, voffA);
            PG8_WAIT_V(8); PG8_WAIT_L(0); PG8_BAR; PG8_MMA(0, 0, At, B0); PG8_MMA(0, 1, At, B1); PG8_BAR; PG8_SCHED;
            PG8_LDA(At, 1, 1); PG8_STAGE(PG8_SB(1, 0), b3, voffB); PG8_STAGE(PG8_SB(1, 1), b3 + hstep, voffB); PG8_STAGE(PG8_SA(1, 0), a3, voffA);
            PG8_WAIT_V(8); PG8_WAIT_L(0); PG8_BAR; PG8_MMA(1, 0, At, B0); PG8_MMA(1, 1, At, B1); PG8_BAR; PG8_SCHED;
            } else {
            PG8_LDB(B0, 0, 0); PG8_SCHED; PG8_LDA(At, 0, 0); PG8_STAGE(PG8_SA(1, 1), a1 + hstep, voffA);
            PG8_WAIT_L(8); PG8_BAR; PG8_WAIT_L(0); PG8_MMA(0, 0, At, B0); PG8_BAR; PG8_SCHED;
            PG8_LDB(B1, 0, 1); PG8_STAGE(PG8_SB(0, 0), b2, voffB);
            PG8_BAR; PG8_WAIT_L(0); PG8_MMA(0, 1, At, B1); PG8_BAR;
            PG8_LDA(At, 0, 1); PG8_STAGE(PG8_SA(0, 0), a2, voffA);
            PG8_BAR; PG8_WAIT_L(0); PG8_MMA(1, 0, At, B0); PG8_BAR; PG8_SCHED;
            PG8_STAGE(PG8_SB(0, 1), b2 + hstep, voffB);
            PG8_WAIT_V(6); PG8_BAR; PG8_MMA(1, 1, At, B1); PG8_BAR;
            PG8_LDB(B0, 1, 0); PG8_SCHED; PG8_LDA(At, 1, 0); PG8_STAGE(PG8_SA(0, 1), a2 + hstep, voffA);
            PG8_WAIT_L(8); PG8_BAR; PG8_WAIT_L(0); PG8_MMA(0, 0, At, B0); PG8_BAR; PG8_SCHED;
            PG8_LDB(B1, 1, 1); PG8_STAGE(PG8_SB(1, 0), b3, voffB);
            PG8_BAR; PG8_WAIT_L(0); PG8_MMA(0, 1, At, B1); PG8_BAR;
            PG8_LDA(At, 1, 1); PG8_STAGE(PG8_SA(1, 0), a3, voffA);
            PG8_BAR; PG8_WAIT_L(0); PG8_MMA(1, 0, At, B0); PG8_BAR; PG8_SCHED;
            PG8_STAGE(PG8_SB(1, 1), b3 + hstep, voffB);
            PG8_WAIT_V(6); PG8_BAR; PG8_MMA(1, 1, At, B1); PG8_BAR;
            }
        }
        if constexpr (ALIGN_EPI) { if (wr == 0) PG8_BAR; }
        if constexpr (!Epi::AFTER_DRAIN) { E(acc, cur, wr, wc, fr, fq); S.done(cur); }
        if (!has_next) break;
#pragma unroll
        for (int a = 0; a < 2; ++a)
#pragma unroll
            for (int b = 0; b < 2; ++b)
#pragma unroll
                for (int m = 0; m < 4; ++m)
#pragma unroll
                    for (int n = 0; n < 2; ++n) acc[a][b][m][n] = (f32x4){0.f, 0.f, 0.f, 0.f};
        cur = nxt; cA = nA; cB = nB; ++ui;
        if constexpr (ALIGN_EPI) { if (wr == 1) PG8_BAR; }
    }
    PG8_WAIT_V(0);
    if constexpr (!ALIGN_EPI) { if (wr == 0) PG8_BAR; }
    PG8_BAR;
    if constexpr (Epi::AFTER_DRAIN) { E.fused(acc, cur, wr, wc, fr, fq, lds, wid, lane); S.done(cur); }
#undef PG8_SA
#undef PG8_SB
#undef PG8_STAGE
#undef PG8_LDA
#undef PG8_LDB
#undef PG8_MMA
#undef PG8_WAIT_V
#undef PG8_WAIT_L
#undef PG8_BAR
#undef PG8_SCHED
}
}
#define XB_TMO      128
#define XB_XCNT(j)  (256  + 64 * (j))
#define XB_XSUB(j)  (1280 + 64 * (j))
#define XB_XGEN(j)  (2304 + 64 * (j))
#define XB_TOP      3328
#define XB_TOPGEN   3392
#define XCD_BAR_WORDS 3456
#define XB_SPIN_CAP (1u << 18)

__device__ __forceinline__ unsigned xb_ld(unsigned* p)              { return __hip_atomic_load(p, __ATOMIC_RELAXED, __HIP_MEMORY_SCOPE_AGENT); }
__device__ __forceinline__ unsigned xb_add(unsigned* p, unsigned v) { return __hip_atomic_fetch_add(p, v, __ATOMIC_RELAXED, __HIP_MEMORY_SCOPE_AGENT); }
__device__ __forceinline__ unsigned xb_xcc_id() { return (unsigned)__builtin_amdgcn_s_getreg((3 << 11) | 20) & 0xFu; }
#define XB_SPIN(cond, bar) do { unsigned _sp = 0; while (cond) { __builtin_amdgcn_s_sleep(1); \
    if ((++_sp & 255u) == 0u) { if (xb_ld(&(bar)[XB_TMO])) break; if (_sp > XB_SPIN_CAP) { atomicAdd(&(bar)[XB_TMO], 1u); break; } } } } while (0)

struct XcdBarrier {
    unsigned* bar; unsigned x;
    volatile LAS unsigned* st;
};

__device__ __forceinline__ XcdBarrier xcd_barrier_post(unsigned* bar, volatile LAS unsigned* st) {
    XcdBarrier b; b.bar = bar; b.x = xb_xcc_id(); b.st = st;
    if (threadIdx.x == 0) (void)xb_add(&bar[XB_XCNT(b.x)], 1u);
    return b;
}
__device__ __forceinline__ void xcd_barrier_complete(unsigned* bar, unsigned x, unsigned& nloc, unsigned& nx) {
    const unsigned G = gridDim.x * gridDim.y * gridDim.z;
    unsigned sum, cnt, mine, sp = 0u;
    for (;;) {
        sum = 0u; cnt = 0u; mine = 0u;
#pragma unroll
        for (unsigned j = 0; j < 16; ++j) { const unsigned c = xb_ld(&bar[XB_XCNT(j)]); sum += c; cnt += (c > 0u) ? 1u : 0u; mine = (j == x) ? c : mine; }
        if (sum == G) break;
        __builtin_amdgcn_s_sleep(1);
        if ((++sp & 255u) == 0u) { if (xb_ld(&bar[XB_TMO])) break; if (sp > XB_SPIN_CAP) { atomicAdd(&bar[XB_TMO], 1u); break; } }
    }
    nloc = mine > 0u ? mine : 1u; nx = cnt > 0u ? cnt : 1u;
}

__device__ __forceinline__ void xcd_barrier(const XcdBarrier& b) {
    asm volatile("s_waitcnt vmcnt(0)" ::: "memory");
    __syncthreads();
    if (threadIdx.x == 0) {
        unsigned* bar = b.bar;
        __builtin_amdgcn_s_waitcnt(0);
        unsigned nloc = b.st[0], nx = b.st[1];
        if (nloc == 0u) { xcd_barrier_complete(bar, b.x, nloc, nx); b.st[0] = nloc; b.st[1] = nx; }
        const unsigned old = xb_add(&bar[XB_XSUB(b.x)], 1u);
        const unsigned gen = old / nloc;
        if (old + 1u == (gen + 1u) * nloc) {
            __builtin_amdgcn_fence(__ATOMIC_RELEASE, "agent");
            asm volatile("s_waitcnt vmcnt(0)" ::: "memory");
            const unsigned og = xb_add(&bar[XB_TOP], 1u);
            const unsigned tg = og / nx;
            if (og + 1u == (tg + 1u) * nx) xb_add(&bar[XB_TOPGEN], 1u);
            else XB_SPIN(xb_ld(&bar[XB_TOPGEN]) == tg, bar);
            __builtin_amdgcn_fence(__ATOMIC_ACQUIRE, "agent");
            xb_add(&bar[XB_XGEN(b.x)], 1u);
            asm volatile("s_waitcnt vmcnt(0)" ::: "memory");
        } else {
            XB_SPIN(xb_ld(&bar[XB_XGEN(b.x)]) == gen, bar);
            __builtin_amdgcn_fence(__ATOMIC_ACQUIRE, "agent");
            asm volatile("s_waitcnt vmcnt(0)" ::: "memory");
        }
    }
    __syncthreads();
}
namespace fk {
using pg8::bf16_t; using pg8::bf16x8; using pg8::f32x4; using pg8::u32x4; using pg8::Unit;
typedef float f32x16 __attribute__((ext_vector_type(16)));
typedef float f32x2 __attribute__((ext_vector_type(2)));
typedef __bf16 bf16x2_t __attribute__((ext_vector_type(2)));
typedef short s16x4 __attribute__((ext_vector_type(4)));
typedef unsigned u32x2 __attribute__((ext_vector_type(2)));
#define DI __device__ __forceinline__

constexpr int NB = 8, S = 2048, M = NB * S, D = 1024;
constexpr float EPS = 1e-6f, LOG2E = 1.4426950408889634f;
constexpr int NTHR = 512;

DI int tidx() { int t = threadIdx.x; asm volatile("" : "+v"(t)); return t; }
DI unsigned pk2(float lo, float hi) { f32x2 v = {lo, hi}; return __builtin_bit_cast(unsigned, __builtin_convertvector(v, bf16x2_t)); }
DI float bflo(unsigned u) { return __uint_as_float(u << 16); }
DI float bfhi(unsigned u) { return __uint_as_float(u & 0xffff0000u); }
DI float bf1(unsigned short b) { return __uint_as_float((unsigned)b << 16); }
DI float ex2(float x) { return __builtin_amdgcn_exp2f(x); }
DI float sigm(float x) { return __builtin_amdgcn_rcpf(1.f + ex2(-LOG2E * x)); }
DI float silu(float x) { return x * sigm(x); }
DI float sigm_silu(float o, float z) { return z * __builtin_amdgcn_rcpf((1.f + ex2(-LOG2E * o)) * (1.f + ex2(-LOG2E * z))); }
DI u32x4 pk8(const f32x4& a, const f32x4& b) { u32x4 w; w.x = pk2(a[0], a[1]); w.y = pk2(a[2], a[3]); w.z = pk2(b[0], b[1]); w.w = pk2(b[2], b[3]); return w; }
DI void unpk8(u32x4 w, f32x4& a, f32x4& b) { a[0] = bflo(w.x); a[1] = bfhi(w.x); a[2] = bflo(w.y); a[3] = bfhi(w.y); b[0] = bflo(w.z); b[1] = bfhi(w.z); b[2] = bflo(w.w); b[3] = bfhi(w.w); }

constexpr size_t KiB = 1024, MiB = 1u << 20;
constexpr size_t WS_CTL = 0;
constexpr size_t WS_SSQ = 64 * KiB;
constexpr int SSQ_X = 0  , SSQ_1 = 5  , SSQ_Q = 9  , SSQ_KV = 11  ;
constexpr size_t ZERO_BYTES = 1792 * KiB;
constexpr size_t WS_GW8 = 1792 * KiB;
constexpr size_t WS_WMIX = 2 * MiB;
constexpr size_t WS_WPLE = 23 * MiB;
constexpr size_t WS_XBA = 26 * MiB;
constexpr size_t WS_BIG = 58 * MiB;
constexpr size_t WS_CS = WS_BIG + 192 * MiB, WS_SN = WS_CS + 1 * MiB, WS_IG = WS_SN + 1 * MiB, WS_LF = WS_IG + 256 * KiB;
constexpr size_t WS_END = 256 * MiB;
static_assert(WS_LF + 256 * KiB <= WS_END, "ws map");
constexpr size_t WM_IN = 0, WM_QB = 4 * MiB, WM_KVB = 6 * MiB, WM_OUT_MLA = 8 * MiB, WM_OUT_CONV = 8 * MiB, WM_OUT_LSTM = 16 * MiB;
constexpr size_t A_SZ = 0, A_Q = 32 * MiB, A_KN = 80 * MiB, A_VT = 112 * MiB, A_CQ = 144 * MiB, A_CKV = 156 * MiB, A_KR = 164 * MiB, A_XBB = 32 * MiB, A_PP = 80 * MiB, A_PB = 166 * MiB;
constexpr size_t C_CH = 0, C_BZ = 32 * MiB, C_XBB = 64 * MiB, C_PP = 96 * MiB, C_PB = 166 * MiB;
constexpr size_t L_Q = 0, L_K = 32 * MiB, L_VT = 64 * MiB, L_OG = 128 * MiB, L_XBB = 0, L_PP = 64 * MiB;

struct Args { const float* in[19]; float* out; unsigned char* ws; int ph_lo, ph_hi; };
enum { I_X = 0, I_P, I_POS, I_NORMG, I_MLA_WIN, I_MLA_QN, I_MLA_WQB, I_MLA_KVN, I_MLA_WKVB, I_MLA_WOUT, I_CONV_WIN, I_CONV_W, I_CONV_WOUT, I_L_WIN, I_L_BG, I_L_WOUT, I_PLE_PROJ, I_PLE_GATE, I_FNORM };

enum { PM_ID = 0, PM_MLA_IN, PM_MLA_QB, PM_MLA_KVB, PM_CONV_IN, PM_LSTM_IN };
DI int prep_src(int mode, int n, float& sc) {
    sc = 1.f;
    switch (mode) {
    case PM_MLA_IN: { if (n < 1024) return 672 + n; if (n < 1408) return n - 1024; if (n < 1664) return 384 + (n - 1408); if (n < 1696) { const int jj = n - 1664; return 640 + (jj >> 1) + 16 * (jj & 1); } return -1; }
    case PM_MLA_QB: { sc = 0.10206207261596577f * LOG2E; const int hd = n / 96, d = n % 96; if (d < 64) return n; const int jj = d - 64; return 96 * hd + 64 + (jj >> 1) + 16 * (jj & 1); }
    case PM_MLA_KVB: { if (n < 1024) return 128 * (n >> 6) + (n & 63); const int n2 = n - 1024; return 128 * (n2 >> 6) + 64 + (n2 & 63); }
    case PM_CONV_IN: { const int pn = n >> 8, bj = (n >> 7) & 1, i = n & 127; if (pn < 8) return (bj ? 2048 : 1024) + 128 * pn + i; return (bj ? 3072 : 0) + 128 * (pn - 8) + i; }
    case PM_LSTM_IN: { if (n < 4096) { if (n >= 1024 && n < 2048) sc = 0.0625f; return n; } const int n2 = n - 4096, pn = n2 >> 8, bj = (n2 >> 7) & 1, i = n2 & 127; return (bj ? 6144 : 4096) + 128 * pn + i; }
    default: return n;
    }
}
struct PrepTask { const float* W; int ldw; const float* gk; int K, Nst, mode; bf16_t* out; };
DI void prep_tile(const PrepTask& t, int tile, LAS float* scr) {
    const int tid = tidx(), nkb = t.K >> 7, nb = tile / nkb, kb = tile % nkb, n0 = nb << 6, k0 = kb << 7;
    const int nn = tid & 63, kq = tid >> 6;
    float sc; const int src = prep_src(t.mode, n0 + nn, sc);
    float v[16];
#pragma unroll
    for (int i = 0; i < 16; ++i) { const int kk = kq + 8 * i; v[i] = (src >= 0) ? t.W[(size_t)(k0 + kk) * t.ldw + src] : 0.f; }
#pragma unroll
    for (int i = 0; i < 16; ++i) { const int kk = kq + 8 * i; float x = v[i] * sc; if (t.gk) x *= t.gk[k0 + kk]; scr[nn * 129 + kk] = x; }
    __syncthreads();
#pragma unroll
    for (int h2 = 0; h2 < 2; ++h2) { const int e = tid + h2 * NTHR, n2 = e >> 4, c = e & 15; const LAS float* sp = scr + n2 * 129 + 8 * c;
      u32x4 o; o.x = pk2(sp[0], sp[1]); o.y = pk2(sp[2], sp[3]); o.z = pk2(sp[4], sp[5]); o.w = pk2(sp[6], sp[7]);
      *(u32x4*)(t.out + (size_t)(n0 + n2) * t.K + k0 + 8 * c) = o; }
    __syncthreads();
}
DI void prep_run1(const PrepTask& t, LAS float* scr, int cu, int G) {
    const int total = (t.Nst >> 6) * (t.K >> 7);
#pragma unroll 1
    for (int it = cu; it < total; it += G) prep_tile(t, it, scr);
}

DI float wave_sum(float v) {
#pragma unroll
    for (int o = 1; o < 64; o <<= 1) v += __shfl_xor(v, o);
    return v;
}
DI void rows_to_bf16_ssq(const float* x, bf16_t* xb, unsigned long long* ssq, int gw, int NGW, int lane) {
    for (int m0 = gw; m0 < M; m0 += 4 * NGW) {
        f32x4 v[4][4];
#pragma unroll
        for (int r = 0; r < 4; ++r) { const int m = m0 + r * NGW; const f32x4* xr = (const f32x4*)(x + (size_t)(m < M ? m : m0) * D) + lane;
#pragma unroll
            for (int j = 0; j < 4; ++j) v[r][j] = xr[64 * j]; }
#pragma unroll
        for (int r = 0; r < 4; ++r) { const int m = m0 + r * NGW; if (m < M) {
            float s = 0.f; u32x2* o8 = (u32x2*)(xb + (size_t)m * D) + lane;
#pragma unroll
            for (int j = 0; j < 4; ++j) { s += (v[r][j][0] * v[r][j][0] + v[r][j][1] * v[r][j][1]) + (v[r][j][2] * v[r][j][2] + v[r][j][3] * v[r][j][3]); u32x2 w; w.x = pk2(v[r][j][0], v[r][j][1]); w.y = pk2(v[r][j][2], v[r][j][3]); o8[64 * j] = w; }
            s = wave_sum(s); if (lane == 0) ssq[m] = (unsigned long long)(s * 16777216.f); } }
    }
}
DI void p_to_bf16(const float* p, bf16_t* pb, int gt, int NGT) {
    constexpr size_t N8 = (size_t)M * 256 / 8;
    for (size_t i = gt; i < N8; i += (size_t)4 * NGT) {
        f32x4 a[4], b[4];
#pragma unroll
        for (int k = 0; k < 4; ++k) { const size_t e = i + (size_t)k * NGT; if (e < N8) { a[k] = ((const f32x4*)p)[2 * e]; b[k] = ((const f32x4*)p)[2 * e + 1]; } }
#pragma unroll
        for (int k = 0; k < 4; ++k) { const size_t e = i + (size_t)k * NGT; if (e < N8) ((u32x4*)pb)[e] = pk8(a[k], b[k]); }
    }
}
DI void rope_tables(const int* pos, float* cs, float* sn, int gt, int NGT) {
    for (int i = gt; i < M * 16; i += NGT) {
        const int t = i >> 4, j = i & 15;
        const float inv = powf(10000.0f, -(float)(2 * j) / 32.0f);
        const float ang = (float)pos[t] * inv;
        double rev = (double)ang * 0.15915494309189533577; rev -= rint(rev);
        const float fr = (float)rev;
        cs[i] = __builtin_amdgcn_cosf(fr); sn[i] = __builtin_amdgcn_sinf(fr);
    }
}

#define EPI_ROW(u, ai, m) ((u).pm * 256 + (ai) * 128 + wr * 64 + (m) * 16 + fr)
#define EPI_LOOP_AM _Pragma("unroll") for (int ai = 0; ai < 2; ++ai) _Pragma("unroll") for (int m = 0; m < 4; ++m)
typedef const f32x4 (&AccRef)[2][2][4][2];
#ifndef NT_STORES
#define NT_STORES 0
#endif
#ifndef SC1_STORES
#define SC1_STORES 0
#endif
DI void st16(const void* base, bf16_t* p, const u32x4& v) {
    if (SC1_STORES) __builtin_amdgcn_raw_buffer_store_b128(v, __builtin_amdgcn_make_buffer_rsrc((void*)base, 0, 0xFFFFFFFFu, 0x00020000), (unsigned)((const char*)p - (const char*)base), 0, 16);
    else if (NT_STORES) __builtin_nontemporal_store(v, (u32x4*)p); else *(u32x4*)p = v; }
DI float sq8(const f32x4& a, const f32x4& b) { return (a[0] * a[0] + a[1] * a[1]) + (a[2] * a[2] + a[3] * a[3]) + (b[0] * b[0] + b[1] * b[1]) + (b[2] * b[2] + b[3] * b[3]); }
DI float red_fq(float s) { s += __shfl_xor(s, 16); s += __shfl_xor(s, 32); return s; }
DI void rope8(f32x4& a, f32x4& b, const float* cs, const float* sn, int row, int p0) {
    const f32x4 c = *(const f32x4*)(cs + (size_t)row * 16 + p0), s = *(const f32x4*)(sn + (size_t)row * 16 + p0);
    const f32x4 a0 = a, b0 = b;
    a[0] = a0[0] * c[0] - a0[1] * s[0]; a[1] = a0[0] * s[0] + a0[1] * c[0];
    a[2] = a0[2] * c[1] - a0[3] * s[1]; a[3] = a0[2] * s[1] + a0[3] * c[1];
    b[0] = b0[0] * c[2] - b0[1] * s[2]; b[1] = b0[0] * s[2] + b0[1] * c[2];
    b[2] = b0[2] * c[3] - b0[3] * s[3]; b[3] = b0[2] * s[3] + b0[3] * c[3];
}

DI int opaque(int v) { asm volatile("" : "+s"(v)); return v; }
template <class T> DI T* launder(T* p) { asm volatile("" : "+s"(p)); return p; }
typedef unsigned long long u64;
constexpr float SSQ_SCALE = 16777216.f, SSQ_INV = 1.f / 16777216.f;
DI u64* ssq_arr(unsigned char* ws, int idx) { return (u64*)(ws + WS_SSQ) + (size_t)idx * M; }
DI void ssq_add(u64* p, float s) { atomicAdd(p, (u64)(s * SSQ_SCALE)); }
DI float ssq_rstd(const u64* p, float invn) { return rsqrtf((float)(*p) * SSQ_INV * invn + EPS); }

#define EPI_RS8(rsarr, ssqp, invn) float rsarr[2][4]; { u64 t_[2][4]; _Pragma("unroll") for (int ai = 0; ai < 2; ++ai) _Pragma("unroll") for (int m = 0; m < 4; ++m) t_[ai][m] = (ssqp)[EPI_ROW(u, ai, m)]; \
    _Pragma("unroll") for (int ai = 0; ai < 2; ++ai) _Pragma("unroll") for (int m = 0; m < 4; ++m) rsarr[ai][m] = rsqrtf((float)t_[ai][m] * SSQ_INV * (invn) + EPS); }

struct EpiA1 {
    static constexpr bool PERM = true, AFTER_DRAIN = false;
    unsigned char* ws; int i, j;
    DI void operator()(AccRef acc, const Unit& u, int wr, int wc, int fr, int fq) const {
        unsigned char* w = launder(ws); unsigned char* big = w + WS_BIG;
        const u64* ssq_x = ssq_arr(w, SSQ_X + i); u64* ssq_q = ssq_arr(w, SSQ_Q + j); u64* ssq_kv = ssq_arr(w, SSQ_KV + j);
        bf16_t *SZ = (bf16_t*)(big + A_SZ), *CQ = (bf16_t*)(big + A_CQ), *CKV = (bf16_t*)(big + A_CKV), *KR = (bf16_t*)(big + A_KR);
        const float *CS = (const float*)(w + WS_CS), *SN = (const float*)(w + WS_SN);
        EPI_RS8(rsv, ssq_x, 1.f / 1024.f);
        EPI_LOOP_AM {
            const int row = EPI_ROW(u, ai, m); const float rs = rsv[ai][m];
            float sq = 0.f, skv = 0.f; bool hq = false, hkv = false;
#pragma unroll
            for (int bj = 0; bj < 2; ++bj) {
                f32x4 v0 = acc[ai][bj][m][0] * rs, v1 = acc[ai][bj][m][1] * rs;
                if (u.pn < 4) {
                    const int col = u.pn * 256 + bj * 128 + wc * 32 + 8 * fq;
#pragma unroll
                    for (int jj = 0; jj < 4; ++jj) { v0[jj] = silu(v0[jj]); v1[jj] = silu(v1[jj]); }
                    st16(w, SZ + (size_t)row * 1024 + col, pk8(v0, v1));
                } else {
                    const int c = (u.pn - 4) * 256 + bj * 128 + wc * 32 + 8 * fq;
                    if (c < 384) { st16(w, CQ + (size_t)row * 384 + c, pk8(v0, v1)); sq += sq8(v0, v1); hq = true; }
                    else if (c < 640) { st16(w, CKV + (size_t)row * 256 + (c - 384), pk8(v0, v1)); skv += sq8(v0, v1); hkv = true; }
                    else if (c < 672) { const int jj0 = c - 640; rope8(v0, v1, CS, SN, row, jj0 >> 1); st16(w, KR + (size_t)row * 32 + jj0, pk8(v0, v1)); }
                }
            }
            if (u.pn >= 4) {
                sq = red_fq(sq); skv = red_fq(skv);
                if (fq == 0 && hq) ssq_add(ssq_q + row, sq);
                if (fq == 0 && hkv) ssq_add(ssq_kv + row, skv);
            }
        }
    }
};
struct EpiQ {
    static constexpr bool PERM = true, AFTER_DRAIN = false;
    unsigned char* ws; int j;
    DI void operator()(AccRef acc, const Unit& u, int wr, int wc, int fr, int fq) const {
        unsigned char* w = launder(ws); const u64* ssq_q = ssq_arr(w, SSQ_Q + j); bf16_t* Q = (bf16_t*)(w + WS_BIG + A_Q);
        const float *CS = (const float*)(w + WS_CS), *SN = (const float*)(w + WS_SN);
        EPI_RS8(rsv, ssq_q, 1.f / 384.f);
        EPI_LOOP_AM {
            const int row = EPI_ROW(u, ai, m); const float rs = rsv[ai][m];
#pragma unroll
            for (int bj = 0; bj < 2; ++bj) {
                const int col = u.pn * 256 + bj * 128 + wc * 32 + 8 * fq, d = col % 96;
                f32x4 v0 = acc[ai][bj][m][0] * rs, v1 = acc[ai][bj][m][1] * rs;
                if (d >= 64) rope8(v0, v1, CS, SN, row, (d - 64) >> 1);
                st16(w, Q + (size_t)row * 1536 + col, pk8(v0, v1));
            }
        }
    }
};
struct EpiKV {
    static constexpr bool PERM = true, AFTER_DRAIN = false;
    unsigned char* ws; int j;
    DI void operator()(AccRef acc, const Unit& u, int wr, int wc, int fr, int fq) const {
        unsigned char* w = launder(ws); const u64* ssq_kv = ssq_arr(w, SSQ_KV + j); bf16_t* O = (bf16_t*)(w + WS_BIG + (u.pn < 4 ? A_KN : A_VT));
        EPI_RS8(rsv, ssq_kv, 1.f / 256.f);
        EPI_LOOP_AM {
            const int row = EPI_ROW(u, ai, m); const float rs = rsv[ai][m];
#pragma unroll
            for (int bj = 0; bj < 2; ++bj) {
                const int col = (u.pn & 3) * 256 + bj * 128 + wc * 32 + 8 * fq;
                st16(w, O + (size_t)row * 1024 + col, pk8(acc[ai][bj][m][0] * rs, acc[ai][bj][m][1] * rs));
            }
        }
    }
};
struct EpiOut {
    static constexpr bool PERM = true, AFTER_DRAIN = false;
    unsigned char* ws; size_t xbb_off; int i;
    DI void operator()(AccRef acc, const Unit& u, int wr, int wc, int fr, int fq) const {
        unsigned char* w = launder(ws); u64* ssq = ssq_arr(w, SSQ_1 + i); bf16_t* XB = (bf16_t*)(w + WS_BIG + xbb_off); const bf16_t* xin = (const bf16_t*)(w + WS_XBA);
        const size_t cb = (size_t)u.pn * 256 + wc * 32 + 8 * fq;
        u32x4 cur[2], nxt[2];
#define EO_LOAD(dst, it) do { const size_t o_ = (size_t)EPI_ROW(u, (it) >> 2, (it) & 3) * 1024 + cb; dst[0] = *(const u32x4*)(xin + o_); dst[1] = *(const u32x4*)(xin + o_ + 128); } while (0)
        EO_LOAD(cur, 0);
#pragma unroll
        for (int it = 0; it < 8; ++it) {
            const int ai = it >> 2, m = it & 3;
            if (it < 7) EO_LOAD(nxt, it + 1);
            const int row = EPI_ROW(u, ai, m); float sq = 0.f;
#pragma unroll
            for (int bj = 0; bj < 2; ++bj) {
                const size_t off = (size_t)row * 1024 + cb + bj * 128;
                f32x4 x0, x1; unpk8(cur[bj], x0, x1);
                const f32x4 y0 = x0 + acc[ai][bj][m][0], y1 = x1 + acc[ai][bj][m][1];
                st16(w, XB + off, pk8(y0, y1)); sq += sq8(y0, y1);
            }
            sq = red_fq(sq); if (fq == 0) ssq_add(ssq + row, sq);
            cur[0] = nxt[0]; cur[1] = nxt[1];
        }
#undef EO_LOAD
    }
};
struct EpiPP {
    static constexpr bool PERM = true, AFTER_DRAIN = false;
    bf16_t* pp;
    DI void operator()(AccRef acc, const Unit& u, int wr, int wc, int fr, int fq) const {
        bf16_t* PP = launder(pp);
        EPI_LOOP_AM { const int row = EPI_ROW(u, ai, m);
#pragma unroll
            for (int bj = 0; bj < 2; ++bj) { const size_t off = (size_t)row * 1024 + u.pn * 256 + bj * 128 + wc * 32 + 8 * fq; st16(PP, PP + off, pk8(acc[ai][bj][m][0], acc[ai][bj][m][1])); } }
    }
};
struct EpiPle {
    static constexpr bool PERM = true, AFTER_DRAIN = false;
    unsigned char* ws; const bf16_t* pp; size_t xbb_off; int i;
    DI void operator()(AccRef acc, const Unit& u, int wr, int wc, int fr, int fq) const {
        unsigned char* w = launder(ws); const u64* ssq1 = ssq_arr(w, SSQ_1 + i); u64* ssq = ssq_arr(w, SSQ_X + i + 1);
        const bf16_t* PP = launder(pp); const bf16_t* X1 = (const bf16_t*)(w + WS_BIG + xbb_off); bf16_t* XB = (bf16_t*)(w + WS_XBA);
        const size_t cb = (size_t)u.pn * 256 + wc * 32 + 8 * fq;
        EPI_RS8(rsv, ssq1, 1.f / 1024.f);
        u32x4 cur[2], nxt[2], pc[2], pn2[2];
#define EP_LOAD(dst, pd, it) do { const size_t o_ = (size_t)EPI_ROW(u, (it) >> 2, (it) & 3) * 1024 + cb; dst[0] = *(const u32x4*)(X1 + o_); dst[1] = *(const u32x4*)(X1 + o_ + 128); \
            pd[0] = *(const u32x4*)(PP + o_); pd[1] = *(const u32x4*)(PP + o_ + 128); } while (0)
        EP_LOAD(cur, pc, 0);
#pragma unroll
        for (int it = 0; it < 8; ++it) {
            const int ai = it >> 2, m = it & 3;
            if (it < 7) EP_LOAD(nxt, pn2, it + 1);
            const int row = EPI_ROW(u, ai, m); const float rs = rsv[ai][m]; float sq = 0.f;
#pragma unroll
            for (int bj = 0; bj < 2; ++bj) {
                const size_t off = (size_t)row * 1024 + cb + bj * 128;
                f32x4 p0, p1, y0, y1; unpk8(pc[bj], p0, p1); unpk8(cur[bj], y0, y1);
#pragma unroll
                for (int jj = 0; jj < 4; ++jj) { y0[jj] += sigm(acc[ai][bj][m][0][jj] * rs) * p0[jj]; y1[jj] += sigm(acc[ai][bj][m][1][jj] * rs) * p1[jj]; }
                st16(w, XB + off, pk8(y0, y1)); sq += sq8(y0, y1);
            }
            sq = red_fq(sq); if (fq == 0) ssq_add(ssq + row, sq);
#pragma unroll
            for (int bj = 0; bj < 2; ++bj) { cur[bj] = nxt[bj]; pc[bj] = pn2[bj]; }
        }
#undef EP_LOAD
    }
};
struct EpiPleLast {
    static constexpr bool PERM = true, AFTER_DRAIN = true;
    unsigned char* ws; float* out; const float* gfin; const bf16_t* pp; size_t xbb_off; int i; unsigned xcc; volatile LAS unsigned* st;
    DI void fused(f32x4 (&acc)[2][2][4][2], const Unit& u, int wr, int wc, int fr, int fq, LAS unsigned char* lds, int wid, int lane) const {
        unsigned char* w = launder(ws); const u64* ssq1 = ssq_arr(w, SSQ_1 + i); u64* ssq = ssq_arr(w, SSQ_X + i + 1);
        const bf16_t* PP = launder(pp); const bf16_t* X1 = (const bf16_t*)(w + WS_BIG + xbb_off);
        const size_t cb = (size_t)u.pn * 256 + wc * 32 + 8 * fq;
        {
            EPI_RS8(rsv, ssq1, 1.f / 1024.f);
#pragma unroll
            for (int it = 0; it < 8; ++it) {
                const int ai = it >> 2, m = it & 3; const int row = EPI_ROW(u, ai, m); const float rs = rsv[ai][m]; float sq = 0.f;
#pragma unroll
                for (int bj = 0; bj < 2; ++bj) {
                    const size_t off = (size_t)row * 1024 + cb + bj * 128;
                    f32x4 p0, p1, y0, y1; unpk8(*(const u32x4*)(PP + off), p0, p1); unpk8(*(const u32x4*)(X1 + off), y0, y1);
#pragma unroll
                    for (int jj = 0; jj < 4; ++jj) { y0[jj] += sigm(acc[ai][bj][m][0][jj] * rs) * p0[jj]; y1[jj] += sigm(acc[ai][bj][m][1][jj] * rs) * p1[jj]; }
                    acc[ai][bj][m][0] = y0; acc[ai][bj][m][1] = y1; sq += sq8(y0, y1);
                }
                sq = red_fq(sq); if (fq == 0) ssq_add(ssq + row, sq);
            }
        }
        { XcdBarrier b; b.bar = (unsigned*)(launder(ws) + WS_CTL); b.x = xcc; b.st = st; xcd_barrier(b); }
        {
            const u64* ssqf = ssq_arr(launder(ws), SSQ_X + i + 1);
            EPI_RS8(rsf, ssqf, 1.f / 1024.f);
#pragma unroll
            for (int bj = 0; bj < 2; ++bj) {
                const f32x4 g0 = *(const f32x4*)(gfin + cb + bj * 128), g1 = *(const f32x4*)(gfin + cb + bj * 128 + 4);
                EPI_LOOP_AM { const size_t off = (size_t)EPI_ROW(u, ai, m) * 1024 + cb + bj * 128; const float rs = rsf[ai][m];
                    *(f32x4*)(out + off) = acc[ai][bj][m][0] * rs * g0; *(f32x4*)(out + off + 4) = acc[ai][bj][m][1] * rs * g1; }
            }
        }
    }
};
struct EpiC1 {
    static constexpr bool PERM = true, AFTER_DRAIN = false;
    unsigned char* ws; int i; int dry;
    DI void operator()(AccRef acc, const Unit& u, int wr, int wc, int fr, int fq) const {
        if (dry == 1) { asm volatile("" :: "v"(acc[0][0][0][0][0]), "v"(acc[1][1][3][1][3])); return; }
        unsigned char* w = launder(ws); const u64* ssq_x = ssq_arr(w, SSQ_X + i); bf16_t *CH = (bf16_t*)(w + WS_BIG + C_CH), *BZ = (bf16_t*)(w + WS_BIG + C_BZ);
        EPI_RS8(rsv, ssq_x, 1.f / 1024.f);
        EPI_LOOP_AM {
            const int row = EPI_ROW(u, ai, m); const float rs = rsv[ai][m];
            const size_t off = (size_t)row * 1024 + (u.pn & 7) * 128 + wc * 32 + 8 * fq;
            f32x4 r0, r1;
            if (u.pn < 8) { r0 = (acc[ai][0][m][0] * rs) * (acc[ai][1][m][0] * rs); r1 = (acc[ai][0][m][1] * rs) * (acc[ai][1][m][1] * rs); { const u32x4 o_ = pk8(r0, r1); if (dry == 2) asm volatile("" :: "v"(o_)); else if (dry == 3) { const int blk = ((wr * 2 + ai) * 4 + m) * 4 + wc, ln = fr + 16 * fq; st16(w, CH + (size_t)(u.pm * 256 + (blk >> 1) * 8 + (ln >> 3)) * 1024 + (u.pn & 7) * 128 + (blk & 1) * 64 + (ln & 7) * 8, o_); } else st16(w, CH + off, o_); } }
            else {
#pragma unroll
                for (int jj = 0; jj < 4; ++jj) { r0[jj] = (acc[ai][0][m][0][jj] * rs) * silu(acc[ai][1][m][0][jj] * rs); r1[jj] = (acc[ai][0][m][1][jj] * rs) * silu(acc[ai][1][m][1][jj] * rs); }
                { const u32x4 o_ = pk8(r0, r1); if (dry == 2) asm volatile("" :: "v"(o_)); else if (dry == 3) { const int blk = ((wr * 2 + ai) * 4 + m) * 4 + wc, ln = fr + 16 * fq; st16(w, BZ + (size_t)(u.pm * 256 + (blk >> 1) * 8 + (ln >> 3)) * 1024 + (u.pn & 7) * 128 + (blk & 1) * 64 + (ln & 7) * 8, o_); } else st16(w, BZ + off, o_); }
            }
        }
    }
};
struct EpiL1 {
    static constexpr bool PERM = true, AFTER_DRAIN = false;
    unsigned char* ws; int i;
    DI void operator()(AccRef acc, const Unit& u, int wr, int wc, int fr, int fq) const {
        unsigned char* w = launder(ws); const u64* ssq_x = ssq_arr(w, SSQ_X + i); unsigned char* big = w + WS_BIG;
        EPI_RS8(rsv, ssq_x, 1.f / 1024.f);
        if (u.pn < 16) {
            bf16_t* O; int ld, c0;
            if (u.pn < 4) { O = (bf16_t*)(big + L_Q); ld = 1024; c0 = u.pn * 256; } else if (u.pn < 8) { O = (bf16_t*)(big + L_K); ld = 1024; c0 = (u.pn - 4) * 256; } else { O = (bf16_t*)(big + L_VT); ld = 2048; c0 = (u.pn - 8) * 256; }
            EPI_LOOP_AM {
                const int row = EPI_ROW(u, ai, m); const float rs = rsv[ai][m];
#pragma unroll
                for (int bj = 0; bj < 2; ++bj) st16(w, O + (size_t)row * ld + c0 + bj * 128 + wc * 32 + 8 * fq, pk8(acc[ai][bj][m][0] * rs, acc[ai][bj][m][1] * rs));
            }
        } else {
            bf16_t* OG = (bf16_t*)(big + L_OG);
            EPI_LOOP_AM {
                const int row = EPI_ROW(u, ai, m); const float rs = rsv[ai][m];
                const size_t off = (size_t)row * 2048 + (u.pn - 16) * 128 + wc * 32 + 8 * fq; f32x4 r0, r1;
#pragma unroll
                for (int jj = 0; jj < 4; ++jj) { r0[jj] = sigm_silu(acc[ai][0][m][0][jj] * rs, acc[ai][1][m][0][jj] * rs); r1[jj] = sigm_silu(acc[ai][0][m][1][jj] * rs, acc[ai][1][m][1][jj] * rs); }
                st16(w, OG + off, pk8(r0, r1));
            }
        }
    }
};
#ifndef QFUSE
#define QFUSE 0
#endif
constexpr int AT_WQS = 784  , AT_WQOFF = 2 * 64 * 208 + 2 * 64 * 192;
constexpr int AT_KSTR = 208, AT_VSTR = 192, AT_KB = 64 * AT_KSTR, AT_VB = 64 * AT_VSTR;
#define MFMA32(a, b, c) __builtin_amdgcn_mfma_f32_32x32x16_bf16((a), (b), (c), 0, 0, 0)
#define MFMA16(a, b, c) __builtin_amdgcn_mfma_f32_16x16x32_bf16((a), (b), (c), 0, 0, 0)
DI float max3f(float a, float b, float c) { float r; asm("v_max3_f32 %0, %1, %2, %3" : "=v"(r) : "v"(a), "v"(b), "v"(c)); return r; }
DI bf16x8 cat4(s16x4 lo, s16x4 hi) { return __builtin_shufflevector(lo, hi, 0, 1, 2, 3, 4, 5, 6, 7); }

struct AttnT { const bf16_t *Q, *KN, *KR, *VT; bf16_t* SZOG; const bf16_t *CQ, *WQ; const u64* ssq_q; const float *CS, *SN; };
#ifndef DIAG_NOLOAD
#define DIAG_NOLOAD 0
#endif
#ifndef AT_ORD0
#define AT_ORD0 0x3407
#define AT_ORD1 0x2516
#endif
struct AttnStage { u32x4 k, r, v; };
DI void attn_unit(LAS unsigned char* lds, const AttnT& T, int b, int h, int qb, int dry) {
    const int tid = tidx(), w = __builtin_amdgcn_readfirstlane(tid >> 6), lane = tid & 63, r = lane & 31, hh = lane >> 5;
    const int tok0 = b * S, row0 = tok0 + qb * 256 + 32 * w;
    bf16x8 qf[6];
#if QFUSE
    {
        f32x16 qT[3];
#pragma unroll
        for (int db = 0; db < 3; ++db)
#pragma unroll
            for (int i = 0; i < 16; ++i) qT[db][i] = 0.f;
        const bf16_t* cqp = T.CQ + (size_t)(row0 + r) * 384 + 8 * hh;
        bf16x8 cf[24];
#pragma unroll
        for (int ks = 0; ks < 24; ++ks) cf[ks] = *(const bf16x8*)(cqp + 16 * ks);
        const LAS unsigned char* wl = lds + AT_WQOFF + r * AT_WQS + 16 * hh;
#pragma unroll
        for (int ks = 0; ks < 24; ++ks) {
            const bf16x8 w0 = *(const LAS bf16x8*)(wl + 32 * ks), w1 = *(const LAS bf16x8*)(wl + 32 * AT_WQS + 32 * ks), w2 = *(const LAS bf16x8*)(wl + 64 * AT_WQS + 32 * ks);
            qT[0] = MFMA32(w0, cf[ks], qT[0]); qT[1] = MFMA32(w1, cf[ks], qT[1]); qT[2] = MFMA32(w2, cf[ks], qT[2]);
        }
        const float rsq = ssq_rstd(T.ssq_q + row0 + r, 1.f / 384.f);
#pragma unroll
        for (int db = 0; db < 3; ++db)
#pragma unroll
            for (int i = 0; i < 16; ++i) qT[db][i] *= rsq;
#pragma unroll
        for (int g4 = 0; g4 < 4; ++g4) {
            const f32x2 c2 = *(const f32x2*)(T.CS + (size_t)(row0 + r) * 16 + 4 * g4 + 2 * hh), s2 = *(const f32x2*)(T.SN + (size_t)(row0 + r) * 16 + 4 * g4 + 2 * hh);
#pragma unroll
            for (int e = 0; e < 2; ++e) { const float x1 = qT[2][4 * g4 + 2 * e], x2 = qT[2][4 * g4 + 2 * e + 1], cc = e ? c2[1] : c2[0], ss = e ? s2[1] : s2[0];
                qT[2][4 * g4 + 2 * e] = x1 * cc - x2 * ss; qT[2][4 * g4 + 2 * e + 1] = x1 * ss + x2 * cc; }
        }
#pragma unroll
        for (int db = 0; db < 3; ++db)
#pragma unroll
            for (int s2i = 0; s2i < 2; ++s2i) { u32x4 pw; pw.x = pk2(qT[db][8 * s2i + 0], qT[db][8 * s2i + 1]); pw.y = pk2(qT[db][8 * s2i + 2], qT[db][8 * s2i + 3]); pw.z = pk2(qT[db][8 * s2i + 4], qT[db][8 * s2i + 5]); pw.w = pk2(qT[db][8 * s2i + 6], qT[db][8 * s2i + 7]);
                qf[2 * db + s2i] = __builtin_bit_cast(bf16x8, pw); }
    }
#else
#pragma unroll
    for (int ks = 0; ks < 6; ++ks) qf[ks] = *(const bf16x8*)(T.Q + (size_t)(row0 + r) * 1536 + 96 * h + 16 * ks + 8 * hh);
#endif
    f32x16 O0, O1;
#pragma unroll
    for (int i = 0; i < 16; ++i) { O0[i] = 0.f; O1[i] = 0.f; }
    float mrun = -1e30f, lrun = 0.f;
    const int ntiles = 4 * qb + 4, myvis = 4 * qb + (w >> 1);
    const int kkey = tid >> 3, kch = tid & 7, rkey = tid >> 2, rch = tid & 3;
    const bf16_t* gK = T.KN + (size_t)(tok0 + kkey) * 1024 + 64 * h + 8 * kch;
    const bf16_t* gR = T.KR + (size_t)(tok0 + rkey) * 32 + 8 * rch;
    const bf16_t* gV = T.VT + (size_t)(tok0 + kkey) * 1024 + 64 * h + 8 * kch;
    const int lK = QFUSE ? kkey * AT_KSTR + 32 * (kch >> 1) + 8 * (kch & 1) : kkey * AT_KSTR + 16 * kch, lR = QFUSE ? rkey * AT_KSTR + 128 + 32 * (rch >> 1) + 8 * (rch & 1) : rkey * AT_KSTR + 128 + 16 * rch, lV = kkey * AT_VSTR + 16 * kch;
    const int krd = r * AT_KSTR + 16 * hh;
    const int vrd = (4 * hh + ((lane & 15) >> 2)) * AT_VSTR + (16 * ((lane >> 4) & 1) + 4 * (lane & 3)) * 2;
#define AT_LOADK(st, kt) do { if (DIAG_NOLOAD && dry) break; (st).k = *(const u32x4*)(gK + (size_t)(kt) * 64 * 1024); if (tid < 256) (st).r = *(const u32x4*)(gR + (size_t)(kt) * 64 * 32); } while (0)
#define AT_LOADV(st, kt) do { if (DIAG_NOLOAD && dry) break; (st).v = *(const u32x4*)(gV + (size_t)(kt) * 64 * 1024); } while (0)
#define AT_WRITEK(st, buf) do { LAS unsigned char* kb_ = lds + (buf) * AT_KB; *(LAS u32x2*)(kb_ + lK) = (u32x2){(st).k.x, (st).k.y}; *(LAS u32x2*)(kb_ + lK + (QFUSE ? 16 : 8)) = (u32x2){(st).k.z, (st).k.w}; \
        if (tid < 256) { *(LAS u32x2*)(kb_ + lR) = (u32x2){(st).r.x, (st).r.y}; *(LAS u32x2*)(kb_ + lR + (QFUSE ? 16 : 8)) = (u32x2){(st).r.z, (st).r.w}; } } while (0)
#define AT_WRITEV(st, buf) do { *(LAS u32x4*)(lds + 2 * AT_KB + (buf) * AT_VB + lV) = (st).v; } while (0)
#define AT_QK1(sX, buf, blk) do { const LAS unsigned char* kb = lds + (buf) * AT_KB + krd + (blk) * 32 * AT_KSTR; \
        _Pragma("unroll") for (int i = 0; i < 16; ++i) sX[i] = 0.f; \
        _Pragma("unroll") for (int ks = 0; ks < 6; ++ks) sX = MFMA32(*(const LAS bf16x8*)(kb + 32 * ks), qf[ks], sX); } while (0)
#define AT_QK(sA, sB, buf) do { AT_QK1(sA, buf, 0); AT_QK1(sB, buf, 1); } while (0)
#define AT_MAX(s0, s1) \
          \
        asm volatile("s_nop 7\n\ts_nop 7\n\ts_nop 7" : "+v"(s0[0]), "+v"(s1[0])); \
        float mx = max3f(s0[0], s1[0], mrun); \
        _Pragma("unroll") for (int i = 1; i < 16; ++i) mx = max3f(mx, s0[i], s1[i]); \
        const float mnew = max3f(mx, __shfl_xor(mx, 32), mx), alpha = ex2(mrun - mnew); mrun = mnew;
#define AT_EXP(s0, s1) do { float ps = 0.f; \
        _Pragma("unroll") for (int i = 0; i < 16; ++i) { s0[i] = ex2(s0[i] - mrun); s1[i] = ex2(s1[i] - mrun); ps += s0[i] + s1[i]; } \
        lrun = lrun * alpha + ps; \
        _Pragma("unroll") for (int i = 0; i < 16; ++i) { O0[i] *= alpha; O1[i] *= alpha; } } while (0)
#define AT_PV(s0, s1, buf) do { LAS unsigned char* vb = lds + 2 * AT_KB + (buf) * AT_VB + vrd; \
        _Pragma("unroll") for (int kb2 = 0; kb2 < 2; ++kb2) _Pragma("unroll") for (int s = 0; s < 2; ++s) { \
            const f32x16& sx = kb2 ? s1 : s0; \
            u32x4 pw; pw.x = pk2(sx[8 * s + 0], sx[8 * s + 1]); pw.y = pk2(sx[8 * s + 2], sx[8 * s + 3]); pw.z = pk2(sx[8 * s + 4], sx[8 * s + 5]); pw.w = pk2(sx[8 * s + 6], sx[8 * s + 7]); \
            const bf16x8 pf = __builtin_bit_cast(bf16x8, pw); \
            LAS unsigned char* vp = vb + (32 * kb2 + 16 * s) * AT_VSTR; \
            const bf16x8 v0 = cat4(__builtin_amdgcn_ds_read_tr16_b64_v4i16((LAS s16x4*)vp), __builtin_amdgcn_ds_read_tr16_b64_v4i16((LAS s16x4*)(vp + 8 * AT_VSTR))); \
            const bf16x8 v1 = cat4(__builtin_amdgcn_ds_read_tr16_b64_v4i16((LAS s16x4*)(vp + 64)), __builtin_amdgcn_ds_read_tr16_b64_v4i16((LAS s16x4*)(vp + 64 + 8 * AT_VSTR))); \
            O0 = MFMA32(v0, pf, O0); O1 = MFMA32(v1, pf, O1); } } while (0)
#define AT_SOFTMAX_PV(s0, s1, buf) do { AT_MAX(s0, s1); AT_EXP(s0, s1); AT_PV(s0, s1, buf); } while (0)
#define AT_FUSED(c0, c1, n0, n1, bufK, bufV) do { AT_QK1(n0, bufK, 0); AT_MAX(c0, c1); __builtin_amdgcn_sched_barrier(0); \
        AT_QK1(n1, bufK, 1); AT_EXP(c0, c1); __builtin_amdgcn_sched_barrier(0); AT_PV(c0, c1, bufV); } while (0)
    AttnStage RA, RB;
    f32x16 a0, a1, b0, b1;
    AT_LOADK(RA, 0); AT_LOADV(RA, 0); AT_LOADK(RB, 1);
    AT_WRITEK(RA, 0); AT_WRITEV(RA, 0); AT_WRITEK(RB, 1);
    AT_LOADK(RA, 2); AT_LOADV(RA, 1);
    __syncthreads();
    AT_QK(a0, a1, 0);
    const int nmain = 4 * qb, jv = w >> 1;
    int t = 0;
#pragma unroll 1
    for (; t < nmain; t += 2) {
        AT_LOADK(RB, t + 3); AT_LOADV(RB, t + 2);
        AT_FUSED(a0, a1, b0, b1, 1, 0);
        AT_WRITEK(RA, 0); AT_WRITEV(RA, 1);
        __syncthreads();
        AT_LOADK(RA, t + 4); AT_LOADV(RA, t + 3);
        AT_FUSED(b0, b1, a0, a1, 0, 1);
        AT_WRITEK(RB, 1); AT_WRITEV(RB, 0);
        __syncthreads();
    }
    AT_LOADK(RB, t + 3); AT_LOADV(RB, t + 2);
    if (jv >= 1) AT_QK(b0, b1, 1);
    AT_SOFTMAX_PV(a0, a1, 0);
    AT_WRITEK(RA, 0); AT_WRITEV(RA, 1);
    __syncthreads();
    AT_LOADV(RA, t + 3);
    if (jv >= 2) AT_QK(a0, a1, 0);
    if (jv >= 1) AT_SOFTMAX_PV(b0, b1, 1);
    AT_WRITEK(RB, 1); AT_WRITEV(RB, 0);
    __syncthreads();
    if (jv >= 3) AT_QK(b0, b1, 1);
    if (jv >= 2) AT_SOFTMAX_PV(a0, a1, 0);
    AT_WRITEV(RA, 1);
    __syncthreads();
    if (jv >= 3) AT_SOFTMAX_PV(b0, b1, 1);
    __syncthreads();
#undef AT_LOADK
#undef AT_LOADV
#undef AT_WRITEK
#undef AT_WRITEV
#undef AT_QK
#undef AT_SOFTMAX_PV
#undef AT_QK1
#undef AT_MAX
#undef AT_EXP
#undef AT_PV
#undef AT_FUSED
    const float linv = 1.f / (lrun + __shfl_xor(lrun, 32));
    bf16_t* op = T.SZOG + (size_t)(row0 + r) * 1024 + 64 * h + 4 * hh;
#pragma unroll
    for (int db = 0; db < 2; ++db)
#pragma unroll
        for (int g4 = 0; g4 < 4; ++g4) {
            const f32x16& ox = db ? O1 : O0; bf16_t* p = op + 32 * db + 8 * g4;
            const u32x2 z = *(const u32x2*)p; u32x2 o;
            o.x = pk2(ox[4 * g4 + 0] * linv * bflo(z.x), ox[4 * g4 + 1] * linv * bfhi(z.x)); o.y = pk2(ox[4 * g4 + 2] * linv * bflo(z.y), ox[4 * g4 + 3] * linv * bfhi(z.y));
            if (!dry) *(u32x2*)p = o;
        }
}
DI void attn_phase(LAS unsigned char* lds, const AttnT& T, int cu, int dry) {
    const int bh = (cu & 7) + 8 * (cu >> 4), half = (cu >> 3) & 1, b = bh >> 4, h = bh & 15;
#if QFUSE
    {
        const int tid = tidx();
#pragma unroll
        for (int i = 0; i < 9; ++i) { const int e = tid + i * NTHR, row = e / 48, ch = e % 48; *(LAS u32x4*)(lds + AT_WQOFF + row * AT_WQS + 16 * ch) = *(const u32x4*)(T.WQ + (size_t)(96 * h + row) * 384 + 8 * ch); }
        __syncthreads();
    }
#endif
#pragma unroll 1
    for (int ui = 0; ui < 4; ++ui) attn_unit(lds, T, b, h, ((half ? AT_ORD1 : AT_ORD0) >> (4 * ui)) & 0xF, dry);
}

DI void conv_phase(const bf16_t* CH, bf16_t* BZ, const float* cw, int gt, int NGT, int dry) {
    for (int it = gt; it < (M / 8) * 128; it += NGT) {
        const int c8 = (it & 127) * 8, m0 = (it >> 7) * 8, t0 = m0 & (S - 1);
        const f32x4 w0a = *(const f32x4*)(cw + c8), w0b = *(const f32x4*)(cw + c8 + 4), w1a = *(const f32x4*)(cw + 1024 + c8), w1b = *(const f32x4*)(cw + 1024 + c8 + 4), w2a = *(const f32x4*)(cw + 2048 + c8), w2b = *(const f32x4*)(cw + 2048 + c8 + 4);
        u32x4 ch[10], bz[8];
#pragma unroll
        for (int r = 0; r < 10; ++r) { const int m = m0 - 2 + r; ch[r] = (r >= 2 || t0 > 0) ? *(const u32x4*)(CH + (size_t)m * 1024 + c8) : (u32x4){0u, 0u, 0u, 0u}; }
#pragma unroll
        for (int r = 0; r < 8; ++r) bz[r] = *(const u32x4*)(BZ + (size_t)(m0 + r) * 1024 + c8);
        f32x4 pa, pb, qa, qb;
        unpk8(ch[0], pa, pb); unpk8(ch[1], qa, qb);
#pragma unroll
        for (int r = 0; r < 8; ++r) {
            f32x4 ca, cb, ba, bb; unpk8(ch[r + 2], ca, cb); unpk8(bz[r], ba, bb);
            const f32x4 ya = w0a * pa + w1a * qa + w2a * ca, yb = w0b * pb + w1b * qb + w2b * cb;
            const u32x4 ov = pk8(ba * ya, bb * yb); if (!dry) *(u32x4*)(BZ + (size_t)(m0 + r) * 1024 + c8) = ov;
            pa = qa; pb = qb; qa = ca; qb = cb;
        }
    }
}

DI void gates_phase(const bf16_t* XB, const u64* ssq_x, const float* Wg8, const float* bg, float* IG, float* LF, int gw, int NGW, int lane) {
    f32x4 wv[8][2][2];
#pragma unroll
    for (int j = 0; j < 8; ++j)
#pragma unroll
        for (int half = 0; half < 2; ++half) { const int k0 = half * 512 + lane * 8; wv[j][half][0] = *(const f32x4*)(Wg8 + j * 1024 + k0); wv[j][half][1] = *(const f32x4*)(Wg8 + j * 1024 + k0 + 4); }
    float bgv[8];
#pragma unroll
    for (int j = 0; j < 8; ++j) bgv[j] = bg[j];
    for (int m = gw; m < M; m += NGW) {
        float acc[8];
#pragma unroll
        for (int j = 0; j < 8; ++j) acc[j] = 0.f;
        const u32x4 xw0 = *(const u32x4*)(XB + (size_t)m * 1024 + lane * 8), xw1 = *(const u32x4*)(XB + (size_t)m * 1024 + 512 + lane * 8);
#pragma unroll
        for (int half = 0; half < 2; ++half) {
            f32x4 xa, xb2; unpk8(half ? xw1 : xw0, xa, xb2);
#pragma unroll
            for (int j = 0; j < 8; ++j) { const f32x4 wa = wv[j][half][0], wb = wv[j][half][1];
                acc[j] += (xa[0] * wa[0] + xa[1] * wa[1]) + (xa[2] * wa[2] + xa[3] * wa[3]) + (xb2[0] * wb[0] + xb2[1] * wb[1]) + (xb2[2] * wb[2] + xb2[3] * wb[3]); }
        }
        const float rs = ssq_rstd(ssq_x + m, 1.f / 1024.f);
#pragma unroll
        for (int j = 0; j < 8; ++j) acc[j] = wave_sum(acc[j]) * rs + bgv[j];
        if (lane == 0) {
            *(f32x4*)(IG + (size_t)m * 4) = (f32x4){acc[0], acc[1], acc[2], acc[3]};
            f32x4 lf;
#pragma unroll
            for (int j = 0; j < 4; ++j) { const float x = acc[4 + j]; lf[j] = fminf(x, 0.f) - log1pf(__expf(-fabsf(x))); }
            *(f32x4*)(LF + (size_t)m * 4) = lf;
        }
    }
}
DI void gw8_prep(const float* w_in, const float* g, float* Wg8, int gt, int NGT) {
    for (int i = gt; i < 8 * 1024; i += NGT) { const int j = i >> 10, k = i & 1023; Wg8[i] = w_in[(size_t)k * 8200 + 8192 + j] * g[k]; }
}

constexpr int SC_QSTR = 528, SC_VSTR = 136  , SC_VVSTR = 144  ;
constexpr int SC_QS = 0, SC_KS = 64 * SC_QSTR, SC_VS = 2 * 64 * SC_QSTR, SC_SP = SC_VS + 64 * SC_VVSTR, SC_QCX = SC_SP + 64 * SC_VSTR, SC_GT = SC_QCX + 16384, SC_VEC = SC_GT + 3 * 32 * 64 * 4 + 512, SC_OT = SC_VEC + (832 + 512) * 4;
constexpr int G_B = 0, G_CC = 2048, G_PM = 4096, G_SC = 6144;
constexpr int V_QNP = 0  , V_RS = 512  , V_WS = 768, V_WH = 832  ;
constexpr int SC_END = SC_OT + 64 * SC_VVSTR;
struct ScanT { const bf16_t *Q, *K, *VT; bf16_t* OG; const float *IG, *LF; };
DI float scan_add(float v, int lane) {
#pragma unroll
    for (int o = 1; o < 64; o <<= 1) { const float t = __shfl_up(v, o); if (lane >= o) v += t; }
    return v;
}
DI float scan_max(float v, int lane) {
#pragma unroll
    for (int o = 1; o < 64; o <<= 1) { const float t = __shfl_up(v, o); if (lane >= o) v = fmaxf(v, t); }
    return v;
}
DI void scan_item(LAS unsigned char* lds, const ScanT& T, int b, int h, int sl, int dry) {
    const int tid0 = tidx(), w = __builtin_amdgcn_readfirstlane(tid0 >> 6), g = w >> 2, c = w & 3;
    int tid = tid0, lane = tid & 63, l15 = lane & 15, q = lane >> 4;
    const int tok0 = b * S;
    LAS float* vec = (LAS float*)(lds + SC_VEC);
    LAS float* gt = (LAS float*)(lds + SC_GT);
    f32x4 Cacc[8];
#pragma unroll
    for (int i = 0; i < 8; ++i) Cacc[i] = (f32x4){0.f, 0.f, 0.f, 0.f};
    f32x4 nacc[2] = {(f32x4){0.f, 0.f, 0.f, 0.f}, (f32x4){0.f, 0.f, 0.f, 0.f}};
    u32x4 sQ[4], sK[4], sV;
    const int vd = tid >> 3, vch = tid & 7;
    const bf16_t* gQ = T.Q + (size_t)tok0 * 1024 + 256 * h;
    const bf16_t* gK = T.K + (size_t)tok0 * 1024 + 256 * h;
    const bf16_t* gV = T.VT + (size_t)(tok0 + vd) * 2048 + 512 * h + 64 * sl + 8 * vch;
#define SC_LOAD(ci) do { _Pragma("unroll") for (int i = 0; i < 4; ++i) { const int e = tid + i * NTHR, row = e >> 5, ch = e & 31; \
        sQ[i] = *(const u32x4*)(gQ + (size_t)((ci) * 64 + row) * 1024 + 8 * ch); sK[i] = *(const u32x4*)(gK + (size_t)((ci) * 64 + row) * 1024 + 8 * ch); } \
        sV = *(const u32x4*)(gV + (size_t)(ci) * 64 * 2048); } while (0)
    u32x4 sOG;
    bf16_t* gOG = T.OG + (size_t)(tok0 + vd) * 2048 + 512 * h + 64 * sl + 8 * vch;
#define SC_LOADOG(ci) do { sOG = *(const u32x4*)(gOG + (size_t)(ci) * 64 * 2048); } while (0)
    SC_LOAD(0); SC_LOADOG(0);
    {
        float lfv[4], igv[4];
#pragma unroll
        for (int k = 0; k < 4; ++k) { const size_t gi = (size_t)(tok0 + (w + 8 * k) * 64 + lane) * 4 + h; lfv[k] = T.LF[gi]; igv[k] = T.IG[gi]; }
#pragma unroll
        for (int k = 0; k < 4; ++k) {
            const int ck = w + 8 * k; const float bb = scan_add(lfv[k], lane), cc = igv[k] - bb, pm = scan_max(cc, lane);
            gt[G_B + ck * 64 + lane] = bb; gt[G_CC + ck * 64 + lane] = cc; gt[G_PM + ck * 64 + lane] = pm;
            if (lane == 63) { gt[G_SC + ck * 4 + 0] = bb; gt[G_SC + ck * 4 + 1] = pm; }
        }
        __syncthreads();
        if (tid == 0) { float m = 0.f;
#pragma unroll 1
            for (int ck = 0; ck < 32; ++ck) { const float bl = gt[G_SC + ck * 4], cm = gt[G_SC + ck * 4 + 1]; gt[G_SC + ck * 4 + 2] = m; m = fmaxf(bl + m, bl + cm); gt[G_SC + ck * 4 + 3] = m; } }
        __syncthreads();
    }
    for (int ci = 0; ci < S / 64; ++ci) {
        tid = tid0; asm volatile("" : "+v"(tid)); lane = tid & 63; l15 = lane & 15; q = lane >> 4;
#pragma unroll
        for (int i = 0; i < 4; ++i) { const int e = tid + i * NTHR, row = e >> 5, ch = e & 31; *(LAS u32x4*)(lds + SC_QS + row * SC_QSTR + 16 * ch) = sQ[i]; *(LAS u32x4*)(lds + SC_KS + row * SC_QSTR + 16 * ch) = sK[i]; }
        *(LAS u32x4*)(lds + SC_VS + vd * SC_VVSTR + 16 * vch) = sV;
        if (ci > 0 && !dry) *(u32x4*)(gOG + (size_t)(ci - 1) * 64 * 2048) = *(const LAS u32x4*)(lds + SC_OT + vd * SC_VVSTR + 16 * vch);
        *(LAS u32x4*)(lds + SC_OT + vd * SC_VVSTR + 16 * vch) = sOG;
        const f32x4 scal = *(const LAS f32x4*)(gt + G_SC + ci * 4);
        const float m_c = scal[2], blast = scal[0], mnew = scal[3];
        const LAS float* gB = gt + G_B + ci * 64; const LAS float* gC = gt + G_CC + ci * 64; const LAS float* gP = gt + G_PM + ci * 64;
        __syncthreads();
        if (ci + 1 < S / 64) SC_LOAD(ci + 1);
        {
            const int sb = w >> 1;
#pragma unroll
            for (int tt = 0; tt < 2; ++tt) {
                const int tb = 2 * (w & 1) + tt;
                const int t = 16 * tb + l15, s0 = 16 * sb + 4 * q;
                if (sb <= tb) {
                    f32x4 a4 = (f32x4){0.f, 0.f, 0.f, 0.f};
#pragma unroll
                    for (int ks = 0; ks < 8; ++ks) {
                        const bf16x8 ka = *(const LAS bf16x8*)(lds + SC_KS + (16 * sb + l15) * SC_QSTR + 64 * ks + 16 * q);
                        const bf16x8 qb2 = *(const LAS bf16x8*)(lds + SC_QS + (16 * tb + l15) * SC_QSTR + 64 * ks + 16 * q);
                        a4 = MFMA16(ka, qb2, a4);
                    }
                    const float a2 = -fmaxf(m_c, gP[t]) * LOG2E; const f32x4 c2 = *(const LAS f32x4*)(gC + s0);
                    float rsum = 0.f;
#pragma unroll
                    for (int r2 = 0; r2 < 4; ++r2) { const float wgt = (s0 + r2 <= t) ? ex2(a2 + c2[r2] * LOG2E) : 0.f; a4[r2] *= wgt; rsum += a4[r2]; }
                    u32x2 pw; pw.x = pk2(a4[0], a4[1]); pw.y = pk2(a4[2], a4[3]);
                    *(LAS u32x2*)(lds + SC_SP + t * SC_VSTR + s0 * 2) = pw;
                    rsum = red_fq(rsum); if (q == 0) vec[V_RS + 64 * sb + t] = rsum;
                } else {
                    *(LAS u32x2*)(lds + SC_SP + t * SC_VSTR + s0 * 2) = (u32x2){0u, 0u};
                    if (q == 0) vec[V_RS + 64 * sb + t] = 0.f;
                }
            }
        }
        f32x4 qc[4];
        {
            bf16x8 cf[4]; f32x4 qnp[4];
            u32x4 nw; nw.x = pk2(nacc[0][0], nacc[0][1]); nw.y = pk2(nacc[0][2], nacc[0][3]); nw.z = pk2(nacc[1][0], nacc[1][1]); nw.w = pk2(nacc[1][2], nacc[1][3]);
            const bf16x8 nf = __builtin_bit_cast(bf16x8, nw);
#pragma unroll
            for (int ks = 0; ks < 4; ++ks) { u32x4 cw; cw.x = pk2(Cacc[2 * ks][0], Cacc[2 * ks][1]); cw.y = pk2(Cacc[2 * ks][2], Cacc[2 * ks][3]); cw.z = pk2(Cacc[2 * ks + 1][0], Cacc[2 * ks + 1][1]); cw.w = pk2(Cacc[2 * ks + 1][2], Cacc[2 * ks + 1][3]); cf[ks] = __builtin_bit_cast(bf16x8, cw); }
#pragma unroll
            for (int tb = 0; tb < 4; ++tb) {
                qc[tb] = (f32x4){0.f, 0.f, 0.f, 0.f}; qnp[tb] = (f32x4){0.f, 0.f, 0.f, 0.f};
#pragma unroll
                for (int ks = 0; ks < 4; ++ks) {
                    const LAS unsigned char* qp = lds + SC_QS + (16 * tb + l15) * SC_QSTR + (128 * g + 32 * ks + 4 * q) * 2;
                    const bf16x8 qa = cat4(*(const LAS s16x4*)qp, *(const LAS s16x4*)(qp + 32));
                    qc[tb] = MFMA16(cf[ks], qa, qc[tb]);
                    if (ks == c) qnp[tb] = MFMA16(nf, qa, qnp[tb]);
                }
            }
            if (q == 0) {
#pragma unroll
                for (int tb = 0; tb < 4; ++tb) vec[V_QNP + w * 64 + 16 * tb + l15] = qnp[tb][0];
            }
            LAS f32x4* qx = (LAS f32x4*)(lds + SC_QCX) + (w * 2) * 64 + lane;
            qx[0] = g ? qc[0] : qc[2]; qx[64] = g ? qc[1] : qc[3];
        }
        if (tid < 64) vec[V_WS + tid] = __expf(blast + gC[tid] - mnew);
        __syncthreads();
        bf16x8 vf[2];
#pragma unroll
        for (int ks = 0; ks < 2; ++ks) { LAS unsigned char* vp = lds + SC_VS + (32 * ks + 8 * q + (l15 >> 2)) * SC_VVSTR + (16 * c + 4 * (lane & 3)) * 2;
            vf[ks] = cat4(__builtin_amdgcn_ds_read_tr16_b64_v4i16((LAS s16x4*)vp), __builtin_amdgcn_ds_read_tr16_b64_v4i16((LAS s16x4*)(vp + 4 * SC_VVSTR))); }
        {
            LAS float* wh = vec + V_WH + w * 64;
            if (lane < 32) {
                const int t = 32 * g + lane; float qn = 0.f, rs = 0.f;
#pragma unroll
                for (int k = 0; k < 8; ++k) qn += vec[V_QNP + 64 * k + t];
#pragma unroll
                for (int k = 0; k < 4; ++k) rs += vec[V_RS + 64 * k + t];
                const float mxv = fmaxf(m_c, gP[t]), wi = __expf(m_c - mxv), em = __expf(-gB[t] - mxv);
                wh[lane] = wi; wh[32 + lane] = __builtin_amdgcn_rcpf(fmaxf(fabsf(wi * qn + rs), em));
            }
            const LAS f32x4* px = (const LAS f32x4*)(lds + SC_QCX) + ((w ^ 4) * 2) * 64 + lane;
#define SC_FIN(tt, QCV) do { const int tb = 2 * g + (tt); \
                f32x4 sv = (f32x4){0.f, 0.f, 0.f, 0.f}; \
                _Pragma("unroll") for (int ks = 0; ks < 2; ++ks) { const LAS unsigned char* sp = lds + SC_SP + (16 * tb + l15) * SC_VSTR + 64 * ks + 16 * q; const bf16x8 sa = cat4(*(const LAS s16x4*)sp, *(const LAS s16x4*)(sp + 8)); sv = MFMA16(vf[ks], sa, sv); } \
                const f32x4 qct = (QCV) + px[64 * (tt)]; \
                const float wi = wh[16 * (tt) + l15], hi_ = wh[32 + 16 * (tt) + l15]; \
                LAS u32x2* op = (LAS u32x2*)(lds + SC_OT + (16 * tb + l15) * SC_VVSTR + (16 * c + 4 * q) * 2); const u32x2 ogw = *op; \
                u32x2 ow; ow.x = pk2((wi * qct[0] + sv[0]) * hi_ * bflo(ogw.x), (wi * qct[1] + sv[1]) * hi_ * bfhi(ogw.x)); ow.y = pk2((wi * qct[2] + sv[2]) * hi_ * bflo(ogw.y), (wi * qct[3] + sv[3]) * hi_ * bfhi(ogw.y)); \
                *op = ow; } while (0)
            if (g) { SC_FIN(0, qc[2]); SC_FIN(1, qc[3]); } else { SC_FIN(0, qc[0]); SC_FIN(1, qc[1]); }
#undef SC_FIN
        }
        if (ci + 1 < S / 64) SC_LOADOG(ci + 1);
        {
            const float decay = __expf(blast + m_c - mnew);
            bf16x8 vw[2], wsf[2];
#pragma unroll
            for (int ks = 0; ks < 2; ++ks) {
                const f32x4 w0 = *(const LAS f32x4*)(vec + V_WS + 32 * ks + 8 * q), w1 = *(const LAS f32x4*)(vec + V_WS + 32 * ks + 8 * q + 4);
                f32x4 x0, x1; unpk8(__builtin_bit_cast(u32x4, vf[ks]), x0, x1); vw[ks] = __builtin_bit_cast(bf16x8, pk8(x0 * w0, x1 * w1));
                const u32x4 wz = pk8(w0, w1); wsf[ks] = __builtin_bit_cast(bf16x8, l15 == 0 ? wz : (u32x4){0u, 0u, 0u, 0u});
            }
#pragma unroll
            for (int i = 0; i < 8; ++i) {
                if ((i & 1) == 0) __builtin_amdgcn_sched_barrier(0);
                Cacc[i] *= decay;
#pragma unroll
                for (int ks = 0; ks < 2; ++ks) {
                    LAS unsigned char* kp = lds + SC_KS + (32 * ks + 8 * q + (l15 >> 2)) * SC_QSTR + (128 * g + 16 * i + 4 * (lane & 3)) * 2;
                    const s16x4 lo = __builtin_amdgcn_ds_read_tr16_b64_v4i16((LAS s16x4*)kp), hi = __builtin_amdgcn_ds_read_tr16_b64_v4i16((LAS s16x4*)(kp + 4 * SC_QSTR));
                    Cacc[i] = MFMA16(cat4(lo, hi), vw[ks], Cacc[i]);
                }
            }
#pragma unroll
            for (int ib = 0; ib < 2; ++ib) {
                nacc[ib] *= decay;
#pragma unroll
                for (int ks = 0; ks < 2; ++ks) {
                    LAS unsigned char* kp = lds + SC_KS + (32 * ks + 8 * q + (l15 >> 2)) * SC_QSTR + (128 * g + 16 * (2 * c + ib) + 4 * (lane & 3)) * 2;
                    const s16x4 lo = __builtin_amdgcn_ds_read_tr16_b64_v4i16((LAS s16x4*)kp), hi = __builtin_amdgcn_ds_read_tr16_b64_v4i16((LAS s16x4*)(kp + 4 * SC_QSTR));
                    nacc[ib] = MFMA16(cat4(lo, hi), wsf[ks], nacc[ib]);
                }
            }
        }
        __syncthreads();
    }
    if (!dry) *(u32x4*)(gOG + (size_t)(S / 64 - 1) * 64 * 2048) = *(const LAS u32x4*)(lds + SC_OT + vd * SC_VVSTR + 16 * vch);
    __syncthreads();
#undef SC_LOAD
#undef SC_LOADOG
}
DI void scan_phase(LAS unsigned char* lds, const ScanT& T, int cu, int dry) {
    const int xcd = cu & 7, idx = cu >> 3, bh = xcd * 4 + (idx >> 3), sl = idx & 7;
    scan_item(lds, T, bh >> 2, bh & 3, sl, dry);
}

DI void final_phase(const bf16_t* xb, float* out, const u64* ssq, const float* g, int gw, int NGW, int lane) {
    for (int m = gw; m < M; m += NGW) {
        const float rs = ssq_rstd(ssq + m, 1.f / 1024.f);
#pragma unroll
        for (int j = 0; j < 2; ++j) {
            const int c0 = (lane + 64 * j) * 8; f32x4 a, b; unpk8(*(const u32x4*)(xb + (size_t)m * D + c0), a, b);
            *(f32x4*)(out + (size_t)m * D + c0) = a * rs * *(const f32x4*)(g + c0); *(f32x4*)(out + (size_t)m * D + c0 + 4) = b * rs * *(const f32x4*)(g + c0 + 4);
        }
    }
}
constexpr int LDS_BYTES = 147456, MISC_OFF = 146944;
static_assert(SC_END <= MISC_OFF && AT_WQOFF + 96 * AT_WQS <= MISC_OFF && AT_WQOFF == 2 * AT_KB + 2 * AT_VB, "LDS map");
constexpr int PH_PER_LAYER = 6, PH_FINAL = 1 + 4 * PH_PER_LAYER, PH_REFRESH = 100;
#ifndef GEMM_ALIGN
#define GEMM_ALIGN true
#endif
#ifndef GEMM_SP2
#define GEMM_SP2 true
#endif
#ifndef C1_DRYMODE
#define C1_DRYMODE 1
#endif
#ifndef BAR_TWICE
#define BAR_TWICE 0
#endif
#ifndef STAGGER
#define STAGGER 0
#endif
#ifndef STAGGER_MASK
#define STAGGER_MASK 3
#endif
#ifndef STAGGER_L1
#define STAGGER_L1 0
#endif
#define STAGGER_SLEEP_N(n_) do { if (n_) { for (int s_ = 0; s_ < (int)(((cu >> 3) & STAGGER_MASK) * (n_)); ++s_) __builtin_amdgcn_s_sleep(32); } } while (0)
#define STAGGER_SLEEP() STAGGER_SLEEP_N(STAGGER)
#ifndef PP_HOLES
#define PP_HOLES 0
#endif
#ifndef A2_REV
#define A2_REV 1
#endif
#ifndef A2_QREV
#define A2_QREV 0
#endif
#ifndef GEMM_ALIGN1
#define GEMM_ALIGN1 GEMM_ALIGN
#endif
#ifndef P0_ORDER
#define P0_ORDER 0
#endif
#ifndef PHM
#define PHM 0xFFFF
#endif
#define PH_ON(b) ((PHM >> (b)) & 1)
#ifndef REPEAT
#define REPEAT 0
#endif
#ifndef REPEAT_AFTER
#define REPEAT_AFTER 0
#endif
#if REPEAT_AFTER
#define REP_LOOP(b) for (int rep_ = 0, nrep_ = opaque((REPEAT >> (b)) & 1); rep_ <= nrep_; ++rep_)
#else
#define REP_LOOP(b) for (int rep_ = opaque((REPEAT >> (b)) & 1); rep_ >= 0; --rep_)
#endif
typedef const __attribute__((address_space(4))) Args* KArgs;
DI KArgs kargs() { KArgs p = (KArgs)__builtin_amdgcn_kernarg_segment_ptr(); asm volatile("" : "+s"(p)); return p; }

#define TID_DEFS const int tid = tidx(), w = __builtin_amdgcn_readfirstlane(tid >> 6), lane = tid & 63; (void)w; (void)lane
DI void prep_mixer(LAS unsigned char* lds, int i, int cu, int G) {
    TID_DEFS; KArgs A = kargs(); unsigned char* ws = A->ws; LAS float* scr = (LAS float*)lds;
    const int kind = i % 3, j = i / 3;
    const float* normg = A->in[I_NORMG] + (size_t)i * D; bf16_t* wmix = (bf16_t*)(ws + WS_WMIX);
    if (kind == 0) {
        constexpr int n0 = 28 * 8, n1 = 24 * 3, n2 = 32 * 2, n3 = 16 * 8;
#pragma unroll 1
        for (int it = cu; it < n0 + n1 + n2 + n3; it += G) {
            if (it < n0) prep_tile(PrepTask{A->in[I_MLA_WIN] + (size_t)j * D * 1696, 1696, normg, D, 1792, PM_MLA_IN, wmix}, it, scr);
            else if (it < n0 + n1) prep_tile(PrepTask{A->in[I_MLA_WQB] + (size_t)j * 384 * 1536, 1536, A->in[I_MLA_QN] + j * 384, 384, 1536, PM_MLA_QB, (bf16_t*)(ws + WS_WMIX + WM_QB)}, it - n0, scr);
            else if (it < n0 + n1 + n2) prep_tile(PrepTask{A->in[I_MLA_WKVB] + (size_t)j * 256 * 2048, 2048, A->in[I_MLA_KVN] + j * 256, 256, 2048, PM_MLA_KVB, (bf16_t*)(ws + WS_WMIX + WM_KVB)}, it - n0 - n1, scr);
            else prep_tile(PrepTask{A->in[I_MLA_WOUT] + (size_t)j * D * D, D, nullptr, D, D, PM_ID, (bf16_t*)(ws + WS_WMIX + WM_OUT_MLA)}, it - n0 - n1 - n2, scr);
        }
    } else if (kind == 1) {
        constexpr int n0 = 64 * 8, n1 = 16 * 8;
#pragma unroll 1
        for (int it = cu; it < n0 + n1; it += G) {
            if (it < n0) prep_tile(PrepTask{A->in[I_CONV_WIN] + (size_t)j * D * 4096, 4096, normg, D, 4096, PM_CONV_IN, wmix}, it, scr);
            else prep_tile(PrepTask{A->in[I_CONV_WOUT] + (size_t)j * D * D, D, nullptr, D, D, PM_ID, (bf16_t*)(ws + WS_WMIX + WM_OUT_CONV)}, it - n0, scr);
        }
    } else {
        constexpr int n0 = 128 * 8, n1 = 16 * 16;
#pragma unroll 1
        for (int it = cu; it < n0 + n1; it += G) {
            if (it < n0) prep_tile(PrepTask{A->in[I_L_WIN] + (size_t)j * D * 8200, 8200, normg, D, 8192, PM_LSTM_IN, wmix}, it, scr);
            else prep_tile(PrepTask{A->in[I_L_WOUT] + (size_t)j * 2048 * D, D, nullptr, 2048, D, PM_ID, (bf16_t*)(ws + WS_WMIX + WM_OUT_LSTM)}, it - n0, scr);
        }
        gw8_prep(A->in[I_L_WIN] + (size_t)j * D * 8200, normg, (float*)(ws + WS_GW8), cu * NTHR + tid, G * NTHR);
    }
    if (kind != 2) p_to_bf16(A->in[I_P] + (size_t)i * M * 256, (bf16_t*)(ws + WS_BIG + A_PB), cu * NTHR + tid, G * NTHR);
#pragma unroll 1
    for (int it = cu; it < 16 * 2; it += G) prep_tile(PrepTask{A->in[I_PLE_PROJ] + (size_t)i * 256 * D, D, nullptr, 256, D, PM_ID, (bf16_t*)(ws + WS_WPLE + 2 * MiB)}, it, scr);
}
DI void prep_ple(LAS unsigned char* lds, int i, int cu, int G) {
    KArgs A = kargs(); unsigned char* ws = A->ws; LAS float* scr = (LAS float*)lds;
#pragma unroll 1
    for (int it = cu; it < 16 * 8; it += G) prep_tile(PrepTask{A->in[I_PLE_GATE] + (size_t)i * D * D, D, nullptr, D, D, PM_ID, (bf16_t*)(ws + WS_WPLE)}, it, scr);
}

__global__ void __launch_bounds__(NTHR, 2) fwd(Args a_) {
    extern __shared__ __attribute__((aligned(16))) unsigned char lds_[];
    LAS unsigned char* lds = (LAS unsigned char*)lds_;
    const int cu = blockIdx.x, G = gridDim.x;
#define GW (cu * 8 + w)
#define NGW (G * 8)
#define GT (cu * NTHR + tid)
#define NGT (G * NTHR)
    const int lo = a_.ph_lo, hi = a_.ph_hi;
    volatile LAS unsigned* misc = (volatile LAS unsigned*)(lds + MISC_OFF);
    { TID_DEFS; if (tid < 32) misc[tid] = 0u; }
    __syncthreads();
    const bool multi = (hi - lo) > 1;
    XcdBarrier bar; bar.bar = nullptr; bar.x = 0; bar.st = misc + 8;
    if (multi) bar = xcd_barrier_post((unsigned*)(kargs()->ws + WS_CTL), misc + 8);
#define IN(k) (lo <= (k) && (k) < hi)
#ifdef TIMELINE
#define STAMP(idx) do { if (blockIdx.x == 0 && threadIdx.x == 0) ((unsigned long long*)(kargs()->ws + WS_CTL + 32 * KiB))[(idx)] = __builtin_amdgcn_s_memrealtime(); } while (0)
#else
#define STAMP(idx) do { } while (0)
#endif
#define SEAM(k) do { if (multi && (k) + 1 < hi) { XcdBarrier b2 = bar; b2.bar = (unsigned*)(kargs()->ws + WS_CTL); xcd_barrier(b2); if (BAR_TWICE) xcd_barrier(b2); } STAMP((k) + 1); } while (0)

    STAMP(0);
    if (lo >= PH_REFRESH) {
        TID_DEFS; KArgs A = kargs(); const int i = lo - PH_REFRESH; rows_to_bf16_ssq(A->out, (bf16_t*)(A->ws + WS_XBA), ssq_arr(A->ws, SSQ_X + i), GW, NGW, lane); return;
    }
    if (IN(0)) {
#if P0_ORDER
        REP_LOOP(13) prep_mixer(lds, 0, cu, G);
        REP_LOOP(11) { TID_DEFS; KArgs A = kargs(); unsigned char* ws = A->ws; rows_to_bf16_ssq(A->in[I_X], (bf16_t*)(ws + WS_XBA), ssq_arr(ws, SSQ_X), GW, NGW, lane); }
        REP_LOOP(12) { TID_DEFS; KArgs A = kargs(); unsigned char* ws = A->ws; rope_tables((const int*)A->in[I_POS], (float*)(ws + WS_CS), (float*)(ws + WS_SN), GT, NGT); }
#else
        REP_LOOP(11) { TID_DEFS; KArgs A = kargs(); unsigned char* ws = A->ws; rows_to_bf16_ssq(A->in[I_X], (bf16_t*)(ws + WS_XBA), ssq_arr(ws, SSQ_X), GW, NGW, lane); }
        REP_LOOP(12) { TID_DEFS; KArgs A = kargs(); unsigned char* ws = A->ws; rope_tables((const int*)A->in[I_POS], (float*)(ws + WS_CS), (float*)(ws + WS_SN), GT, NGT); }
        REP_LOOP(13) prep_mixer(lds, 0, cu, G);
#endif
    }
    if (IN(0)) SEAM(0);
#pragma unroll 1
    for (int i = 0; i < 4; ++i) {
        const int kind = i % 3, j = i / 3, base = 1 + PH_PER_LAYER * i;
        if (hi <= base || lo >= base + PH_PER_LAYER) continue;
        if (IN(base + 1)) {
            REP_LOOP(0) prep_ple(lds, i, cu, G);
            if (kind == 0 && PH_ON(1)) {
                unsigned char* ws = kargs()->ws;
                pg8::Gemm g{(bf16_t*)(ws + WS_XBA), (bf16_t*)(ws + WS_WMIX), M, 1792, opaque(D)}; pg8::StaticOrder So; So.init(M, 1792, G, cu);
                EpiA1 E{ws, i, j}; STAGGER_SLEEP();
                pg8::gemm_phase<EpiA1, pg8::StaticOrder, GEMM_ALIGN, GEMM_SP2>(lds, g, So, E);
                if (PP_HOLES && G == 256 && cu >= 192) {
                    KArgs A2 = kargs(); unsigned char* ws2 = A2->ws;
                    pg8::Gemm g2{(bf16_t*)(ws2 + WS_BIG + A_PB), (bf16_t*)(ws2 + WS_WPLE + 2 * MiB), M, D, opaque(256)}; pg8::StaticOrder So2; So2.init(M, D, 64, cu - 192);
                    EpiPP E2{(bf16_t*)A2->out};
                    pg8::gemm_phase<EpiPP, pg8::StaticOrder, GEMM_ALIGN, GEMM_SP2>(lds, g2, So2, E2);
                }
            } else if (kind == 1 && PH_ON(2)) REP_LOOP(2) {
                unsigned char* ws = kargs()->ws;
                pg8::Gemm g{(bf16_t*)(ws + WS_XBA), (bf16_t*)(ws + WS_WMIX), M, 4096, opaque(D)}; pg8::StaticOrder So; So.init(M, 4096, G, cu);
                EpiC1 E{ws, i, rep_ * C1_DRYMODE}; STAGGER_SLEEP();
                pg8::gemm_phase<EpiC1, pg8::StaticOrder, GEMM_ALIGN, GEMM_SP2>(lds, g, So, E);
            } else if (kind == 2 && PH_ON(3)) REP_LOOP(3) {
                { TID_DEFS; KArgs A = kargs(); unsigned char* ws = A->ws;
                  gates_phase((bf16_t*)(ws + WS_XBA), ssq_arr(ws, SSQ_X + i), (const float*)(ws + WS_GW8), A->in[I_L_BG] + j * 8, (float*)(ws + WS_IG), (float*)(ws + WS_LF), GW, NGW, lane); }
                unsigned char* ws = kargs()->ws;
                pg8::Gemm g{(bf16_t*)(ws + WS_XBA), (bf16_t*)(ws + WS_WMIX), M, 8192, opaque(D)}; pg8::StaticOrder So; So.init(M, 8192, G, cu);
                EpiL1 E{ws, i}; STAGGER_SLEEP(); STAGGER_SLEEP_N(STAGGER_L1);
                pg8::gemm_phase<EpiL1, pg8::StaticOrder, GEMM_ALIGN, GEMM_SP2>(lds, g, So, E);
            }
            SEAM(base + 1);
        }
        if (IN(base + 2) && kind != 2) {
            if (kind == 0 && PH_ON(4)) REP_LOOP(4) {
                if (!QFUSE) { unsigned char* ws = kargs()->ws;
                  pg8::Gemm g{(bf16_t*)(ws + WS_BIG + A_CQ), (bf16_t*)(ws + WS_WMIX + WM_QB), M, 1536, opaque(384)}; pg8::StaticOrder So; So.init(M, 1536, G, A2_QREV ? G - 1 - cu : cu);
                  EpiQ E{ws, j};
                  pg8::gemm_phase<EpiQ, pg8::StaticOrder, GEMM_ALIGN, GEMM_SP2>(lds, g, So, E); }
                { unsigned char* ws = kargs()->ws;
                  pg8::Gemm g{(bf16_t*)(ws + WS_BIG + A_CKV), (bf16_t*)(ws + WS_WMIX + WM_KVB), M, 2048, opaque(256)}; pg8::StaticOrder So; So.init(M, 2048, G, A2_REV ? G - 1 - cu : cu);
                  EpiKV E{ws, j};
                  pg8::gemm_phase<EpiKV, pg8::StaticOrder, GEMM_ALIGN, GEMM_SP2>(lds, g, So, E); }
            } else if (kind == 1 && PH_ON(5)) REP_LOOP(5) {
                TID_DEFS; KArgs A = kargs(); unsigned char* ws = A->ws;
                conv_phase((const bf16_t*)(ws + WS_BIG + C_CH), (bf16_t*)(ws + WS_BIG + C_BZ), A->in[I_CONV_W] + (size_t)j * 3 * 1024, GT, NGT, rep_);
            }
            SEAM(base + 2);
        }
        if (IN(base + 3) && kind != 1) {
            if (kind == 0 && PH_ON(6)) REP_LOOP(6) {
                unsigned char* wsA = kargs()->ws; unsigned char* big = wsA + WS_BIG;
                AttnT T{(bf16_t*)(big + A_Q), (bf16_t*)(big + A_KN), (bf16_t*)(big + A_KR), (bf16_t*)(big + A_VT), (bf16_t*)(big + A_SZ),
                        (bf16_t*)(big + A_CQ), (bf16_t*)(wsA + WS_WMIX + WM_QB), ssq_arr(wsA, SSQ_Q + j), (const float*)(wsA + WS_CS), (const float*)(wsA + WS_SN)};
                attn_phase(lds, T, cu, rep_);
            } else if (kind == 2 && PH_ON(7)) {
                { unsigned char* ws = kargs()->ws; unsigned char* big = ws + WS_BIG;
                  ScanT T{(bf16_t*)(big + L_Q), (bf16_t*)(big + L_K), (bf16_t*)(big + L_VT), (bf16_t*)(big + L_OG), (float*)(ws + WS_IG), (float*)(ws + WS_LF)};
                  REP_LOOP(7) scan_phase(lds, T, cu, rep_); }
                TID_DEFS; KArgs A = kargs();
                p_to_bf16(A->in[I_P] + (size_t)i * M * 256, (bf16_t*)A->out, GT, NGT);
            }
            SEAM(base + 3);
        }
        if (IN(base + 4)) {
            const size_t xbb_off = kind == 0 ? A_XBB : kind == 1 ? C_XBB : L_XBB, pp_off = kind == 0 ? A_PP : kind == 1 ? C_PP : L_PP;
            if (PH_ON(8)) { KArgs A = kargs(); unsigned char* ws = A->ws;
              const size_t oin = kind == 0 ? A_SZ : kind == 1 ? C_BZ : L_OG, wout = kind == 2 ? WM_OUT_LSTM : WM_OUT_MLA;
              pg8::Gemm g{(bf16_t*)(ws + WS_BIG + oin), (bf16_t*)(ws + WS_WMIX + wout), M, D, opaque(kind == 2 ? 2048 : 1024)}; pg8::StaticOrder So; So.init(M, D, G, cu);
              EpiOut E{ws, xbb_off, i};
              pg8::gemm_phase<EpiOut, pg8::StaticOrder, GEMM_ALIGN1, GEMM_SP2>(lds, g, So, E); }
            if (PH_ON(9) && !(PP_HOLES && kind == 0 && G == 256)) REP_LOOP(9) { KArgs A = kargs(); unsigned char* ws = A->ws;
              pg8::Gemm g{kind == 2 ? (bf16_t*)A->out : (bf16_t*)(ws + WS_BIG + A_PB), (bf16_t*)(ws + WS_WPLE + 2 * MiB), M, D, opaque(256)}; pg8::StaticOrder So; So.init(M, D, G, cu);
              EpiPP E{(bf16_t*)(ws + WS_BIG + pp_off)};
              pg8::gemm_phase<EpiPP, pg8::StaticOrder, GEMM_ALIGN, GEMM_SP2>(lds, g, So, E); }
            SEAM(base + 4);
        }
        if (IN(base + 5)) {
            if (PH_ON(10)) { KArgs A = kargs(); unsigned char* ws = A->ws;
              const size_t xbb_off = kind == 0 ? A_XBB : kind == 1 ? C_XBB : L_XBB, pp_off = kind == 0 ? A_PP : kind == 1 ? C_PP : L_PP;
              const bf16_t* ppp = (PP_HOLES && kind == 0 && G == 256) ? (const bf16_t*)A->out : (const bf16_t*)(ws + WS_BIG + pp_off);
              pg8::Gemm g{(bf16_t*)(ws + WS_BIG + xbb_off), (bf16_t*)(ws + WS_WPLE), M, D, opaque(D)}; pg8::StaticOrder So; So.init(M, D, G, cu);
              if (i == 3 && multi && G == 256 && hi > PH_FINAL) {
                  EpiPleLast E{ws, A->out, A->in[I_FNORM], ppp, xbb_off, i, bar.x, bar.st};
                  pg8::gemm_phase<EpiPleLast, pg8::StaticOrder, false, GEMM_SP2>(lds, g, So, E);
              } else {
                  EpiPle E{ws, ppp, xbb_off, i};
                  pg8::gemm_phase<EpiPle, pg8::StaticOrder, GEMM_ALIGN1, GEMM_SP2>(lds, g, So, E); } }
            if (i < 3) REP_LOOP(1) prep_mixer(lds, i + 1, cu, G);
            if (!(i == 3 && multi && G == 256 && hi > PH_FINAL)) SEAM(base + 5);
        }
    }
    if (IN(PH_FINAL) && !(multi && G == 256 && lo <= PH_FINAL - 1)) { TID_DEFS; KArgs A = kargs(); final_phase((const bf16_t*)(A->ws + WS_XBA), A->out, ssq_arr(A->ws, SSQ_X + 4), A->in[I_FNORM], GW, NGW, lane); }
#ifdef TIMELINE
    {
        SEAM(PH_FINAL);
        TID_DEFS; KArgs A = kargs(); const unsigned long long* ts = (const unsigned long long*)(A->ws + WS_CTL + 32 * KiB);
        const float dA = (float)(ts[TS_A1] - ts[TS_A0]) * 0.01f, dB = (float)(ts[TS_B1] - ts[TS_B0]) * 0.01f;
        const float c = sqrtf(dA);
        for (size_t e = GT; e < (size_t)M * D; e += NGT) A->out[e] = (e == 0) ? 60.f + dB : c;
    }
#endif
#undef IN
#undef SEAM
}
}
#ifndef FAST_LAYERS
#define FAST_LAYERS 15
#endif
#ifndef ONE_LAUNCH
#define ONE_LAUNCH 1
#endif

extern "C" void kernel_launch(void* const* d_in, const int* in_sizes, int n_in, void* d_out, int out_size, void* d_ws, size_t ws_size, hipStream_t stream) {
    static int grid = 0;
    if (grid == 0) {
        int dev = 0, cus = 0;
        if (n_in != 19 || ws_size < fk::WS_END || out_size != fk::M * fk::D) { fprintf(stderr, "kernel_launch: unexpected shapes (n_in %d, ws %zu, out %d)\n", n_in, ws_size, out_size); grid = -1; return; }
        if (hipGetDevice(&dev) != hipSuccess || hipDeviceGetAttribute(&cus, hipDeviceAttributeMultiprocessorCount, dev) != hipSuccess) { grid = -1; return; }
        if (hipFuncSetAttribute((const void*)fk::fwd, hipFuncAttributeMaxDynamicSharedMemorySize, fk::LDS_BYTES) != hipSuccess) { fprintf(stderr, "kernel_launch: hipFuncSetAttribute failed\n"); grid = -1; return; }
        int per_cu = 0;
        if (hipOccupancyMaxActiveBlocksPerMultiprocessor(&per_cu, (const void*)fk::fwd, fk::NTHR, fk::LDS_BYTES) != hipSuccess || per_cu < 1) { fprintf(stderr, "kernel_launch: occupancy query says %d\n", per_cu); }
        (void)hipGetLastError();
        grid = cus;
        if (grid != 256) fprintf(stderr, "kernel_launch: %d CUs (built for 256)\n", grid);
    }
    if (grid < 0) return;
    (void)hipMemsetAsync(d_ws, 0, fk::ZERO_BYTES, stream);
    fk::Args a{};
    for (int i = 0; i < 19; ++i) a.in[i] = (const float*)d_in[i];
    a.out = (float*)d_out; a.ws = (unsigned char*)d_ws;
#define LAUNCH(lo_, hi_) do { a.ph_lo = (lo_); a.ph_hi = (hi_); hipLaunchKernelGGL(fk::fwd, dim3(grid), dim3(fk::NTHR), fk::LDS_BYTES, stream, a); } while (0)
#if ONE_LAUNCH && (FAST_LAYERS == 15)
#ifdef TIMELINE
    LAUNCH(0, fk::PH_FINAL + 2);
#else
    LAUNCH(0, fk::PH_FINAL + 1);
#endif
#else
    nv::In in;
    in.x = (const float*)d_in[0]; in.p = (const float*)d_in[1]; in.pos = (const int*)d_in[2]; in.norm_g = (const float*)d_in[3];
    in.mla_w_in = (const float*)d_in[4]; in.mla_q_norm = (const float*)d_in[5]; in.mla_w_q_b = (const float*)d_in[6];
    in.mla_kv_norm = (const float*)d_in[7]; in.mla_w_kv_b = (const float*)d_in[8]; in.mla_w_out = (const float*)d_in[9];
    in.conv_w_in = (const float*)d_in[10]; in.conv_w = (const float*)d_in[11]; in.conv_w_out = (const float*)d_in[12];
    in.mlstm_w_in = (const float*)d_in[13]; in.mlstm_b_gates = (const float*)d_in[14]; in.mlstm_w_out = (const float*)d_in[15];
    in.ple_proj = (const float*)d_in[16]; in.ple_gate = (const float*)d_in[17]; in.final_norm = (const float*)d_in[18];
    float* nws = (float*)((char*)d_ws + 2 * fk::MiB);
    LAUNCH(0, 1);
    for (int i = 0; i < 4; ++i) {
        if ((FAST_LAYERS >> i) & 1) {
            if (i > 0 && !((FAST_LAYERS >> (i - 1)) & 1)) LAUNCH(fk::PH_REFRESH + i, fk::PH_REFRESH + i + 1);
            for (int s = 0; s < fk::PH_PER_LAYER; ++s) LAUNCH(1 + fk::PH_PER_LAYER * i + s, 1 + fk::PH_PER_LAYER * i + s + 1);
        } else {
            nv::layer(in, (float*)d_out, nws, stream, i, i == 0);
        }
    }
    if ((FAST_LAYERS >> 3) & 1) LAUNCH(fk::PH_FINAL, fk::PH_FINAL + 1);
    else nv::final_norm(in, (float*)d_out, stream);
#endif
#undef LAUNCH
}
```

```cpp
#include <hip/hip_runtime.h>
#include <cstdio>
#include <cstdint>
#include <math.h>
#define LAS __attribute__((address_space(3)))
#define GAS __attribute__((address_space(1)))
#define FAST_LAYERS 15
#define ONE_LAUNCH 1
namespace pg8 {
#define PG8_LAS __attribute__((address_space(3)))
typedef unsigned short bf16_t;
typedef short bf16x8 __attribute__((ext_vector_type(8)));
typedef float f32x4 __attribute__((ext_vector_type(4)));
typedef unsigned u32x4 __attribute__((ext_vector_type(4)));
constexpr int BM = 256, BK = 64, HALF = 128, HTB = HALF * BK * 2  , STAGE_BYTES = 8 * HTB, NXCD = 8, WGM = 8;

__host__ __device__ __forceinline__ int lds_byte(int r, int c) { const int st = (r >> 4) * 2 + (c >> 5), rr = r & 15, cc = c & 31, ob = rr * 64 + cc * 2; return st * 1024 + (ob ^ (((ob >> 9) & 1) << 5)); }
__host__ __device__ __forceinline__ void stage_rc(int b, int& R, int& C) { const int st = b / 1024, sb = b % 1024, swz = sb ^ (((sb >> 9) & 1) << 5); R = (st >> 1) * 16 + swz / 64; C = (st & 1) * 32 + (swz % 64) / 2; }
__host__ __device__ __forceinline__ int perm32(int rho) { const int n = rho >> 4, i = rho & 15; return 8 * (i >> 2) + 4 * n + (i & 3); }

struct Unit { int pm, pn; };
struct Gemm { const bf16_t* A; const bf16_t* Bt; int M, N, K; };

struct StaticOrder {
    int nM, nN, nwg, G, c;
    __host__ __device__ void init(int M, int N, int G_, int c_) { nM = M / BM; nN = N / BM; nwg = nM * nN; G = G_; c = c_; }
    __host__ __device__ bool next(int i, Unit& u) const {
        const long L = (long)i * G + c; if (L >= nwg) return false;
        int wgid = (int)L; { const int q = nwg / NXCD, r = nwg % NXCD, xcd = wgid % NXCD, off = wgid / NXCD; wgid = (xcd < r ? xcd * (q + 1) : r * (q + 1) + (xcd - r) * q) + off; }
        const int nig = WGM * nN, gid = wgid / nig, fm = gid * WGM, gsz = (nM - fm) < WGM ? (nM - fm) : WGM;
        u.pm = fm + ((wgid % nig) % gsz); u.pn = (wgid % nig) / gsz; return true;
    }
    __device__ __forceinline__ void a_ready(const Unit&) const {}
    __device__ __forceinline__ void done(const Unit&) const {}
};

template <class Epi, class Sched, bool ALIGN_EPI = false, bool SP2 = false>
__device__ __forceinline__ void gemm_phase(PG8_LAS unsigned char* lds, const Gemm g, const Sched& S, const Epi& E) {
    int tid_ = threadIdx.x; asm volatile("" : "+v"(tid_));
    const int tid = tid_, wid = __builtin_amdgcn_readfirstlane(tid >> 6), lane = tid & 63, wr = wid >> 2, wc = wid & 3, fr = lane & 15, fq = lane >> 4;
    const int K = g.K, nt = K / BK;
    unsigned voffA[2], voffB[2];
#pragma unroll
    for (int i = 0; i < 2; ++i) { int R, C; stage_rc(tid * 16 + i * 8192, R, C); const int Rb = Epi::PERM ? ((R & ~31) + perm32(R & 31)) : R;
        voffA[i] = (unsigned)(R * K + C) * 2u; voffB[i] = (unsigned)(Rb * K + C) * 2u; }
    const size_t kstep = (size_t)(BK * 2);
    const size_t hstep = (size_t)HALF * K * 2;
    const size_t tstep = 2 * hstep;
    const unsigned ldsw = (unsigned)wid * 1024u;
    const int aoff = lds_byte(wr * 64 + fr, fq * 8), boff = lds_byte(wc * 32 + fr, fq * 8);
#define PG8_SA(b, h) (((b) * 2 + (h)) * HTB)
#define PG8_SB(b, h) ((4 + (b) * 2 + (h)) * HTB)
#define PG8_STAGE(bufoff, gbase, voff) do { _Pragma("unroll") for (int _i = 0; _i < 2; ++_i) \
        __builtin_amdgcn_global_load_lds((const unsigned*)((const char*)(gbase) + (voff)[_i]), (PG8_LAS unsigned*)(lds + (bufoff) + ldsw + _i * 8192), 16, 0, 0); } while (0)
#define PG8_LDA(dst, b, h) do { _Pragma("unroll") for (int m = 0; m < 4; ++m) _Pragma("unroll") for (int k = 0; k < 2; ++k) dst[m][k] = *(const PG8_LAS bf16x8*)(lds + PG8_SA(b, h) + aoff + m * 2048 + k * 1024); } while (0)
#define PG8_LDB(dst, b, h) do { _Pragma("unroll") for (int n = 0; n < 2; ++n) _Pragma("unroll") for (int k = 0; k < 2; ++k) dst[n][k] = *(const PG8_LAS bf16x8*)(lds + PG8_SB(b, h) + boff + n * 2048 + k * 1024); } while (0)
#define PG8_MMA(ai, bj, At, Bt) do { __builtin_amdgcn_s_setprio(1); _Pragma("unroll") for (int m = 0; m < 4; ++m) _Pragma("unroll") for (int n = 0; n < 2; ++n) _Pragma("unroll") for (int k = 0; k < 2; ++k) \
        acc[ai][bj][m][n] = __builtin_amdgcn_mfma_f32_16x16x32_bf16(Bt[n][k], At[m][k], acc[ai][bj][m][n], 0, 0, 0); __builtin_amdgcn_s_setprio(0); } while (0)
#define PG8_WAIT_V(n) asm volatile("s_waitcnt vmcnt(" #n ")" ::: "memory")
#define PG8_WAIT_L(n) asm volatile("s_waitcnt lgkmcnt(" #n ")" ::: "memory")
#define PG8_BAR __builtin_amdgcn_s_barrier()
#define PG8_SCHED __builtin_amdgcn_sched_barrier(0)
    Unit cur, nxt; int ui = 0;
    if (!S.next(0, cur)) return;
    f32x4 acc[2][2][4][2];
#pragma unroll
    for (int a = 0; a < 2; ++a)
#pragma unroll
        for (int b = 0; b < 2; ++b)
#pragma unroll
            for (int m = 0; m < 4; ++m)
#pragma unroll
                for (int n = 0; n < 2; ++n) acc[a][b][m][n] = (f32x4){0.f, 0.f, 0.f, 0.f};
    bf16x8 At[4][2], B0[2][2], B1[2][2];
    const char* cA = (const char*)g.A + (size_t)cur.pm * tstep; const char* cB = (const char*)g.Bt + (size_t)cur.pn * tstep;
    S.a_ready(cur);
    if constexpr (SP2) {
        PG8_STAGE(PG8_SB(0, 0), cB, voffB); PG8_STAGE(PG8_SB(0, 1), cB + hstep, voffB); PG8_STAGE(PG8_SA(0, 0), cA, voffA); PG8_STAGE(PG8_SA(0, 1), cA + hstep, voffA);
        if (wr == 1) PG8_BAR;
        PG8_WAIT_V(2); PG8_BAR;
        PG8_STAGE(PG8_SB(1, 0), cB + kstep, voffB); PG8_STAGE(PG8_SA(1, 0), cA + kstep, voffA); PG8_STAGE(PG8_SB(1, 1), cB + hstep + kstep, voffB);
        PG8_WAIT_V(6); PG8_BAR;
    } else {
        PG8_STAGE(PG8_SB(0, 0), cB, voffB); PG8_STAGE(PG8_SA(0, 0), cA, voffA); PG8_STAGE(PG8_SB(0, 1), cB + hstep, voffB); PG8_STAGE(PG8_SA(0, 1), cA + hstep, voffA);
        if (wr == 1) PG8_BAR;
        PG8_WAIT_V(4); PG8_BAR;
        PG8_STAGE(PG8_SB(1, 0), cB + kstep, voffB); PG8_STAGE(PG8_SA(1, 0), cA + kstep, voffA); PG8_STAGE(PG8_SB(1, 1), cB + hstep + kstep, voffB);
        PG8_WAIT_V(6); PG8_BAR;
    }
    for (;;) {
        const bool has_next = S.next(ui + 1, nxt);
        const char* nA = has_next ? (const char*)g.A + (size_t)nxt.pm * tstep : cA; const char* nB = has_next ? (const char*)g.Bt + (size_t)nxt.pn * tstep : cB;
        for (int t = 0; t < nt; t += 2) {
            const bool last = (t == nt - 2);
            const char* a1 = cA + (size_t)(t + 1) * kstep;
            const char* a2 = last ? nA : cA + (size_t)(t + 2) * kstep; const char* b2 = last ? nB : cB + (size_t)(t + 2) * kstep;
            const char* a3 = a2 + kstep; const char* b3 = b2 + kstep;
            if (last && has_next) S.a_ready(nxt);
            if constexpr (SP2) {
            PG8_LDB(B0, 0, 0); PG8_LDB(B1, 0, 1); PG8_SCHED; PG8_LDA(At, 0, 0); PG8_STAGE(PG8_SA(1, 1), a1 + hstep, voffA);
            PG8_WAIT_V(8); PG8_WAIT_L(0); PG8_BAR; PG8_MMA(0, 0, At, B0); PG8_MMA(0, 1, At, B1); PG8_BAR; PG8_SCHED;
            PG8_LDA(At, 0, 1); PG8_STAGE(PG8_SB(0, 0), b2, voffB); PG8_STAGE(PG8_SB(0, 1), b2 + hstep, voffB); PG8_STAGE(PG8_SA(0, 0), a2, voffA);
            PG8_WAIT_V(8); PG8_WAIT_L(0); PG8_BAR; PG8_MMA(1, 0, At, B0); PG8_MMA(1, 1, At, B1); PG8_BAR; PG8_SCHED;
            PG8_LDB(B0, 1, 0); PG8_LDB(B1, 1, 1); PG8_SCHED; PG8_LDA(At, 1, 0); PG8_STAGE(PG8_SA(0, 1), a2 + hstep, voffA);
            PG8_WAIT_V(8); PG8_WAIT_L(0); PG8_BAR; PG8_MMA(0, 0, At, B0); PG8_MMA(0, 1, At, B1); PG8_BAR; PG8_SCHED;
            PG8_LDA(At, 1, 1); PG8_STAGE(PG8_SB(1, 0), b3, voffB); PG8_STAGE(PG8_SB(1, 1), b3 + hstep, voffB); PG8_STAGE(PG8_SA(1, 0), a3, voffA);
            PG8_WAIT_V(8); PG8_WAIT_L(0); PG8_BAR; PG8_MMA(1, 0, At, B0); PG8_MMA(1, 1, At, B1); PG8_BAR; PG8_SCHED;
            } else {
            PG8_LDB(B0, 0, 0); PG8_SCHED; PG8_LDA(At, 0, 0); PG8_STAGE(PG8_SA(1, 1), a1 + hstep, voffA);
            PG8_WAIT_L(8); PG8_BAR; PG8_WAIT_L(0); PG8_MMA(0, 0, At, B0); PG8_BAR; PG8_SCHED;
            PG8_LDB(B1, 0, 1); PG8_STAGE(PG8_SB(0, 0), b2, voffB);
            PG8_BAR; PG8_WAIT_L(0); PG8_MMA(0, 1, At, B1); PG8_BAR;
            PG8_LDA(At, 0, 1); PG8_STAGE(PG8_SA(0, 0), a2, voffA);
            PG8_BAR; PG8_WAIT_L(0); PG8_MMA(1, 0, At, B0); PG8_BAR; PG8_SCHED;
            PG8_STAGE(PG8_SB(0, 1), b2 + hstep, voffB);
            PG8_WAIT_V(6); PG8_BAR; PG8_MMA(1, 1, At, B1); PG8_BAR;
            PG8_LDB(B0, 1, 0); PG8_SCHED; PG8_LDA(At, 1, 0); PG8_STAGE(PG8_SA(0, 1), a2 + hstep, voffA);
            PG8_WAIT_L(8); PG8_BAR; PG8_WAIT_L(0); PG8_MMA(0, 0, At, B0); PG8_BAR; PG8_SCHED;
            PG8_LDB(B1, 1, 1); PG8_STAGE(PG8_SB(1, 0), b3, voffB);
            PG8_BAR; PG8_WAIT_L(0); PG8_MMA(0, 1, At, B1); PG8_BAR;
            PG8_LDA(At, 1, 1); PG8_STAGE(PG8_SA(1, 0), a3, voffA);
            PG8_BAR; PG8_WAIT_L(0); PG8_MMA(1, 0, At, B0); PG8_BAR; PG8_SCHED;
            PG8_STAGE(PG8_SB(1, 1), b3 + hstep, voffB);
            PG8_WAIT_V(6); PG8_BAR; PG8_MMA(1, 1, At, B1); PG8_BAR;
            }
        }
        if constexpr (ALIGN_EPI) { if (wr == 0) PG8_BAR; }
        if constexpr (!Epi::AFTER_DRAIN) { E(acc, cur, wr, wc, fr, fq); S.done(cur); }
        if (!has_next) break;
#pragma unroll
        for (int a = 0; a < 2; ++a)
#pragma unroll
            for (int b = 0; b < 2; ++b)
#pragma unroll
                for (int m = 0; m < 4; ++m)
#pragma unroll
                    for (int n = 0; n < 2; ++n) acc[a][b][m][n] = (f32x4){0.f, 0.f, 0.f, 0.f};
        cur = nxt; cA = nA; cB = nB; ++ui;
        if constexpr (ALIGN_EPI) { if (wr == 1) PG8_BAR; }
    }
    PG8_WAIT_V(0);
    if constexpr (!ALIGN_EPI) { if (wr == 0) PG8_BAR; }
    PG8_BAR;
    if constexpr (Epi::AFTER_DRAIN) { E.fused(acc, cur, wr, wc, fr, fq, lds, wid, lane); S.done(cur); }
#undef PG8_SA
#undef PG8_SB
#undef PG8_STAGE
#undef PG8_LDA
#undef PG8_LDB
#undef PG8_MMA
#undef PG8_WAIT_V
#undef PG8_WAIT_L
#undef PG8_BAR
#undef PG8_SCHED
}
}
#define XB_TMO      128
#define XB_XCNT(j)  (256  + 64 * (j))
#define XB_XSUB(j)  (1280 + 64 * (j))
#define XB_XGEN(j)  (2304 + 64 * (j))
#define XB_TOP      3328
#define XB_TOPGEN   3392
#define XCD_BAR_WORDS 3456
#define XB_SPIN_CAP (1u << 18)

__device__ __forceinline__ unsigned xb_ld(unsigned* p)              { return __hip_atomic_load(p, __ATOMIC_RELAXED, __HIP_MEMORY_SCOPE_AGENT); }
__device__ __forceinline__ unsigned xb_add(unsigned* p, unsigned v) { return __hip_atomic_fetch_add(p, v, __ATOMIC_RELAXED, __HIP_MEMORY_SCOPE_AGENT); }
__device__ __forceinline__ unsigned xb_xcc_id() { return (unsigned)__builtin_amdgcn_s_getreg((3 << 11) | 20) & 0xFu; }
#define XB_SPIN(cond, bar) do { unsigned _sp = 0; while (cond) { __builtin_amdgcn_s_sleep(1); \
    if ((++_sp & 255u) == 0u) { if (xb_ld(&(bar)[XB_TMO])) break; if (_sp > XB_SPIN_CAP) { atomicAdd(&(bar)[XB_TMO], 1u); break; } } } } while (0)

struct XcdBarrier {
    unsigned* bar; unsigned x;
    volatile LAS unsigned* st;
};

__device__ __forceinline__ XcdBarrier xcd_barrier_post(unsigned* bar, volatile LAS unsigned* st) {
    XcdBarrier b; b.bar = bar; b.x = xb_xcc_id(); b.st = st;
    if (threadIdx.x == 0) (void)xb_add(&bar[XB_XCNT(b.x)], 1u);
    return b;
}
__device__ __forceinline__ void xcd_barrier_complete(unsigned* bar, unsigned x, unsigned& nloc, unsigned& nx) {
    const unsigned G = gridDim.x * gridDim.y * gridDim.z;
    unsigned sum, cnt, mine, sp = 0u;
    for (;;) {
        sum = 0u; cnt = 0u; mine = 0u;
#pragma unroll
        for (unsigned j = 0; j < 16; ++j) { const unsigned c = xb_ld(&bar[XB_XCNT(j)]); sum += c; cnt += (c > 0u) ? 1u : 0u; mine = (j == x) ? c : mine; }
        if (sum == G) break;
        __builtin_amdgcn_s_sleep(1);
        if ((++sp & 255u) == 0u) { if (xb_ld(&bar[XB_TMO])) break; if (sp > XB_SPIN_CAP) { atomicAdd(&bar[XB_TMO], 1u); break; } }
    }
    nloc = mine > 0u ? mine : 1u; nx = cnt > 0u ? cnt : 1u;
}

__device__ __forceinline__ void xcd_barrier(const XcdBarrier& b) {
    asm volatile("s_waitcnt vmcnt(0)" ::: "memory");
    __syncthreads();
    if (threadIdx.x == 0) {
        unsigned* bar = b.bar;
        __builtin_amdgcn_s_waitcnt(0);
        unsigned nloc = b.st[0], nx = b.st[1];
        if (nloc == 0u) { xcd_barrier_complete(bar, b.x, nloc, nx); b.st[0] = nloc; b.st[1] = nx; }
        const unsigned old = xb_add(&bar[XB_XSUB(b.x)], 1u);
        const unsigned gen = old / nloc;
        if (old + 1u == (gen + 1u) * nloc) {
            __builtin_amdgcn_fence(__ATOMIC_RELEASE, "agent");
            asm volatile("s_waitcnt vmcnt(0)" ::: "memory");
            const unsigned og = xb_add(&bar[XB_TOP], 1u);
            const unsigned tg = og / nx;
            if (og + 1u == (tg + 1u) * nx) xb_add(&bar[XB_TOPGEN], 1u);
            else XB_SPIN(xb_ld(&bar[XB_TOPGEN]) == tg, bar);
            __builtin_amdgcn_fence(__ATOMIC_ACQUIRE, "agent");
            xb_add(&bar[XB_XGEN(b.x)], 1u);
            asm volatile("s_waitcnt vmcnt(0)" ::: "memory");
        } else {
            XB_SPIN(xb_ld(&bar[XB_XGEN(b.x)]) == gen, bar);
            __builtin_amdgcn_fence(__ATOMIC_ACQUIRE, "agent");
            asm volatile("s_waitcnt vmcnt(0)" ::: "memory");
        }
    }
    __syncthreads();
}
namespace fk {
using pg8::bf16_t; using pg8::bf16x8; using pg8::f32x4; using pg8::u32x4; using pg8::Unit;
typedef float f32x16 __attribute__((ext_vector_type(16)));
typedef float f32x2 __attribute__((ext_vector_type(2)));
typedef __bf16 bf16x2_t __attribute__((ext_vector_type(2)));
typedef short s16x4 __attribute__((ext_vector_type(4)));
typedef unsigned u32x2 __attribute__((ext_vector_type(2)));
#define DI __device__ __forceinline__

constexpr int NB = 8, S = 2048, M = NB * S, D = 1024;
constexpr float EPS = 1e-6f, LOG2E = 1.4426950408889634f;
constexpr int NTHR = 512;

DI int tidx() { int t = threadIdx.x; asm volatile("" : "+v"(t)); return t; }
DI unsigned pk2(float lo, float hi) { f32x2 v = {lo, hi}; return __builtin_bit_cast(unsigned, __builtin_convertvector(v, bf16x2_t)); }
DI float bflo(unsigned u) { return __uint_as_float(u << 16); }
DI float bfhi(unsigned u) { return __uint_as_float(u & 0xffff0000u); }
DI float bf1(unsigned short b) { return __uint_as_float((unsigned)b << 16); }
DI float ex2(float x) { return __builtin_amdgcn_exp2f(x); }
DI float sigm(float x) { return __builtin_amdgcn_rcpf(1.f + ex2(-LOG2E * x)); }
DI float silu(float x) { return x * sigm(x); }
DI float sigm_silu(float o, float z) { return z * __builtin_amdgcn_rcpf((1.f + ex2(-LOG2E * o)) * (1.f + ex2(-LOG2E * z))); }
DI u32x4 pk8(const f32x4& a, const f32x4& b) { u32x4 w; w.x = pk2(a[0], a[1]); w.y = pk2(a[2], a[3]); w.z = pk2(b[0], b[1]); w.w = pk2(b[2], b[3]); return w; }
DI void unpk8(u32x4 w, f32x4& a, f32x4& b) { a[0] = bflo(w.x); a[1] = bfhi(w.x); a[2] = bflo(w.y); a[3] = bfhi(w.y); b[0] = bflo(w.z); b[1] = bfhi(w.z); b[2] = bflo(w.w); b[3] = bfhi(w.w); }

constexpr size_t KiB = 1024, MiB = 1u << 20;
constexpr size_t WS_CTL = 0;
constexpr size_t WS_SSQ = 64 * KiB;
constexpr int SSQ_X = 0  , SSQ_1 = 5  , SSQ_Q = 9  , SSQ_KV = 11  ;
constexpr size_t ZERO_BYTES = 1792 * KiB;
constexpr size_t WS_GW8 = 1792 * KiB;
constexpr size_t WS_WMIX = 2 * MiB;
constexpr size_t WS_WPLE = 23 * MiB;
constexpr size_t WS_XBA = 26 * MiB;
constexpr size_t WS_BIG = 58 * MiB;
constexpr size_t WS_CS = WS_BIG + 192 * MiB, WS_SN = WS_CS + 1 * MiB, WS_IG = WS_SN + 1 * MiB, WS_LF = WS_IG + 256 * KiB;
constexpr size_t WS_END = 256 * MiB;
static_assert(WS_LF + 256 * KiB <= WS_END, "ws map");
constexpr size_t WM_IN = 0, WM_QB = 4 * MiB, WM_KVB = 6 * MiB, WM_OUT_MLA = 8 * MiB, WM_OUT_CONV = 8 * MiB, WM_OUT_LSTM = 16 * MiB;
constexpr size_t A_SZ = 0, A_Q = 32 * MiB, A_KN = 80 * MiB, A_VT = 112 * MiB, A_CQ = 144 * MiB, A_CKV = 156 * MiB, A_KR = 164 * MiB, A_XBB = 32 * MiB, A_PP = 80 * MiB, A_PB = 166 * MiB;
constexpr size_t C_CH = 0, C_BZ = 32 * MiB, C_XBB = 64 * MiB, C_PP = 96 * MiB, C_PB = 166 * MiB;
constexpr size_t L_Q = 0, L_K = 32 * MiB, L_VT = 64 * MiB, L_OG = 128 * MiB, L_XBB = 0, L_PP = 64 * MiB;

struct Args { const float* in[19]; float* out; unsigned char* ws; int ph_lo, ph_hi; };
enum { I_X = 0, I_P, I_POS, I_NORMG, I_MLA_WIN, I_MLA_QN, I_MLA_WQB, I_MLA_KVN, I_MLA_WKVB, I_MLA_WOUT, I_CONV_WIN, I_CONV_W, I_CONV_WOUT, I_L_WIN, I_L_BG, I_L_WOUT, I_PLE_PROJ, I_PLE_GATE, I_FNORM };

enum { PM_ID = 0, PM_MLA_IN, PM_MLA_QB, PM_MLA_KVB, PM_CONV_IN, PM_LSTM_IN };
DI int prep_src(int mode, int n, float& sc) {
    sc = 1.f;
    switch (mode) {
    case PM_MLA_IN: { if (n < 1024) return 672 + n; if (n < 1408) return n - 1024; if (n < 1664) return 384 + (n - 1408); if (n < 1696) { const int jj = n - 1664; return 640 + (jj >> 1) + 16 * (jj & 1); } return -1; }
    case PM_MLA_QB: { sc = 0.10206207261596577f * LOG2E; const int hd = n / 96, d = n % 96; if (d < 64) return n; const int jj = d - 64; return 96 * hd + 64 + (jj >> 1) + 16 * (jj & 1); }
    case PM_MLA_KVB: { if (n < 1024) return 128 * (n >> 6) + (n & 63); const int n2 = n - 1024; return 128 * (n2 >> 6) + 64 + (n2 & 63); }
    case PM_CONV_IN: { const int pn = n >> 8, bj = (n >> 7) & 1, i = n & 127; if (pn < 8) return (bj ? 2048 : 1024) + 128 * pn + i; return (bj ? 3072 : 0) + 128 * (pn - 8) + i; }
    case PM_LSTM_IN: { if (n < 4096) { if (n >= 1024 && n < 2048) sc = 0.0625f; return n; } const int n2 = n - 4096, pn = n2 >> 8, bj = (n2 >> 7) & 1, i = n2 & 127; return (bj ? 6144 : 4096) + 128 * pn + i; }
    default: return n;
    }
}
struct PrepTask { const float* W; int ldw; const float* gk; int K, Nst, mode; bf16_t* out; };
DI void prep_tile(const PrepTask& t, int tile, LAS float* scr) {
    const int tid = tidx(), nkb = t.K >> 7, nb = tile / nkb, kb = tile % nkb, n0 = nb << 6, k0 = kb << 7;
    const int nn = tid & 63, kq = tid >> 6;
    float sc; const int src = prep_src(t.mode, n0 + nn, sc);
    float v[16];
#pragma unroll
    for (int i = 0; i < 16; ++i) { const int kk = kq + 8 * i; v[i] = (src >= 0) ? t.W[(size_t)(k0 + kk) * t.ldw + src] : 0.f; }
#pragma unroll
    for (int i = 0; i < 16; ++i) { const int kk = kq + 8 * i; float x = v[i] * sc; if (t.gk) x *= t.gk[k0 + kk]; scr[nn * 129 + kk] = x; }
    __syncthreads();
#pragma unroll
    for (int h2 = 0; h2 < 2; ++h2) { const int e = tid + h2 * NTHR, n2 = e >> 4, c = e & 15; const LAS float* sp = scr + n2 * 129 + 8 * c;
      u32x4 o; o.x = pk2(sp[0], sp[1]); o.y = pk2(sp[2], sp[3]); o.z = pk2(sp[4], sp[5]); o.w = pk2(sp[6], sp[7]);
      *(u32x4*)(t.out + (size_t)(n0 + n2) * t.K + k0 + 8 * c) = o; }
    __syncthreads();
}
DI void prep_load(const PrepTask& t, int tile, float (&v)[16], float (&g)[16]) {
    const int tid = tidx(), nkb = t.K >> 7, nb = tile / nkb, kb = tile % nkb, n0 = nb << 6, k0 = kb << 7;
    const int nn = tid & 63, kq = tid >> 6;
    float sc; const int src = prep_src(t.mode, n0 + nn, sc);
#pragma unroll
    for (int i = 0; i < 16; ++i) { const int kk = kq + 8 * i; v[i] = (src >= 0) ? t.W[(size_t)(k0 + kk) * t.ldw + src] : 0.f; }
#pragma unroll
    for (int i = 0; i < 16; ++i) { const int kk = kq + 8 * i; g[i] = t.gk ? t.gk[k0 + kk] * sc : sc; }
}
DI void prep_store(const PrepTask& t, int tile, const float (&v)[16], const float (&g)[16], LAS float* scr) {
    const int tid = tidx(), nkb = t.K >> 7, nb = tile / nkb, kb = tile % nkb, n0 = nb << 6, k0 = kb << 7;
    const int nn = tid & 63, kq = tid >> 6;
#pragma unroll
    for (int i = 0; i < 16; ++i) { const int kk = kq + 8 * i; scr[nn * 129 + kk] = v[i] * g[i]; }
    __syncthreads();
#pragma unroll
    for (int h2 = 0; h2 < 2; ++h2) { const int e = tid + h2 * NTHR, n2 = e >> 4, c = e & 15; const LAS float* sp = scr + n2 * 129 + 8 * c;
      u32x4 o; o.x = pk2(sp[0], sp[1]); o.y = pk2(sp[2], sp[3]); o.z = pk2(sp[4], sp[5]); o.w = pk2(sp[6], sp[7]);
      *(u32x4*)(t.out + (size_t)(n0 + n2) * t.K + k0 + 8 * c) = o; }
    __syncthreads();
}
#ifndef PREP_BATCH
#define PREP_BATCH 3
#endif
template <class Sel> DI void prep_batched(const Sel& sel, int total, int cu, int G, LAS float* scr) {
#pragma unroll 1
    for (int it0 = cu; it0 < total; it0 += PREP_BATCH * G) {
        float v[PREP_BATCH][16], g[PREP_BATCH][16];
#pragma unroll
        for (int b = 0; b < PREP_BATCH; ++b) { const int it = it0 + b * G;
            if (it < total) sel(it, [&](const PrepTask& t, int tl) { prep_load(t, tl, v[b], g[b]); });
            else {
#pragma unroll
                for (int i = 0; i < 16; ++i) { v[b][i] = 0.f; g[b][i] = 0.f; } } }
#pragma unroll
        for (int b = 0; b < PREP_BATCH; ++b) { const int it = it0 + b * G;
            if (it < total) sel(it, [&](const PrepTask& t, int tl) { prep_store(t, tl, v[b], g[b], scr); }); }
    }
}
DI void prep_run1(const PrepTask& t, LAS float* scr, int cu, int G) {
    const int total = (t.Nst >> 6) * (t.K >> 7);
#pragma unroll 1
    for (int it = cu; it < total; it += G) prep_tile(t, it, scr);
}

DI float wave_sum(float v) {
#pragma unroll
    for (int o = 1; o < 64; o <<= 1) v += __shfl_xor(v, o);
    return v;
}
DI void rows_to_bf16_ssq(const float* x, bf16_t* xb, unsigned long long* ssq, int gw, int NGW, int lane) {
    for (int m0 = gw; m0 < M; m0 += 4 * NGW) {
        f32x4 v[4][4];
#pragma unroll
        for (int r = 0; r < 4; ++r) { const int m = m0 + r * NGW; const f32x4* xr = (const f32x4*)(x + (size_t)(m < M ? m : m0) * D) + lane;
#pragma unroll
            for (int j = 0; j < 4; ++j) v[r][j] = xr[64 * j]; }
#pragma unroll
        for (int r = 0; r < 4; ++r) { const int m = m0 + r * NGW; if (m < M) {
            float s = 0.f; u32x2* o8 = (u32x2*)(xb + (size_t)m * D) + lane;
#pragma unroll
            for (int j = 0; j < 4; ++j) { s += (v[r][j][0] * v[r][j][0] + v[r][j][1] * v[r][j][1]) + (v[r][j][2] * v[r][j][2] + v[r][j][3] * v[r][j][3]); u32x2 w; w.x = pk2(v[r][j][0], v[r][j][1]); w.y = pk2(v[r][j][2], v[r][j][3]); o8[64 * j] = w; }
            s = wave_sum(s); if (lane == 0) ssq[m] = (unsigned long long)(s * 16777216.f); } }
    }
}
DI void p_to_bf16(const float* p, bf16_t* pb, int gt, int NGT) {
    constexpr size_t N8 = (size_t)M * 256 / 8;
    for (size_t i = gt; i < N8; i += (size_t)4 * NGT) {
        f32x4 a[4], b[4];
#pragma unroll
        for (int k = 0; k < 4; ++k) { const size_t e = i + (size_t)k * NGT; if (e < N8) { a[k] = ((const f32x4*)p)[2 * e]; b[k] = ((const f32x4*)p)[2 * e + 1]; } }
#pragma unroll
        for (int k = 0; k < 4; ++k) { const size_t e = i + (size_t)k * NGT; if (e < N8) ((u32x4*)pb)[e] = pk8(a[k], b[k]); }
    }
}
DI void rope_tables(const int* pos, float* cs, float* sn, int gt, int NGT) {
    for (int i = gt; i < M * 16; i += NGT) {
        const int t = i >> 4, j = i & 15;
        const float inv = powf(10000.0f, -(float)(2 * j) / 32.0f);
        const float ang = (float)pos[t] * inv;
        double rev = (double)ang * 0.15915494309189533577; rev -= rint(rev);
        const float fr = (float)rev;
        cs[i] = __builtin_amdgcn_cosf(fr); sn[i] = __builtin_amdgcn_sinf(fr);
    }
}

#define EPI_ROW(u, ai, m) ((u).pm * 256 + (ai) * 128 + wr * 64 + (m) * 16 + fr)
#define EPI_LOOP_AM _Pragma("unroll") for (int ai = 0; ai < 2; ++ai) _Pragma("unroll") for (int m = 0; m < 4; ++m)
typedef const f32x4 (&AccRef)[2][2][4][2];
#ifndef NT_STORES
#define NT_STORES 0
#endif
#ifndef SC1_STORES
#define SC1_STORES 0
#endif
DI void st16(const void* base, bf16_t* p, const u32x4& v) {
    if (SC1_STORES) __builtin_amdgcn_raw_buffer_store_b128(v, __builtin_amdgcn_make_buffer_rsrc((void*)base, 0, 0xFFFFFFFFu, 0x00020000), (unsigned)((const char*)p - (const char*)base), 0, 16);
    else if (NT_STORES) __builtin_nontemporal_store(v, (u32x4*)p); else *(u32x4*)p = v; }
DI float sq8(const f32x4& a, const f32x4& b) { return (a[0] * a[0] + a[1] * a[1]) + (a[2] * a[2] + a[3] * a[3]) + (b[0] * b[0] + b[1] * b[1]) + (b[2] * b[2] + b[3] * b[3]); }
DI float red_fq(float s) { s += __shfl_xor(s, 16); s += __shfl_xor(s, 32); return s; }
DI void rope8(f32x4& a, f32x4& b, const float* cs, const float* sn, int row, int p0) {
    const f32x4 c = *(const f32x4*)(cs + (size_t)row * 16 + p0), s = *(const f32x4*)(sn + (size_t)row * 16 + p0);
    const f32x4 a0 = a, b0 = b;
    a[0] = a0[0] * c[0] - a0[1] * s[0]; a[1] = a0[0] * s[0] + a0[1] * c[0];
    a[2] = a0[2] * c[1] - a0[3] * s[1]; a[3] = a0[2] * s[1] + a0[3] * c[1];
    b[0] = b0[0] * c[2] - b0[1] * s[2]; b[1] = b0[0] * s[2] + b0[1] * c[2];
    b[2] = b0[2] * c[3] - b0[3] * s[3]; b[3] = b0[2] * s[3] + b0[3] * c[3];
}

DI int opaque(int v) { asm volatile("" : "+s"(v)); return v; }
template <class T> DI T* launder(T* p) { asm volatile("" : "+s"(p)); return p; }
typedef unsigned long long u64;
constexpr float SSQ_SCALE = 16777216.f, SSQ_INV = 1.f / 16777216.f;
DI u64* ssq_arr(unsigned char* ws, int idx) { return (u64*)(ws + WS_SSQ) + (size_t)idx * M; }
DI void ssq_add(u64* p, float s) { atomicAdd(p, (u64)(s * SSQ_SCALE)); }
DI float ssq_rstd(const u64* p, float invn) { return rsqrtf((float)(*p) * SSQ_INV * invn + EPS); }

#define EPI_RS8(rsarr, ssqp, invn) float rsarr[2][4]; { u64 t_[2][4]; _Pragma("unroll") for (int ai = 0; ai < 2; ++ai) _Pragma("unroll") for (int m = 0; m < 4; ++m) t_[ai][m] = (ssqp)[EPI_ROW(u, ai, m)]; \
    _Pragma("unroll") for (int ai = 0; ai < 2; ++ai) _Pragma("unroll") for (int m = 0; m < 4; ++m) rsarr[ai][m] = rsqrtf((float)t_[ai][m] * SSQ_INV * (invn) + EPS); }

struct EpiA1 {
    static constexpr bool PERM = true, AFTER_DRAIN = false;
    unsigned char* ws; int i, j;
    DI void operator()(AccRef acc, const Unit& u, int wr, int wc, int fr, int fq) const {
        unsigned char* w = launder(ws); unsigned char* big = w + WS_BIG;
        const u64* ssq_x = ssq_arr(w, SSQ_X + i); u64* ssq_q = ssq_arr(w, SSQ_Q + j); u64* ssq_kv = ssq_arr(w, SSQ_KV + j);
        bf16_t *SZ = (bf16_t*)(big + A_SZ), *CQ = (bf16_t*)(big + A_CQ), *CKV = (bf16_t*)(big + A_CKV), *KR = (bf16_t*)(big + A_KR);
        const float *CS = (const float*)(w + WS_CS), *SN = (const float*)(w + WS_SN);
        EPI_RS8(rsv, ssq_x, 1.f / 1024.f);
        EPI_LOOP_AM {
            const int row = EPI_ROW(u, ai, m); const float rs = rsv[ai][m];
            float sq = 0.f, skv = 0.f; bool hq = false, hkv = false;
#pragma unroll
            for (int bj = 0; bj < 2; ++bj) {
                f32x4 v0 = acc[ai][bj][m][0] * rs, v1 = acc[ai][bj][m][1] * rs;
                if (u.pn < 4) {
                    const int col = u.pn * 256 + bj * 128 + wc * 32 + 8 * fq;
#pragma unroll
                    for (int jj = 0; jj < 4; ++jj) { v0[jj] = silu(v0[jj]); v1[jj] = silu(v1[jj]); }
                    st16(w, SZ + (size_t)row * 1024 + col, pk8(v0, v1));
                } else {
                    const int c = (u.pn - 4) * 256 + bj * 128 + wc * 32 + 8 * fq;
                    if (c < 384) { st16(w, CQ + (size_t)row * 384 + c, pk8(v0, v1)); sq += sq8(v0, v1); hq = true; }
                    else if (c < 640) { st16(w, CKV + (size_t)row * 256 + (c - 384), pk8(v0, v1)); skv += sq8(v0, v1); hkv = true; }
                    else if (c < 672) { const int jj0 = c - 640; rope8(v0, v1, CS, SN, row, jj0 >> 1); st16(w, KR + (size_t)row * 32 + jj0, pk8(v0, v1)); }
                }
            }
            if (u.pn >= 4) {
                sq = red_fq(sq); skv = red_fq(skv);
                if (fq == 0 && hq) ssq_add(ssq_q + row, sq);
                if (fq == 0 && hkv) ssq_add(ssq_kv + row, skv);
            }
        }
    }
};
struct EpiQ {
    static constexpr bool PERM = true, AFTER_DRAIN = false;
    unsigned char* ws; int j;
    DI void operator()(AccRef acc, const Unit& u, int wr, int wc, int fr, int fq) const {
        unsigned char* w = launder(ws); const u64* ssq_q = ssq_arr(w, SSQ_Q + j); bf16_t* Q = (bf16_t*)(w + WS_BIG + A_Q);
        const float *CS = (const float*)(w + WS_CS), *SN = (const float*)(w + WS_SN);
        EPI_RS8(rsv, ssq_q, 1.f / 384.f);
        EPI_LOOP_AM {
            const int row = EPI_ROW(u, ai, m); const float rs = rsv[ai][m];
#pragma unroll
            for (int bj = 0; bj < 2; ++bj) {
                const int col = u.pn * 256 + bj * 128 + wc * 32 + 8 * fq, d = col % 96;
                f32x4 v0 = acc[ai][bj][m][0] * rs, v1 = acc[ai][bj][m][1] * rs;
                if (d >= 64) rope8(v0, v1, CS, SN, row, (d - 64) >> 1);
                st16(w, Q + (size_t)row * 1536 + col, pk8(v0, v1));
            }
        }
    }
};
struct EpiKV {
    static constexpr bool PERM = true, AFTER_DRAIN = false;
    unsigned char* ws; int j;
    DI void operator()(AccRef acc, const Unit& u, int wr, int wc, int fr, int fq) const {
        unsigned char* w = launder(ws); const u64* ssq_kv = ssq_arr(w, SSQ_KV + j); bf16_t* O = (bf16_t*)(w + WS_BIG + (u.pn < 4 ? A_KN : A_VT));
        EPI_RS8(rsv, ssq_kv, 1.f / 256.f);
        EPI_LOOP_AM {
            const int row = EPI_ROW(u, ai, m); const float rs = rsv[ai][m];
#pragma unroll
            for (int bj = 0; bj < 2; ++bj) {
                const int col = (u.pn & 3) * 256 + bj * 128 + wc * 32 + 8 * fq;
                st16(w, O + (size_t)row * 1024 + col, pk8(acc[ai][bj][m][0] * rs, acc[ai][bj][m][1] * rs));
            }
        }
    }
};
struct EpiOut {
    static constexpr bool PERM = true, AFTER_DRAIN = false;
    unsigned char* ws; size_t xbb_off; int i;
    DI void operator()(AccRef acc, const Unit& u, int wr, int wc, int fr, int fq) const {
        unsigned char* w = launder(ws); u64* ssq = ssq_arr(w, SSQ_1 + i); bf16_t* XB = (bf16_t*)(w + WS_BIG + xbb_off); const bf16_t* xin = (const bf16_t*)(w + WS_XBA);
        const size_t cb = (size_t)u.pn * 256 + wc * 32 + 8 * fq;
        u32x4 cur[2], nxt[2];
#define EO_LOAD(dst, it) do { const size_t o_ = (size_t)EPI_ROW(u, (it) >> 2, (it) & 3) * 1024 + cb; dst[0] = *(const u32x4*)(xin + o_); dst[1] = *(const u32x4*)(xin + o_ + 128); } while (0)
        EO_LOAD(cur, 0);
#pragma unroll
        for (int it = 0; it < 8; ++it) {
            const int ai = it >> 2, m = it & 3;
            if (it < 7) EO_LOAD(nxt, it + 1);
            const int row = EPI_ROW(u, ai, m); float sq = 0.f;
#pragma unroll
            for (int bj = 0; bj < 2; ++bj) {
                const size_t off = (size_t)row * 1024 + cb + bj * 128;
                f32x4 x0, x1; unpk8(cur[bj], x0, x1);
                const f32x4 y0 = x0 + acc[ai][bj][m][0], y1 = x1 + acc[ai][bj][m][1];
                st16(w, XB + off, pk8(y0, y1)); sq += sq8(y0, y1);
            }
            sq = red_fq(sq); if (fq == 0) ssq_add(ssq + row, sq);
            cur[0] = nxt[0]; cur[1] = nxt[1];
        }
#undef EO_LOAD
    }
};
struct EpiPP {
    static constexpr bool PERM = true, AFTER_DRAIN = false;
    bf16_t* pp;
    DI void operator()(AccRef acc, const Unit& u, int wr, int wc, int fr, int fq) const {
        bf16_t* PP = launder(pp);
        EPI_LOOP_AM { const int row = EPI_ROW(u, ai, m);
#pragma unroll
            for (int bj = 0; bj < 2; ++bj) { const size_t off = (size_t)row * 1024 + u.pn * 256 + bj * 128 + wc * 32 + 8 * fq; st16(PP, PP + off, pk8(acc[ai][bj][m][0], acc[ai][bj][m][1])); } }
    }
};
struct EpiPle {
    static constexpr bool PERM = true, AFTER_DRAIN = false;
    unsigned char* ws; const bf16_t* pp; size_t xbb_off; int i;
    DI void operator()(AccRef acc, const Unit& u, int wr, int wc, int fr, int fq) const {
        unsigned char* w = launder(ws); const u64* ssq1 = ssq_arr(w, SSQ_1 + i); u64* ssq = ssq_arr(w, SSQ_X + i + 1);
        const bf16_t* PP = launder(pp); const bf16_t* X1 = (const bf16_t*)(w + WS_BIG + xbb_off); bf16_t* XB = (bf16_t*)(w + WS_XBA);
        const size_t cb = (size_t)u.pn * 256 + wc * 32 + 8 * fq;
        EPI_RS8(rsv, ssq1, 1.f / 1024.f);
        u32x4 cur[2], nxt[2], pc[2], pn2[2];
#define EP_LOAD(dst, pd, it) do { const size_t o_ = (size_t)EPI_ROW(u, (it) >> 2, (it) & 3) * 1024 + cb; dst[0] = *(const u32x4*)(X1 + o_); dst[1] = *(const u32x4*)(X1 + o_ + 128); \
            pd[0] = *(const u32x4*)(PP + o_); pd[1] = *(const u32x4*)(PP + o_ + 128); } while (0)
        EP_LOAD(cur, pc, 0);
#pragma unroll
        for (int it = 0; it < 8; ++it) {
            const int ai = it >> 2, m = it & 3;
            if (it < 7) EP_LOAD(nxt, pn2, it + 1);
            const int row = EPI_ROW(u, ai, m); const float rs = rsv[ai][m]; float sq = 0.f;
#pragma unroll
            for (int bj = 0; bj < 2; ++bj) {
                const size_t off = (size_t)row * 1024 + cb + bj * 128;
                f32x4 p0, p1, y0, y1; unpk8(pc[bj], p0, p1); unpk8(cur[bj], y0, y1);
#pragma unroll
                for (int jj = 0; jj < 4; ++jj) { y0[jj] += sigm(acc[ai][bj][m][0][jj] * rs) * p0[jj]; y1[jj] += sigm(acc[ai][bj][m][1][jj] * rs) * p1[jj]; }
                st16(w, XB + off, pk8(y0, y1)); sq += sq8(y0, y1);
            }
            sq = red_fq(sq); if (fq == 0) ssq_add(ssq + row, sq);
#pragma unroll
            for (int bj = 0; bj < 2; ++bj) { cur[bj] = nxt[bj]; pc[bj] = pn2[bj]; }
        }
#undef EP_LOAD
    }
};
struct EpiPleLast {
    static constexpr bool PERM = true, AFTER_DRAIN = true;
    unsigned char* ws; float* out; const float* gfin; const bf16_t* pp; size_t xbb_off; int i; unsigned xcc; volatile LAS unsigned* st;
    DI void fused(f32x4 (&acc)[2][2][4][2], const Unit& u, int wr, int wc, int fr, int fq, LAS unsigned char* lds, int wid, int lane) const {
        unsigned char* w = launder(ws); const u64* ssq1 = ssq_arr(w, SSQ_1 + i); u64* ssq = ssq_arr(w, SSQ_X + i + 1);
        const bf16_t* PP = launder(pp); const bf16_t* X1 = (const bf16_t*)(w + WS_BIG + xbb_off);
        const size_t cb = (size_t)u.pn * 256 + wc * 32 + 8 * fq;
        {
            EPI_RS8(rsv, ssq1, 1.f / 1024.f);
#pragma unroll
            for (int it = 0; it < 8; ++it) {
                const int ai = it >> 2, m = it & 3; const int row = EPI_ROW(u, ai, m); const float rs = rsv[ai][m]; float sq = 0.f;
#pragma unroll
                for (int bj = 0; bj < 2; ++bj) {
                    const size_t off = (size_t)row * 1024 + cb + bj * 128;
                    f32x4 p0, p1, y0, y1; unpk8(*(const u32x4*)(PP + off), p0, p1); unpk8(*(const u32x4*)(X1 + off), y0, y1);
#pragma unroll
                    for (int jj = 0; jj < 4; ++jj) { y0[jj] += sigm(acc[ai][bj][m][0][jj] * rs) * p0[jj]; y1[jj] += sigm(acc[ai][bj][m][1][jj] * rs) * p1[jj]; }
                    acc[ai][bj][m][0] = y0; acc[ai][bj][m][1] = y1; sq += sq8(y0, y1);
                }
                sq = red_fq(sq); if (fq == 0) ssq_add(ssq + row, sq);
            }
        }
        { XcdBarrier b; b.bar = (unsigned*)(launder(ws) + WS_CTL); b.x = xcc; b.st = st; xcd_barrier(b); }
        {
            const u64* ssqf = ssq_arr(launder(ws), SSQ_X + i + 1);
            EPI_RS8(rsf, ssqf, 1.f / 1024.f);
#pragma unroll
            for (int bj = 0; bj < 2; ++bj) {
                const f32x4 g0 = *(const f32x4*)(gfin + cb + bj * 128), g1 = *(const f32x4*)(gfin + cb + bj * 128 + 4);
                EPI_LOOP_AM { const size_t off = (size_t)EPI_ROW(u, ai, m) * 1024 + cb + bj * 128; const float rs = rsf[ai][m];
                    *(f32x4*)(out + off) = acc[ai][bj][m][0] * rs * g0; *(f32x4*)(out + off + 4) = acc[ai][bj][m][1] * rs * g1; }
            }
        }
    }
};
struct EpiC1 {
    static constexpr bool PERM = true, AFTER_DRAIN = false;
    unsigned char* ws; int i; int dry;
    DI void operator()(AccRef acc, const Unit& u, int wr, int wc, int fr, int fq) const {
        if (dry == 1) { asm volatile("" :: "v"(acc[0][0][0][0][0]), "v"(acc[1][1][3][1][3])); return; }
        unsigned char* w = launder(ws); const u64* ssq_x = ssq_arr(w, SSQ_X + i); bf16_t *CH = (bf16_t*)(w + WS_BIG + C_CH), *BZ = (bf16_t*)(w + WS_BIG + C_BZ);
        float rsv[2][4];
        if (dry == 4) { EPI_LOOP_AM rsv[ai][m] = 1.f; } else { EPI_RS8(rsl_, ssq_x, 1.f / 1024.f); EPI_LOOP_AM rsv[ai][m] = rsl_[ai][m]; }
        EPI_LOOP_AM {
            const int row = EPI_ROW(u, ai, m); const float rs = rsv[ai][m];
            const size_t off = (size_t)row * 1024 + (u.pn & 7) * 128 + wc * 32 + 8 * fq;
            f32x4 r0, r1;
            if (u.pn < 8) { r0 = (acc[ai][0][m][0] * rs) * (acc[ai][1][m][0] * rs); r1 = (acc[ai][0][m][1] * rs) * (acc[ai][1][m][1] * rs); { const u32x4 o_ = pk8(r0, r1); if (dry == 2) asm volatile("" :: "v"(o_)); else if (dry == 3) { const int blk = ((wr * 2 + ai) * 4 + m) * 4 + wc, ln = fr + 16 * fq; st16(w, CH + (size_t)(u.pm * 256 + (blk >> 1) * 8 + (ln >> 3)) * 1024 + (u.pn & 7) * 128 + (blk & 1) * 64 + (ln & 7) * 8, o_); } else st16(w, CH + off, o_); } }
            else {
#pragma unroll
                for (int jj = 0; jj < 4; ++jj) { r0[jj] = (acc[ai][0][m][0][jj] * rs) * silu(acc[ai][1][m][0][jj] * rs); r1[jj] = (acc[ai][0][m][1][jj] * rs) * silu(acc[ai][1][m][1][jj] * rs); }
                { const u32x4 o_ = pk8(r0, r1); if (dry == 2) asm volatile("" :: "v"(o_)); else if (dry == 3) { const int blk = ((wr * 2 + ai) * 4 + m) * 4 + wc, ln = fr + 16 * fq; st16(w, BZ + (size_t)(u.pm * 256 + (blk >> 1) * 8 + (ln >> 3)) * 1024 + (u.pn & 7) * 128 + (blk & 1) * 64 + (ln & 7) * 8, o_); } else st16(w, BZ + off, o_); }
            }
        }
    }
};
struct EpiL1 {
    static constexpr bool PERM = true, AFTER_DRAIN = false;
    unsigned char* ws; int i;
    DI void operator()(AccRef acc, const Unit& u, int wr, int wc, int fr, int fq) const {
        unsigned char* w = launder(ws); const u64* ssq_x = ssq_arr(w, SSQ_X + i); unsigned char* big = w + WS_BIG;
        EPI_RS8(rsv, ssq_x, 1.f / 1024.f);
        if (u.pn < 16) {
            bf16_t* O; int ld, c0;
            if (u.pn < 4) { O = (bf16_t*)(big + L_Q); ld = 1024; c0 = u.pn * 256; } else if (u.pn < 8) { O = (bf16_t*)(big + L_K); ld = 1024; c0 = (u.pn - 4) * 256; } else { O = (bf16_t*)(big + L_VT); ld = 2048; c0 = (u.pn - 8) * 256; }
            EPI_LOOP_AM {
                const int row = EPI_ROW(u, ai, m); const float rs = rsv[ai][m];
#pragma unroll
                for (int bj = 0; bj < 2; ++bj) st16(w, O + (size_t)row * ld + c0 + bj * 128 + wc * 32 + 8 * fq, pk8(acc[ai][bj][m][0] * rs, acc[ai][bj][m][1] * rs));
            }
        } else {
            bf16_t* OG = (bf16_t*)(big + L_OG);
            EPI_LOOP_AM {
                const int row = EPI_ROW(u, ai, m); const float rs = rsv[ai][m];
                const size_t off = (size_t)row * 2048 + (u.pn - 16) * 128 + wc * 32 + 8 * fq; f32x4 r0, r1;
#pragma unroll
                for (int jj = 0; jj < 4; ++jj) { r0[jj] = sigm_silu(acc[ai][0][m][0][jj] * rs, acc[ai][1][m][0][jj] * rs); r1[jj] = sigm_silu(acc[ai][0][m][1][jj] * rs, acc[ai][1][m][1][jj] * rs); }
                st16(w, OG + off, pk8(r0, r1));
            }
        }
    }
};
#ifndef QFUSE
#define QFUSE 0
#endif
constexpr int AT_WQS = 784  , AT_WQOFF = 2 * 64 * 208 + 2 * 64 * 192;
constexpr int AT_KSTR = 208, AT_VSTR = 192, AT_KB = 64 * AT_KSTR, AT_VB = 64 * AT_VSTR;
#define MFMA32(a, b, c) __builtin_amdgcn_mfma_f32_32x32x16_bf16((a), (b), (c), 0, 0, 0)
#define MFMA16(a, b, c) __builtin_amdgcn_mfma_f32_16x16x32_bf16((a), (b), (c), 0, 0, 0)
DI float max3f(float a, float b, float c) { float r; asm("v_max3_f32 %0, %1, %2, %3" : "=v"(r) : "v"(a), "v"(b), "v"(c)); return r; }
DI bf16x8 cat4(s16x4 lo, s16x4 hi) { return __builtin_shufflevector(lo, hi, 0, 1, 2, 3, 4, 5, 6, 7); }

struct AttnT { const bf16_t *Q, *KN, *KR, *VT; bf16_t* SZOG; const bf16_t *CQ, *WQ; const u64* ssq_q; const float *CS, *SN; };
#ifndef DIAG_NOLOAD
#define DIAG_NOLOAD 0
#endif
#ifndef AT_ORD0
#define AT_ORD0 0x3407
#define AT_ORD1 0x2516
#endif
struct AttnStage { u32x4 k, r, v; };
DI void attn_unit(LAS unsigned char* lds, const AttnT& T, int b, int h, int qb, int dry) {
    const int tid = tidx(), w = __builtin_amdgcn_readfirstlane(tid >> 6), lane = tid & 63, r = lane & 31, hh = lane >> 5;
    const int tok0 = b * S, row0 = tok0 + qb * 256 + 32 * w;
    bf16x8 qf[6];
#if QFUSE
    {
        f32x16 qT[3];
#pragma unroll
        for (int db = 0; db < 3; ++db)
#pragma unroll
            for (int i = 0; i < 16; ++i) qT[db][i] = 0.f;
        const bf16_t* cqp = T.CQ + (size_t)(row0 + r) * 384 + 8 * hh;
        bf16x8 cf[24];
#pragma unroll
        for (int ks = 0; ks < 24; ++ks) cf[ks] = *(const bf16x8*)(cqp + 16 * ks);
        const LAS unsigned char* wl = lds + AT_WQOFF + r * AT_WQS + 16 * hh;
#pragma unroll
        for (int ks = 0; ks < 24; ++ks) {
            const bf16x8 w0 = *(const LAS bf16x8*)(wl + 32 * ks), w1 = *(const LAS bf16x8*)(wl + 32 * AT_WQS + 32 * ks), w2 = *(const LAS bf16x8*)(wl + 64 * AT_WQS + 32 * ks);
            qT[0] = MFMA32(w0, cf[ks], qT[0]); qT[1] = MFMA32(w1, cf[ks], qT[1]); qT[2] = MFMA32(w2, cf[ks], qT[2]);
        }
        const float rsq = ssq_rstd(T.ssq_q + row0 + r, 1.f / 384.f);
#pragma unroll
        for (int db = 0; db < 3; ++db)
#pragma unroll
            for (int i = 0; i < 16; ++i) qT[db][i] *= rsq;
#pragma unroll
        for (int g4 = 0; g4 < 4; ++g4) {
            const f32x2 c2 = *(const f32x2*)(T.CS + (size_t)(row0 + r) * 16 + 4 * g4 + 2 * hh), s2 = *(const f32x2*)(T.SN + (size_t)(row0 + r) * 16 + 4 * g4 + 2 * hh);
#pragma unroll
            for (int e = 0; e < 2; ++e) { const float x1 = qT[2][4 * g4 + 2 * e], x2 = qT[2][4 * g4 + 2 * e + 1], cc = e ? c2[1] : c2[0], ss = e ? s2[1] : s2[0];
                qT[2][4 * g4 + 2 * e] = x1 * cc - x2 * ss; qT[2][4 * g4 + 2 * e + 1] = x1 * ss + x2 * cc; }
        }
#pragma unroll
        for (int db = 0; db < 3; ++db)
#pragma unroll
            for (int s2i = 0; s2i < 2; ++s2i) { u32x4 pw; pw.x = pk2(qT[db][8 * s2i + 0], qT[db][8 * s2i + 1]); pw.y = pk2(qT[db][8 * s2i + 2], qT[db][8 * s2i + 3]); pw.z = pk2(qT[db][8 * s2i + 4], qT[db][8 * s2i + 5]); pw.w = pk2(qT[db][8 * s2i + 6], qT[db][8 * s2i + 7]);
                qf[2 * db + s2i] = __builtin_bit_cast(bf16x8, pw); }
    }
#else
#pragma unroll
    for (int ks = 0; ks < 6; ++ks) qf[ks] = *(const bf16x8*)(T.Q + (size_t)(row0 + r) * 1536 + 96 * h + 16 * ks + 8 * hh);
#endif
    f32x16 O0, O1;
#pragma unroll
    for (int i = 0; i < 16; ++i) { O0[i] = 0.f; O1[i] = 0.f; }
    float mrun = -1e30f, lrun = 0.f;
    const int ntiles = 4 * qb + 4, myvis = 4 * qb + (w >> 1);
    const int kkey = tid >> 3, kch = tid & 7, rkey = tid >> 2, rch = tid & 3;
    const bf16_t* gK = T.KN + (size_t)(tok0 + kkey) * 1024 + 64 * h + 8 * kch;
    const bf16_t* gR = T.KR + (size_t)(tok0 + rkey) * 32 + 8 * rch;
    const bf16_t* gV = T.VT + (size_t)(tok0 + kkey) * 1024 + 64 * h + 8 * kch;
    const int lK = QFUSE ? kkey * AT_KSTR + 32 * (kch >> 1) + 8 * (kch & 1) : kkey * AT_KSTR + 16 * kch, lR = QFUSE ? rkey * AT_KSTR + 128 + 32 * (rch >> 1) + 8 * (rch & 1) : rkey * AT_KSTR + 128 + 16 * rch, lV = kkey * AT_VSTR + 16 * kch;
    const int krd = r * AT_KSTR + 16 * hh;
    const int vrd = (4 * hh + ((lane & 15) >> 2)) * AT_VSTR + (16 * ((lane >> 4) & 1) + 4 * (lane & 3)) * 2;
#define AT_LOADK(st, kt) do { if (DIAG_NOLOAD && dry) break; (st).k = *(const u32x4*)(gK + (size_t)(kt) * 64 * 1024); if (tid < 256) (st).r = *(const u32x4*)(gR + (size_t)(kt) * 64 * 32); } while (0)
#define AT_LOADV(st, kt) do { if (DIAG_NOLOAD && dry) break; (st).v = *(const u32x4*)(gV + (size_t)(kt) * 64 * 1024); } while (0)
#define AT_WRITEK(st, buf) do { LAS unsigned char* kb_ = lds + (buf) * AT_KB; *(LAS u32x2*)(kb_ + lK) = (u32x2){(st).k.x, (st).k.y}; *(LAS u32x2*)(kb_ + lK + (QFUSE ? 16 : 8)) = (u32x2){(st).k.z, (st).k.w}; \
        if (tid < 256) { *(LAS u32x2*)(kb_ + lR) = (u32x2){(st).r.x, (st).r.y}; *(LAS u32x2*)(kb_ + lR + (QFUSE ? 16 : 8)) = (u32x2){(st).r.z, (st).r.w}; } } while (0)
#define AT_WRITEV(st, buf) do { *(LAS u32x4*)(lds + 2 * AT_KB + (buf) * AT_VB + lV) = (st).v; } while (0)
#define AT_QK1(sX, buf, blk) do { const LAS unsigned char* kb = lds + (buf) * AT_KB + krd + (blk) * 32 * AT_KSTR; \
        _Pragma("unroll") for (int i = 0; i < 16; ++i) sX[i] = 0.f; \
        _Pragma("unroll") for (int ks = 0; ks < 6; ++ks) sX = MFMA32(*(const LAS bf16x8*)(kb + 32 * ks), qf[ks], sX); } while (0)
#define AT_QK(sA, sB, buf) do { AT_QK1(sA, buf, 0); AT_QK1(sB, buf, 1); } while (0)
#define AT_MAX(s0, s1) \
          \
        asm volatile("s_nop 7\n\ts_nop 7\n\ts_nop 7" : "+v"(s0[0]), "+v"(s1[0])); \
        float mx = max3f(s0[0], s1[0], mrun); \
        _Pragma("unroll") for (int i = 1; i < 16; ++i) mx = max3f(mx, s0[i], s1[i]); \
        const float mnew = max3f(mx, __shfl_xor(mx, 32), mx), alpha = ex2(mrun - mnew); mrun = mnew;
#define AT_EXP(s0, s1) do { float ps = 0.f; \
        _Pragma("unroll") for (int i = 0; i < 16; ++i) { s0[i] = ex2(s0[i] - mrun); s1[i] = ex2(s1[i] - mrun); ps += s0[i] + s1[i]; } \
        lrun = lrun * alpha + ps; \
        _Pragma("unroll") for (int i = 0; i < 16; ++i) { O0[i] *= alpha; O1[i] *= alpha; } } while (0)
#define AT_PV(s0, s1, buf) do { LAS unsigned char* vb = lds + 2 * AT_KB + (buf) * AT_VB + vrd; \
        _Pragma("unroll") for (int kb2 = 0; kb2 < 2; ++kb2) _Pragma("unroll") for (int s = 0; s < 2; ++s) { \
            const f32x16& sx = kb2 ? s1 : s0; \
            u32x4 pw; pw.x = pk2(sx[8 * s + 0], sx[8 * s + 1]); pw.y = pk2(sx[8 * s + 2], sx[8 * s + 3]); pw.z = pk2(sx[8 * s + 4], sx[8 * s + 5]); pw.w = pk2(sx[8 * s + 6], sx[8 * s + 7]); \
            const bf16x8 pf = __builtin_bit_cast(bf16x8, pw); \
            LAS unsigned char* vp = vb + (32 * kb2 + 16 * s) * AT_VSTR; \
            const bf16x8 v0 = cat4(__builtin_amdgcn_ds_read_tr16_b64_v4i16((LAS s16x4*)vp), __builtin_amdgcn_ds_read_tr16_b64_v4i16((LAS s16x4*)(vp + 8 * AT_VSTR))); \
            const bf16x8 v1 = cat4(__builtin_amdgcn_ds_read_tr16_b64_v4i16((LAS s16x4*)(vp + 64)), __builtin_amdgcn_ds_read_tr16_b64_v4i16((LAS s16x4*)(vp + 64 + 8 * AT_VSTR))); \
            O0 = MFMA32(v0, pf, O0); O1 = MFMA32(v1, pf, O1); } } while (0)
#define AT_SOFTMAX_PV(s0, s1, buf) do { AT_MAX(s0, s1); AT_EXP(s0, s1); AT_PV(s0, s1, buf); } while (0)
#define AT_FUSED(c0, c1, n0, n1, bufK, bufV) do { AT_QK1(n0, bufK, 0); AT_MAX(c0, c1); __builtin_amdgcn_sched_barrier(0); \
        AT_QK1(n1, bufK, 1); AT_EXP(c0, c1); __builtin_amdgcn_sched_barrier(0); AT_PV(c0, c1, bufV); } while (0)
    AttnStage RA, RB;
    f32x16 a0, a1, b0, b1;
    AT_LOADK(RA, 0); AT_LOADV(RA, 0); AT_LOADK(RB, 1);
    AT_WRITEK(RA, 0); AT_WRITEV(RA, 0); AT_WRITEK(RB, 1);
    AT_LOADK(RA, 2); AT_LOADV(RA, 1);
    __syncthreads();
    AT_QK(a0, a1, 0);
    const int nmain = 4 * qb, jv = w >> 1;
    int t = 0;
#pragma unroll 1
    for (; t < nmain; t += 2) {
        AT_LOADK(RB, t + 3); AT_LOADV(RB, t + 2);
        AT_FUSED(a0, a1, b0, b1, 1, 0);
        AT_WRITEK(RA, 0); AT_WRITEV(RA, 1);
        __syncthreads();
        AT_LOADK(RA, t + 4); AT_LOADV(RA, t + 3);
        AT_FUSED(b0, b1, a0, a1, 0, 1);
        AT_WRITEK(RB, 1); AT_WRITEV(RB, 0);
        __syncthreads();
    }
    AT_LOADK(RB, t + 3); AT_LOADV(RB, t + 2);
    if (jv >= 1) AT_QK(b0, b1, 1);
    AT_SOFTMAX_PV(a0, a1, 0);
    AT_WRITEK(RA, 0); AT_WRITEV(RA, 1);
    __syncthreads();
    AT_LOADV(RA, t + 3);
    if (jv >= 2) AT_QK(a0, a1, 0);
    if (jv >= 1) AT_SOFTMAX_PV(b0, b1, 1);
    AT_WRITEK(RB, 1); AT_WRITEV(RB, 0);
    __syncthreads();
    if (jv >= 3) AT_QK(b0, b1, 1);
    if (jv >= 2) AT_SOFTMAX_PV(a0, a1, 0);
    AT_WRITEV(RA, 1);
    __syncthreads();
    if (jv >= 3) AT_SOFTMAX_PV(b0, b1, 1);
    __syncthreads();
#undef AT_LOADK
#undef AT_LOADV
#undef AT_WRITEK
#undef AT_WRITEV
#undef AT_QK
#undef AT_SOFTMAX_PV
#undef AT_QK1
#undef AT_MAX
#undef AT_EXP
#undef AT_PV
#undef AT_FUSED
    const float linv = 1.f / (lrun + __shfl_xor(lrun, 32));
    bf16_t* op = T.SZOG + (size_t)(row0 + r) * 1024 + 64 * h + 4 * hh;
#pragma unroll
    for (int db = 0; db < 2; ++db)
#pragma unroll
        for (int g4 = 0; g4 < 4; ++g4) {
            const f32x16& ox = db ? O1 : O0; bf16_t* p = op + 32 * db + 8 * g4;
            const u32x2 z = *(const u32x2*)p; u32x2 o;
            o.x = pk2(ox[4 * g4 + 0] * linv * bflo(z.x), ox[4 * g4 + 1] * linv * bfhi(z.x)); o.y = pk2(ox[4 * g4 + 2] * linv * bflo(z.y), ox[4 * g4 + 3] * linv * bfhi(z.y));
            if (!dry) *(u32x2*)p = o;
        }
}
DI void attn_phase(LAS unsigned char* lds, const AttnT& T, int cu, int dry) {
    const int bh = (cu & 7) + 8 * (cu >> 4), half = (cu >> 3) & 1, b = bh >> 4, h = bh & 15;
#if QFUSE
    {
        const int tid = tidx();
#pragma unroll
        for (int i = 0; i < 9; ++i) { const int e = tid + i * NTHR, row = e / 48, ch = e % 48; *(LAS u32x4*)(lds + AT_WQOFF + row * AT_WQS + 16 * ch) = *(const u32x4*)(T.WQ + (size_t)(96 * h + row) * 384 + 8 * ch); }
        __syncthreads();
    }
#endif
#pragma unroll 1
    for (int ui = 0; ui < 4; ++ui) attn_unit(lds, T, b, h, ((half ? AT_ORD1 : AT_ORD0) >> (4 * ui)) & 0xF, dry);
}

DI void conv_phase(const bf16_t* CH, bf16_t* BZ, const float* cw, int gt, int NGT, int dry) {
    for (int it = gt; it < (M / 8) * 128; it += NGT) {
        const int c8 = (it & 127) * 8, m0 = (it >> 7) * 8, t0 = m0 & (S - 1);
        const f32x4 w0a = *(const f32x4*)(cw + c8), w0b = *(const f32x4*)(cw + c8 + 4), w1a = *(const f32x4*)(cw + 1024 + c8), w1b = *(const f32x4*)(cw + 1024 + c8 + 4), w2a = *(const f32x4*)(cw + 2048 + c8), w2b = *(const f32x4*)(cw + 2048 + c8 + 4);
        u32x4 ch[10], bz[8];
#pragma unroll
        for (int r = 0; r < 10; ++r) { const int m = m0 - 2 + r; ch[r] = (r >= 2 || t0 > 0) ? *(const u32x4*)(CH + (size_t)m * 1024 + c8) : (u32x4){0u, 0u, 0u, 0u}; }
#pragma unroll
        for (int r = 0; r < 8; ++r) bz[r] = *(const u32x4*)(BZ + (size_t)(m0 + r) * 1024 + c8);
        f32x4 pa, pb, qa, qb;
        unpk8(ch[0], pa, pb); unpk8(ch[1], qa, qb);
#pragma unroll
        for (int r = 0; r < 8; ++r) {
            f32x4 ca, cb, ba, bb; unpk8(ch[r + 2], ca, cb); unpk8(bz[r], ba, bb);
            const f32x4 ya = w0a * pa + w1a * qa + w2a * ca, yb = w0b * pb + w1b * qb + w2b * cb;
            const u32x4 ov = pk8(ba * ya, bb * yb); if (!dry) *(u32x4*)(BZ + (size_t)(m0 + r) * 1024 + c8) = ov;
            pa = qa; pb = qb; qa = ca; qb = cb;
        }
    }
}

DI void gates_phase(const bf16_t* XB, const u64* ssq_x, const float* Wg8, const float* bg, float* IG, float* LF, int gw, int NGW, int lane) {
    f32x4 wv[8][2][2];
#pragma unroll
    for (int j = 0; j < 8; ++j)
#pragma unroll
        for (int half = 0; half < 2; ++half) { const int k0 = half * 512 + lane * 8; wv[j][half][0] = *(const f32x4*)(Wg8 + j * 1024 + k0); wv[j][half][1] = *(const f32x4*)(Wg8 + j * 1024 + k0 + 4); }
    float bgv[8];
#pragma unroll
    for (int j = 0; j < 8; ++j) bgv[j] = bg[j];
    for (int m = gw; m < M; m += NGW) {
        float acc[8];
#pragma unroll
        for (int j = 0; j < 8; ++j) acc[j] = 0.f;
        const u32x4 xw0 = *(const u32x4*)(XB + (size_t)m * 1024 + lane * 8), xw1 = *(const u32x4*)(XB + (size_t)m * 1024 + 512 + lane * 8);
#pragma unroll
        for (int half = 0; half < 2; ++half) {
            f32x4 xa, xb2; unpk8(half ? xw1 : xw0, xa, xb2);
#pragma unroll
            for (int j = 0; j < 8; ++j) { const f32x4 wa = wv[j][half][0], wb = wv[j][half][1];
                acc[j] += (xa[0] * wa[0] + xa[1] * wa[1]) + (xa[2] * wa[2] + xa[3] * wa[3]) + (xb2[0] * wb[0] + xb2[1] * wb[1]) + (xb2[2] * wb[2] + xb2[3] * wb[3]); }
        }
        const float rs = ssq_rstd(ssq_x + m, 1.f / 1024.f);
#pragma unroll
        for (int j = 0; j < 8; ++j) acc[j] = wave_sum(acc[j]) * rs + bgv[j];
        if (lane == 0) {
            *(f32x4*)(IG + (size_t)m * 4) = (f32x4){acc[0], acc[1], acc[2], acc[3]};
            f32x4 lf;
#pragma unroll
            for (int j = 0; j < 4; ++j) { const float x = acc[4 + j]; lf[j] = fminf(x, 0.f) - log1pf(__expf(-fabsf(x))); }
            *(f32x4*)(LF + (size_t)m * 4) = lf;
        }
    }
}
DI void gw8_prep(const float* w_in, const float* g, float* Wg8, int gt, int NGT) {
    for (int i = gt; i < 8 * 1024; i += NGT) { const int j = i >> 10, k = i & 1023; Wg8[i] = w_in[(size_t)k * 8200 + 8192 + j] * g[k]; }
}

constexpr int SC_QSTR = 528, SC_VSTR = 136  , SC_VVSTR = 144  ;
constexpr int SC_QS = 0, SC_KS = 64 * SC_QSTR, SC_VS = 2 * 64 * SC_QSTR, SC_SP = SC_VS + 64 * SC_VVSTR, SC_QCX = SC_SP + 64 * SC_VSTR, SC_GT = SC_QCX + 16384, SC_VEC = SC_GT + 3 * 32 * 64 * 4 + 512, SC_OT = SC_VEC + (832 + 512) * 4;
constexpr int G_B = 0, G_CC = 2048, G_PM = 4096, G_SC = 6144;
constexpr int V_QNP = 0  , V_RS = 512  , V_WS = 768, V_WH = 832  ;
constexpr int SC_END = SC_OT + 64 * SC_VVSTR;
struct ScanT { const bf16_t *Q, *K, *VT; bf16_t* OG; const float *IG, *LF; };
DI float scan_add(float v, int lane) {
#pragma unroll
    for (int o = 1; o < 64; o <<= 1) { const float t = __shfl_up(v, o); if (lane >= o) v += t; }
    return v;
}
DI float scan_max(float v, int lane) {
#pragma unroll
    for (int o = 1; o < 64; o <<= 1) { const float t = __shfl_up(v, o); if (lane >= o) v = fmaxf(v, t); }
    return v;
}
DI void scan_item(LAS unsigned char* lds, const ScanT& T, int b, int h, int sl, int dry) {
    const int tid0 = tidx(), w = __builtin_amdgcn_readfirstlane(tid0 >> 6), g = w >> 2, c = w & 3;
    int tid = tid0, lane = tid & 63, l15 = lane & 15, q = lane >> 4;
    const int tok0 = b * S;
    LAS float* vec = (LAS float*)(lds + SC_VEC);
    LAS float* gt = (LAS float*)(lds + SC_GT);
    f32x4 Cacc[8];
#pragma unroll
    for (int i = 0; i < 8; ++i) Cacc[i] = (f32x4){0.f, 0.f, 0.f, 0.f};
    f32x4 nacc[2] = {(f32x4){0.f, 0.f, 0.f, 0.f}, (f32x4){0.f, 0.f, 0.f, 0.f}};
    u32x4 sQ[4], sK[4], sV;
    const int vd = tid >> 3, vch = tid & 7;
    const bf16_t* gQ = T.Q + (size_t)tok0 * 1024 + 256 * h;
    const bf16_t* gK = T.K + (size_t)tok0 * 1024 + 256 * h;
    const bf16_t* gV = T.VT + (size_t)(tok0 + vd) * 2048 + 512 * h + 64 * sl + 8 * vch;
#define SC_LOAD(ci) do { _Pragma("unroll") for (int i = 0; i < 4; ++i) { const int e = tid + i * NTHR, row = e >> 5, ch = e & 31; \
        sQ[i] = *(const u32x4*)(gQ + (size_t)((ci) * 64 + row) * 1024 + 8 * ch); sK[i] = *(const u32x4*)(gK + (size_t)((ci) * 64 + row) * 1024 + 8 * ch); } \
        sV = *(const u32x4*)(gV + (size_t)(ci) * 64 * 2048); } while (0)
    u32x4 sOG;
    bf16_t* gOG = T.OG + (size_t)(tok0 + vd) * 2048 + 512 * h + 64 * sl + 8 * vch;
#define SC_LOADOG(ci) do { sOG = *(const u32x4*)(gOG + (size_t)(ci) * 64 * 2048); } while (0)
    SC_LOAD(0); SC_LOADOG(0);
    {
        float lfv[4], igv[4];
#pragma unroll
        for (int k = 0; k < 4; ++k) { const size_t gi = (size_t)(tok0 + (w + 8 * k) * 64 + lane) * 4 + h; lfv[k] = T.LF[gi]; igv[k] = T.IG[gi]; }
#pragma unroll
        for (int k = 0; k < 4; ++k) {
            const int ck = w + 8 * k; const float bb = scan_add(lfv[k], lane), cc = igv[k] - bb, pm = scan_max(cc, lane);
            gt[G_B + ck * 64 + lane] = bb; gt[G_CC + ck * 64 + lane] = cc; gt[G_PM + ck * 64 + lane] = pm;
            if (lane == 63) { gt[G_SC + ck * 4 + 0] = bb; gt[G_SC + ck * 4 + 1] = pm; }
        }
        __syncthreads();
        if (tid == 0) { float m = 0.f;
#pragma unroll 1
            for (int ck = 0; ck < 32; ++ck) { const float bl = gt[G_SC + ck * 4], cm = gt[G_SC + ck * 4 + 1]; gt[G_SC + ck * 4 + 2] = m; m = fmaxf(bl + m, bl + cm); gt[G_SC + ck * 4 + 3] = m; } }
        __syncthreads();
    }
    for (int ci = 0; ci < S / 64; ++ci) {
        tid = tid0; asm volatile("" : "+v"(tid)); lane = tid & 63; l15 = lane & 15; q = lane >> 4;
#pragma unroll
        for (int i = 0; i < 4; ++i) { const int e = tid + i * NTHR, row = e >> 5, ch = e & 31; *(LAS u32x4*)(lds + SC_QS + row * SC_QSTR + 16 * ch) = sQ[i]; *(LAS u32x4*)(lds + SC_KS + row * SC_QSTR + 16 * ch) = sK[i]; }
        *(LAS u32x4*)(lds + SC_VS + vd * SC_VVSTR + 16 * vch) = sV;
        if (ci > 0 && !dry) *(u32x4*)(gOG + (size_t)(ci - 1) * 64 * 2048) = *(const LAS u32x4*)(lds + SC_OT + vd * SC_VVSTR + 16 * vch);
        *(LAS u32x4*)(lds + SC_OT + vd * SC_VVSTR + 16 * vch) = sOG;
        const f32x4 scal = *(const LAS f32x4*)(gt + G_SC + ci * 4);
        const float m_c = scal[2], blast = scal[0], mnew = scal[3];
        const LAS float* gB = gt + G_B + ci * 64; const LAS float* gC = gt + G_CC + ci * 64; const LAS float* gP = gt + G_PM + ci * 64;
        __syncthreads();
        if (ci + 1 < S / 64) SC_LOAD(ci + 1);
        {
            const int sb = w >> 1;
#pragma unroll
            for (int tt = 0; tt < 2; ++tt) {
                const int tb = 2 * (w & 1) + tt;
                const int t = 16 * tb + l15, s0 = 16 * sb + 4 * q;
                if (sb <= tb) {
                    f32x4 a4 = (f32x4){0.f, 0.f, 0.f, 0.f};
#pragma unroll
                    for (int ks = 0; ks < 8; ++ks) {
                        const bf16x8 ka = *(const LAS bf16x8*)(lds + SC_KS + (16 * sb + l15) * SC_QSTR + 64 * ks + 16 * q);
                        const bf16x8 qb2 = *(const LAS bf16x8*)(lds + SC_QS + (16 * tb + l15) * SC_QSTR + 64 * ks + 16 * q);
                        a4 = MFMA16(ka, qb2, a4);
                    }
                    const float a2 = -fmaxf(m_c, gP[t]) * LOG2E; const f32x4 c2 = *(const LAS f32x4*)(gC + s0);
                    float rsum = 0.f;
#pragma unroll
                    for (int r2 = 0; r2 < 4; ++r2) { const float wgt = (s0 + r2 <= t) ? ex2(a2 + c2[r2] * LOG2E) : 0.f; a4[r2] *= wgt; rsum += a4[r2]; }
                    u32x2 pw; pw.x = pk2(a4[0], a4[1]); pw.y = pk2(a4[2], a4[3]);
                    *(LAS u32x2*)(lds + SC_SP + t * SC_VSTR + s0 * 2) = pw;
                    rsum = red_fq(rsum); if (q == 0) vec[V_RS + 64 * sb + t] = rsum;
                } else {
                    *(LAS u32x2*)(lds + SC_SP + t * SC_VSTR + s0 * 2) = (u32x2){0u, 0u};
                    if (q == 0) vec[V_RS + 64 * sb + t] = 0.f;
                }
            }
        }
        f32x4 qc[4];
        {
            bf16x8 cf[4]; f32x4 qnp[4];
            u32x4 nw; nw.x = pk2(nacc[0][0], nacc[0][1]); nw.y = pk2(nacc[0][2], nacc[0][3]); nw.z = pk2(nacc[1][0], nacc[1][1]); nw.w = pk2(nacc[1][2], nacc[1][3]);
            const bf16x8 nf = __builtin_bit_cast(bf16x8, nw);
#pragma unroll
            for (int ks = 0; ks < 4; ++ks) { u32x4 cw; cw.x = pk2(Cacc[2 * ks][0], Cacc[2 * ks][1]); cw.y = pk2(Cacc[2 * ks][2], Cacc[2 * ks][3]); cw.z = pk2(Cacc[2 * ks + 1][0], Cacc[2 * ks + 1][1]); cw.w = pk2(Cacc[2 * ks + 1][2], Cacc[2 * ks + 1][3]); cf[ks] = __builtin_bit_cast(bf16x8, cw); }
#pragma unroll
            for (int tb = 0; tb < 4; ++tb) {
                qc[tb] = (f32x4){0.f, 0.f, 0.f, 0.f}; qnp[tb] = (f32x4){0.f, 0.f, 0.f, 0.f};
#pragma unroll
                for (int ks = 0; ks < 4; ++ks) {
                    const LAS unsigned char* qp = lds + SC_QS + (16 * tb + l15) * SC_QSTR + (128 * g + 32 * ks + 4 * q) * 2;
                    const bf16x8 qa = cat4(*(const LAS s16x4*)qp, *(const LAS s16x4*)(qp + 32));
                    qc[tb] = MFMA16(cf[ks], qa, qc[tb]);
                    if (ks == c) qnp[tb] = MFMA16(nf, qa, qnp[tb]);
                }
            }
            if (q == 0) {
#pragma unroll
                for (int tb = 0; tb < 4; ++tb) vec[V_QNP + w * 64 + 16 * tb + l15] = qnp[tb][0];
            }
            LAS f32x4* qx = (LAS f32x4*)(lds + SC_QCX) + (w * 2) * 64 + lane;
            qx[0] = g ? qc[0] : qc[2]; qx[64] = g ? qc[1] : qc[3];
        }
        if (tid < 64) vec[V_WS + tid] = __expf(blast + gC[tid] - mnew);
        __syncthreads();
        bf16x8 vf[2];
#pragma unroll
        for (int ks = 0; ks < 2; ++ks) { LAS unsigned char* vp = lds + SC_VS + (32 * ks + 8 * q + (l15 >> 2)) * SC_VVSTR + (16 * c + 4 * (lane & 3)) * 2;
            vf[ks] = cat4(__builtin_amdgcn_ds_read_tr16_b64_v4i16((LAS s16x4*)vp), __builtin_amdgcn_ds_read_tr16_b64_v4i16((LAS s16x4*)(vp + 4 * SC_VVSTR))); }
        {
            LAS float* wh = vec + V_WH + w * 64;
            if (lane < 32) {
                const int t = 32 * g + lane; float qn = 0.f, rs = 0.f;
#pragma unroll
                for (int k = 0; k < 8; ++k) qn += vec[V_QNP + 64 * k + t];
#pragma unroll
                for (int k = 0; k < 4; ++k) rs += vec[V_RS + 64 * k + t];
                const float mxv = fmaxf(m_c, gP[t]), wi = __expf(m_c - mxv), em = __expf(-gB[t] - mxv);
                wh[lane] = wi; wh[32 + lane] = __builtin_amdgcn_rcpf(fmaxf(fabsf(wi * qn + rs), em));
            }
            const LAS f32x4* px = (const LAS f32x4*)(lds + SC_QCX) + ((w ^ 4) * 2) * 64 + lane;
#define SC_FIN(tt, QCV) do { const int tb = 2 * g + (tt); \
                f32x4 sv = (f32x4){0.f, 0.f, 0.f, 0.f}; \
                _Pragma("unroll") for (int ks = 0; ks < 2; ++ks) { const LAS unsigned char* sp = lds + SC_SP + (16 * tb + l15) * SC_VSTR + 64 * ks + 16 * q; const bf16x8 sa = cat4(*(const LAS s16x4*)sp, *(const LAS s16x4*)(sp + 8)); sv = MFMA16(vf[ks], sa, sv); } \
                const f32x4 qct = (QCV) + px[64 * (tt)]; \
                const float wi = wh[16 * (tt) + l15], hi_ = wh[32 + 16 * (tt) + l15]; \
                LAS u32x2* op = (LAS u32x2*)(lds + SC_OT + (16 * tb + l15) * SC_VVSTR + (16 * c + 4 * q) * 2); const u32x2 ogw = *op; \
                u32x2 ow; ow.x = pk2((wi * qct[0] + sv[0]) * hi_ * bflo(ogw.x), (wi * qct[1] + sv[1]) * hi_ * bfhi(ogw.x)); ow.y = pk2((wi * qct[2] + sv[2]) * hi_ * bflo(ogw.y), (wi * qct[3] + sv[3]) * hi_ * bfhi(ogw.y)); \
                *op = ow; } while (0)
            if (g) { SC_FIN(0, qc[2]); SC_FIN(1, qc[3]); } else { SC_FIN(0, qc[0]); SC_FIN(1, qc[1]); }
#undef SC_FIN
        }
        if (ci + 1 < S / 64) SC_LOADOG(ci + 1);
        {
            const float decay = __expf(blast + m_c - mnew);
            bf16x8 vw[2], wsf[2];
#pragma unroll
            for (int ks = 0; ks < 2; ++ks) {
                const f32x4 w0 = *(const LAS f32x4*)(vec + V_WS + 32 * ks + 8 * q), w1 = *(const LAS f32x4*)(vec + V_WS + 32 * ks + 8 * q + 4);
                f32x4 x0, x1; unpk8(__builtin_bit_cast(u32x4, vf[ks]), x0, x1); vw[ks] = __builtin_bit_cast(bf16x8, pk8(x0 * w0, x1 * w1));
                const u32x4 wz = pk8(w0, w1); wsf[ks] = __builtin_bit_cast(bf16x8, l15 == 0 ? wz : (u32x4){0u, 0u, 0u, 0u});
            }
#pragma unroll
            for (int i = 0; i < 8; ++i) {
                if ((i & 1) == 0) __builtin_amdgcn_sched_barrier(0);
                Cacc[i] *= decay;
#pragma unroll
                for (int ks = 0; ks < 2; ++ks) {
                    LAS unsigned char* kp = lds + SC_KS + (32 * ks + 8 * q + (l15 >> 2)) * SC_QSTR + (128 * g + 16 * i + 4 * (lane & 3)) * 2;
                    const s16x4 lo = __builtin_amdgcn_ds_read_tr16_b64_v4i16((LAS s16x4*)kp), hi = __builtin_amdgcn_ds_read_tr16_b64_v4i16((LAS s16x4*)(kp + 4 * SC_QSTR));
                    Cacc[i] = MFMA16(cat4(lo, hi), vw[ks], Cacc[i]);
                }
            }
#pragma unroll
            for (int ib = 0; ib < 2; ++ib) {
                nacc[ib] *= decay;
#pragma unroll
                for (int ks = 0; ks < 2; ++ks) {
                    LAS unsigned char* kp = lds + SC_KS + (32 * ks + 8 * q + (l15 >> 2)) * SC_QSTR + (128 * g + 16 * (2 * c + ib) + 4 * (lane & 3)) * 2;
                    const s16x4 lo = __builtin_amdgcn_ds_read_tr16_b64_v4i16((LAS s16x4*)kp), hi = __builtin_amdgcn_ds_read_tr16_b64_v4i16((LAS s16x4*)(kp + 4 * SC_QSTR));
                    nacc[ib] = MFMA16(cat4(lo, hi), wsf[ks], nacc[ib]);
                }
            }
        }
        __syncthreads();
    }
    if (!dry) *(u32x4*)(gOG + (size_t)(S / 64 - 1) * 64 * 2048) = *(const LAS u32x4*)(lds + SC_OT + vd * SC_VVSTR + 16 * vch);
    __syncthreads();
#undef SC_LOAD
#undef SC_LOADOG
}
DI void scan_phase(LAS unsigned char* lds, const ScanT& T, int cu, int dry) {
    const int xcd = cu & 7, idx = cu >> 3, bh = xcd * 4 + (idx >> 3), sl = idx & 7;
    scan_item(lds, T, bh >> 2, bh & 3, sl, dry);
}

DI void final_phase(const bf16_t* xb, float* out, const u64* ssq, const float* g, int gw, int NGW, int lane) {
    for (int m = gw; m < M; m += NGW) {
        const float rs = ssq_rstd(ssq + m, 1.f / 1024.f);
#pragma unroll
        for (int j = 0; j < 2; ++j) {
            const int c0 = (lane + 64 * j) * 8; f32x4 a, b; unpk8(*(const u32x4*)(xb + (size_t)m * D + c0), a, b);
            *(f32x4*)(out + (size_t)m * D + c0) = a * rs * *(const f32x4*)(g + c0); *(f32x4*)(out + (size_t)m * D + c0 + 4) = b * rs * *(const f32x4*)(g + c0 + 4);
        }
    }
}
constexpr int LDS_BYTES = 147456, MISC_OFF = 146944;
static_assert(SC_END <= MISC_OFF && AT_WQOFF + 96 * AT_WQS <= MISC_OFF && AT_WQOFF == 2 * AT_KB + 2 * AT_VB, "LDS map");
constexpr int PH_PER_LAYER = 6, PH_FINAL = 1 + 4 * PH_PER_LAYER, PH_REFRESH = 100;
#ifndef GEMM_ALIGN
#define GEMM_ALIGN true
#endif
#ifndef GEMM_SP2
#define GEMM_SP2 true
#endif
#ifndef C1_DRYMODE
#define C1_DRYMODE 1
#endif
#ifndef BAR_TWICE
#define BAR_TWICE 0
#endif
#ifndef STAGGER
#define STAGGER 0
#endif
#ifndef STAGGER_MASK
#define STAGGER_MASK 3
#endif
#ifndef STAGGER_L1
#define STAGGER_L1 0
#endif
#define STAGGER_SLEEP_N(n_) do { if (n_) { for (int s_ = 0; s_ < (int)(((cu >> 3) & STAGGER_MASK) * (n_)); ++s_) __builtin_amdgcn_s_sleep(32); } } while (0)
#define STAGGER_SLEEP() STAGGER_SLEEP_N(STAGGER)
#ifndef PP_HOLES
#define PP_HOLES 0
#endif
#ifndef A2_REV
#define A2_REV 1
#endif
#ifndef A2_QREV
#define A2_QREV 0
#endif
#ifndef GEMM_ALIGN1
#define GEMM_ALIGN1 GEMM_ALIGN
#endif
#ifndef P0_ORDER
#define P0_ORDER 0
#endif
#ifndef PHM
#define PHM 0xFFFF
#endif
#define PH_ON(b) ((PHM >> (b)) & 1)
#ifndef REPEAT
#define REPEAT 0
#endif
#ifndef REPEAT_AFTER
#define REPEAT_AFTER 0
#endif
#if REPEAT_AFTER
#define REP_LOOP(b) for (int rep_ = 0, nrep_ = opaque((REPEAT >> (b)) & 1); rep_ <= nrep_; ++rep_)
#else
#define REP_LOOP(b) for (int rep_ = opaque((REPEAT >> (b)) & 1); rep_ >= 0; --rep_)
#endif
typedef const __attribute__((address_space(4))) Args* KArgs;
DI KArgs kargs() { KArgs p = (KArgs)__builtin_amdgcn_kernarg_segment_ptr(); asm volatile("" : "+s"(p)); return p; }

#define TID_DEFS const int tid = tidx(), w = __builtin_amdgcn_readfirstlane(tid >> 6), lane = tid & 63; (void)w; (void)lane
DI void prep_mixer(LAS unsigned char* lds, int i, int cu, int G) {
    TID_DEFS; KArgs A = kargs(); unsigned char* ws = A->ws; LAS float* scr = (LAS float*)lds;
    const int kind = i % 3, j = i / 3;
    const float* normg = A->in[I_NORMG] + (size_t)i * D; bf16_t* wmix = (bf16_t*)(ws + WS_WMIX);
    const PrepTask tple{A->in[I_PLE_PROJ] + (size_t)i * 256 * D, D, nullptr, 256, D, PM_ID, (bf16_t*)(ws + WS_WPLE + 2 * MiB)};
    if (kind == 0) {
        constexpr int n0 = 28 * 8, n1 = 24 * 3, n2 = 32 * 2, n3 = 16 * 8;
        const PrepTask t0{A->in[I_MLA_WIN] + (size_t)j * D * 1696, 1696, normg, D, 1792, PM_MLA_IN, wmix};
        const PrepTask t1{A->in[I_MLA_WQB] + (size_t)j * 384 * 1536, 1536, A->in[I_MLA_QN] + j * 384, 384, 1536, PM_MLA_QB, (bf16_t*)(ws + WS_WMIX + WM_QB)};
        const PrepTask t2{A->in[I_MLA_WKVB] + (size_t)j * 256 * 2048, 2048, A->in[I_MLA_KVN] + j * 256, 256, 2048, PM_MLA_KVB, (bf16_t*)(ws + WS_WMIX + WM_KVB)};
        const PrepTask t3{A->in[I_MLA_WOUT] + (size_t)j * D * D, D, nullptr, D, D, PM_ID, (bf16_t*)(ws + WS_WMIX + WM_OUT_MLA)};
        prep_batched([&](int it, auto&& f) {
            if (it < n0) f(t0, it); else if (it < n0 + n1) f(t1, it - n0); else if (it < n0 + n1 + n2) f(t2, it - n0 - n1); else if (it < n0 + n1 + n2 + n3) f(t3, it - n0 - n1 - n2); else f(tple, it - n0 - n1 - n2 - n3);
        }, n0 + n1 + n2 + n3 + 32, cu, G, scr);
    } else if (kind == 1) {
        constexpr int n0 = 64 * 8, n1 = 16 * 8;
        const PrepTask t0{A->in[I_CONV_WIN] + (size_t)j * D * 4096, 4096, normg, D, 4096, PM_CONV_IN, wmix};
        const PrepTask t1{A->in[I_CONV_WOUT] + (size_t)j * D * D, D, nullptr, D, D, PM_ID, (bf16_t*)(ws + WS_WMIX + WM_OUT_CONV)};
        prep_batched([&](int it, auto&& f) { if (it < n0) f(t0, it); else if (it < n0 + n1) f(t1, it - n0); else f(tple, it - n0 - n1); }, n0 + n1 + 32, cu, G, scr);
    } else {
        constexpr int n0 = 128 * 8, n1 = 16 * 16;
        const PrepTask t0{A->in[I_L_WIN] + (size_t)j * D * 8200, 8200, normg, D, 8192, PM_LSTM_IN, wmix};
        const PrepTask t1{A->in[I_L_WOUT] + (size_t)j * 2048 * D, D, nullptr, 2048, D, PM_ID, (bf16_t*)(ws + WS_WMIX + WM_OUT_LSTM)};
        prep_batched([&](int it, auto&& f) { if (it < n0) f(t0, it); else if (it < n0 + n1) f(t1, it - n0); else f(tple, it - n0 - n1); }, n0 + n1 + 32, cu, G, scr);
        gw8_prep(A->in[I_L_WIN] + (size_t)j * D * 8200, normg, (float*)(ws + WS_GW8), cu * NTHR + tid, G * NTHR);
    }
    if (kind != 2) p_to_bf16(A->in[I_P] + (size_t)i * M * 256, (bf16_t*)(ws + WS_BIG + A_PB), cu * NTHR + tid, G * NTHR);
}
DI void prep_ple(LAS unsigned char* lds, int i, int cu, int G) {
    KArgs A = kargs(); unsigned char* ws = A->ws; LAS float* scr = (LAS float*)lds;
    const PrepTask t0{A->in[I_PLE_GATE] + (size_t)i * D * D, D, nullptr, D, D, PM_ID, (bf16_t*)(ws + WS_WPLE)};
    prep_batched([&](int it, auto&& f) { f(t0, it); }, 16 * 8, cu, G, scr);
}

__global__ void __launch_bounds__(NTHR, 2) fwd(Args a_) {
    extern __shared__ __attribute__((aligned(16))) unsigned char lds_[];
    LAS unsigned char* lds = (LAS unsigned char*)lds_;
    const int cu = blockIdx.x, G = gridDim.x;
#define GW (cu * 8 + w)
#define NGW (G * 8)
#define GT (cu * NTHR + tid)
#define NGT (G * NTHR)
    const int lo = a_.ph_lo, hi = a_.ph_hi;
    volatile LAS unsigned* misc = (volatile LAS unsigned*)(lds + MISC_OFF);
    { TID_DEFS; if (tid < 32) misc[tid] = 0u; }
    __syncthreads();
    const bool multi = (hi - lo) > 1;
    XcdBarrier bar; bar.bar = nullptr; bar.x = 0; bar.st = misc + 8;
    if (multi) bar = xcd_barrier_post((unsigned*)(kargs()->ws + WS_CTL), misc + 8);
#define IN(k) (lo <= (k) && (k) < hi)
#ifdef TIMELINE
#define STAMP(idx) do { if (blockIdx.x == 0 && threadIdx.x == 0) ((unsigned long long*)(kargs()->ws + WS_CTL + 32 * KiB))[(idx)] = __builtin_amdgcn_s_memrealtime(); } while (0)
#else
#define STAMP(idx) do { } while (0)
#endif
#define SEAM(k) do { if (multi && (k) + 1 < hi) { XcdBarrier b2 = bar; b2.bar = (unsigned*)(kargs()->ws + WS_CTL); xcd_barrier(b2); if (BAR_TWICE) xcd_barrier(b2); } STAMP((k) + 1); } while (0)

    STAMP(0);
    if (lo >= PH_REFRESH) {
        TID_DEFS; KArgs A = kargs(); const int i = lo - PH_REFRESH; rows_to_bf16_ssq(A->out, (bf16_t*)(A->ws + WS_XBA), ssq_arr(A->ws, SSQ_X + i), GW, NGW, lane); return;
    }
    if (IN(0)) {
#if P0_ORDER
        REP_LOOP(13) prep_mixer(lds, 0, cu, G);
        REP_LOOP(11) { TID_DEFS; KArgs A = kargs(); unsigned char* ws = A->ws; rows_to_bf16_ssq(A->in[I_X], (bf16_t*)(ws + WS_XBA), ssq_arr(ws, SSQ_X), GW, NGW, lane); }
        REP_LOOP(12) { TID_DEFS; KArgs A = kargs(); unsigned char* ws = A->ws; rope_tables((const int*)A->in[I_POS], (float*)(ws + WS_CS), (float*)(ws + WS_SN), GT, NGT); }
#else
        REP_LOOP(11) { TID_DEFS; KArgs A = kargs(); unsigned char* ws = A->ws; rows_to_bf16_ssq(A->in[I_X], (bf16_t*)(ws + WS_XBA), ssq_arr(ws, SSQ_X), GW, NGW, lane); }
        REP_LOOP(12) { TID_DEFS; KArgs A = kargs(); unsigned char* ws = A->ws; rope_tables((const int*)A->in[I_POS], (float*)(ws + WS_CS), (float*)(ws + WS_SN), GT, NGT); }
        REP_LOOP(13) prep_mixer(lds, 0, cu, G);
#endif
    }
    if (IN(0)) SEAM(0);
#pragma unroll 1
    for (int i = 0; i < 4; ++i) {
        const int kind = i % 3, j = i / 3, base = 1 + PH_PER_LAYER * i;
        if (hi <= base || lo >= base + PH_PER_LAYER) continue;
        if (IN(base + 1)) {
            REP_LOOP(0) prep_ple(lds, i, cu, G);
            if (kind == 0 && PH_ON(1)) {
                unsigned char* ws = kargs()->ws;
                pg8::Gemm g{(bf16_t*)(ws + WS_XBA), (bf16_t*)(ws + WS_WMIX), M, 1792, opaque(D)}; pg8::StaticOrder So; So.init(M, 1792, G, cu);
                EpiA1 E{ws, i, j}; STAGGER_SLEEP();
                pg8::gemm_phase<EpiA1, pg8::StaticOrder, GEMM_ALIGN, GEMM_SP2>(lds, g, So, E);
                if (PP_HOLES && G == 256 && cu >= 192) {
                    KArgs A2 = kargs(); unsigned char* ws2 = A2->ws;
                    pg8::Gemm g2{(bf16_t*)(ws2 + WS_BIG + A_PB), (bf16_t*)(ws2 + WS_WPLE + 2 * MiB), M, D, opaque(256)}; pg8::StaticOrder So2; So2.init(M, D, 64, cu - 192);
                    EpiPP E2{(bf16_t*)A2->out};
                    pg8::gemm_phase<EpiPP, pg8::StaticOrder, GEMM_ALIGN, GEMM_SP2>(lds, g2, So2, E2);
                }
            } else if (kind == 1 && PH_ON(2)) REP_LOOP(2) {
                unsigned char* ws = kargs()->ws;
                pg8::Gemm g{(bf16_t*)(ws + WS_XBA), (bf16_t*)(ws + WS_WMIX), M, 4096, opaque(D)}; pg8::StaticOrder So; So.init(M, 4096, G, cu);
                EpiC1 E{ws, i, rep_ * C1_DRYMODE}; STAGGER_SLEEP();
                pg8::gemm_phase<EpiC1, pg8::StaticOrder, GEMM_ALIGN, GEMM_SP2>(lds, g, So, E);
            } else if (kind == 2 && PH_ON(3)) REP_LOOP(3) {
                { TID_DEFS; KArgs A = kargs(); unsigned char* ws = A->ws;
                  gates_phase((bf16_t*)(ws + WS_XBA), ssq_arr(ws, SSQ_X + i), (const float*)(ws + WS_GW8), A->in[I_L_BG] + j * 8, (float*)(ws + WS_IG), (float*)(ws + WS_LF), GW, NGW, lane); }
                unsigned char* ws = kargs()->ws;
                pg8::Gemm g{(bf16_t*)(ws + WS_XBA), (bf16_t*)(ws + WS_WMIX), M, 8192, opaque(D)}; pg8::StaticOrder So; So.init(M, 8192, G, cu);
                EpiL1 E{ws, i}; STAGGER_SLEEP(); STAGGER_SLEEP_N(STAGGER_L1);
                pg8::gemm_phase<EpiL1, pg8::StaticOrder, GEMM_ALIGN, GEMM_SP2>(lds, g, So, E);
            }
            SEAM(base + 1);
        }
        if (IN(base + 2) && kind != 2) {
            if (kind == 0 && PH_ON(4)) REP_LOOP(4) {
                if (!QFUSE) { unsigned char* ws = kargs()->ws;
                  pg8::Gemm g{(bf16_t*)(ws + WS_BIG + A_CQ), (bf16_t*)(ws + WS_WMIX + WM_QB), M, 1536, opaque(384)}; pg8::StaticOrder So; So.init(M, 1536, G, A2_QREV ? G - 1 - cu : cu);
                  EpiQ E{ws, j};
                  pg8::gemm_phase<EpiQ, pg8::StaticOrder, GEMM_ALIGN, GEMM_SP2>(lds, g, So, E); }
                { unsigned char* ws = kargs()->ws;
                  pg8::Gemm g{(bf16_t*)(ws + WS_BIG + A_CKV), (bf16_t*)(ws + WS_WMIX + WM_KVB), M, 2048, opaque(256)}; pg8::StaticOrder So; So.init(M, 2048, G, A2_REV ? G - 1 - cu : cu);
                  EpiKV E{ws, j};
                  pg8::gemm_phase<EpiKV, pg8::StaticOrder, GEMM_ALIGN, GEMM_SP2>(lds, g, So, E); }
            } else if (kind == 1 && PH_ON(5)) REP_LOOP(5) {
                TID_DEFS; KArgs A = kargs(); unsigned char* ws = A->ws;
                conv_phase((const bf16_t*)(ws + WS_BIG + C_CH), (bf16_t*)(ws + WS_BIG + C_BZ), A->in[I_CONV_W] + (size_t)j * 3 * 1024, GT, NGT, rep_);
            }
            SEAM(base + 2);
        }
        if (IN(base + 3) && kind != 1) {
            if (kind == 0 && PH_ON(6)) REP_LOOP(6) {
                unsigned char* wsA = kargs()->ws; unsigned char* big = wsA + WS_BIG;
                AttnT T{(bf16_t*)(big + A_Q), (bf16_t*)(big + A_KN), (bf16_t*)(big + A_KR), (bf16_t*)(big + A_VT), (bf16_t*)(big + A_SZ),
                        (bf16_t*)(big + A_CQ), (bf16_t*)(wsA + WS_WMIX + WM_QB), ssq_arr(wsA, SSQ_Q + j), (const float*)(wsA + WS_CS), (const float*)(wsA + WS_SN)};
                attn_phase(lds, T, cu, rep_);
            } else if (kind == 2 && PH_ON(7)) {
                { unsigned char* ws = kargs()->ws; unsigned char* big = ws + WS_BIG;
                  ScanT T{(bf16_t*)(big + L_Q), (bf16_t*)(big + L_K), (bf16_t*)(big + L_VT), (bf16_t*)(big + L_OG), (float*)(ws + WS_IG), (float*)(ws + WS_LF)};
                  REP_LOOP(7) scan_phase(lds, T, cu, rep_); }
                TID_DEFS; KArgs A = kargs();
                p_to_bf16(A->in[I_P] + (size_t)i * M * 256, (bf16_t*)A->out, GT, NGT);
            }
            SEAM(base + 3);
        }
        if (IN(base + 4)) {
            const size_t xbb_off = kind == 0 ? A_XBB : kind == 1 ? C_XBB : L_XBB, pp_off = kind == 0 ? A_PP : kind == 1 ? C_PP : L_PP;
            if (PH_ON(8)) { KArgs A = kargs(); unsigned char* ws = A->ws;
              const size_t oin = kind == 0 ? A_SZ : kind == 1 ? C_BZ : L_OG, wout = kind == 2 ? WM_OUT_LSTM : WM_OUT_MLA;
              pg8::Gemm g{(bf16_t*)(ws + WS_BIG + oin), (bf16_t*)(ws + WS_WMIX + wout), M, D, opaque(kind == 2 ? 2048 : 1024)}; pg8::StaticOrder So; So.init(M, D, G, cu);
              EpiOut E{ws, xbb_off, i};
              pg8::gemm_phase<EpiOut, pg8::StaticOrder, GEMM_ALIGN1, GEMM_SP2>(lds, g, So, E); }
            if (PH_ON(9) && !(PP_HOLES && kind == 0 && G == 256)) REP_LOOP(9) { KArgs A = kargs(); unsigned char* ws = A->ws;
              pg8::Gemm g{kind == 2 ? (bf16_t*)A->out : (bf16_t*)(ws + WS_BIG + A_PB), (bf16_t*)(ws + WS_WPLE + 2 * MiB), M, D, opaque(256)}; pg8::StaticOrder So; So.init(M, D, G, cu);
              EpiPP E{(bf16_t*)(ws + WS_BIG + pp_off)};
              pg8::gemm_phase<EpiPP, pg8::StaticOrder, GEMM_ALIGN, GEMM_SP2>(lds, g, So, E); }
            SEAM(base + 4);
        }
        if (IN(base + 5)) {
            if (PH_ON(10)) { KArgs A = kargs(); unsigned char* ws = A->ws;
              const size_t xbb_off = kind == 0 ? A_XBB : kind == 1 ? C_XBB : L_XBB, pp_off = kind == 0 ? A_PP : kind == 1 ? C_PP : L_PP;
              const bf16_t* ppp = (PP_HOLES && kind == 0 && G == 256) ? (const bf16_t*)A->out : (const bf16_t*)(ws + WS_BIG + pp_off);
              pg8::Gemm g{(bf16_t*)(ws + WS_BIG + xbb_off), (bf16_t*)(ws + WS_WPLE), M, D, opaque(D)}; pg8::StaticOrder So; So.init(M, D, G, cu);
              if (i == 3 && multi && G == 256 && hi > PH_FINAL) {
                  EpiPleLast E{ws, A->out, A->in[I_FNORM], ppp, xbb_off, i, bar.x, bar.st};
                  pg8::gemm_phase<EpiPleLast, pg8::StaticOrder, false, GEMM_SP2>(lds, g, So, E);
              } else {
                  EpiPle E{ws, ppp, xbb_off, i};
                  pg8::gemm_phase<EpiPle, pg8::StaticOrder, GEMM_ALIGN1, GEMM_SP2>(lds, g, So, E); } }
            if (i < 3) REP_LOOP(1) prep_mixer(lds, i + 1, cu, G);
            if (!(i == 3 && multi && G == 256 && hi > PH_FINAL)) SEAM(base + 5);
        }
    }
    if (IN(PH_FINAL) && !(multi && G == 256 && lo <= PH_FINAL - 1)) { TID_DEFS; KArgs A = kargs(); final_phase((const bf16_t*)(A->ws + WS_XBA), A->out, ssq_arr(A->ws, SSQ_X + 4), A->in[I_FNORM], GW, NGW, lane); }
#ifdef TIMELINE
    {
        SEAM(PH_FINAL);
        TID_DEFS; KArgs A = kargs(); const unsigned long long* ts = (const unsigned long long*)(A->ws + WS_CTL + 32 * KiB);
        const float dA = (float)(ts[TS_A1] - ts[TS_A0]) * 0.01f, dB = (float)(ts[TS_B1] - ts[TS_B0]) * 0.01f;
        const float c = sqrtf(dA);
        for (size_t e = GT; e < (size_t)M * D; e += NGT) A->out[e] = (e == 0) ? 60.f + dB : c;
    }
#endif
#undef IN
#undef SEAM
}
}
#ifndef FAST_LAYERS
#define FAST_LAYERS 15
#endif
#ifndef ONE_LAUNCH
#define ONE_LAUNCH 1
#endif

extern "C" void kernel_launch(void* const* d_in, const int* in_sizes, int n_in, void* d_out, int out_size, void* d_ws, size_t ws_size, hipStream_t stream) {
    static int grid = 0;
    if (grid == 0) {
        int dev = 0, cus = 0;
        if (n_in != 19 || ws_size < fk::WS_END || out_size != fk::M * fk::D) { fprintf(stderr, "kernel_launch: unexpected shapes (n_in %d, ws %zu, out %d)\n", n_in, ws_size, out_size); grid = -1; return; }
        if (hipGetDevice(&dev) != hipSuccess || hipDeviceGetAttribute(&cus, hipDeviceAttributeMultiprocessorCount, dev) != hipSuccess) { grid = -1; return; }
        if (hipFuncSetAttribute((const void*)fk::fwd, hipFuncAttributeMaxDynamicSharedMemorySize, fk::LDS_BYTES) != hipSuccess) { fprintf(stderr, "kernel_launch: hipFuncSetAttribute failed\n"); grid = -1; return; }
        int per_cu = 0;
        if (hipOccupancyMaxActiveBlocksPerMultiprocessor(&per_cu, (const void*)fk::fwd, fk::NTHR, fk::LDS_BYTES) != hipSuccess || per_cu < 1) { fprintf(stderr, "kernel_launch: occupancy query says %d\n", per_cu); }
        (void)hipGetLastError();
        grid = cus;
        if (grid != 256) fprintf(stderr, "kernel_launch: %d CUs (built for 256)\n", grid);
    }
    if (grid < 0) return;
    (void)hipMemsetAsync(d_ws, 0, fk::ZERO_BYTES, stream);
    fk::Args a{};
    for (int i = 0; i < 19; ++i) a.in[i] = (const float*)d_in[i];
    a.out = (float*)d_out; a.ws = (unsigned char*)d_ws;
#define LAUNCH(lo_, hi_) do { a.ph_lo = (lo_); a.ph_hi = (hi_); hipLaunchKernelGGL(fk::fwd, dim3(grid), dim3(fk::NTHR), fk::LDS_BYTES, stream, a); } while (0)
#if ONE_LAUNCH && (FAST_LAYERS == 15)
#ifdef TIMELINE
    LAUNCH(0, fk::PH_FINAL + 2);
#else
    LAUNCH(0, fk::PH_FINAL + 1);
#endif
#else
    nv::In in;
    in.x = (const float*)d_in[0]; in.p = (const float*)d_in[1]; in.pos = (const int*)d_in[2]; in.norm_g = (const float*)d_in[3];
    in.mla_w_in = (const float*)d_in[4]; in.mla_q_norm = (const float*)d_in[5]; in.mla_w_q_b = (const float*)d_in[6];
    in.mla_kv_norm = (const float*)d_in[7]; in.mla_w_kv_b = (const float*)d_in[8]; in.mla_w_out = (const float*)d_in[9];
    in.conv_w_in = (const float*)d_in[10]; in.conv_w = (const float*)d_in[11]; in.conv_w_out = (const float*)d_in[12];
    in.mlstm_w_in = (const float*)d_in[13]; in.mlstm_b_gates = (const float*)d_in[14]; in.mlstm_w_out = (const float*)d_in[15];
    in.ple_proj = (const float*)d_in[16]; in.ple_gate = (const float*)d_in[17]; in.final_norm = (const float*)d_in[18];
    float* nws = (float*)((char*)d_ws + 2 * fk::MiB);
    LAUNCH(0, 1);
    for (int i = 0; i < 4; ++i) {
        if ((FAST_LAYERS >> i) & 1) {
            if (i > 0 && !((FAST_LAYERS >> (i - 1)) & 1)) LAUNCH(fk::PH_REFRESH + i, fk::PH_REFRESH + i + 1);
            for (int s = 0; s < fk::PH_PER_LAYER; ++s) LAUNCH(1 + fk::PH_PER_LAYER * i + s, 1 + fk::PH_PER_LAYER * i + s + 1);
        } else {
            nv::layer(in, (float*)d_out, nws, stream, i, i == 0);
        }
    }
    if ((FAST_LAYERS >> 3) & 1) LAUNCH(fk::PH_FINAL, fk::PH_FINAL + 1);
    else nv::final_norm(in, (float*)d_out, stream);
#endif
#undef LAUNCH
}
```

```cpp
#include <hip/hip_runtime.h>
#include <cstdio>
#include <cstdint>
#include <math.h>
#define LAS __attribute__((address_space(3)))
#define GAS __attribute__((address_space(1)))
#define FAST_LAYERS 15
#define ONE_LAUNCH 1
namespace pg8 {
#define PG8_LAS __attribute__((address_space(3)))
typedef unsigned short bf16_t;
typedef short bf16x8 __attribute__((ext_vector_type(8)));
typedef float f32x4 __attribute__((ext_vector_type(4)));
typedef unsigned u32x4 __attribute__((ext_vector_type(4)));
constexpr int BM = 256, BK = 64, HALF = 128, HTB = HALF * BK * 2  , STAGE_BYTES = 8 * HTB, NXCD = 8, WGM = 8;

__host__ __device__ __forceinline__ int lds_byte(int r, int c) { const int st = (r >> 4) * 2 + (c >> 5), rr = r & 15, cc = c & 31, ob = rr * 64 + cc * 2; return st * 1024 + (ob ^ (((ob >> 9) & 1) << 5)); }
__host__ __device__ __forceinline__ void stage_rc(int b, int& R, int& C) { const int st = b / 1024, sb = b % 1024, swz = sb ^ (((sb >> 9) & 1) << 5); R = (st >> 1) * 16 + swz / 64; C = (st & 1) * 32 + (swz % 64) / 2; }
__host__ __device__ __forceinline__ int perm32(int rho) { const int n = rho >> 4, i = rho & 15; return 8 * (i >> 2) + 4 * n + (i & 3); }

struct Unit { int pm, pn; };
struct Gemm { const bf16_t* A; const bf16_t* Bt; int M, N, K; };

struct StaticOrder {
    int nM, nN, nwg, G, c;
    __host__ __device__ void init(int M, int N, int G_, int c_) { nM = M / BM; nN = N / BM; nwg = nM * nN; G = G_; c = c_; }
    __host__ __device__ bool next(int i, Unit& u) const {
        const long L = (long)i * G + c; if (L >= nwg) return false;
        int wgid = (int)L; { const int q = nwg / NXCD, r = nwg % NXCD, xcd = wgid % NXCD, off = wgid / NXCD; wgid = (xcd < r ? xcd * (q + 1) : r * (q + 1) + (xcd - r) * q) + off; }
        const int nig = WGM * nN, gid = wgid / nig, fm = gid * WGM, gsz = (nM - fm) < WGM ? (nM - fm) : WGM;
        u.pm = fm + ((wgid % nig) % gsz); u.pn = (wgid % nig) / gsz; return true;
    }
    __device__ __forceinline__ void a_ready(const Unit&) const {}
    __device__ __forceinline__ void done(const Unit&) const {}
};

template <class Epi, class Sched, bool ALIGN_EPI = false, bool SP2 = false>
__device__ __forceinline__ void gemm_phase(PG8_LAS unsigned char* lds, const Gemm g, const Sched& S, const Epi& E) {
    int tid_ = threadIdx.x; asm volatile("" : "+v"(tid_));
    const int tid = tid_, wid = __builtin_amdgcn_readfirstlane(tid >> 6), lane = tid & 63, wr = wid >> 2, wc = wid & 3, fr = lane & 15, fq = lane >> 4;
    const int K = g.K, nt = K / BK;
    unsigned voffA[2], voffB[2];
#pragma unroll
    for (int i = 0; i < 2; ++i) { int R, C; stage_rc(tid * 16 + i * 8192, R, C); const int Rb = Epi::PERM ? ((R & ~31) + perm32(R & 31)) : R;
        voffA[i] = (unsigned)(R * K + C) * 2u; voffB[i] = (unsigned)(Rb * K + C) * 2u; }
    const size_t kstep = (size_t)(BK * 2);
    const size_t hstep = (size_t)HALF * K * 2;
    const size_t tstep = 2 * hstep;
    const unsigned ldsw = (unsigned)wid * 1024u;
    const int aoff = lds_byte(wr * 64 + fr, fq * 8), boff = lds_byte(wc * 32 + fr, fq * 8);
#define PG8_SA(b, h) (((b) * 2 + (h)) * HTB)
#define PG8_SB(b, h) ((4 + (b) * 2 + (h)) * HTB)
#define PG8_STAGE(bufoff, gbase, voff) do { _Pragma("unroll") for (int _i = 0; _i < 2; ++_i) \
        __builtin_amdgcn_global_load_lds((const unsigned*)((const char*)(gbase) + (voff)[_i]), (PG8_LAS unsigned*)(lds + (bufoff) + ldsw + _i * 8192), 16, 0, 0); } while (0)
#define PG8_LDA(dst, b, h) do { _Pragma("unroll") for (int m = 0; m < 4; ++m) _Pragma("unroll") for (int k = 0; k < 2; ++k) dst[m][k] = *(const PG8_LAS bf16x8*)(lds + PG8_SA(b, h) + aoff + m * 2048 + k * 1024); } while (0)
#define PG8_LDB(dst, b, h) do { _Pragma("unroll") for (int n = 0; n < 2; ++n) _Pragma("unroll") for (int k = 0; k < 2; ++k) dst[n][k] = *(const PG8_LAS bf16x8*)(lds + PG8_SB(b, h) + boff + n * 2048 + k * 1024); } while (0)
#define PG8_MMA(ai, bj, At, Bt) do { __builtin_amdgcn_s_setprio(1); _Pragma("unroll") for (int m = 0; m < 4; ++m) _Pragma("unroll") for (int n = 0; n < 2; ++n) _Pragma("unroll") for (int k = 0; k < 2; ++k) \
        acc[ai][bj][m][n] = __builtin_amdgcn_mfma_f32_16x16x32_bf16(Bt[n][k], At[m][k], acc[ai][bj][m][n], 0, 0, 0); __builtin_amdgcn_s_setprio(0); } while (0)
#define PG8_WAIT_V(n) asm volatile("s_waitcnt vmcnt(" #n ")" ::: "memory")
#define PG8_WAIT_L(n) asm volatile("s_waitcnt lgkmcnt(" #n ")" ::: "memory")
#define PG8_BAR __builtin_amdgcn_s_barrier()
#define PG8_SCHED __builtin_amdgcn_sched_barrier(0)
    Unit cur, nxt; int ui = 0;
    if (!S.next(0, cur)) return;
    f32x4 acc[2][2][4][2];
#pragma unroll
    for (int a = 0; a < 2; ++a)
#pragma unroll
        for (int b = 0; b < 2; ++b)
#pragma unroll
            for (int m = 0; m < 4; ++m)
#pragma unroll
                for (int n = 0; n < 2; ++n) acc[a][b][m][n] = (f32x4){0.f, 0.f, 0.f, 0.f};
    bf16x8 At[4][2], B0[2][2], B1[2][2];
    const char* cA = (const char*)g.A + (size_t)cur.pm * tstep; const char* cB = (const char*)g.Bt + (size_t)cur.pn * tstep;
    S.a_ready(cur);
    if constexpr (SP2) {
        PG8_STAGE(PG8_SB(0, 0), cB, voffB); PG8_STAGE(PG8_SB(0, 1), cB + hstep, voffB); PG8_STAGE(PG8_SA(0, 0), cA, voffA); PG8_STAGE(PG8_SA(0, 1), cA + hstep, voffA);
        if (wr == 1) PG8_BAR;
        PG8_WAIT_V(2); PG8_BAR;
        PG8_STAGE(PG8_SB(1, 0), cB + kstep, voffB); PG8_STAGE(PG8_SA(1, 0), cA + kstep, voffA); PG8_STAGE(PG8_SB(1, 1), cB + hstep + kstep, voffB);
        PG8_WAIT_V(6); PG8_BAR;
    } else {
        PG8_STAGE(PG8_SB(0, 0), cB, voffB); PG8_STAGE(PG8_SA(0, 0), cA, voffA); PG8_STAGE(PG8_SB(0, 1), cB + hstep, voffB); PG8_STAGE(PG8_SA(0, 1), cA + hstep, voffA);
        if (wr == 1) PG8_BAR;
        PG8_WAIT_V(4); PG8_BAR;
        PG8_STAGE(PG8_SB(1, 0), cB + kstep, voffB); PG8_STAGE(PG8_SA(1, 0), cA + kstep, voffA); PG8_STAGE(PG8_SB(1, 1), cB + hstep + kstep, voffB);
        PG8_WAIT_V(6); PG8_BAR;
    }
    for (;;) {
        const bool has_next = S.next(ui + 1, nxt);
        const char* nA = has_next ? (const char*)g.A + (size_t)nxt.pm * tstep : cA; const char* nB = has_next ? (const char*)g.Bt + (size_t)nxt.pn * tstep : cB;
        for (int t = 0; t < nt; t += 2) {
            const bool last = (t == nt - 2);
            const char* a1 = cA + (size_t)(t + 1) * kstep;
            const char* a2 = last ? nA : cA + (size_t)(t + 2) * kstep; const char* b2 = last ? nB : cB + (size_t)(t + 2) * kstep;
            const char* a3 = a2 + kstep; const char* b3 = b2 + kstep;
            if (last && has_next) S.a_ready(nxt);
            if constexpr (SP2) {
            PG8_LDB(B0, 0, 0); PG8_LDB(B1, 0, 1); PG8_SCHED; PG8_LDA(At, 0, 0); PG8_STAGE(PG8_SA(1, 1), a1 + hstep, voffA);
            PG8_WAIT_V(8); PG8_WAIT_L(0); PG8_BAR; PG8_MMA(0, 0, At, B0); PG8_MMA(0, 1, At, B1); PG8_BAR; PG8_SCHED;
            PG8_LDA(At, 0, 1); PG8_STAGE(PG8_SB(0, 0), b2, voffB); PG8_STAGE(PG8_SB(0, 1), b2 + hstep, voffB); PG8_STAGE(PG8_SA(0, 0), a2, voffA);
            PG8_WAIT_V(8); PG8_WAIT_L(0); PG8_BAR; PG8_MMA(1, 0, At, B0); PG8_MMA(1, 1, At, B1); PG8_BAR; PG8_SCHED;
            PG8_LDB(B0, 1, 0); PG8_LDB(B1, 1, 1); PG8_SCHED; PG8_LDA(At, 1, 0); PG8_STAGE(PG8_SA(0, 1), a2 + hstep, voffA);
            PG8_WAIT_V(8); PG8_WAIT_L(0); PG8_BAR; PG8_MMA(0, 0, At, B0); PG8_MMA(0, 1, At, B1); PG8_BAR; PG8_SCHED;
            PG8_LDA(At, 1, 1); PG8_STAGE(PG8_SB(1, 0), b3, voffB); PG8_STAGE(PG8_SB(1, 1), b3 + hstep, voffB); PG8_STAGE(PG8_SA(1, 0), a3, voffA);
            PG8_WAIT_V(8); PG8_WAIT_L(0); PG8_BAR; PG8_MMA(1, 0, At, B0); PG8_MMA(1, 1, At, B1); PG8_BAR; PG8_SCHED;
            } else {
            PG8_LDB(B0, 0, 0); PG8_SCHED; PG8_LDA(At, 0, 0); PG8_STAGE(PG8_SA(1, 1), a1 + hstep, voffA);
            PG8_WAIT_L(8); PG8_BAR; PG8_WAIT_L(0); PG8_MMA(0, 0, At, B0); PG8_BAR; PG8_SCHED;
            PG8_LDB(B1, 0, 1); PG8_STAGE(PG8_SB(0, 0), b2, voffB);
            PG8_BAR; PG8_WAIT_L(0); PG8_MMA(0, 1, At, B1); PG8_BAR;
            PG8_LDA(At, 0, 1); PG8_STAGE(PG8_SA(0, 0), a2, voffA);
            PG8_BAR; PG8_WAIT_L(0); PG8_MMA(1, 0, At, B0); PG8_BAR; PG8_SCHED;
            PG8_STAGE(PG8_SB(0, 1), b2 + hstep, voffB);
            PG8_WAIT_V(6); PG8_BAR; PG8_MMA(1, 1, At, B1); PG8_BAR;
            PG8_LDB(B0, 1, 0); PG8_SCHED; PG8_LDA(At, 1, 0); PG8_STAGE(PG8_SA(0, 1), a2 + hstep, voffA);
            PG8_WAIT_L(8); PG8_BAR; PG8_WAIT_L(0); PG8_MMA(0, 0, At, B0); PG8_BAR; PG8_SCHED;
            PG8_LDB(B1, 1, 1); PG8_STAGE(PG8_SB(1, 0), b3, voffB);
            PG8_BAR; PG8_WAIT_L(0); PG8_MMA(0, 1, At, B1); PG8_BAR;
            PG8_LDA(At, 1, 1); PG8_STAGE(PG8_SA(1, 0), a3, voffA);
            PG8_BAR; PG8_WAIT_L(0); PG8_MMA(1, 0, At, B0); PG8_BAR; PG8_SCHED;
            PG8_STAGE(PG8_SB(1, 1), b3 + hstep, voffB);
            PG8_WAIT_V(6); PG8_BAR; PG8_MMA(1, 1, At, B1); PG8_BAR;
            }
        }
        if constexpr (ALIGN_EPI) { if (wr == 0) PG8_BAR; }
        if constexpr (!Epi::AFTER_DRAIN) { E(acc, cur, wr, wc, fr, fq); S.done(cur); }
        if (!has_next) break;
#pragma unroll
        for (int a = 0; a < 2; ++a)
#pragma unroll
            for (int b = 0; b < 2; ++b)
#pragma unroll
                for (int m = 0; m < 4; ++m)
#pragma unroll
                    for (int n = 0; n < 2; ++n) acc[a][b][m][n] = (f32x4){0.f, 0.f, 0.f, 0.f};
        cur = nxt; cA = nA; cB = nB; ++ui;
        if constexpr (ALIGN_EPI) { if (wr == 1) PG8_BAR; }
    }
    PG8_WAIT_V(0);
    if constexpr (!ALIGN_EPI) { if (wr == 0) PG8_BAR; }
    PG8_BAR;
    if constexpr (Epi::AFTER_DRAIN) { E.fused(acc, cur, wr, wc, fr, fq, lds, wid, lane); S.done(cur); }
#undef PG8_SA
#undef PG8_SB
#undef PG8_STAGE
#undef PG8_LDA
#undef PG8_LDB
#undef PG8_MMA
#undef PG8_WAIT_V
#undef PG8_WAIT_L
#undef PG8_BAR
#undef PG8_SCHED
}
}
#define XB_TMO      128
#define XB_XCNT(j)  (256  + 64 * (j))
#define XB_XSUB(j)  (1280 + 64 * (j))
#define XB_XGEN(j)  (2304 + 64 * (j))
#define XB_TOP      3328
#define XB_TOPGEN   3392
#define XCD_BAR_WORDS 3456
#define XB_SPIN_CAP (1u << 18)

__device__ __forceinline__ unsigned xb_ld(unsigned* p)              { return __hip_atomic_load(p, __ATOMIC_RELAXED, __HIP_MEMORY_SCOPE_AGENT); }
__device__ __forceinline__ unsigned xb_add(unsigned* p, unsigned v) { return __hip_atomic_fetch_add(p, v, __ATOMIC_RELAXED, __HIP_MEMORY_SCOPE_AGENT); }
__device__ __forceinline__ unsigned xb_xcc_id() { return (unsigned)__builtin_amdgcn_s_getreg((3 << 11) | 20) & 0xFu; }
#define XB_SPIN(cond, bar) do { unsigned _sp = 0; while (cond) { __builtin_amdgcn_s_sleep(1); \
    if ((++_sp & 255u) == 0u) { if (xb_ld(&(bar)[XB_TMO])) break; if (_sp > XB_SPIN_CAP) { atomicAdd(&(bar)[XB_TMO], 1u); break; } } } } while (0)

struct XcdBarrier {
    unsigned* bar; unsigned x;
    volatile LAS unsigned* st;
};

__device__ __forceinline__ XcdBarrier xcd_barrier_post(unsigned* bar, volatile LAS unsigned* st) {
    XcdBarrier b; b.bar = bar; b.x = xb_xcc_id(); b.st = st;
    if (threadIdx.x == 0) (void)xb_add(&bar[XB_XCNT(b.x)], 1u);
    return b;
}
__device__ __forceinline__ void xcd_barrier_complete(unsigned* bar, unsigned x, unsigned& nloc, unsigned& nx) {
    const unsigned G = gridDim.x * gridDim.y * gridDim.z;
    unsigned sum, cnt, mine, sp = 0u;
    for (;;) {
        sum = 0u; cnt = 0u; mine = 0u;
#pragma unroll
        for (unsigned j = 0; j < 16; ++j) { const unsigned c = xb_ld(&bar[XB_XCNT(j)]); sum += c; cnt += (c > 0u) ? 1u : 0u; mine = (j == x) ? c : mine; }
        if (sum == G) break;
        __builtin_amdgcn_s_sleep(1);
        if ((++sp & 255u) == 0u) { if (xb_ld(&bar[XB_TMO])) break; if (sp > XB_SPIN_CAP) { atomicAdd(&bar[XB_TMO], 1u); break; } }
    }
    nloc = mine > 0u ? mine : 1u; nx = cnt > 0u ? cnt : 1u;
}

__device__ __forceinline__ void xcd_barrier(const XcdBarrier& b) {
    asm volatile("s_waitcnt vmcnt(0)" ::: "memory");
    __syncthreads();
    if (threadIdx.x == 0) {
        unsigned* bar = b.bar;
        __builtin_amdgcn_s_waitcnt(0);
        unsigned nloc = b.st[0], nx = b.st[1];
        if (nloc == 0u) { xcd_barrier_complete(bar, b.x, nloc, nx); b.st[0] = nloc; b.st[1] = nx; }
        const unsigned old = xb_add(&bar[XB_XSUB(b.x)], 1u);
        const unsigned gen = old / nloc;
        if (old + 1u == (gen + 1u) * nloc) {
            __builtin_amdgcn_fence(__ATOMIC_RELEASE, "agent");
            asm volatile("s_waitcnt vmcnt(0)" ::: "memory");
            const unsigned og = xb_add(&bar[XB_TOP], 1u);
            const unsigned tg = og / nx;
            if (og + 1u == (tg + 1u) * nx) xb_add(&bar[XB_TOPGEN], 1u);
            else XB_SPIN(xb_ld(&bar[XB_TOPGEN]) == tg, bar);
            __builtin_amdgcn_fence(__ATOMIC_ACQUIRE, "agent");
            xb_add(&bar[XB_XGEN(b.x)], 1u);
            asm volatile("s_waitcnt vmcnt(0)" ::: "memory");
        } else {
            XB_SPIN(xb_ld(&bar[XB_XGEN(b.x)]) == gen, bar);
            __builtin_amdgcn_fence(__ATOMIC_ACQUIRE, "agent");
            asm volatile("s_waitcnt vmcnt(0)" ::: "memory");
        }
    }
    __syncthreads();
}
namespace fk {
using pg8::bf16_t; using pg8::bf16x8; using pg8::f32x4; using pg8::u32x4; using pg8::Unit;
typedef float f32x16 __attribute__((ext_vector_type(16)));
typedef float f32x2 __attribute__((ext_vector_type(2)));
typedef __bf16 bf16x2_t __attribute__((ext_vector_type(2)));
typedef short s16x4 __attribute__((ext_vector_type(4)));
typedef unsigned u32x2 __attribute__((ext_vector_type(2)));
#define DI __device__ __forceinline__

constexpr int NB = 8, S = 2048, M = NB * S, D = 1024;
constexpr float EPS = 1e-6f, LOG2E = 1.4426950408889634f;
constexpr int NTHR = 512;

DI int tidx() { int t = threadIdx.x; asm volatile("" : "+v"(t)); return t; }
DI unsigned pk2(float lo, float hi) { f32x2 v = {lo, hi}; return __builtin_bit_cast(unsigned, __builtin_convertvector(v, bf16x2_t)); }
DI float bflo(unsigned u) { return __uint_as_float(u << 16); }
DI float bfhi(unsigned u) { return __uint_as_float(u & 0xffff0000u); }
DI float bf1(unsigned short b) { return __uint_as_float((unsigned)b << 16); }
DI float ex2(float x) { return __builtin_amdgcn_exp2f(x); }
DI float sigm(float x) { return __builtin_amdgcn_rcpf(1.f + ex2(-LOG2E * x)); }
DI float silu(float x) { return x * sigm(x); }
DI float sigm_silu(float o, float z) { return z * __builtin_amdgcn_rcpf((1.f + ex2(-LOG2E * o)) * (1.f + ex2(-LOG2E * z))); }
DI u32x4 pk8(const f32x4& a, const f32x4& b) { u32x4 w; w.x = pk2(a[0], a[1]); w.y = pk2(a[2], a[3]); w.z = pk2(b[0], b[1]); w.w = pk2(b[2], b[3]); return w; }
DI void unpk8(u32x4 w, f32x4& a, f32x4& b) { a[0] = bflo(w.x); a[1] = bfhi(w.x); a[2] = bflo(w.y); a[3] = bfhi(w.y); b[0] = bflo(w.z); b[1] = bfhi(w.z); b[2] = bflo(w.w); b[3] = bfhi(w.w); }

constexpr size_t KiB = 1024, MiB = 1u << 20;
constexpr size_t WS_CTL = 0;
constexpr size_t WS_SSQ = 64 * KiB;
constexpr int SSQ_X = 0  , SSQ_1 = 5  , SSQ_Q = 9  , SSQ_KV = 11  ;
constexpr size_t ZERO_BYTES = 1792 * KiB;
constexpr size_t WS_GW8 = 1792 * KiB;
constexpr size_t WS_WMIX = 2 * MiB;
constexpr size_t WS_WPLE = 23 * MiB;
constexpr size_t WS_XBA = 26 * MiB;
constexpr size_t WS_BIG = 58 * MiB;
constexpr size_t WS_CS = WS_BIG + 192 * MiB, WS_SN = WS_CS + 1 * MiB, WS_IG = WS_SN + 1 * MiB, WS_LF = WS_IG + 256 * KiB;
constexpr size_t WS_END = 256 * MiB;
static_assert(WS_LF + 256 * KiB <= WS_END, "ws map");
constexpr size_t WM_IN = 0, WM_QB = 4 * MiB, WM_KVB = 6 * MiB, WM_OUT_MLA = 8 * MiB, WM_OUT_CONV = 8 * MiB, WM_OUT_LSTM = 16 * MiB;
constexpr size_t A_SZ = 0, A_Q = 32 * MiB, A_KN = 80 * MiB, A_VT = 112 * MiB, A_CQ = 144 * MiB, A_CKV = 156 * MiB, A_KR = 164 * MiB, A_XBB = 32 * MiB, A_PP = 80 * MiB, A_PB = 166 * MiB;
constexpr size_t C_CH = 0, C_BZ = 32 * MiB, C_XBB = 64 * MiB, C_PP = 96 * MiB, C_PB = 166 * MiB;
constexpr size_t L_Q = 0, L_K = 32 * MiB, L_VT = 64 * MiB, L_OG = 128 * MiB, L_XBB = 0, L_PP = 64 * MiB;

struct Args { const float* in[19]; float* out; unsigned char* ws; int ph_lo, ph_hi; };
enum { I_X = 0, I_P, I_POS, I_NORMG, I_MLA_WIN, I_MLA_QN, I_MLA_WQB, I_MLA_KVN, I_MLA_WKVB, I_MLA_WOUT, I_CONV_WIN, I_CONV_W, I_CONV_WOUT, I_L_WIN, I_L_BG, I_L_WOUT, I_PLE_PROJ, I_PLE_GATE, I_FNORM };

enum { PM_ID = 0, PM_MLA_IN, PM_MLA_QB, PM_MLA_KVB, PM_CONV_IN, PM_LSTM_IN };
DI int prep_src(int mode, int n, float& sc) {
    sc = 1.f;
    switch (mode) {
    case PM_MLA_IN: { if (n < 1024) return 672 + n; if (n < 1408) return n - 1024; if (n < 1664) return 384 + (n - 1408); if (n < 1696) { const int jj = n - 1664; return 640 + (jj >> 1) + 16 * (jj & 1); } return -1; }
    case PM_MLA_QB: { sc = 0.10206207261596577f * LOG2E; const int hd = n / 96, d = n % 96; if (d < 64) return n; const int jj = d - 64; return 96 * hd + 64 + (jj >> 1) + 16 * (jj & 1); }
    case PM_MLA_KVB: { if (n < 1024) return 128 * (n >> 6) + (n & 63); const int n2 = n - 1024; return 128 * (n2 >> 6) + 64 + (n2 & 63); }
    case PM_CONV_IN: { const int pn = n >> 8, bj = (n >> 7) & 1, i = n & 127; if (pn < 8) return (bj ? 2048 : 1024) + 128 * pn + i; return (bj ? 3072 : 0) + 128 * (pn - 8) + i; }
    case PM_LSTM_IN: { if (n < 4096) { if (n >= 1024 && n < 2048) sc = 0.0625f; return n; } const int n2 = n - 4096, pn = n2 >> 8, bj = (n2 >> 7) & 1, i = n2 & 127; return (bj ? 6144 : 4096) + 128 * pn + i; }
    default: return n;
    }
}
struct PrepTask { const float* W; int ldw; const float* gk; int K, Nst, mode; bf16_t* out; };
DI void prep_tile(const PrepTask& t, int tile, LAS float* scr) {
    const int tid = tidx(), nkb = t.K >> 7, nb = tile / nkb, kb = tile % nkb, n0 = nb << 6, k0 = kb << 7;
    const int nn = tid & 63, kq = tid >> 6;
    float sc; const int src = prep_src(t.mode, n0 + nn, sc);
    float v[16];
#pragma unroll
    for (int i = 0; i < 16; ++i) { const int kk = kq + 8 * i; v[i] = (src >= 0) ? t.W[(size_t)(k0 + kk) * t.ldw + src] : 0.f; }
#pragma unroll
    for (int i = 0; i < 16; ++i) { const int kk = kq + 8 * i; float x = v[i] * sc; if (t.gk) x *= t.gk[k0 + kk]; scr[nn * 129 + kk] = x; }
    __syncthreads();
#pragma unroll
    for (int h2 = 0; h2 < 2; ++h2) { const int e = tid + h2 * NTHR, n2 = e >> 4, c = e & 15; const LAS float* sp = scr + n2 * 129 + 8 * c;
      u32x4 o; o.x = pk2(sp[0], sp[1]); o.y = pk2(sp[2], sp[3]); o.z = pk2(sp[4], sp[5]); o.w = pk2(sp[6], sp[7]);
      *(u32x4*)(t.out + (size_t)(n0 + n2) * t.K + k0 + 8 * c) = o; }
    __syncthreads();
}
DI void prep_load(const PrepTask& t, int tile, float (&v)[16], float (&g)[16]) {
    const int tid = tidx(), nkb = t.K >> 7, nb = tile / nkb, kb = tile % nkb, n0 = nb << 6, k0 = kb << 7;
    const int nn = tid & 63, kq = tid >> 6;
    float sc; const int src = prep_src(t.mode, n0 + nn, sc);
#pragma unroll
    for (int i = 0; i < 16; ++i) { const int kk = kq + 8 * i; v[i] = (src >= 0) ? t.W[(size_t)(k0 + kk) * t.ldw + src] : 0.f; }
#pragma unroll
    for (int i = 0; i < 16; ++i) { const int kk = kq + 8 * i; g[i] = t.gk ? t.gk[k0 + kk] * sc : sc; }
}
DI void prep_store(const PrepTask& t, int tile, const float (&v)[16], const float (&g)[16], LAS float* scr) {
    const int tid = tidx(), nkb = t.K >> 7, nb = tile / nkb, kb = tile % nkb, n0 = nb << 6, k0 = kb << 7;
    const int nn = tid & 63, kq = tid >> 6;
#pragma unroll
    for (int i = 0; i < 16; ++i) { const int kk = kq + 8 * i; scr[nn * 129 + kk] = v[i] * g[i]; }
    __syncthreads();
#pragma unroll
    for (int h2 = 0; h2 < 2; ++h2) { const int e = tid + h2 * NTHR, n2 = e >> 4, c = e & 15; const LAS float* sp = scr + n2 * 129 + 8 * c;
      u32x4 o; o.x = pk2(sp[0], sp[1]); o.y = pk2(sp[2], sp[3]); o.z = pk2(sp[4], sp[5]); o.w = pk2(sp[6], sp[7]);
      *(u32x4*)(t.out + (size_t)(n0 + n2) * t.K + k0 + 8 * c) = o; }
    __syncthreads();
}
#ifndef PREP_BATCH
#define PREP_BATCH 3
#endif
template <class Sel> DI void prep_batched(const Sel& sel, int total, int cu, int G, LAS float* scr) {
#pragma unroll 1
    for (int it0 = cu; it0 < total; it0 += PREP_BATCH * G) {
        float v[PREP_BATCH][16], g[PREP_BATCH][16];
#pragma unroll
        for (int b = 0; b < PREP_BATCH; ++b) { const int it = it0 + b * G;
            if (it < total) sel(it, [&](const PrepTask& t, int tl) { prep_load(t, tl, v[b], g[b]); });
            else {
#pragma unroll
                for (int i = 0; i < 16; ++i) { v[b][i] = 0.f; g[b][i] = 0.f; } } }
#pragma unroll
        for (int b = 0; b < PREP_BATCH; ++b) { const int it = it0 + b * G;
            if (it < total) sel(it, [&](const PrepTask& t, int tl) { prep_store(t, tl, v[b], g[b], scr); }); }
    }
}
DI void prep_run1(const PrepTask& t, LAS float* scr, int cu, int G) {
    const int total = (t.Nst >> 6) * (t.K >> 7);
#pragma unroll 1
    for (int it = cu; it < total; it += G) prep_tile(t, it, scr);
}

DI float wave_sum(float v) {
#pragma unroll
    for (int o = 1; o < 64; o <<= 1) v += __shfl_xor(v, o);
    return v;
}
#ifndef ROWS_IF
#define ROWS_IF 4
#endif
DI void rows_to_bf16_ssq(const float* x, bf16_t* xb, unsigned long long* ssq, int gw, int NGW, int lane) {
    for (int m0 = gw; m0 < M; m0 += ROWS_IF * NGW) {
        f32x4 v[ROWS_IF][4];
#pragma unroll
        for (int r = 0; r < ROWS_IF; ++r) { const int m = m0 + r * NGW; const f32x4* xr = (const f32x4*)(x + (size_t)(m < M ? m : m0) * D) + lane;
#pragma unroll
            for (int j = 0; j < 4; ++j) v[r][j] = xr[64 * j]; }
#pragma unroll
        for (int r = 0; r < ROWS_IF; ++r) { const int m = m0 + r * NGW; if (m < M) {
            float s = 0.f; u32x2* o8 = (u32x2*)(xb + (size_t)m * D) + lane;
#pragma unroll
            for (int j = 0; j < 4; ++j) { s += (v[r][j][0] * v[r][j][0] + v[r][j][1] * v[r][j][1]) + (v[r][j][2] * v[r][j][2] + v[r][j][3] * v[r][j][3]); u32x2 w; w.x = pk2(v[r][j][0], v[r][j][1]); w.y = pk2(v[r][j][2], v[r][j][3]); o8[64 * j] = w; }
            s = wave_sum(s); if (lane == 0) ssq[m] = (unsigned long long)(s * 16777216.f); } }
    }
}
DI void p_to_bf16(const float* p, bf16_t* pb, int gt, int NGT) {
    constexpr size_t N8 = (size_t)M * 256 / 8;
    for (size_t i = gt; i < N8; i += (size_t)4 * NGT) {
        f32x4 a[4], b[4];
#pragma unroll
        for (int k = 0; k < 4; ++k) { const size_t e = i + (size_t)k * NGT; if (e < N8) { a[k] = ((const f32x4*)p)[2 * e]; b[k] = ((const f32x4*)p)[2 * e + 1]; } }
#pragma unroll
        for (int k = 0; k < 4; ++k) { const size_t e = i + (size_t)k * NGT; if (e < N8) ((u32x4*)pb)[e] = pk8(a[k], b[k]); }
    }
}
DI void rope_tables(const int* pos, float* cs, float* sn, int gt, int NGT) {
    for (int i = gt; i < M * 16; i += NGT) {
        const int t = i >> 4, j = i & 15;
        const float inv = powf(10000.0f, -(float)(2 * j) / 32.0f);
        const float ang = (float)pos[t] * inv;
        double rev = (double)ang * 0.15915494309189533577; rev -= rint(rev);
        const float fr = (float)rev;
        cs[i] = __builtin_amdgcn_cosf(fr); sn[i] = __builtin_amdgcn_sinf(fr);
    }
}

#define EPI_ROW(u, ai, m) ((u).pm * 256 + (ai) * 128 + wr * 64 + (m) * 16 + fr)
#define EPI_LOOP_AM _Pragma("unroll") for (int ai = 0; ai < 2; ++ai) _Pragma("unroll") for (int m = 0; m < 4; ++m)
typedef const f32x4 (&AccRef)[2][2][4][2];
#ifndef NT_STORES
#define NT_STORES 0
#endif
#ifndef SC1_STORES
#define SC1_STORES 0
#endif
DI void st16(const void* base, bf16_t* p, const u32x4& v) {
    if (SC1_STORES) __builtin_amdgcn_raw_buffer_store_b128(v, __builtin_amdgcn_make_buffer_rsrc((void*)base, 0, 0xFFFFFFFFu, 0x00020000), (unsigned)((const char*)p - (const char*)base), 0, 16);
    else if (NT_STORES) __builtin_nontemporal_store(v, (u32x4*)p); else *(u32x4*)p = v; }
DI float sq8(const f32x4& a, const f32x4& b) { return (a[0] * a[0] + a[1] * a[1]) + (a[2] * a[2] + a[3] * a[3]) + (b[0] * b[0] + b[1] * b[1]) + (b[2] * b[2] + b[3] * b[3]); }
DI float red_fq(float s) { s += __shfl_xor(s, 16); s += __shfl_xor(s, 32); return s; }
DI void rope8(f32x4& a, f32x4& b, const float* cs, const float* sn, int row, int p0) {
    const f32x4 c = *(const f32x4*)(cs + (size_t)row * 16 + p0), s = *(const f32x4*)(sn + (size_t)row * 16 + p0);
    const f32x4 a0 = a, b0 = b;
    a[0] = a0[0] * c[0] - a0[1] * s[0]; a[1] = a0[0] * s[0] + a0[1] * c[0];
    a[2] = a0[2] * c[1] - a0[3] * s[1]; a[3] = a0[2] * s[1] + a0[3] * c[1];
    b[0] = b0[0] * c[2] - b0[1] * s[2]; b[1] = b0[0] * s[2] + b0[1] * c[2];
    b[2] = b0[2] * c[3] - b0[3] * s[3]; b[3] = b0[2] * s[3] + b0[3] * c[3];
}

DI int opaque(int v) { asm volatile("" : "+s"(v)); return v; }
template <class T> DI T* launder(T* p) { asm volatile("" : "+s"(p)); return p; }
typedef unsigned long long u64;
constexpr float SSQ_SCALE = 16777216.f, SSQ_INV = 1.f / 16777216.f;
DI u64* ssq_arr(unsigned char* ws, int idx) { return (u64*)(ws + WS_SSQ) + (size_t)idx * M; }
DI void ssq_add(u64* p, float s) { atomicAdd(p, (u64)(s * SSQ_SCALE)); }
DI float ssq_rstd(const u64* p, float invn) { return rsqrtf((float)(*p) * SSQ_INV * invn + EPS); }

#define EPI_RS8(rsarr, ssqp, invn) float rsarr[2][4]; { u64 t_[2][4]; _Pragma("unroll") for (int ai = 0; ai < 2; ++ai) _Pragma("unroll") for (int m = 0; m < 4; ++m) t_[ai][m] = (ssqp)[EPI_ROW(u, ai, m)]; \
    _Pragma("unroll") for (int ai = 0; ai < 2; ++ai) _Pragma("unroll") for (int m = 0; m < 4; ++m) rsarr[ai][m] = rsqrtf((float)t_[ai][m] * SSQ_INV * (invn) + EPS); }

struct EpiA1 {
    static constexpr bool PERM = true, AFTER_DRAIN = false;
    unsigned char* ws; int i, j;
    DI void operator()(AccRef acc, const Unit& u, int wr, int wc, int fr, int fq) const {
        unsigned char* w = launder(ws); unsigned char* big = w + WS_BIG;
        const u64* ssq_x = ssq_arr(w, SSQ_X + i); u64* ssq_q = ssq_arr(w, SSQ_Q + j); u64* ssq_kv = ssq_arr(w, SSQ_KV + j);
        bf16_t *SZ = (bf16_t*)(big + A_SZ), *CQ = (bf16_t*)(big + A_CQ), *CKV = (bf16_t*)(big + A_CKV), *KR = (bf16_t*)(big + A_KR);
        const float *CS = (const float*)(w + WS_CS), *SN = (const float*)(w + WS_SN);
        EPI_RS8(rsv, ssq_x, 1.f / 1024.f);
        EPI_LOOP_AM {
            const int row = EPI_ROW(u, ai, m); const float rs = rsv[ai][m];
            float sq = 0.f, skv = 0.f; bool hq = false, hkv = false;
#pragma unroll
            for (int bj = 0; bj < 2; ++bj) {
                f32x4 v0 = acc[ai][bj][m][0] * rs, v1 = acc[ai][bj][m][1] * rs;
                if (u.pn < 4) {
                    const int col = u.pn * 256 + bj * 128 + wc * 32 + 8 * fq;
#pragma unroll
                    for (int jj = 0; jj < 4; ++jj) { v0[jj] = silu(v0[jj]); v1[jj] = silu(v1[jj]); }
                    st16(w, SZ + (size_t)row * 1024 + col, pk8(v0, v1));
                } else {
                    const int c = (u.pn - 4) * 256 + bj * 128 + wc * 32 + 8 * fq;
                    if (c < 384) { st16(w, CQ + (size_t)row * 384 + c, pk8(v0, v1)); sq += sq8(v0, v1); hq = true; }
                    else if (c < 640) { st16(w, CKV + (size_t)row * 256 + (c - 384), pk8(v0, v1)); skv += sq8(v0, v1); hkv = true; }
                    else if (c < 672) { const int jj0 = c - 640; rope8(v0, v1, CS, SN, row, jj0 >> 1); st16(w, KR + (size_t)row * 32 + jj0, pk8(v0, v1)); }
                }
            }
            if (u.pn >= 4) {
                sq = red_fq(sq); skv = red_fq(skv);
                if (fq == 0 && hq) ssq_add(ssq_q + row, sq);
                if (fq == 0 && hkv) ssq_add(ssq_kv + row, skv);
            }
        }
    }
};
struct EpiQ {
    static constexpr bool PERM = true, AFTER_DRAIN = false;
    unsigned char* ws; int j;
    DI void operator()(AccRef acc, const Unit& u, int wr, int wc, int fr, int fq) const {
        unsigned char* w = launder(ws); const u64* ssq_q = ssq_arr(w, SSQ_Q + j); bf16_t* Q = (bf16_t*)(w + WS_BIG + A_Q);
        const float *CS = (const float*)(w + WS_CS), *SN = (const float*)(w + WS_SN);
        EPI_RS8(rsv, ssq_q, 1.f / 384.f);
        EPI_LOOP_AM {
            const int row = EPI_ROW(u, ai, m); const float rs = rsv[ai][m];
#pragma unroll
            for (int bj = 0; bj < 2; ++bj) {
                const int col = u.pn * 256 + bj * 128 + wc * 32 + 8 * fq, d = col % 96;
                f32x4 v0 = acc[ai][bj][m][0] * rs, v1 = acc[ai][bj][m][1] * rs;
                if (d >= 64) rope8(v0, v1, CS, SN, row, (d - 64) >> 1);
                st16(w, Q + (size_t)row * 1536 + col, pk8(v0, v1));
            }
        }
    }
};
struct EpiKV {
    static constexpr bool PERM = true, AFTER_DRAIN = false;
    unsigned char* ws; int j;
    DI void operator()(AccRef acc, const Unit& u, int wr, int wc, int fr, int fq) const {
        unsigned char* w = launder(ws); const u64* ssq_kv = ssq_arr(w, SSQ_KV + j); bf16_t* O = (bf16_t*)(w + WS_BIG + (u.pn < 4 ? A_KN : A_VT));
        EPI_RS8(rsv, ssq_kv, 1.f / 256.f);
        EPI_LOOP_AM {
            const int row = EPI_ROW(u, ai, m); const float rs = rsv[ai][m];
#pragma unroll
            for (int bj = 0; bj < 2; ++bj) {
                const int col = (u.pn & 3) * 256 + bj * 128 + wc * 32 + 8 * fq;
                st16(w, O + (size_t)row * 1024 + col, pk8(acc[ai][bj][m][0] * rs, acc[ai][bj][m][1] * rs));
            }
        }
    }
};
struct EpiOut {
    static constexpr bool PERM = true, AFTER_DRAIN = false;
    unsigned char* ws; size_t xbb_off; int i;
    DI void operator()(AccRef acc, const Unit& u, int wr, int wc, int fr, int fq) const {
        unsigned char* w = launder(ws); u64* ssq = ssq_arr(w, SSQ_1 + i); bf16_t* XB = (bf16_t*)(w + WS_BIG + xbb_off); const bf16_t* xin = (const bf16_t*)(w + WS_XBA);
        const size_t cb = (size_t)u.pn * 256 + wc * 32 + 8 * fq;
        u32x4 cur[2], nxt[2];
#define EO_LOAD(dst, it) do { const size_t o_ = (size_t)EPI_ROW(u, (it) >> 2, (it) & 3) * 1024 + cb; dst[0] = *(const u32x4*)(xin + o_); dst[1] = *(const u32x4*)(xin + o_ + 128); } while (0)
        EO_LOAD(cur, 0);
#pragma unroll
        for (int it = 0; it < 8; ++it) {
            const int ai = it >> 2, m = it & 3;
            if (it < 7) EO_LOAD(nxt, it + 1);
            const int row = EPI_ROW(u, ai, m); float sq = 0.f;
#pragma unroll
            for (int bj = 0; bj < 2; ++bj) {
                const size_t off = (size_t)row * 1024 + cb + bj * 128;
                f32x4 x0, x1; unpk8(cur[bj], x0, x1);
                const f32x4 y0 = x0 + acc[ai][bj][m][0], y1 = x1 + acc[ai][bj][m][1];
                st16(w, XB + off, pk8(y0, y1)); sq += sq8(y0, y1);
            }
            sq = red_fq(sq); if (fq == 0) ssq_add(ssq + row, sq);
            cur[0] = nxt[0]; cur[1] = nxt[1];
        }
#undef EO_LOAD
    }
};
struct EpiPP {
    static constexpr bool PERM = true, AFTER_DRAIN = false;
    bf16_t* pp;
    DI void operator()(AccRef acc, const Unit& u, int wr, int wc, int fr, int fq) const {
        bf16_t* PP = launder(pp);
        EPI_LOOP_AM { const int row = EPI_ROW(u, ai, m);
#pragma unroll
            for (int bj = 0; bj < 2; ++bj) { const size_t off = (size_t)row * 1024 + u.pn * 256 + bj * 128 + wc * 32 + 8 * fq; st16(PP, PP + off, pk8(acc[ai][bj][m][0], acc[ai][bj][m][1])); } }
    }
};
struct EpiPle {
    static constexpr bool PERM = true, AFTER_DRAIN = false;
    unsigned char* ws; const bf16_t* pp; size_t xbb_off; int i;
    DI void operator()(AccRef acc, const Unit& u, int wr, int wc, int fr, int fq) const {
        unsigned char* w = launder(ws); const u64* ssq1 = ssq_arr(w, SSQ_1 + i); u64* ssq = ssq_arr(w, SSQ_X + i + 1);
        const bf16_t* PP = launder(pp); const bf16_t* X1 = (const bf16_t*)(w + WS_BIG + xbb_off); bf16_t* XB = (bf16_t*)(w + WS_XBA);
        const size_t cb = (size_t)u.pn * 256 + wc * 32 + 8 * fq;
        EPI_RS8(rsv, ssq1, 1.f / 1024.f);
        u32x4 cur[2], nxt[2], pc[2], pn2[2];
#define EP_LOAD(dst, pd, it) do { const size_t o_ = (size_t)EPI_ROW(u, (it) >> 2, (it) & 3) * 1024 + cb; dst[0] = *(const u32x4*)(X1 + o_); dst[1] = *(const u32x4*)(X1 + o_ + 128); \
            pd[0] = *(const u32x4*)(PP + o_); pd[1] = *(const u32x4*)(PP + o_ + 128); } while (0)
        EP_LOAD(cur, pc, 0);
#pragma unroll
        for (int it = 0; it < 8; ++it) {
            const int ai = it >> 2, m = it & 3;
            if (it < 7) EP_LOAD(nxt, pn2, it + 1);
            const int row = EPI_ROW(u, ai, m); const float rs = rsv[ai][m]; float sq = 0.f;
#pragma unroll
            for (int bj = 0; bj < 2; ++bj) {
                const size_t off = (size_t)row * 1024 + cb + bj * 128;
                f32x4 p0, p1, y0, y1; unpk8(pc[bj], p0, p1); unpk8(cur[bj], y0, y1);
#pragma unroll
                for (int jj = 0; jj < 4; ++jj) { y0[jj] += sigm(acc[ai][bj][m][0][jj] * rs) * p0[jj]; y1[jj] += sigm(acc[ai][bj][m][1][jj] * rs) * p1[jj]; }
                st16(w, XB + off, pk8(y0, y1)); sq += sq8(y0, y1);
            }
            sq = red_fq(sq); if (fq == 0) ssq_add(ssq + row, sq);
#pragma unroll
            for (int bj = 0; bj < 2; ++bj) { cur[bj] = nxt[bj]; pc[bj] = pn2[bj]; }
        }
#undef EP_LOAD
    }
};
struct EpiPleLast {
    static constexpr bool PERM = true, AFTER_DRAIN = true;
    unsigned char* ws; float* out; const float* gfin; const bf16_t* pp; size_t xbb_off; int i; unsigned xcc; volatile LAS unsigned* st;
    DI void fused(f32x4 (&acc)[2][2][4][2], const Unit& u, int wr, int wc, int fr, int fq, LAS unsigned char* lds, int wid, int lane) const {
        unsigned char* w = launder(ws); const u64* ssq1 = ssq_arr(w, SSQ_1 + i); u64* ssq = ssq_arr(w, SSQ_X + i + 1);
        const bf16_t* PP = launder(pp); const bf16_t* X1 = (const bf16_t*)(w + WS_BIG + xbb_off);
        const size_t cb = (size_t)u.pn * 256 + wc * 32 + 8 * fq;
        {
            EPI_RS8(rsv, ssq1, 1.f / 1024.f);
#pragma unroll
            for (int it = 0; it < 8; ++it) {
                const int ai = it >> 2, m = it & 3; const int row = EPI_ROW(u, ai, m); const float rs = rsv[ai][m]; float sq = 0.f;
#pragma unroll
                for (int bj = 0; bj < 2; ++bj) {
                    const size_t off = (size_t)row * 1024 + cb + bj * 128;
                    f32x4 p0, p1, y0, y1; unpk8(*(const u32x4*)(PP + off), p0, p1); unpk8(*(const u32x4*)(X1 + off), y0, y1);
#pragma unroll
                    for (int jj = 0; jj < 4; ++jj) { y0[jj] += sigm(acc[ai][bj][m][0][jj] * rs) * p0[jj]; y1[jj] += sigm(acc[ai][bj][m][1][jj] * rs) * p1[jj]; }
                    acc[ai][bj][m][0] = y0; acc[ai][bj][m][1] = y1; sq += sq8(y0, y1);
                }
                sq = red_fq(sq); if (fq == 0) ssq_add(ssq + row, sq);
            }
        }
        { XcdBarrier b; b.bar = (unsigned*)(launder(ws) + WS_CTL); b.x = xcc; b.st = st; xcd_barrier(b); }
        {
            const u64* ssqf = ssq_arr(launder(ws), SSQ_X + i + 1);
            EPI_RS8(rsf, ssqf, 1.f / 1024.f);
#pragma unroll
            for (int bj = 0; bj < 2; ++bj) {
                const f32x4 g0 = *(const f32x4*)(gfin + cb + bj * 128), g1 = *(const f32x4*)(gfin + cb + bj * 128 + 4);
                EPI_LOOP_AM { const size_t off = (size_t)EPI_ROW(u, ai, m) * 1024 + cb + bj * 128; const float rs = rsf[ai][m];
                    *(f32x4*)(out + off) = acc[ai][bj][m][0] * rs * g0; *(f32x4*)(out + off + 4) = acc[ai][bj][m][1] * rs * g1; }
            }
        }
    }
};
struct EpiC1 {
    static constexpr bool PERM = true, AFTER_DRAIN = false;
    unsigned char* ws; int i; int dry;
    DI void operator()(AccRef acc, const Unit& u, int wr, int wc, int fr, int fq) const {
        if (dry == 1) { asm volatile("" :: "v"(acc[0][0][0][0][0]), "v"(acc[1][1][3][1][3])); return; }
        unsigned char* w = launder(ws); const u64* ssq_x = ssq_arr(w, SSQ_X + i); bf16_t *CH = (bf16_t*)(w + WS_BIG + C_CH), *BZ = (bf16_t*)(w + WS_BIG + C_BZ);
        float rsv[2][4];
        if (dry == 4) { EPI_LOOP_AM rsv[ai][m] = 1.f; } else { EPI_RS8(rsl_, ssq_x, 1.f / 1024.f); EPI_LOOP_AM rsv[ai][m] = rsl_[ai][m]; }
        EPI_LOOP_AM {
            const int row = EPI_ROW(u, ai, m); const float rs = rsv[ai][m];
            const size_t off = (size_t)row * 1024 + (u.pn & 7) * 128 + wc * 32 + 8 * fq;
            f32x4 r0, r1;
            if (u.pn < 8) { r0 = (acc[ai][0][m][0] * rs) * (acc[ai][1][m][0] * rs); r1 = (acc[ai][0][m][1] * rs) * (acc[ai][1][m][1] * rs); { const u32x4 o_ = pk8(r0, r1); if (dry == 2) asm volatile("" :: "v"(o_)); else if (dry == 3) { const int blk = ((wr * 2 + ai) * 4 + m) * 4 + wc, ln = fr + 16 * fq; st16(w, CH + (size_t)(u.pm * 256 + (blk >> 1) * 8 + (ln >> 3)) * 1024 + (u.pn & 7) * 128 + (blk & 1) * 64 + (ln & 7) * 8, o_); } else st16(w, CH + off, o_); } }
            else {
#pragma unroll
                for (int jj = 0; jj < 4; ++jj) { r0[jj] = (acc[ai][0][m][0][jj] * rs) * silu(acc[ai][1][m][0][jj] * rs); r1[jj] = (acc[ai][0][m][1][jj] * rs) * silu(acc[ai][1][m][1][jj] * rs); }
                { const u32x4 o_ = pk8(r0, r1); if (dry == 2) asm volatile("" :: "v"(o_)); else if (dry == 3) { const int blk = ((wr * 2 + ai) * 4 + m) * 4 + wc, ln = fr + 16 * fq; st16(w, BZ + (size_t)(u.pm * 256 + (blk >> 1) * 8 + (ln >> 3)) * 1024 + (u.pn & 7) * 128 + (blk & 1) * 64 + (ln & 7) * 8, o_); } else st16(w, BZ + off, o_); }
            }
        }
    }
};
struct EpiL1 {
    static constexpr bool PERM = true, AFTER_DRAIN = false;
    unsigned char* ws; int i;
    DI void operator()(AccRef acc, const Unit& u, int wr, int wc, int fr, int fq) const {
        unsigned char* w = launder(ws); const u64* ssq_x = ssq_arr(w, SSQ_X + i); unsigned char* big = w + WS_BIG;
        EPI_RS8(rsv, ssq_x, 1.f / 1024.f);
        if (u.pn < 16) {
            bf16_t* O; int ld, c0;
            if (u.pn < 4) { O = (bf16_t*)(big + L_Q); ld = 1024; c0 = u.pn * 256; } else if (u.pn < 8) { O = (bf16_t*)(big + L_K); ld = 1024; c0 = (u.pn - 4) * 256; } else { O = (bf16_t*)(big + L_VT); ld = 2048; c0 = (u.pn - 8) * 256; }
            EPI_LOOP_AM {
                const int row = EPI_ROW(u, ai, m); const float rs = rsv[ai][m];
#pragma unroll
                for (int bj = 0; bj < 2; ++bj) st16(w, O + (size_t)row * ld + c0 + bj * 128 + wc * 32 + 8 * fq, pk8(acc[ai][bj][m][0] * rs, acc[ai][bj][m][1] * rs));
            }
        } else {
            bf16_t* OG = (bf16_t*)(big + L_OG);
            EPI_LOOP_AM {
                const int row = EPI_ROW(u, ai, m); const float rs = rsv[ai][m];
                const size_t off = (size_t)row * 2048 + (u.pn - 16) * 128 + wc * 32 + 8 * fq; f32x4 r0, r1;
#pragma unroll
                for (int jj = 0; jj < 4; ++jj) { r0[jj] = sigm_silu(acc[ai][0][m][0][jj] * rs, acc[ai][1][m][0][jj] * rs); r1[jj] = sigm_silu(acc[ai][0][m][1][jj] * rs, acc[ai][1][m][1][jj] * rs); }
                st16(w, OG + off, pk8(r0, r1));
            }
        }
    }
};
#ifndef QFUSE
#define QFUSE 0
#endif
constexpr int AT_WQS = 784  , AT_WQOFF = 2 * 64 * 208 + 2 * 64 * 192;
constexpr int AT_KSTR = 208, AT_VSTR = 192, AT_KB = 64 * AT_KSTR, AT_VB = 64 * AT_VSTR;
#define MFMA32(a, b, c) __builtin_amdgcn_mfma_f32_32x32x16_bf16((a), (b), (c), 0, 0, 0)
#define MFMA16(a, b, c) __builtin_amdgcn_mfma_f32_16x16x32_bf16((a), (b), (c), 0, 0, 0)
DI float max3f(float a, float b, float c) { float r; asm("v_max3_f32 %0, %1, %2, %3" : "=v"(r) : "v"(a), "v"(b), "v"(c)); return r; }
DI bf16x8 cat4(s16x4 lo, s16x4 hi) { return __builtin_shufflevector(lo, hi, 0, 1, 2, 3, 4, 5, 6, 7); }

struct AttnT { const bf16_t *Q, *KN, *KR, *VT; bf16_t* SZOG; const bf16_t *CQ, *WQ; const u64* ssq_q; const float *CS, *SN; };
#ifndef DIAG_NOLOAD
#define DIAG_NOLOAD 0
#endif
#ifndef AT_ORD0
#define AT_ORD0 0x3407
#define AT_ORD1 0x2516
#endif
struct AttnStage { u32x4 k, r, v; };
DI void attn_unit(LAS unsigned char* lds, const AttnT& T, int b, int h, int qb, int dry) {
    const int tid = tidx(), w = __builtin_amdgcn_readfirstlane(tid >> 6), lane = tid & 63, r = lane & 31, hh = lane >> 5;
    const int tok0 = b * S, row0 = tok0 + qb * 256 + 32 * w;
    bf16x8 qf[6];
#if QFUSE
    {
        f32x16 qT[3];
#pragma unroll
        for (int db = 0; db < 3; ++db)
#pragma unroll
            for (int i = 0; i < 16; ++i) qT[db][i] = 0.f;
        const bf16_t* cqp = T.CQ + (size_t)(row0 + r) * 384 + 8 * hh;
        bf16x8 cf[24];
#pragma unroll
        for (int ks = 0; ks < 24; ++ks) cf[ks] = *(const bf16x8*)(cqp + 16 * ks);
        const LAS unsigned char* wl = lds + AT_WQOFF + r * AT_WQS + 16 * hh;
#pragma unroll
        for (int ks = 0; ks < 24; ++ks) {
            const bf16x8 w0 = *(const LAS bf16x8*)(wl + 32 * ks), w1 = *(const LAS bf16x8*)(wl + 32 * AT_WQS + 32 * ks), w2 = *(const LAS bf16x8*)(wl + 64 * AT_WQS + 32 * ks);
            qT[0] = MFMA32(w0, cf[ks], qT[0]); qT[1] = MFMA32(w1, cf[ks], qT[1]); qT[2] = MFMA32(w2, cf[ks], qT[2]);
        }
        const float rsq = ssq_rstd(T.ssq_q + row0 + r, 1.f / 384.f);
#pragma unroll
        for (int db = 0; db < 3; ++db)
#pragma unroll
            for (int i = 0; i < 16; ++i) qT[db][i] *= rsq;
#pragma unroll
        for (int g4 = 0; g4 < 4; ++g4) {
            const f32x2 c2 = *(const f32x2*)(T.CS + (size_t)(row0 + r) * 16 + 4 * g4 + 2 * hh), s2 = *(const f32x2*)(T.SN + (size_t)(row0 + r) * 16 + 4 * g4 + 2 * hh);
#pragma unroll
            for (int e = 0; e < 2; ++e) { const float x1 = qT[2][4 * g4 + 2 * e], x2 = qT[2][4 * g4 + 2 * e + 1], cc = e ? c2[1] : c2[0], ss = e ? s2[1] : s2[0];
                qT[2][4 * g4 + 2 * e] = x1 * cc - x2 * ss; qT[2][4 * g4 + 2 * e + 1] = x1 * ss + x2 * cc; }
        }
#pragma unroll
        for (int db = 0; db < 3; ++db)
#pragma unroll
            for (int s2i = 0; s2i < 2; ++s2i) { u32x4 pw; pw.x = pk2(qT[db][8 * s2i + 0], qT[db][8 * s2i + 1]); pw.y = pk2(qT[db][8 * s2i + 2], qT[db][8 * s2i + 3]); pw.z = pk2(qT[db][8 * s2i + 4], qT[db][8 * s2i + 5]); pw.w = pk2(qT[db][8 * s2i + 6], qT[db][8 * s2i + 7]);
                qf[2 * db + s2i] = __builtin_bit_cast(bf16x8, pw); }
    }
#else
#pragma unroll
    for (int ks = 0; ks < 6; ++ks) qf[ks] = *(const bf16x8*)(T.Q + (size_t)(row0 + r) * 1536 + 96 * h + 16 * ks + 8 * hh);
#endif
    f32x16 O0, O1;
#pragma unroll
    for (int i = 0; i < 16; ++i) { O0[i] = 0.f; O1[i] = 0.f; }
    float mrun = -1e30f, lrun = 0.f;
    const int ntiles = 4 * qb + 4, myvis = 4 * qb + (w >> 1);
    const int kkey = tid >> 3, kch = tid & 7, rkey = tid >> 2, rch = tid & 3;
    const bf16_t* gK = T.KN + (size_t)(tok0 + kkey) * 1024 + 64 * h + 8 * kch;
    const bf16_t* gR = T.KR + (size_t)(tok0 + rkey) * 32 + 8 * rch;
    const bf16_t* gV = T.VT + (size_t)(tok0 + kkey) * 1024 + 64 * h + 8 * kch;
    const int lK = QFUSE ? kkey * AT_KSTR + 32 * (kch >> 1) + 8 * (kch & 1) : kkey * AT_KSTR + 16 * kch, lR = QFUSE ? rkey * AT_KSTR + 128 + 32 * (rch >> 1) + 8 * (rch & 1) : rkey * AT_KSTR + 128 + 16 * rch, lV = kkey * AT_VSTR + 16 * kch;
    const int krd = r * AT_KSTR + 16 * hh;
    const int vrd = (4 * hh + ((lane & 15) >> 2)) * AT_VSTR + (16 * ((lane >> 4) & 1) + 4 * (lane & 3)) * 2;
#define AT_LOADK(st, kt) do { if (DIAG_NOLOAD && dry) break; (st).k = *(const u32x4*)(gK + (size_t)(kt) * 64 * 1024); if (tid < 256) (st).r = *(const u32x4*)(gR + (size_t)(kt) * 64 * 32); } while (0)
#define AT_LOADV(st, kt) do { if (DIAG_NOLOAD && dry) break; (st).v = *(const u32x4*)(gV + (size_t)(kt) * 64 * 1024); } while (0)
#define AT_WRITEK(st, buf) do { LAS unsigned char* kb_ = lds + (buf) * AT_KB; *(LAS u32x2*)(kb_ + lK) = (u32x2){(st).k.x, (st).k.y}; *(LAS u32x2*)(kb_ + lK + (QFUSE ? 16 : 8)) = (u32x2){(st).k.z, (st).k.w}; \
        if (tid < 256) { *(LAS u32x2*)(kb_ + lR) = (u32x2){(st).r.x, (st).r.y}; *(LAS u32x2*)(kb_ + lR + (QFUSE ? 16 : 8)) = (u32x2){(st).r.z, (st).r.w}; } } while (0)
#define AT_WRITEV(st, buf) do { *(LAS u32x4*)(lds + 2 * AT_KB + (buf) * AT_VB + lV) = (st).v; } while (0)
#define AT_QK1(sX, buf, blk) do { const LAS unsigned char* kb = lds + (buf) * AT_KB + krd + (blk) * 32 * AT_KSTR; \
        _Pragma("unroll") for (int i = 0; i < 16; ++i) sX[i] = 0.f; \
        _Pragma("unroll") for (int ks = 0; ks < 6; ++ks) sX = MFMA32(*(const LAS bf16x8*)(kb + 32 * ks), qf[ks], sX); } while (0)
#define AT_QK(sA, sB, buf) do { AT_QK1(sA, buf, 0); AT_QK1(sB, buf, 1); } while (0)
#define AT_MAX(s0, s1) \
          \
        asm volatile("s_nop 7\n\ts_nop 7\n\ts_nop 7" : "+v"(s0[0]), "+v"(s1[0])); \
        float mx = max3f(s0[0], s1[0], mrun); \
        _Pragma("unroll") for (int i = 1; i < 16; ++i) mx = max3f(mx, s0[i], s1[i]); \
        const float mnew = max3f(mx, __shfl_xor(mx, 32), mx), alpha = ex2(mrun - mnew); mrun = mnew;
#define AT_EXP(s0, s1) do { float ps = 0.f; \
        _Pragma("unroll") for (int i = 0; i < 16; ++i) { s0[i] = ex2(s0[i] - mrun); s1[i] = ex2(s1[i] - mrun); ps += s0[i] + s1[i]; } \
        lrun = lrun * alpha + ps; \
        _Pragma("unroll") for (int i = 0; i < 16; ++i) { O0[i] *= alpha; O1[i] *= alpha; } } while (0)
#define AT_PV(s0, s1, buf) do { LAS unsigned char* vb = lds + 2 * AT_KB + (buf) * AT_VB + vrd; \
        _Pragma("unroll") for (int kb2 = 0; kb2 < 2; ++kb2) _Pragma("unroll") for (int s = 0; s < 2; ++s) { \
            const f32x16& sx = kb2 ? s1 : s0; \
            u32x4 pw; pw.x = pk2(sx[8 * s + 0], sx[8 * s + 1]); pw.y = pk2(sx[8 * s + 2], sx[8 * s + 3]); pw.z = pk2(sx[8 * s + 4], sx[8 * s + 5]); pw.w = pk2(sx[8 * s + 6], sx[8 * s + 7]); \
            const bf16x8 pf = __builtin_bit_cast(bf16x8, pw); \
            LAS unsigned char* vp = vb + (32 * kb2 + 16 * s) * AT_VSTR; \
            const bf16x8 v0 = cat4(__builtin_amdgcn_ds_read_tr16_b64_v4i16((LAS s16x4*)vp), __builtin_amdgcn_ds_read_tr16_b64_v4i16((LAS s16x4*)(vp + 8 * AT_VSTR))); \
            const bf16x8 v1 = cat4(__builtin_amdgcn_ds_read_tr16_b64_v4i16((LAS s16x4*)(vp + 64)), __builtin_amdgcn_ds_read_tr16_b64_v4i16((LAS s16x4*)(vp + 64 + 8 * AT_VSTR))); \
            O0 = MFMA32(v0, pf, O0); O1 = MFMA32(v1, pf, O1); } } while (0)
#define AT_SOFTMAX_PV(s0, s1, buf) do { AT_MAX(s0, s1); AT_EXP(s0, s1); AT_PV(s0, s1, buf); } while (0)
#define AT_FUSED(c0, c1, n0, n1, bufK, bufV) do { AT_QK1(n0, bufK, 0); AT_MAX(c0, c1); __builtin_amdgcn_sched_barrier(0); \
        AT_QK1(n1, bufK, 1); AT_EXP(c0, c1); __builtin_amdgcn_sched_barrier(0); AT_PV(c0, c1, bufV); } while (0)
    AttnStage RA, RB;
    f32x16 a0, a1, b0, b1;
    AT_LOADK(RA, 0); AT_LOADV(RA, 0); AT_LOADK(RB, 1);
    AT_WRITEK(RA, 0); AT_WRITEV(RA, 0); AT_WRITEK(RB, 1);
    AT_LOADK(RA, 2); AT_LOADV(RA, 1);
    __syncthreads();
    AT_QK(a0, a1, 0);
    const int nmain = 4 * qb, jv = w >> 1;
    int t = 0;
#pragma unroll 1
    for (; t < nmain; t += 2) {
        AT_LOADK(RB, t + 3); AT_LOADV(RB, t + 2);
        AT_FUSED(a0, a1, b0, b1, 1, 0);
        AT_WRITEK(RA, 0); AT_WRITEV(RA, 1);
        __syncthreads();
        AT_LOADK(RA, t + 4); AT_LOADV(RA, t + 3);
        AT_FUSED(b0, b1, a0, a1, 0, 1);
        AT_WRITEK(RB, 1); AT_WRITEV(RB, 0);
        __syncthreads();
    }
    AT_LOADK(RB, t + 3); AT_LOADV(RB, t + 2);
    if (jv >= 1) AT_QK(b0, b1, 1);
    AT_SOFTMAX_PV(a0, a1, 0);
    AT_WRITEK(RA, 0); AT_WRITEV(RA, 1);
    __syncthreads();
    AT_LOADV(RA, t + 3);
    if (jv >= 2) AT_QK(a0, a1, 0);
    if (jv >= 1) AT_SOFTMAX_PV(b0, b1, 1);
    AT_WRITEK(RB, 1); AT_WRITEV(RB, 0);
    __syncthreads();
    if (jv >= 3) AT_QK(b0, b1, 1);
    if (jv >= 2) AT_SOFTMAX_PV(a0, a1, 0);
    AT_WRITEV(RA, 1);
    __syncthreads();
    if (jv >= 3) AT_SOFTMAX_PV(b0, b1, 1);
    __syncthreads();
#undef AT_LOADK
#undef AT_LOADV
#undef AT_WRITEK
#undef AT_WRITEV
#undef AT_QK
#undef AT_SOFTMAX_PV
#undef AT_QK1
#undef AT_MAX
#undef AT_EXP
#undef AT_PV
#undef AT_FUSED
    const float linv = 1.f / (lrun + __shfl_xor(lrun, 32));
    bf16_t* op = T.SZOG + (size_t)(row0 + r) * 1024 + 64 * h + 4 * hh;
#pragma unroll
    for (int db = 0; db < 2; ++db)
#pragma unroll
        for (int g4 = 0; g4 < 4; ++g4) {
            const f32x16& ox = db ? O1 : O0; bf16_t* p = op + 32 * db + 8 * g4;
            const u32x2 z = *(const u32x2*)p; u32x2 o;
            o.x = pk2(ox[4 * g4 + 0] * linv * bflo(z.x), ox[4 * g4 + 1] * linv * bfhi(z.x)); o.y = pk2(ox[4 * g4 + 2] * linv * bflo(z.y), ox[4 * g4 + 3] * linv * bfhi(z.y));
            if (!dry) *(u32x2*)p = o;
        }
}
DI void attn_phase(LAS unsigned char* lds, const AttnT& T, int cu, int dry) {
    const int bh = (cu & 7) + 8 * (cu >> 4), half = (cu >> 3) & 1, b = bh >> 4, h = bh & 15;
#if QFUSE
    {
        const int tid = tidx();
#pragma unroll
        for (int i = 0; i < 9; ++i) { const int e = tid + i * NTHR, row = e / 48, ch = e % 48; *(LAS u32x4*)(lds + AT_WQOFF + row * AT_WQS + 16 * ch) = *(const u32x4*)(T.WQ + (size_t)(96 * h + row) * 384 + 8 * ch); }
        __syncthreads();
    }
#endif
#pragma unroll 1
    for (int ui = 0; ui < 4; ++ui) attn_unit(lds, T, b, h, ((half ? AT_ORD1 : AT_ORD0) >> (4 * ui)) & 0xF, dry);
}

DI void conv_phase(const bf16_t* CH, bf16_t* BZ, const float* cw, int gt, int NGT, int dry) {
    for (int it = gt; it < (M / 8) * 128; it += NGT) {
        const int c8 = (it & 127) * 8, m0 = (it >> 7) * 8, t0 = m0 & (S - 1);
        const f32x4 w0a = *(const f32x4*)(cw + c8), w0b = *(const f32x4*)(cw + c8 + 4), w1a = *(const f32x4*)(cw + 1024 + c8), w1b = *(const f32x4*)(cw + 1024 + c8 + 4), w2a = *(const f32x4*)(cw + 2048 + c8), w2b = *(const f32x4*)(cw + 2048 + c8 + 4);
        u32x4 ch[10], bz[8];
#pragma unroll
        for (int r = 0; r < 10; ++r) { const int m = m0 - 2 + r; ch[r] = (r >= 2 || t0 > 0) ? *(const u32x4*)(CH + (size_t)m * 1024 + c8) : (u32x4){0u, 0u, 0u, 0u}; }
#pragma unroll
        for (int r = 0; r < 8; ++r) bz[r] = *(const u32x4*)(BZ + (size_t)(m0 + r) * 1024 + c8);
        f32x4 pa, pb, qa, qb;
        unpk8(ch[0], pa, pb); unpk8(ch[1], qa, qb);
#pragma unroll
        for (int r = 0; r < 8; ++r) {
            f32x4 ca, cb, ba, bb; unpk8(ch[r + 2], ca, cb); unpk8(bz[r], ba, bb);
            const f32x4 ya = w0a * pa + w1a * qa + w2a * ca, yb = w0b * pb + w1b * qb + w2b * cb;
            const u32x4 ov = pk8(ba * ya, bb * yb); if (!dry) *(u32x4*)(BZ + (size_t)(m0 + r) * 1024 + c8) = ov;
            pa = qa; pb = qb; qa = ca; qb = cb;
        }
    }
}

DI void gates_phase(const bf16_t* XB, const u64* ssq_x, const float* Wg8, const float* bg, float* IG, float* LF, int gw, int NGW, int lane) {
    f32x4 wv[8][2][2];
#pragma unroll
    for (int j = 0; j < 8; ++j)
#pragma unroll
        for (int half = 0; half < 2; ++half) { const int k0 = half * 512 + lane * 8; wv[j][half][0] = *(const f32x4*)(Wg8 + j * 1024 + k0); wv[j][half][1] = *(const f32x4*)(Wg8 + j * 1024 + k0 + 4); }
    const int jl = lane >> 3; const float bgl = bg[jl];
    for (int m0 = gw; m0 < M; m0 += 4 * NGW) {
        u32x4 xw[4][2]; u64 sq4[4];
#pragma unroll
        for (int r = 0; r < 4; ++r) { const int m = m0 + r * NGW, mc = m < M ? m : m0; xw[r][0] = *(const u32x4*)(XB + (size_t)mc * 1024 + lane * 8); xw[r][1] = *(const u32x4*)(XB + (size_t)mc * 1024 + 512 + lane * 8); sq4[r] = ssq_x[mc]; }
#pragma unroll
        for (int r = 0; r < 4; ++r) {
            const int m = m0 + r * NGW; if (m >= M) break;
            float acc[8];
#pragma unroll
            for (int j = 0; j < 8; ++j) acc[j] = 0.f;
#pragma unroll
            for (int half = 0; half < 2; ++half) {
                f32x4 xa, xb2; unpk8(xw[r][half], xa, xb2);
#pragma unroll
                for (int j = 0; j < 8; ++j) { const f32x4 wa = wv[j][half][0], wb = wv[j][half][1];
                    acc[j] += (xa[0] * wa[0] + xa[1] * wa[1]) + (xa[2] * wa[2] + xa[3] * wa[3]) + (xb2[0] * wb[0] + xb2[1] * wb[1]) + (xb2[2] * wb[2] + xb2[3] * wb[3]); }
            }
            float a4[4], a2[2], a1;
            { const bool hi = lane & 32;
#pragma unroll
              for (int k = 0; k < 4; ++k) { const float keep = hi ? acc[k + 4] : acc[k], send = hi ? acc[k] : acc[k + 4]; a4[k] = keep + __shfl_xor(send, 32); } }
            { const bool hi = lane & 16;
#pragma unroll
              for (int k = 0; k < 2; ++k) { const float keep = hi ? a4[k + 2] : a4[k], send = hi ? a4[k] : a4[k + 2]; a2[k] = keep + __shfl_xor(send, 16); } }
            { const bool hi = lane & 8; const float keep = hi ? a2[1] : a2[0], send = hi ? a2[0] : a2[1]; a1 = keep + __shfl_xor(send, 8); }
            a1 += __shfl_xor(a1, 4); a1 += __shfl_xor(a1, 2); a1 += __shfl_xor(a1, 1);
            const float rs = rsqrtf((float)sq4[r] * SSQ_INV * (1.f / 1024.f) + EPS);
            const float gv = a1 * rs + bgl;
            if ((lane & 7) == 0) {
                if (jl < 4) IG[(size_t)m * 4 + jl] = gv;
                else LF[(size_t)m * 4 + (jl - 4)] = fminf(gv, 0.f) - log1pf(__expf(-fabsf(gv)));
            }
        }
    }
}
DI void gw8_prep(const float* w_in, const float* g, float* Wg8, int gt, int NGT) {
    for (int i = gt; i < 8 * 1024; i += NGT) { const int j = i >> 10, k = i & 1023; Wg8[i] = w_in[(size_t)k * 8200 + 8192 + j] * g[k]; }
}

constexpr int SC_QSTR = 528, SC_VSTR = 136  , SC_VVSTR = 144  ;
constexpr int SC_QS = 0, SC_KS = 64 * SC_QSTR, SC_VS = 2 * 64 * SC_QSTR, SC_SP = SC_VS + 64 * SC_VVSTR, SC_QCX = SC_SP + 64 * SC_VSTR, SC_GT = SC_QCX + 16384, SC_VEC = SC_GT + 3 * 32 * 64 * 4 + 512, SC_OT = SC_VEC + (832 + 512) * 4;
constexpr int G_B = 0, G_CC = 2048, G_PM = 4096, G_SC = 6144;
constexpr int V_QNP = 0  , V_RS = 512  , V_WS = 768, V_WH = 832  ;
constexpr int SC_END = SC_OT + 64 * SC_VVSTR;
struct ScanT { const bf16_t *Q, *K, *VT; bf16_t* OG; const float *IG, *LF; };
DI float scan_add(float v, int lane) {
#pragma unroll
    for (int o = 1; o < 64; o <<= 1) { const float t = __shfl_up(v, o); if (lane >= o) v += t; }
    return v;
}
DI float scan_max(float v, int lane) {
#pragma unroll
    for (int o = 1; o < 64; o <<= 1) { const float t = __shfl_up(v, o); if (lane >= o) v = fmaxf(v, t); }
    return v;
}
DI void scan_item(LAS unsigned char* lds, const ScanT& T, int b, int h, int sl, int dry) {
    const int tid0 = tidx(), w = __builtin_amdgcn_readfirstlane(tid0 >> 6), g = w >> 2, c = w & 3;
    int tid = tid0, lane = tid & 63, l15 = lane & 15, q = lane >> 4;
    const int tok0 = b * S;
    LAS float* vec = (LAS float*)(lds + SC_VEC);
    LAS float* gt = (LAS float*)(lds + SC_GT);
    f32x4 Cacc[8];
#pragma unroll
    for (int i = 0; i < 8; ++i) Cacc[i] = (f32x4){0.f, 0.f, 0.f, 0.f};
    f32x4 nacc[2] = {(f32x4){0.f, 0.f, 0.f, 0.f}, (f32x4){0.f, 0.f, 0.f, 0.f}};
    u32x4 sQ[4], sK[4], sV;
    const int vd = tid >> 3, vch = tid & 7;
    const bf16_t* gQ = T.Q + (size_t)tok0 * 1024 + 256 * h;
    const bf16_t* gK = T.K + (size_t)tok0 * 1024 + 256 * h;
    const bf16_t* gV = T.VT + (size_t)(tok0 + vd) * 2048 + 512 * h + 64 * sl + 8 * vch;
#define SC_LOAD(ci) do { _Pragma("unroll") for (int i = 0; i < 4; ++i) { const int e = tid + i * NTHR, row = e >> 5, ch = e & 31; \
        sQ[i] = *(const u32x4*)(gQ + (size_t)((ci) * 64 + row) * 1024 + 8 * ch); sK[i] = *(const u32x4*)(gK + (size_t)((ci) * 64 + row) * 1024 + 8 * ch); } \
        sV = *(const u32x4*)(gV + (size_t)(ci) * 64 * 2048); } while (0)
    u32x4 sOG;
    bf16_t* gOG = T.OG + (size_t)(tok0 + vd) * 2048 + 512 * h + 64 * sl + 8 * vch;
#define SC_LOADOG(ci) do { sOG = *(const u32x4*)(gOG + (size_t)(ci) * 64 * 2048); } while (0)
    SC_LOAD(0); SC_LOADOG(0);
    {
        float lfv[4], igv[4];
#pragma unroll
        for (int k = 0; k < 4; ++k) { const size_t gi = (size_t)(tok0 + (w + 8 * k) * 64 + lane) * 4 + h; lfv[k] = T.LF[gi]; igv[k] = T.IG[gi]; }
#pragma unroll
        for (int k = 0; k < 4; ++k) {
            const int ck = w + 8 * k; const float bb = scan_add(lfv[k], lane), cc = igv[k] - bb, pm = scan_max(cc, lane);
            gt[G_B + ck * 64 + lane] = bb; gt[G_CC + ck * 64 + lane] = cc; gt[G_PM + ck * 64 + lane] = pm;
            if (lane == 63) { gt[G_SC + ck * 4 + 0] = bb; gt[G_SC + ck * 4 + 1] = pm; }
        }
        __syncthreads();
        if (tid == 0) { float m = 0.f;
#pragma unroll 1
            for (int ck = 0; ck < 32; ++ck) { const float bl = gt[G_SC + ck * 4], cm = gt[G_SC + ck * 4 + 1]; gt[G_SC + ck * 4 + 2] = m; m = fmaxf(bl + m, bl + cm); gt[G_SC + ck * 4 + 3] = m; } }
        __syncthreads();
    }
    for (int ci = 0; ci < S / 64; ++ci) {
        tid = tid0; asm volatile("" : "+v"(tid)); lane = tid & 63; l15 = lane & 15; q = lane >> 4;
#pragma unroll
        for (int i = 0; i < 4; ++i) { const int e = tid + i * NTHR, row = e >> 5, ch = e & 31; *(LAS u32x4*)(lds + SC_QS + row * SC_QSTR + 16 * ch) = sQ[i]; *(LAS u32x4*)(lds + SC_KS + row * SC_QSTR + 16 * ch) = sK[i]; }
        *(LAS u32x4*)(lds + SC_VS + vd * SC_VVSTR + 16 * vch) = sV;
        if (ci > 0 && !dry) *(u32x4*)(gOG + (size_t)(ci - 1) * 64 * 2048) = *(const LAS u32x4*)(lds + SC_OT + vd * SC_VVSTR + 16 * vch);
        *(LAS u32x4*)(lds + SC_OT + vd * SC_VVSTR + 16 * vch) = sOG;
        const f32x4 scal = *(const LAS f32x4*)(gt + G_SC + ci * 4);
        const float m_c = scal[2], blast = scal[0], mnew = scal[3];
        const LAS float* gB = gt + G_B + ci * 64; const LAS float* gC = gt + G_CC + ci * 64; const LAS float* gP = gt + G_PM + ci * 64;
        __syncthreads();
        if (ci + 1 < S / 64) SC_LOAD(ci + 1);
        {
            const int sb = w >> 1;
#pragma unroll
            for (int tt = 0; tt < 2; ++tt) {
                const int tb = 2 * (w & 1) + tt;
                const int t = 16 * tb + l15, s0 = 16 * sb + 4 * q;
                if (sb <= tb) {
                    f32x4 a4 = (f32x4){0.f, 0.f, 0.f, 0.f};
#pragma unroll
                    for (int ks = 0; ks < 8; ++ks) {
                        const bf16x8 ka = *(const LAS bf16x8*)(lds + SC_KS + (16 * sb + l15) * SC_QSTR + 64 * ks + 16 * q);
                        const bf16x8 qb2 = *(const LAS bf16x8*)(lds + SC_QS + (16 * tb + l15) * SC_QSTR + 64 * ks + 16 * q);
                        a4 = MFMA16(ka, qb2, a4);
                    }
                    const float a2 = -fmaxf(m_c, gP[t]) * LOG2E; const f32x4 c2 = *(const LAS f32x4*)(gC + s0);
                    float rsum = 0.f;
#pragma unroll
                    for (int r2 = 0; r2 < 4; ++r2) { const float wgt = (s0 + r2 <= t) ? ex2(a2 + c2[r2] * LOG2E) : 0.f; a4[r2] *= wgt; rsum += a4[r2]; }
                    u32x2 pw; pw.x = pk2(a4[0], a4[1]); pw.y = pk2(a4[2], a4[3]);
                    *(LAS u32x2*)(lds + SC_SP + t * SC_VSTR + s0 * 2) = pw;
                    rsum = red_fq(rsum); if (q == 0) vec[V_RS + 64 * sb + t] = rsum;
                } else {
                    *(LAS u32x2*)(lds + SC_SP + t * SC_VSTR + s0 * 2) = (u32x2){0u, 0u};
                    if (q == 0) vec[V_RS + 64 * sb + t] = 0.f;
                }
            }
        }
        f32x4 qc[4];
        {
            bf16x8 cf[4]; f32x4 qnp[4];
            u32x4 nw; nw.x = pk2(nacc[0][0], nacc[0][1]); nw.y = pk2(nacc[0][2], nacc[0][3]); nw.z = pk2(nacc[1][0], nacc[1][1]); nw.w = pk2(nacc[1][2], nacc[1][3]);
            const bf16x8 nf = __builtin_bit_cast(bf16x8, nw);
#pragma unroll
            for (int ks = 0; ks < 4; ++ks) { u32x4 cw; cw.x = pk2(Cacc[2 * ks][0], Cacc[2 * ks][1]); cw.y = pk2(Cacc[2 * ks][2], Cacc[2 * ks][3]); cw.z = pk2(Cacc[2 * ks + 1][0], Cacc[2 * ks + 1][1]); cw.w = pk2(Cacc[2 * ks + 1][2], Cacc[2 * ks + 1][3]); cf[ks] = __builtin_bit_cast(bf16x8, cw); }
#pragma unroll
            for (int tb = 0; tb < 4; ++tb) {
                qc[tb] = (f32x4){0.f, 0.f, 0.f, 0.f}; qnp[tb] = (f32x4){0.f, 0.f, 0.f, 0.f};
#pragma unroll
                for (int ks = 0; ks < 4; ++ks) {
                    const LAS unsigned char* qp = lds + SC_QS + (16 * tb + l15) * SC_QSTR + (128 * g + 32 * ks + 4 * q) * 2;
                    const bf16x8 qa = cat4(*(const LAS s16x4*)qp, *(const LAS s16x4*)(qp + 32));
                    qc[tb] = MFMA16(cf[ks], qa, qc[tb]);
                    if (ks == c) qnp[tb] = MFMA16(nf, qa, qnp[tb]);
                }
            }
            if (q == 0) {
#pragma unroll
                for (int tb = 0; tb < 4; ++tb) vec[V_QNP + w * 64 + 16 * tb + l15] = qnp[tb][0];
            }
            LAS f32x4* qx = (LAS f32x4*)(lds + SC_QCX) + (w * 2) * 64 + lane;
            qx[0] = g ? qc[0] : qc[2]; qx[64] = g ? qc[1] : qc[3];
        }
        if (tid < 64) vec[V_WS + tid] = __expf(blast + gC[tid] - mnew);
        __syncthreads();
        bf16x8 vf[2];
#pragma unroll
        for (int ks = 0; ks < 2; ++ks) { LAS unsigned char* vp = lds + SC_VS + (32 * ks + 8 * q + (l15 >> 2)) * SC_VVSTR + (16 * c + 4 * (lane & 3)) * 2;
            vf[ks] = cat4(__builtin_amdgcn_ds_read_tr16_b64_v4i16((LAS s16x4*)vp), __builtin_amdgcn_ds_read_tr16_b64_v4i16((LAS s16x4*)(vp + 4 * SC_VVSTR))); }
        {
            LAS float* wh = vec + V_WH + w * 64;
            if (lane < 32) {
                const int t = 32 * g + lane; float qn = 0.f, rs = 0.f;
#pragma unroll
                for (int k = 0; k < 8; ++k) qn += vec[V_QNP + 64 * k + t];
#pragma unroll
                for (int k = 0; k < 4; ++k) rs += vec[V_RS + 64 * k + t];
                const float mxv = fmaxf(m_c, gP[t]), wi = __expf(m_c - mxv), em = __expf(-gB[t] - mxv);
                wh[lane] = wi; wh[32 + lane] = __builtin_amdgcn_rcpf(fmaxf(fabsf(wi * qn + rs), em));
            }
            const LAS f32x4* px = (const LAS f32x4*)(lds + SC_QCX) + ((w ^ 4) * 2) * 64 + lane;
#define SC_FIN(tt, QCV) do { const int tb = 2 * g + (tt); \
                f32x4 sv = (f32x4){0.f, 0.f, 0.f, 0.f}; \
                _Pragma("unroll") for (int ks = 0; ks < 2; ++ks) { const LAS unsigned char* sp = lds + SC_SP + (16 * tb + l15) * SC_VSTR + 64 * ks + 16 * q; const bf16x8 sa = cat4(*(const LAS s16x4*)sp, *(const LAS s16x4*)(sp + 8)); sv = MFMA16(vf[ks], sa, sv); } \
                const f32x4 qct = (QCV) + px[64 * (tt)]; \
                const float wi = wh[16 * (tt) + l15], hi_ = wh[32 + 16 * (tt) + l15]; \
                LAS u32x2* op = (LAS u32x2*)(lds + SC_OT + (16 * tb + l15) * SC_VVSTR + (16 * c + 4 * q) * 2); const u32x2 ogw = *op; \
                u32x2 ow; ow.x = pk2((wi * qct[0] + sv[0]) * hi_ * bflo(ogw.x), (wi * qct[1] + sv[1]) * hi_ * bfhi(ogw.x)); ow.y = pk2((wi * qct[2] + sv[2]) * hi_ * bflo(ogw.y), (wi * qct[3] + sv[3]) * hi_ * bfhi(ogw.y)); \
                *op = ow; } while (0)
            if (g) { SC_FIN(0, qc[2]); SC_FIN(1, qc[3]); } else { SC_FIN(0, qc[0]); SC_FIN(1, qc[1]); }
#undef SC_FIN
        }
        if (ci + 1 < S / 64) SC_LOADOG(ci + 1);
        {
            const float decay = __expf(blast + m_c - mnew);
            bf16x8 vw[2], wsf[2];
#pragma unroll
            for (int ks = 0; ks < 2; ++ks) {
                const f32x4 w0 = *(const LAS f32x4*)(vec + V_WS + 32 * ks + 8 * q), w1 = *(const LAS f32x4*)(vec + V_WS + 32 * ks + 8 * q + 4);
                f32x4 x0, x1; unpk8(__builtin_bit_cast(u32x4, vf[ks]), x0, x1); vw[ks] = __builtin_bit_cast(bf16x8, pk8(x0 * w0, x1 * w1));
                const u32x4 wz = pk8(w0, w1); wsf[ks] = __builtin_bit_cast(bf16x8, l15 == 0 ? wz : (u32x4){0u, 0u, 0u, 0u});
            }
#pragma unroll
            for (int i = 0; i < 8; ++i) {
                if ((i & 1) == 0) __builtin_amdgcn_sched_barrier(0);
                Cacc[i] *= decay;
#pragma unroll
                for (int ks = 0; ks < 2; ++ks) {
                    LAS unsigned char* kp = lds + SC_KS + (32 * ks + 8 * q + (l15 >> 2)) * SC_QSTR + (128 * g + 16 * i + 4 * (lane & 3)) * 2;
                    const s16x4 lo = __builtin_amdgcn_ds_read_tr16_b64_v4i16((LAS s16x4*)kp), hi = __builtin_amdgcn_ds_read_tr16_b64_v4i16((LAS s16x4*)(kp + 4 * SC_QSTR));
                    Cacc[i] = MFMA16(cat4(lo, hi), vw[ks], Cacc[i]);
                }
            }
#pragma unroll
            for (int ib = 0; ib < 2; ++ib) {
                nacc[ib] *= decay;
#pragma unroll
                for (int ks = 0; ks < 2; ++ks) {
                    LAS unsigned char* kp = lds + SC_KS + (32 * ks + 8 * q + (l15 >> 2)) * SC_QSTR + (128 * g + 16 * (2 * c + ib) + 4 * (lane & 3)) * 2;
                    const s16x4 lo = __builtin_amdgcn_ds_read_tr16_b64_v4i16((LAS s16x4*)kp), hi = __builtin_amdgcn_ds_read_tr16_b64_v4i16((LAS s16x4*)(kp + 4 * SC_QSTR));
                    nacc[ib] = MFMA16(cat4(lo, hi), wsf[ks], nacc[ib]);
                }
            }
        }
        __syncthreads();
    }
    if (!dry) *(u32x4*)(gOG + (size_t)(S / 64 - 1) * 64 * 2048) = *(const LAS u32x4*)(lds + SC_OT + vd * SC_VVSTR + 16 * vch);
    __syncthreads();
#undef SC_LOAD
#undef SC_LOADOG
}
DI void scan_phase(LAS unsigned char* lds, const ScanT& T, int cu, int dry) {
    const int xcd = cu & 7, idx = cu >> 3, bh = xcd * 4 + (idx >> 3), sl = idx & 7;
    scan_item(lds, T, bh >> 2, bh & 3, sl, dry);
}

DI void final_phase(const bf16_t* xb, float* out, const u64* ssq, const float* g, int gw, int NGW, int lane) {
    for (int m = gw; m < M; m += NGW) {
        const float rs = ssq_rstd(ssq + m, 1.f / 1024.f);
#pragma unroll
        for (int j = 0; j < 2; ++j) {
            const int c0 = (lane + 64 * j) * 8; f32x4 a, b; unpk8(*(const u32x4*)(xb + (size_t)m * D + c0), a, b);
            *(f32x4*)(out + (size_t)m * D + c0) = a * rs * *(const f32x4*)(g + c0); *(f32x4*)(out + (size_t)m * D + c0 + 4) = b * rs * *(const f32x4*)(g + c0 + 4);
        }
    }
}
constexpr int LDS_BYTES = 147456, MISC_OFF = 146944;
static_assert(SC_END <= MISC_OFF && AT_WQOFF + 96 * AT_WQS <= MISC_OFF && AT_WQOFF == 2 * AT_KB + 2 * AT_VB, "LDS map");
constexpr int PH_PER_LAYER = 6, PH_FINAL = 1 + 4 * PH_PER_LAYER, PH_REFRESH = 100;
#ifndef GEMM_ALIGN
#define GEMM_ALIGN true
#endif
#ifndef GEMM_SP2
#define GEMM_SP2 true
#endif
#ifndef C1_DRYMODE
#define C1_DRYMODE 1
#endif
#ifndef BAR_TWICE
#define BAR_TWICE 0
#endif
#ifndef STAGGER
#define STAGGER 0
#endif
#ifndef STAGGER_MASK
#define STAGGER_MASK 3
#endif
#ifndef STAGGER_L1
#define STAGGER_L1 0
#endif
#define STAGGER_SLEEP_N(n_) do { if (n_) { for (int s_ = 0; s_ < (int)(((cu >> 3) & STAGGER_MASK) * (n_)); ++s_) __builtin_amdgcn_s_sleep(32); } } while (0)
#define STAGGER_SLEEP() STAGGER_SLEEP_N(STAGGER)
#ifndef PP_HOLES
#define PP_HOLES 0
#endif
#ifndef A2_REV
#define A2_REV 1
#endif
#ifndef A2_QREV
#define A2_QREV 0
#endif
#ifndef GEMM_ALIGN1
#define GEMM_ALIGN1 GEMM_ALIGN
#endif
#ifndef P0_ORDER
#define P0_ORDER 0
#endif
#ifndef PHM
#define PHM 0xFFFF
#endif
#define PH_ON(b) ((PHM >> (b)) & 1)
#ifndef REPEAT
#define REPEAT 0
#endif
#ifndef REPEAT_AFTER
#define REPEAT_AFTER 0
#endif
#if REPEAT_AFTER
#define REP_LOOP(b) for (int rep_ = 0, nrep_ = opaque((REPEAT >> (b)) & 1); rep_ <= nrep_; ++rep_)
#else
#define REP_LOOP(b) for (int rep_ = opaque((REPEAT >> (b)) & 1); rep_ >= 0; --rep_)
#endif
typedef const __attribute__((address_space(4))) Args* KArgs;
DI KArgs kargs() { KArgs p = (KArgs)__builtin_amdgcn_kernarg_segment_ptr(); asm volatile("" : "+s"(p)); return p; }

#define TID_DEFS const int tid = tidx(), w = __builtin_amdgcn_readfirstlane(tid >> 6), lane = tid & 63; (void)w; (void)lane
DI void prep_mixer(LAS unsigned char* lds, int i, int cu, int G) {
    TID_DEFS; KArgs A = kargs(); unsigned char* ws = A->ws; LAS float* scr = (LAS float*)lds;
    const int kind = i % 3, j = i / 3;
    const float* normg = A->in[I_NORMG] + (size_t)i * D; bf16_t* wmix = (bf16_t*)(ws + WS_WMIX);
    const PrepTask tple{A->in[I_PLE_PROJ] + (size_t)i * 256 * D, D, nullptr, 256, D, PM_ID, (bf16_t*)(ws + WS_WPLE + 2 * MiB)};
    if (kind == 0) {
        constexpr int n0 = 28 * 8, n1 = 24 * 3, n2 = 32 * 2, n3 = 16 * 8;
        const PrepTask t0{A->in[I_MLA_WIN] + (size_t)j * D * 1696, 1696, normg, D, 1792, PM_MLA_IN, wmix};
        const PrepTask t1{A->in[I_MLA_WQB] + (size_t)j * 384 * 1536, 1536, A->in[I_MLA_QN] + j * 384, 384, 1536, PM_MLA_QB, (bf16_t*)(ws + WS_WMIX + WM_QB)};
        const PrepTask t2{A->in[I_MLA_WKVB] + (size_t)j * 256 * 2048, 2048, A->in[I_MLA_KVN] + j * 256, 256, 2048, PM_MLA_KVB, (bf16_t*)(ws + WS_WMIX + WM_KVB)};
        const PrepTask t3{A->in[I_MLA_WOUT] + (size_t)j * D * D, D, nullptr, D, D, PM_ID, (bf16_t*)(ws + WS_WMIX + WM_OUT_MLA)};
        prep_batched([&](int it, auto&& f) {
            if (it < n0) f(t0, it); else if (it < n0 + n1) f(t1, it - n0); else if (it < n0 + n1 + n2) f(t2, it - n0 - n1); else if (it < n0 + n1 + n2 + n3) f(t3, it - n0 - n1 - n2); else f(tple, it - n0 - n1 - n2 - n3);
        }, n0 + n1 + n2 + n3 + 32, cu, G, scr);
    } else if (kind == 1) {
        constexpr int n0 = 64 * 8, n1 = 16 * 8;
        const PrepTask t0{A->in[I_CONV_WIN] + (size_t)j * D * 4096, 4096, normg, D, 4096, PM_CONV_IN, wmix};
        const PrepTask t1{A->in[I_CONV_WOUT] + (size_t)j * D * D, D, nullptr, D, D, PM_ID, (bf16_t*)(ws + WS_WMIX + WM_OUT_CONV)};
        prep_batched([&](int it, auto&& f) { if (it < n0) f(t0, it); else if (it < n0 + n1) f(t1, it - n0); else f(tple, it - n0 - n1); }, n0 + n1 + 32, cu, G, scr);
    } else {
        constexpr int n0 = 128 * 8, n1 = 16 * 16;
        const PrepTask t0{A->in[I_L_WIN] + (size_t)j * D * 8200, 8200, normg, D, 8192, PM_LSTM_IN, wmix};
        const PrepTask t1{A->in[I_L_WOUT] + (size_t)j * 2048 * D, D, nullptr, 2048, D, PM_ID, (bf16_t*)(ws + WS_WMIX + WM_OUT_LSTM)};
        prep_batched([&](int it, auto&& f) { if (it < n0) f(t0, it); else if (it < n0 + n1) f(t1, it - n0); else f(tple, it - n0 - n1); }, n0 + n1 + 32, cu, G, scr);
        gw8_prep(A->in[I_L_WIN] + (size_t)j * D * 8200, normg, (float*)(ws + WS_GW8), cu * NTHR + tid, G * NTHR);
    }
    if (kind != 2) p_to_bf16(A->in[I_P] + (size_t)i * M * 256, (bf16_t*)(ws + WS_BIG + A_PB), cu * NTHR + tid, G * NTHR);
}
DI void prep_ple(LAS unsigned char* lds, int i, int cu, int G) {
    KArgs A = kargs(); unsigned char* ws = A->ws; LAS float* scr = (LAS float*)lds;
    const PrepTask t0{A->in[I_PLE_GATE] + (size_t)i * D * D, D, nullptr, D, D, PM_ID, (bf16_t*)(ws + WS_WPLE)};
    prep_batched([&](int it, auto&& f) { f(t0, it); }, 16 * 8, cu, G, scr);
}

__global__ void __launch_bounds__(NTHR, 2) fwd(Args a_) {
    extern __shared__ __attribute__((aligned(16))) unsigned char lds_[];
    LAS unsigned char* lds = (LAS unsigned char*)lds_;
    const int cu = blockIdx.x, G = gridDim.x;
#define GW (cu * 8 + w)
#define NGW (G * 8)
#define GT (cu * NTHR + tid)
#define NGT (G * NTHR)
    const int lo = a_.ph_lo, hi = a_.ph_hi;
    volatile LAS unsigned* misc = (volatile LAS unsigned*)(lds + MISC_OFF);
    { TID_DEFS; if (tid < 32) misc[tid] = 0u; }
    __syncthreads();
    const bool multi = (hi - lo) > 1;
    XcdBarrier bar; bar.bar = nullptr; bar.x = 0; bar.st = misc + 8;
    if (multi) bar = xcd_barrier_post((unsigned*)(kargs()->ws + WS_CTL), misc + 8);
#define IN(k) (lo <= (k) && (k) < hi)
#ifdef TIMELINE
#define STAMP(idx) do { if (blockIdx.x == 0 && threadIdx.x == 0) ((unsigned long long*)(kargs()->ws + WS_CTL + 32 * KiB))[(idx)] = __builtin_amdgcn_s_memrealtime(); } while (0)
#else
#define STAMP(idx) do { } while (0)
#endif
#define SEAM(k) do { if (multi && (k) + 1 < hi) { XcdBarrier b2 = bar; b2.bar = (unsigned*)(kargs()->ws + WS_CTL); xcd_barrier(b2); if (BAR_TWICE) xcd_barrier(b2); } STAMP((k) + 1); } while (0)

    STAMP(0);
    if (lo >= PH_REFRESH) {
        TID_DEFS; KArgs A = kargs(); const int i = lo - PH_REFRESH; rows_to_bf16_ssq(A->out, (bf16_t*)(A->ws + WS_XBA), ssq_arr(A->ws, SSQ_X + i), GW, NGW, lane); return;
    }
    if (IN(0)) {
#if P0_ORDER
        REP_LOOP(13) prep_mixer(lds, 0, cu, G);
        REP_LOOP(11) { TID_DEFS; KArgs A = kargs(); unsigned char* ws = A->ws; rows_to_bf16_ssq(A->in[I_X], (bf16_t*)(ws + WS_XBA), ssq_arr(ws, SSQ_X), GW, NGW, lane); }
        REP_LOOP(12) { TID_DEFS; KArgs A = kargs(); unsigned char* ws = A->ws; rope_tables((const int*)A->in[I_POS], (float*)(ws + WS_CS), (float*)(ws + WS_SN), GT, NGT); }
#else
        REP_LOOP(11) { TID_DEFS; KArgs A = kargs(); unsigned char* ws = A->ws; rows_to_bf16_ssq(A->in[I_X], (bf16_t*)(ws + WS_XBA), ssq_arr(ws, SSQ_X), GW, NGW, lane); }
        REP_LOOP(12) { TID_DEFS; KArgs A = kargs(); unsigned char* ws = A->ws; rope_tables((const int*)A->in[I_POS], (float*)(ws + WS_CS), (float*)(ws + WS_SN), GT, NGT); }
        REP_LOOP(13) prep_mixer(lds, 0, cu, G);
#endif
    }
    if (IN(0)) SEAM(0);
#pragma unroll 1
    for (int i = 0; i < 4; ++i) {
        const int kind = i % 3, j = i / 3, base = 1 + PH_PER_LAYER * i;
        if (hi <= base || lo >= base + PH_PER_LAYER) continue;
        if (IN(base + 1)) {
            REP_LOOP(0) prep_ple(lds, i, cu, G);
            if (kind == 0 && PH_ON(1)) {
                unsigned char* ws = kargs()->ws;
                pg8::Gemm g{(bf16_t*)(ws + WS_XBA), (bf16_t*)(ws + WS_WMIX), M, 1792, opaque(D)}; pg8::StaticOrder So; So.init(M, 1792, G, cu);
                EpiA1 E{ws, i, j}; STAGGER_SLEEP();
                pg8::gemm_phase<EpiA1, pg8::StaticOrder, GEMM_ALIGN, GEMM_SP2>(lds, g, So, E);
                if (PP_HOLES && G == 256 && cu >= 192) {
                    KArgs A2 = kargs(); unsigned char* ws2 = A2->ws;
                    pg8::Gemm g2{(bf16_t*)(ws2 + WS_BIG + A_PB), (bf16_t*)(ws2 + WS_WPLE + 2 * MiB), M, D, opaque(256)}; pg8::StaticOrder So2; So2.init(M, D, 64, cu - 192);
                    EpiPP E2{(bf16_t*)A2->out};
                    pg8::gemm_phase<EpiPP, pg8::StaticOrder, GEMM_ALIGN, GEMM_SP2>(lds, g2, So2, E2);
                }
            } else if (kind == 1 && PH_ON(2)) REP_LOOP(2) {
                unsigned char* ws = kargs()->ws;
                pg8::Gemm g{(bf16_t*)(ws + WS_XBA), (bf16_t*)(ws + WS_WMIX), M, 4096, opaque(D)}; pg8::StaticOrder So; So.init(M, 4096, G, cu);
                EpiC1 E{ws, i, rep_ * C1_DRYMODE}; STAGGER_SLEEP();
                pg8::gemm_phase<EpiC1, pg8::StaticOrder, GEMM_ALIGN, GEMM_SP2>(lds, g, So, E);
            } else if (kind == 2 && PH_ON(3)) REP_LOOP(3) {
                { TID_DEFS; KArgs A = kargs(); unsigned char* ws = A->ws;
                  gates_phase((bf16_t*)(ws + WS_XBA), ssq_arr(ws, SSQ_X + i), (const float*)(ws + WS_GW8), A->in[I_L_BG] + j * 8, (float*)(ws + WS_IG), (float*)(ws + WS_LF), GW, NGW, lane); }
                unsigned char* ws = kargs()->ws;
                pg8::Gemm g{(bf16_t*)(ws + WS_XBA), (bf16_t*)(ws + WS_WMIX), M, 8192, opaque(D)}; pg8::StaticOrder So; So.init(M, 8192, G, cu);
                EpiL1 E{ws, i}; STAGGER_SLEEP(); STAGGER_SLEEP_N(STAGGER_L1);
                pg8::gemm_phase<EpiL1, pg8::StaticOrder, GEMM_ALIGN, GEMM_SP2>(lds, g, So, E);
            }
            SEAM(base + 1);
        }
        if (IN(base + 2) && kind != 2) {
            if (kind == 0 && PH_ON(4)) REP_LOOP(4) {
                if (!QFUSE) { unsigned char* ws = kargs()->ws;
                  pg8::Gemm g{(bf16_t*)(ws + WS_BIG + A_CQ), (bf16_t*)(ws + WS_WMIX + WM_QB), M, 1536, opaque(384)}; pg8::StaticOrder So; So.init(M, 1536, G, A2_QREV ? G - 1 - cu : cu);
                  EpiQ E{ws, j};
                  pg8::gemm_phase<EpiQ, pg8::StaticOrder, GEMM_ALIGN, GEMM_SP2>(lds, g, So, E); }
                { unsigned char* ws = kargs()->ws;
                  pg8::Gemm g{(bf16_t*)(ws + WS_BIG + A_CKV), (bf16_t*)(ws + WS_WMIX + WM_KVB), M, 2048, opaque(256)}; pg8::StaticOrder So; So.init(M, 2048, G, A2_REV ? G - 1 - cu : cu);
                  EpiKV E{ws, j};
                  pg8::gemm_phase<EpiKV, pg8::StaticOrder, GEMM_ALIGN, GEMM_SP2>(lds, g, So, E); }
            } else if (kind == 1 && PH_ON(5)) REP_LOOP(5) {
                TID_DEFS; KArgs A = kargs(); unsigned char* ws = A->ws;
                conv_phase((const bf16_t*)(ws + WS_BIG + C_CH), (bf16_t*)(ws + WS_BIG + C_BZ), A->in[I_CONV_W] + (size_t)j * 3 * 1024, GT, NGT, rep_);
            }
            SEAM(base + 2);
        }
        if (IN(base + 3) && kind != 1) {
            if (kind == 0 && PH_ON(6)) REP_LOOP(6) {
                unsigned char* wsA = kargs()->ws; unsigned char* big = wsA + WS_BIG;
                AttnT T{(bf16_t*)(big + A_Q), (bf16_t*)(big + A_KN), (bf16_t*)(big + A_KR), (bf16_t*)(big + A_VT), (bf16_t*)(big + A_SZ),
                        (bf16_t*)(big + A_CQ), (bf16_t*)(wsA + WS_WMIX + WM_QB), ssq_arr(wsA, SSQ_Q + j), (const float*)(wsA + WS_CS), (const float*)(wsA + WS_SN)};
                attn_phase(lds, T, cu, rep_);
            } else if (kind == 2 && PH_ON(7)) {
                { unsigned char* ws = kargs()->ws; unsigned char* big = ws + WS_BIG;
                  ScanT T{(bf16_t*)(big + L_Q), (bf16_t*)(big + L_K), (bf16_t*)(big + L_VT), (bf16_t*)(big + L_OG), (float*)(ws + WS_IG), (float*)(ws + WS_LF)};
                  REP_LOOP(7) scan_phase(lds, T, cu, rep_); }
                TID_DEFS; KArgs A = kargs();
                p_to_bf16(A->in[I_P] + (size_t)i * M * 256, (bf16_t*)A->out, GT, NGT);
            }
            SEAM(base + 3);
        }
        if (IN(base + 4)) {
            const size_t xbb_off = kind == 0 ? A_XBB : kind == 1 ? C_XBB : L_XBB, pp_off = kind == 0 ? A_PP : kind == 1 ? C_PP : L_PP;
            if (PH_ON(8)) { KArgs A = kargs(); unsigned char* ws = A->ws;
              const size_t oin = kind == 0 ? A_SZ : kind == 1 ? C_BZ : L_OG, wout = kind == 2 ? WM_OUT_LSTM : WM_OUT_MLA;
              pg8::Gemm g{(bf16_t*)(ws + WS_BIG + oin), (bf16_t*)(ws + WS_WMIX + wout), M, D, opaque(kind == 2 ? 2048 : 1024)}; pg8::StaticOrder So; So.init(M, D, G, cu);
              EpiOut E{ws, xbb_off, i};
              pg8::gemm_phase<EpiOut, pg8::StaticOrder, GEMM_ALIGN1, GEMM_SP2>(lds, g, So, E); }
            if (PH_ON(9) && !(PP_HOLES && kind == 0 && G == 256)) REP_LOOP(9) { KArgs A = kargs(); unsigned char* ws = A->ws;
              pg8::Gemm g{kind == 2 ? (bf16_t*)A->out : (bf16_t*)(ws + WS_BIG + A_PB), (bf16_t*)(ws + WS_WPLE + 2 * MiB), M, D, opaque(256)}; pg8::StaticOrder So; So.init(M, D, G, cu);
              EpiPP E{(bf16_t*)(ws + WS_BIG + pp_off)};
              pg8::gemm_phase<EpiPP, pg8::StaticOrder, GEMM_ALIGN, GEMM_SP2>(lds, g, So, E); }
            SEAM(base + 4);
        }
        if (IN(base + 5)) {
            if (PH_ON(10)) { KArgs A = kargs(); unsigned char* ws = A->ws;
              const size_t xbb_off = kind == 0 ? A_XBB : kind == 1 ? C_XBB : L_XBB, pp_off = kind == 0 ? A_PP : kind == 1 ? C_PP : L_PP;
              const bf16_t* ppp = (PP_HOLES && kind == 0 && G == 256) ? (const bf16_t*)A->out : (const bf16_t*)(ws + WS_BIG + pp_off);
              pg8::Gemm g{(bf16_t*)(ws + WS_BIG + xbb_off), (bf16_t*)(ws + WS_WPLE), M, D, opaque(D)}; pg8::StaticOrder So; So.init(M, D, G, cu);
              if (i == 3 && multi && G == 256 && hi > PH_FINAL) {
                  EpiPleLast E{ws, A->out, A->in[I_FNORM], ppp, xbb_off, i, bar.x, bar.st};
                  pg8::gemm_phase<EpiPleLast, pg8::StaticOrder, false, GEMM_SP2>(lds, g, So, E);
              } else {
                  EpiPle E{ws, ppp, xbb_off, i};
                  pg8::gemm_phase<EpiPle, pg8::StaticOrder, GEMM_ALIGN1, GEMM_SP2>(lds, g, So, E); } }
            if (i < 3) REP_LOOP(1) prep_mixer(lds, i + 1, cu, G);
            if (!(i == 3 && multi && G == 256 && hi > PH_FINAL)) SEAM(base + 5);
        }
    }
    if (IN(PH_FINAL) && !(multi && G == 256 && lo <= PH_FINAL - 1)) { TID_DEFS; KArgs A = kargs(); final_phase((const bf16_t*)(A->ws + WS_XBA), A->out, ssq_arr(A->ws, SSQ_X + 4), A->in[I_FNORM], GW, NGW, lane); }
#ifdef TIMELINE
    {
        SEAM(PH_FINAL);
        TID_DEFS; KArgs A = kargs(); const unsigned long long* ts = (const unsigned long long*)(A->ws + WS_CTL + 32 * KiB);
        const float dA = (float)(ts[TS_A1] - ts[TS_A0]) * 0.01f, dB = (float)(ts[TS_B1] - ts[TS_B0]) * 0.01f;
        const float c = sqrtf(dA);
        for (size_t e = GT; e < (size_t)M * D; e += NGT) A->out[e] = (e == 0) ? 60.f + dB : c;
    }
#endif
#undef IN
#undef SEAM
}
}
#ifndef FAST_LAYERS
#define FAST_LAYERS 15
#endif
#ifndef ONE_LAUNCH
#define ONE_LAUNCH 1
#endif

extern "C" void kernel_launch(void* const* d_in, const int* in_sizes, int n_in, void* d_out, int out_size, void* d_ws, size_t ws_size, hipStream_t stream) {
    static int grid = 0;
    if (grid == 0) {
        int dev = 0, cus = 0;
        if (n_in != 19 || ws_size < fk::WS_END || out_size != fk::M * fk::D) { fprintf(stderr, "kernel_launch: unexpected shapes (n_in %d, ws %zu, out %d)\n", n_in, ws_size, out_size); grid = -1; return; }
        if (hipGetDevice(&dev) != hipSuccess || hipDeviceGetAttribute(&cus, hipDeviceAttributeMultiprocessorCount, dev) != hipSuccess) { grid = -1; return; }
        if (hipFuncSetAttribute((const void*)fk::fwd, hipFuncAttributeMaxDynamicSharedMemorySize, fk::LDS_BYTES) != hipSuccess) { fprintf(stderr, "kernel_launch: hipFuncSetAttribute failed\n"); grid = -1; return; }
        int per_cu = 0;
        if (hipOccupancyMaxActiveBlocksPerMultiprocessor(&per_cu, (const void*)fk::fwd, fk::NTHR, fk::LDS_BYTES) != hipSuccess || per_cu < 1) { fprintf(stderr, "kernel_launch: occupancy query says %d\n", per_cu); }
        (void)hipGetLastError();
        grid = cus;
        if (grid != 256) fprintf(stderr, "kernel_launch: %d CUs (built for 256)\n", grid);
    }
    if (grid < 0) return;
    (void)hipMemsetAsync(d_ws, 0, fk::ZERO_BYTES, stream);
    fk::Args a{};
    for (int i = 0; i < 19; ++i) a.in[i] = (const float*)d_in[i];
    a.out = (float*)d_out; a.ws = (unsigned char*)d_ws;
#define LAUNCH(lo_, hi_) do { a.ph_lo = (lo_); a.ph_hi = (hi_); hipLaunchKernelGGL(fk::fwd, dim3(grid), dim3(fk::NTHR), fk::LDS_BYTES, stream, a); } while (0)
#if ONE_LAUNCH && (FAST_LAYERS == 15)
#ifdef TIMELINE
    LAUNCH(0, fk::PH_FINAL + 2);
#else
    LAUNCH(0, fk::PH_FINAL + 1);
#endif
#else
    nv::In in;
    in.x = (const float*)d_in[0]; in.p = (const float*)d_in[1]; in.pos = (const int*)d_in[2]; in.norm_g = (const float*)d_in[3];
    in.mla_w_in = (const float*)d_in[4]; in.mla_q_norm = (const float*)d_in[5]; in.mla_w_q_b = (const float*)d_in[6];
    in.mla_kv_norm = (const float*)d_in[7]; in.mla_w_kv_b = (const float*)d_in[8]; in.mla_w_out = (const float*)d_in[9];
    in.conv_w_in = (const float*)d_in[10]; in.conv_w = (const float*)d_in[11]; in.conv_w_out = (const float*)d_in[12];
    in.mlstm_w_in = (const float*)d_in[13]; in.mlstm_b_gates = (const float*)d_in[14]; in.mlstm_w_out = (const float*)d_in[15];
    in.ple_proj = (const float*)d_in[16]; in.ple_gate = (const float*)d_in[17]; in.final_norm = (const float*)d_in[18];
    float* nws = (float*)((char*)d_ws + 2 * fk::MiB);
    LAUNCH(0, 1);
    for (int i = 0; i < 4; ++i) {
        if ((FAST_LAYERS >> i) & 1) {
            if (i > 0 && !((FAST_LAYERS >> (i - 1)) & 1)) LAUNCH(fk::PH_REFRESH + i, fk::PH_REFRESH + i + 1);
            for (int s = 0; s < fk::PH_PER_LAYER; ++s) LAUNCH(1 + fk::PH_PER_LAYER * i + s, 1 + fk::PH_PER_LAYER * i + s + 1);
        } else {
            nv::layer(in, (float*)d_out, nws, stream, i, i == 0);
        }
    }
    if ((FAST_LAYERS >> 3) & 1) LAUNCH(fk::PH_FINAL, fk::PH_FINAL + 1);
    else nv::final_norm(in, (float*)d_out, stream);
#endif
#undef LAUNCH
}
```

```cpp
#include <hip/hip_runtime.h>
#include <cstdio>
#include <cstdint>
#include <math.h>
#define LAS __attribute__((address_space(3)))
#define GAS __attribute__((address_space(1)))
#define FAST_LAYERS 15
#define ONE_LAUNCH 1
#define NT_ONCE 6
namespace pg8 {
#define PG8_LAS __attribute__((address_space(3)))
typedef unsigned short bf16_t;
typedef short bf16x8 __attribute__((ext_vector_type(8)));
typedef float f32x4 __attribute__((ext_vector_type(4)));
typedef unsigned u32x4 __attribute__((ext_vector_type(4)));
constexpr int BM = 256, BK = 64, HALF = 128, HTB = HALF * BK * 2  , STAGE_BYTES = 8 * HTB, NXCD = 8, WGM = 8;

__host__ __device__ __forceinline__ int lds_byte(int r, int c) { const int st = (r >> 4) * 2 + (c >> 5), rr = r & 15, cc = c & 31, ob = rr * 64 + cc * 2; return st * 1024 + (ob ^ (((ob >> 9) & 1) << 5)); }
__host__ __device__ __forceinline__ void stage_rc(int b, int& R, int& C) { const int st = b / 1024, sb = b % 1024, swz = sb ^ (((sb >> 9) & 1) << 5); R = (st >> 1) * 16 + swz / 64; C = (st & 1) * 32 + (swz % 64) / 2; }
__host__ __device__ __forceinline__ int perm32(int rho) { const int n = rho >> 4, i = rho & 15; return 8 * (i >> 2) + 4 * n + (i & 3); }

struct Unit { int pm, pn; };
struct Gemm { const bf16_t* A; const bf16_t* Bt; int M, N, K; };

struct StaticOrder {
    int nM, nN, nwg, G, c;
    __host__ __device__ void init(int M, int N, int G_, int c_) { nM = M / BM; nN = N / BM; nwg = nM * nN; G = G_; c = c_; }
    __host__ __device__ bool next(int i, Unit& u) const {
        const long L = (long)i * G + c; if (L >= nwg) return false;
        int wgid = (int)L; { const int q = nwg / NXCD, r = nwg % NXCD, xcd = wgid % NXCD, off = wgid / NXCD; wgid = (xcd < r ? xcd * (q + 1) : r * (q + 1) + (xcd - r) * q) + off; }
        const int nig = WGM * nN, gid = wgid / nig, fm = gid * WGM, gsz = (nM - fm) < WGM ? (nM - fm) : WGM;
        u.pm = fm + ((wgid % nig) % gsz); u.pn = (wgid % nig) / gsz; return true;
    }
    __device__ __forceinline__ void a_ready(const Unit&) const {}
    __device__ __forceinline__ void done(const Unit&) const {}
};

template <class Epi, class Sched, bool ALIGN_EPI = false, bool SP2 = false>
__device__ __forceinline__ void gemm_phase(PG8_LAS unsigned char* lds, const Gemm g, const Sched& S, const Epi& E) {
    int tid_ = threadIdx.x; asm volatile("" : "+v"(tid_));
    const int tid = tid_, wid = __builtin_amdgcn_readfirstlane(tid >> 6), lane = tid & 63, wr = wid >> 2, wc = wid & 3, fr = lane & 15, fq = lane >> 4;
    const int K = g.K, nt = K / BK;
    unsigned voffA[2], voffB[2];
#pragma unroll
    for (int i = 0; i < 2; ++i) { int R, C; stage_rc(tid * 16 + i * 8192, R, C); const int Rb = Epi::PERM ? ((R & ~31) + perm32(R & 31)) : R;
        voffA[i] = (unsigned)(R * K + C) * 2u; voffB[i] = (unsigned)(Rb * K + C) * 2u; }
    const size_t kstep = (size_t)(BK * 2);
    const size_t hstep = (size_t)HALF * K * 2;
    const size_t tstep = 2 * hstep;
    const unsigned ldsw = (unsigned)wid * 1024u;
    const int aoff = lds_byte(wr * 64 + fr, fq * 8), boff = lds_byte(wc * 32 + fr, fq * 8);
#define PG8_SA(b, h) (((b) * 2 + (h)) * HTB)
#define PG8_SB(b, h) ((4 + (b) * 2 + (h)) * HTB)
#define PG8_STAGE(bufoff, gbase, voff) do { _Pragma("unroll") for (int _i = 0; _i < 2; ++_i) \
        __builtin_amdgcn_global_load_lds((const unsigned*)((const char*)(gbase) + (voff)[_i]), (PG8_LAS unsigned*)(lds + (bufoff) + ldsw + _i * 8192), 16, 0, 0); } while (0)
#define PG8_LDA(dst, b, h) do { _Pragma("unroll") for (int m = 0; m < 4; ++m) _Pragma("unroll") for (int k = 0; k < 2; ++k) dst[m][k] = *(const PG8_LAS bf16x8*)(lds + PG8_SA(b, h) + aoff + m * 2048 + k * 1024); } while (0)
#define PG8_LDB(dst, b, h) do { _Pragma("unroll") for (int n = 0; n < 2; ++n) _Pragma("unroll") for (int k = 0; k < 2; ++k) dst[n][k] = *(const PG8_LAS bf16x8*)(lds + PG8_SB(b, h) + boff + n * 2048 + k * 1024); } while (0)
#define PG8_MMA(ai, bj, At, Bt) do { __builtin_amdgcn_s_setprio(1); _Pragma("unroll") for (int m = 0; m < 4; ++m) _Pragma("unroll") for (int n = 0; n < 2; ++n) _Pragma("unroll") for (int k = 0; k < 2; ++k) \
        acc[ai][bj][m][n] = __builtin_amdgcn_mfma_f32_16x16x32_bf16(Bt[n][k], At[m][k], acc[ai][bj][m][n], 0, 0, 0); __builtin_amdgcn_s_setprio(0); } while (0)
#define PG8_WAIT_V(n) asm volatile("s_waitcnt vmcnt(" #n ")" ::: "memory")
#define PG8_WAIT_L(n) asm volatile("s_waitcnt lgkmcnt(" #n ")" ::: "memory")
#define PG8_BAR __builtin_amdgcn_s_barrier()
#define PG8_SCHED __builtin_amdgcn_sched_barrier(0)
    Unit cur, nxt; int ui = 0;
    if (!S.next(0, cur)) return;
    f32x4 acc[2][2][4][2];
#pragma unroll
    for (int a = 0; a < 2; ++a)
#pragma unroll
        for (int b = 0; b < 2; ++b)
#pragma unroll
            for (int m = 0; m < 4; ++m)
#pragma unroll
                for (int n = 0; n < 2; ++n) acc[a][b][m][n] = (f32x4){0.f, 0.f, 0.f, 0.f};
    bf16x8 At[4][2], B0[2][2], B1[2][2];
    const char* cA = (const char*)g.A + (size_t)cur.pm * tstep; const char* cB = (const char*)g.Bt + (size_t)cur.pn * tstep;
    S.a_ready(cur);
    if constexpr (SP2) {
        PG8_STAGE(PG8_SB(0, 0), cB, voffB); PG8_STAGE(PG8_SB(0, 1), cB + hstep, voffB); PG8_STAGE(PG8_SA(0, 0), cA, voffA); PG8_STAGE(PG8_SA(0, 1), cA + hstep, voffA);
        if (wr == 1) PG8_BAR;
        PG8_WAIT_V(2); PG8_BAR;
        PG8_STAGE(PG8_SB(1, 0), cB + kstep, voffB); PG8_STAGE(PG8_SA(1, 0), cA + kstep, voffA); PG8_STAGE(PG8_SB(1, 1), cB + hstep + kstep, voffB);
        PG8_WAIT_V(6); PG8_BAR;
    } else {
        PG8_STAGE(PG8_SB(0, 0), cB, voffB); PG8_STAGE(PG8_SA(0, 0), cA, voffA); PG8_STAGE(PG8_SB(0, 1), cB + hstep, voffB); PG8_STAGE(PG8_SA(0, 1), cA + hstep, voffA);
        if (wr == 1) PG8_BAR;
        PG8_WAIT_V(4); PG8_BAR;
        PG8_STAGE(PG8_SB(1, 0), cB + kstep, voffB); PG8_STAGE(PG8_SA(1, 0), cA + kstep, voffA); PG8_STAGE(PG8_SB(1, 1), cB + hstep + kstep, voffB);
        PG8_WAIT_V(6); PG8_BAR;
    }
    for (;;) {
        const bool has_next = S.next(ui + 1, nxt);
        const char* nA = has_next ? (const char*)g.A + (size_t)nxt.pm * tstep : cA; const char* nB = has_next ? (const char*)g.Bt + (size_t)nxt.pn * tstep : cB;
        for (int t = 0; t < nt; t += 2) {
            const bool last = (t == nt - 2);
            const char* a1 = cA + (size_t)(t + 1) * kstep;
            const char* a2 = last ? nA : cA + (size_t)(t + 2) * kstep; const char* b2 = last ? nB : cB + (size_t)(t + 2) * kstep;
            const char* a3 = a2 + kstep; const char* b3 = b2 + kstep;
            if (last && has_next) S.a_ready(nxt);
            if constexpr (SP2) {
            PG8_LDB(B0, 0, 0); PG8_LDB(B1, 0, 1); PG8_SCHED; PG8_LDA(At, 0, 0); PG8_STAGE(PG8_SA(1, 1), a1 + hstep, voffA);
            PG8_WAIT_V(8); PG8_WAIT_L(0); PG8_BAR; PG8_MMA(0, 0, At, B0); PG8_MMA(0, 1, At, B1); PG8_BAR; PG8_SCHED;
            PG8_LDA(At, 0, 1); PG8_STAGE(PG8_SB(0, 0), b2, voffB); PG8_STAGE(PG8_SB(0, 1), b2 + hstep, voffB); PG8_STAGE(PG8_SA(0, 0), a2, voffA);
            PG8_WAIT_V(8); PG8_WAIT_L(0); PG8_BAR; PG8_MMA(1, 0, At, B0); PG8_MMA(1, 1, At, B1); PG8_BAR; PG8_SCHED;
            PG8_LDB(B0, 1, 0); PG8_LDB(B1, 1, 1); PG8_SCHED; PG8_LDA(At, 1, 0); PG8_STAGE(PG8_SA(0, 1), a2 + hstep, voffA);
            PG8_WAIT_V(8); PG8_WAIT_L(0); PG8_BAR; PG8_MMA(0, 0, At, B0); PG8_MMA(0, 1, At, B1); PG8_BAR; PG8_SCHED;
            PG8_LDA(At, 1, 1); PG8_STAGE(PG8_SB(1, 0), b3, voffB); PG8_STAGE(PG8_SB(1, 1), b3 + hstep, voffB); PG8_STAGE(PG8_SA(1, 0), a3, voffA);
            PG8_WAIT_V(8); PG8_WAIT_L(0); PG8_BAR; PG8_MMA(1, 0, At, B0); PG8_MMA(1, 1, At, B1); PG8_BAR; PG8_SCHED;
            } else {
            PG8_LDB(B0, 0, 0); PG8_SCHED; PG8_LDA(At, 0, 0); PG8_STAGE(PG8_SA(1, 1), a1 + hstep, voffA);
            PG8_WAIT_L(8); PG8_BAR; PG8_WAIT_L(0); PG8_MMA(0, 0, At, B0); PG8_BAR; PG8_SCHED;
            PG8_LDB(B1, 0, 1); PG8_STAGE(PG8_SB(0, 0), b2, voffB);
            PG8_BAR; PG8_WAIT_L(0); PG8_MMA(0, 1, At, B1); PG8_BAR;
            PG8_LDA(At, 0, 1); PG8_STAGE(PG8_SA(0, 0), a2, voffA);
            PG8_BAR; PG8_WAIT_L(0); PG8_MMA(1, 0, At, B0); PG8_BAR; PG8_SCHED;
            PG8_STAGE(PG8_SB(0, 1), b2 + hstep, voffB);
            PG8_WAIT_V(6); PG8_BAR; PG8_MMA(1, 1, At, B1); PG8_BAR;
            PG8_LDB(B0, 1, 0); PG8_SCHED; PG8_LDA(At, 1, 0); PG8_STAGE(PG8_SA(0, 1), a2 + hstep, voffA);
            PG8_WAIT_L(8); PG8_BAR; PG8_WAIT_L(0); PG8_MMA(0, 0, At, B0); PG8_BAR; PG8_SCHED;
            PG8_LDB(B1, 1, 1); PG8_STAGE(PG8_SB(1, 0), b3, voffB);
            PG8_BAR; PG8_WAIT_L(0); PG8_MMA(0, 1, At, B1); PG8_BAR;
            PG8_LDA(At, 1, 1); PG8_STAGE(PG8_SA(1, 0), a3, voffA);
            PG8_BAR; PG8_WAIT_L(0); PG8_MMA(1, 0, At, B0); PG8_BAR; PG8_SCHED;
            PG8_STAGE(PG8_SB(1, 1), b3 + hstep, voffB);
            PG8_WAIT_V(6); PG8_BAR; PG8_MMA(1, 1, At, B1); PG8_BAR;
            }
        }
        if constexpr (ALIGN_EPI) { if (wr == 0) PG8_BAR; }
        if constexpr (!Epi::AFTER_DRAIN) { E(acc, cur, wr, wc, fr, fq); S.done(cur); }
        if (!has_next) break;
#pragma unroll
        for (int a = 0; a < 2; ++a)
#pragma unroll
            for (int b = 0; b < 2; ++b)
#pragma unroll
                for (int m = 0; m < 4; ++m)
#pragma unroll
                    for (int n = 0; n < 2; ++n) acc[a][b][m][n] = (f32x4){0.f, 0.f, 0.f, 0.f};
        cur = nxt; cA = nA; cB = nB; ++ui;
        if constexpr (ALIGN_EPI) { if (wr == 1) PG8_BAR; }
    }
    PG8_WAIT_V(0);
    if constexpr (!ALIGN_EPI) { if (wr == 0) PG8_BAR; }
    PG8_BAR;
    if constexpr (Epi::AFTER_DRAIN) { E.fused(acc, cur, wr, wc, fr, fq, lds, wid, lane); S.done(cur); }
#undef PG8_SA
#undef PG8_SB
#undef PG8_STAGE
#undef PG8_LDA
#undef PG8_LDB
#undef PG8_MMA
#undef PG8_WAIT_V
#undef PG8_WAIT_L
#undef PG8_BAR
#undef PG8_SCHED
}
}
#ifndef XB_NO_RELEASE
#define XB_NO_RELEASE 0
#endif
#define XB_TMO      128
#define XB_XCNT(j)  (256  + 64 * (j))
#define XB_XSUB(j)  (1280 + 64 * (j))
#define XB_XGEN(j)  (2304 + 64 * (j))
#define XB_TOP      3328
#define XB_TOPGEN   3392
#define XCD_BAR_WORDS 3456
#define XB_SPIN_CAP (1u << 18)

__device__ __forceinline__ unsigned xb_ld(unsigned* p)              { return __hip_atomic_load(p, __ATOMIC_RELAXED, __HIP_MEMORY_SCOPE_AGENT); }
__device__ __forceinline__ unsigned xb_add(unsigned* p, unsigned v) { return __hip_atomic_fetch_add(p, v, __ATOMIC_RELAXED, __HIP_MEMORY_SCOPE_AGENT); }
__device__ __forceinline__ unsigned xb_xcc_id() { return (unsigned)__builtin_amdgcn_s_getreg((3 << 11) | 20) & 0xFu; }
#define XB_SPIN(cond, bar) do { unsigned _sp = 0; while (cond) { __builtin_amdgcn_s_sleep(1); \
    if ((++_sp & 255u) == 0u) { if (xb_ld(&(bar)[XB_TMO])) break; if (_sp > XB_SPIN_CAP) { atomicAdd(&(bar)[XB_TMO], 1u); break; } } } } while (0)

struct XcdBarrier {
    unsigned* bar; unsigned x;
    volatile LAS unsigned* st;
};

__device__ __forceinline__ XcdBarrier xcd_barrier_post(unsigned* bar, volatile LAS unsigned* st) {
    XcdBarrier b; b.bar = bar; b.x = xb_xcc_id(); b.st = st;
    if (threadIdx.x == 0) (void)xb_add(&bar[XB_XCNT(b.x)], 1u);
    return b;
}
__device__ __forceinline__ void xcd_barrier_complete(unsigned* bar, unsigned x, unsigned& nloc, unsigned& nx, unsigned& mask) {
    const unsigned G = gridDim.x * gridDim.y * gridDim.z;
    unsigned sum, cnt, mine, msk, sp = 0u;
    for (;;) {
        sum = 0u; cnt = 0u; mine = 0u; msk = 0u;
#pragma unroll
        for (unsigned j = 0; j < 16; ++j) { const unsigned c = xb_ld(&bar[XB_XCNT(j)]); sum += c; cnt += (c > 0u) ? 1u : 0u; msk |= (c > 0u) ? (1u << j) : 0u; mine = (j == x) ? c : mine; }
        if (sum == G) break;
        __builtin_amdgcn_s_sleep(1);
        if ((++sp & 255u) == 0u) { if (xb_ld(&bar[XB_TMO])) break; if (sp > XB_SPIN_CAP) { atomicAdd(&bar[XB_TMO], 1u); break; } }
    }
    nloc = mine > 0u ? mine : 1u; nx = cnt > 0u ? cnt : 1u; mask = msk;
}

__device__ __forceinline__ void xcd_barrier(const XcdBarrier& b) {
    asm volatile("s_waitcnt vmcnt(0)" ::: "memory");
    __syncthreads();
    if (threadIdx.x == 0) {
        unsigned* bar = b.bar;
        __builtin_amdgcn_s_waitcnt(0);
        unsigned nloc = b.st[0], nx = b.st[1], mask = b.st[2];
        if (nloc == 0u) { xcd_barrier_complete(bar, b.x, nloc, nx, mask); b.st[0] = nloc; b.st[1] = nx; b.st[2] = mask; }
        const unsigned old = xb_add(&bar[XB_XSUB(b.x)], 1u);
        const unsigned gen = old / nloc;
        if (old + 1u == (gen + 1u) * nloc) {
            if (!XB_NO_RELEASE) __builtin_amdgcn_fence(__ATOMIC_RELEASE, "agent");
            asm volatile("s_waitcnt vmcnt(0)" ::: "memory");
            const unsigned og = xb_add(&bar[XB_TOP], 1u);
            const unsigned tg = og / nx;
            if (og + 1u == (tg + 1u) * nx) {
#pragma unroll
                for (unsigned j = 0; j < 16; ++j) if ((mask >> j) & 1u) (void)xb_add(&bar[XB_XGEN(j)], 1u);
            }
        }
        XB_SPIN(xb_ld(&bar[XB_XGEN(b.x)]) == gen, bar);
        __builtin_amdgcn_fence(__ATOMIC_ACQUIRE, "agent");
        asm volatile("s_waitcnt vmcnt(0)" ::: "memory");
    }
    __syncthreads();
}
namespace fk {
using pg8::bf16_t; using pg8::bf16x8; using pg8::f32x4; using pg8::u32x4; using pg8::Unit;
typedef float f32x16 __attribute__((ext_vector_type(16)));
typedef float f32x2 __attribute__((ext_vector_type(2)));
typedef __bf16 bf16x2_t __attribute__((ext_vector_type(2)));
typedef short s16x4 __attribute__((ext_vector_type(4)));
typedef unsigned u32x2 __attribute__((ext_vector_type(2)));
#define DI __device__ __forceinline__

constexpr int NB = 8, S = 2048, M = NB * S, D = 1024;
constexpr float EPS = 1e-6f, LOG2E = 1.4426950408889634f;
constexpr int NTHR = 512;

DI int tidx() { int t = threadIdx.x; asm volatile("" : "+v"(t)); return t; }
DI unsigned pk2(float lo, float hi) { f32x2 v = {lo, hi}; return __builtin_bit_cast(unsigned, __builtin_convertvector(v, bf16x2_t)); }
DI float bflo(unsigned u) { return __uint_as_float(u << 16); }
DI float bfhi(unsigned u) { return __uint_as_float(u & 0xffff0000u); }
DI float bf1(unsigned short b) { return __uint_as_float((unsigned)b << 16); }
DI float ex2(float x) { return __builtin_amdgcn_exp2f(x); }
DI float sigm(float x) { return __builtin_amdgcn_rcpf(1.f + ex2(-LOG2E * x)); }
DI float silu(float x) { return x * sigm(x); }
DI float sigm_s(float xs) { return __builtin_amdgcn_rcpf(1.f + ex2(xs)); }
DI float sigm_silu(float o, float z) { return z * __builtin_amdgcn_rcpf((1.f + ex2(-LOG2E * o)) * (1.f + ex2(-LOG2E * z))); }
DI u32x4 pk8(const f32x4& a, const f32x4& b) { u32x4 w; w.x = pk2(a[0], a[1]); w.y = pk2(a[2], a[3]); w.z = pk2(b[0], b[1]); w.w = pk2(b[2], b[3]); return w; }
DI void unpk8(u32x4 w, f32x4& a, f32x4& b) { a[0] = bflo(w.x); a[1] = bfhi(w.x); a[2] = bflo(w.y); a[3] = bfhi(w.y); b[0] = bflo(w.z); b[1] = bfhi(w.z); b[2] = bflo(w.w); b[3] = bfhi(w.w); }

constexpr size_t KiB = 1024, MiB = 1u << 20;
constexpr size_t WS_CTL = 0;
constexpr size_t WS_SSQ = 64 * KiB;
constexpr int SSQ_X = 0  , SSQ_1 = 5  , SSQ_Q = 9  , SSQ_KV = 11  ;
constexpr size_t ZERO_BYTES = 64 * KiB;
constexpr size_t WS_GW8 = 1792 * KiB;
constexpr size_t WS_WMIX = 2 * MiB;
constexpr size_t WS_WPLE = 23 * MiB;
constexpr size_t WS_XBA = 26 * MiB;
constexpr size_t WS_BIG = 58 * MiB;
constexpr size_t WS_CS = WS_BIG + 192 * MiB, WS_SN = WS_CS + 1 * MiB, WS_IG = WS_SN + 1 * MiB, WS_LF = WS_IG + 256 * KiB;
constexpr size_t WS_END = 256 * MiB;
static_assert(WS_LF + 256 * KiB <= WS_END, "ws map");
constexpr size_t WM_IN = 0, WM_QB = 4 * MiB, WM_KVB = 6 * MiB, WM_OUT_MLA = 8 * MiB, WM_OUT_CONV = 8 * MiB, WM_OUT_LSTM = 16 * MiB;
constexpr size_t A_SZ = 0, A_Q = 32 * MiB, A_KN = 80 * MiB, A_VT = 112 * MiB, A_CQ = 144 * MiB, A_CKV = 156 * MiB, A_KR = 164 * MiB, A_XBB = 32 * MiB, A_PP = 80 * MiB, A_PB = 166 * MiB;
constexpr size_t C_CH = 0, C_BZ = 32 * MiB, C_XBB = 64 * MiB, C_PP = 96 * MiB, C_PB = 166 * MiB;
constexpr size_t L_Q = 0, L_K = 32 * MiB, L_VT = 64 * MiB, L_OG = 128 * MiB, L_XBB = 0, L_PP = 64 * MiB;

struct Args { const float* in[19]; float* out; unsigned char* ws; int ph_lo, ph_hi; };
enum { I_X = 0, I_P, I_POS, I_NORMG, I_MLA_WIN, I_MLA_QN, I_MLA_WQB, I_MLA_KVN, I_MLA_WKVB, I_MLA_WOUT, I_CONV_WIN, I_CONV_W, I_CONV_WOUT, I_L_WIN, I_L_BG, I_L_WOUT, I_PLE_PROJ, I_PLE_GATE, I_FNORM };

#ifndef WT_STORES
#define WT_STORES 0
#endif
typedef unsigned long long u64_;
DI void gst16(const void* base, void* p, const u32x4 v) {
    if (WT_STORES) __builtin_amdgcn_raw_buffer_store_b128(v, __builtin_amdgcn_make_buffer_rsrc((void*)base, 0, 0xFFFFFFFFu, 0x00020000), (unsigned)((const char*)p - (const char*)base), 0, 16);
    else *(GAS u32x4*)p = v; }
DI void gst8(void* p, u64_ v) { if (WT_STORES) __hip_atomic_store((GAS u64_*)p, v, __ATOMIC_RELAXED, __HIP_MEMORY_SCOPE_AGENT); else *(GAS u64_*)p = v; }
DI void gst4(void* p, unsigned v) { if (WT_STORES) __hip_atomic_store((GAS unsigned*)p, v, __ATOMIC_RELAXED, __HIP_MEMORY_SCOPE_AGENT); else *(GAS unsigned*)p = v; }
DI void gst4f(float* p, float v) { gst4(p, __builtin_bit_cast(unsigned, v)); }
#ifndef NT_INPUTS
#define NT_INPUTS 1
#endif
#define NTLD(ptr) (NT_INPUTS ? __builtin_nontemporal_load(ptr) : *(ptr))
enum { PM_ID = 0, PM_MLA_IN, PM_MLA_QB, PM_MLA_KVB, PM_CONV_IN, PM_LSTM_IN };
DI int prep_src(int mode, int n, float& sc) {
    sc = 1.f;
    switch (mode) {
    case PM_MLA_IN: { if (n < 1024) return 672 + n; if (n < 1408) return n - 1024; if (n < 1664) return 384 + (n - 1408); if (n < 1696) { const int jj = n - 1664; return 640 + (jj >> 1) + 16 * (jj & 1); } return -1; }
    case PM_MLA_QB: { sc = 0.10206207261596577f * LOG2E; const int hd = n / 96, d = n % 96; if (d < 64) return n; const int jj = d - 64; return 96 * hd + 64 + (jj >> 1) + 16 * (jj & 1); }
    case PM_MLA_KVB: { if (n < 1024) return 128 * (n >> 6) + (n & 63); const int n2 = n - 1024; return 128 * (n2 >> 6) + 64 + (n2 & 63); }
    case PM_CONV_IN: { const int pn = n >> 8, bj = (n >> 7) & 1, i = n & 127; if (pn < 8) return (bj ? 2048 : 1024) + 128 * pn + i; return (bj ? 3072 : 0) + 128 * (pn - 8) + i; }
    case PM_LSTM_IN: { if (n < 4096) { if (n >= 1024 && n < 2048) sc = 0.0625f; return n; } const int n2 = n - 4096, pn = n2 >> 8, bj = (n2 >> 7) & 1, i = n2 & 127; return (bj ? 6144 : 4096) + 128 * pn + i; }
    default: return n;
    }
}
struct PrepTask { const float* W; int ldw; const float* gk; int K, Nst, mode; bf16_t* out; };
DI void prep_tile(const PrepTask& t, int tile, LAS float* scr) {
    const int tid = tidx(), nkb = t.K >> 7, nb = tile / nkb, kb = tile % nkb, n0 = nb << 6, k0 = kb << 7;
    const int nn = tid & 63, kq = tid >> 6;
    float sc; const int src = prep_src(t.mode, n0 + nn, sc);
    float v[16];
#pragma unroll
    for (int i = 0; i < 16; ++i) { const int kk = kq + 8 * i; v[i] = (src >= 0) ? t.W[(size_t)(k0 + kk) * t.ldw + src] : 0.f; }
#pragma unroll
    for (int i = 0; i < 16; ++i) { const int kk = kq + 8 * i; float x = v[i] * sc; if (t.gk) x *= t.gk[k0 + kk]; scr[nn * 129 + kk] = x; }
    __syncthreads();
#pragma unroll
    for (int h2 = 0; h2 < 2; ++h2) { const int e = tid + h2 * NTHR, n2 = e >> 4, c = e & 15; const LAS float* sp = scr + n2 * 129 + 8 * c;
      u32x4 o; o.x = pk2(sp[0], sp[1]); o.y = pk2(sp[2], sp[3]); o.z = pk2(sp[4], sp[5]); o.w = pk2(sp[6], sp[7]);
      gst16(t.out, t.out + (size_t)(n0 + n2) * t.K + k0 + 8 * c, o); }
    __syncthreads();
}
DI void prep_load(const PrepTask& t, int tile, float (&v)[16], float (&g)[16]) {
    const int tid = tidx(), nkb = t.K >> 7, nb = tile / nkb, kb = tile % nkb, n0 = nb << 6, k0 = kb << 7;
    const int nn = tid & 63, kq = tid >> 6;
    float sc; const int src = prep_src(t.mode, n0 + nn, sc);
#pragma unroll
    for (int i = 0; i < 16; ++i) { const int kk = kq + 8 * i; v[i] = (src >= 0) ? NTLD(t.W + (size_t)(k0 + kk) * t.ldw + src) : 0.f; }
#pragma unroll
    for (int i = 0; i < 16; ++i) { const int kk = kq + 8 * i; g[i] = t.gk ? t.gk[k0 + kk] * sc : sc; }
}
DI void prep_store(const PrepTask& t, int tile, const float (&v)[16], const float (&g)[16], LAS float* scr) {
    const int tid = tidx(), nkb = t.K >> 7, nb = tile / nkb, kb = tile % nkb, n0 = nb << 6, k0 = kb << 7;
    const int nn = tid & 63, kq = tid >> 6;
#pragma unroll
    for (int i = 0; i < 16; ++i) { const int kk = kq + 8 * i; scr[nn * 129 + kk] = v[i] * g[i]; }
    __syncthreads();
#pragma unroll
    for (int h2 = 0; h2 < 2; ++h2) { const int e = tid + h2 * NTHR, n2 = e >> 4, c = e & 15; const LAS float* sp = scr + n2 * 129 + 8 * c;
      u32x4 o; o.x = pk2(sp[0], sp[1]); o.y = pk2(sp[2], sp[3]); o.z = pk2(sp[4], sp[5]); o.w = pk2(sp[6], sp[7]);
      gst16(t.out, t.out + (size_t)(n0 + n2) * t.K + k0 + 8 * c, o); }
    __syncthreads();
}
#ifndef PREP_BATCH
#define PREP_BATCH 3
#endif
template <class Sel> DI void prep_batched(const Sel& sel, int total, int cu, int G, LAS float* scr) {
#pragma unroll 1
    for (int it0 = cu; it0 < total; it0 += PREP_BATCH * G) {
        float v[PREP_BATCH][16], g[PREP_BATCH][16];
#pragma unroll
        for (int b = 0; b < PREP_BATCH; ++b) { const int it = it0 + b * G;
            if (it < total) sel(it, [&](const PrepTask& t, int tl) { prep_load(t, tl, v[b], g[b]); });
            else {
#pragma unroll
                for (int i = 0; i < 16; ++i) { v[b][i] = 0.f; g[b][i] = 0.f; } } }
#pragma unroll
        for (int b = 0; b < PREP_BATCH; ++b) { const int it = it0 + b * G;
            if (it < total) sel(it, [&](const PrepTask& t, int tl) { prep_store(t, tl, v[b], g[b], scr); }); }
    }
}
DI void prep_run1(const PrepTask& t, LAS float* scr, int cu, int G) {
    const int total = (t.Nst >> 6) * (t.K >> 7);
#pragma unroll 1
    for (int it = cu; it < total; it += G) prep_tile(t, it, scr);
}

DI float wave_sum(float v) {
#pragma unroll
    for (int o = 1; o < 64; o <<= 1) v += __shfl_xor(v, o);
    return v;
}
#ifndef ROWS_IF
#define ROWS_IF 8
#endif
DI void rows_to_bf16_ssq(const float* x, bf16_t* xb, unsigned long long* ssq, int gw, int NGW, int lane) {
    for (int m0 = gw; m0 < M; m0 += ROWS_IF * NGW) {
        f32x4 v[ROWS_IF][4];
#pragma unroll
        for (int r = 0; r < ROWS_IF; ++r) { const int m = m0 + r * NGW; const f32x4* xr = (const f32x4*)(x + (size_t)(m < M ? m : m0) * D) + 2 * lane;
#pragma unroll
            for (int j = 0; j < 2; ++j) { v[r][2 * j] = NTLD(xr + 128 * j); v[r][2 * j + 1] = NTLD(xr + 128 * j + 1); } }
#pragma unroll
        for (int r = 0; r < ROWS_IF; ++r) { const int m = m0 + r * NGW; if (m < M) {
            float s = 0.f; u32x4* o16 = (u32x4*)(xb + (size_t)m * D) + lane;
#pragma unroll
            for (int j = 0; j < 4; ++j) s += (v[r][j][0] * v[r][j][0] + v[r][j][1] * v[r][j][1]) + (v[r][j][2] * v[r][j][2] + v[r][j][3] * v[r][j][3]);
#pragma unroll
            for (int j = 0; j < 2; ++j) gst16(xb, o16 + 64 * j, pk8(v[r][2 * j], v[r][2 * j + 1]));
            s = wave_sum(s); if (lane == 0) gst8(ssq + m, (unsigned long long)(s * 16777216.f)); } }
    }
}
DI void p_to_bf16(const float* p, bf16_t* pb, int gt, int NGT) {
    constexpr size_t N8 = (size_t)M * 256 / 8;
    for (size_t i = gt; i < N8; i += (size_t)4 * NGT) {
        f32x4 a[4], b[4];
#pragma unroll
        for (int k = 0; k < 4; ++k) { const size_t e = i + (size_t)k * NGT; if (e < N8) { a[k] = NTLD((const f32x4*)p + 2 * e); b[k] = NTLD((const f32x4*)p + 2 * e + 1); } }
#pragma unroll
        for (int k = 0; k < 4; ++k) { const size_t e = i + (size_t)k * NGT; if (e < N8) gst16(pb, (u32x4*)pb + e, pk8(a[k], b[k])); }
    }
}
DI void rope_tables(const int* pos, float* cs, float* sn, int gt, int NGT) {
    const int jq = gt & 3;
    const float d4 = jq == 0 ? 1.0f : jq == 1 ? 0.1f : jq == 2 ? 0.01f : 0.001f;
    f32x4 inv;
    inv[0] = (float)((double)1.0f * (double)d4); inv[1] = (float)((double)0.5623413251903491f * (double)d4); inv[2] = (float)((double)0.31622776601683794f * (double)d4); inv[3] = (float)((double)0.17782794100389228f * (double)d4);
    for (int i4 = gt; i4 < M * 4; i4 += NGT) {
        const int t = i4 >> 2; const float pf = (float)pos[t]; f32x4 c, s_;
#pragma unroll
        for (int k = 0; k < 4; ++k) { const float ang = pf * inv[k]; double rev = (double)ang * 0.15915494309189533577; rev -= rint(rev); const float fr = (float)rev; c[k] = __builtin_amdgcn_cosf(fr); s_[k] = __builtin_amdgcn_sinf(fr); }
        gst16(cs, cs + (size_t)i4 * 4, __builtin_bit_cast(u32x4, c)); gst16(sn, sn + (size_t)i4 * 4, __builtin_bit_cast(u32x4, s_));
    }
}

#define EPI_ROW(u, ai, m) ((u).pm * 256 + (ai) * 128 + wr * 64 + (m) * 16 + fr)
#define EPI_LOOP_AM _Pragma("unroll") for (int ai = 0; ai < 2; ++ai) _Pragma("unroll") for (int m = 0; m < 4; ++m)
typedef const f32x4 (&AccRef)[2][2][4][2];
#ifndef NT_STORES
#define NT_STORES 0
#endif
#ifndef SC1_STORES
#define SC1_STORES 0
#endif
DI void st16(const void* base, bf16_t* p, const u32x4& v) {
    if (SC1_STORES || WT_STORES) __builtin_amdgcn_raw_buffer_store_b128(v, __builtin_amdgcn_make_buffer_rsrc((void*)base, 0, 0xFFFFFFFFu, 0x00020000), (unsigned)((const char*)p - (const char*)base), 0, 16);
    else if (NT_STORES) __builtin_nontemporal_store(v, (u32x4*)p);
    else { const unsigned bo = (unsigned)((const char*)p - (const char*)base); *(GAS u32x4*)((GAS char*)base + bo) = v; } }
#ifndef NT_OUT
#define NT_OUT 0
#endif
#ifndef NT_ONCE
#define NT_ONCE 2
#endif
DI u32x4 ld16(const void* base, const bf16_t* p) { const unsigned bo = (unsigned)((const char*)p - (const char*)base);
    return (NT_ONCE & 1) ? __builtin_nontemporal_load((const GAS u32x4*)((const GAS char*)base + bo)) : *(const GAS u32x4*)((const GAS char*)base + bo); }
DI float sq8(const f32x4& a, const f32x4& b) { return (a[0] * a[0] + a[1] * a[1]) + (a[2] * a[2] + a[3] * a[3]) + (b[0] * b[0] + b[1] * b[1]) + (b[2] * b[2] + b[3] * b[3]); }
DI float red_fq(float s) { s += __shfl_xor(s, 16); s += __shfl_xor(s, 32); return s; }
DI void rope8(f32x4& a, f32x4& b, const float* cs, const float* sn, int row, int p0) {
    const f32x4 c = *(const GAS f32x4*)(cs + (size_t)row * 16 + p0), s = *(const GAS f32x4*)(sn + (size_t)row * 16 + p0);
    const f32x4 a0 = a, b0 = b;
    a[0] = a0[0] * c[0] - a0[1] * s[0]; a[1] = a0[0] * s[0] + a0[1] * c[0];
    a[2] = a0[2] * c[1] - a0[3] * s[1]; a[3] = a0[2] * s[1] + a0[3] * c[1];
    b[0] = b0[0] * c[2] - b0[1] * s[2]; b[1] = b0[0] * s[2] + b0[1] * c[2];
    b[2] = b0[2] * c[3] - b0[3] * s[3]; b[3] = b0[2] * s[3] + b0[3] * c[3];
}

DI int opaque(int v) { asm volatile("" : "+s"(v)); return v; }
template <class T> DI T* launder(T* p) { asm volatile("" : "+s"(p)); return p; }
typedef unsigned long long u64;
constexpr float SSQ_SCALE = 16777216.f, SSQ_INV = 1.f / 16777216.f;
DI u64* ssq_arr(unsigned char* ws, int idx) { return (u64*)(ws + WS_SSQ) + (size_t)idx * M; }
DI void ssq_add(u64* p, float s) { (void)__hip_atomic_fetch_add((GAS u64*)p, (u64)(s * SSQ_SCALE), __ATOMIC_RELAXED, __HIP_MEMORY_SCOPE_AGENT); }
DI float ssq_rstd(const u64* p, float invn) { return rsqrtf((float)(*p) * SSQ_INV * invn + EPS); }

#define EPI_RS8(rsarr, ssqp, invn) float rsarr[2][4]; { u64 t_[2][4]; _Pragma("unroll") for (int ai = 0; ai < 2; ++ai) _Pragma("unroll") for (int m = 0; m < 4; ++m) t_[ai][m] = ((const GAS u64*)(ssqp))[EPI_ROW(u, ai, m)]; \
    _Pragma("unroll") for (int ai = 0; ai < 2; ++ai) _Pragma("unroll") for (int m = 0; m < 4; ++m) rsarr[ai][m] = rsqrtf((float)t_[ai][m] * SSQ_INV * (invn) + EPS); }

struct EpiA1 {
    static constexpr bool PERM = true, AFTER_DRAIN = false;
    unsigned char* ws; int i, j;
    DI void operator()(AccRef acc, const Unit& u, int wr, int wc, int fr, int fq) const {
        unsigned char* w = launder(ws); unsigned char* big = w + WS_BIG;
        const u64* ssq_x = ssq_arr(w, SSQ_X + i); u64* ssq_q = ssq_arr(w, SSQ_Q + j); u64* ssq_kv = ssq_arr(w, SSQ_KV + j);
        bf16_t *SZ = (bf16_t*)(big + A_SZ), *CQ = (bf16_t*)(big + A_CQ), *CKV = (bf16_t*)(big + A_CKV), *KR = (bf16_t*)(big + A_KR);
        const float *CS = (const float*)(w + WS_CS), *SN = (const float*)(w + WS_SN);
        EPI_RS8(rsv, ssq_x, 1.f / 1024.f);
        EPI_LOOP_AM {
            const int row = EPI_ROW(u, ai, m); const float rs = rsv[ai][m];
            float sq = 0.f, skv = 0.f; bool hq = false, hkv = false;
#pragma unroll
            for (int bj = 0; bj < 2; ++bj) {
                f32x4 v0 = acc[ai][bj][m][0] * rs, v1 = acc[ai][bj][m][1] * rs;
                if (u.pn < 4) {
                    const int col = u.pn * 256 + bj * 128 + wc * 32 + 8 * fq;
#pragma unroll
                    for (int jj = 0; jj < 4; ++jj) { v0[jj] = silu(v0[jj]); v1[jj] = silu(v1[jj]); }
                    st16(w, SZ + (size_t)row * 1024 + col, pk8(v0, v1));
                } else {
                    const int c = (u.pn - 4) * 256 + bj * 128 + wc * 32 + 8 * fq;
                    if (c < 384) { st16(w, CQ + (size_t)row * 384 + c, pk8(v0, v1)); sq += sq8(v0, v1); hq = true; }
                    else if (c < 640) { st16(w, CKV + (size_t)row * 256 + (c - 384), pk8(v0, v1)); skv += sq8(v0, v1); hkv = true; }
                    else if (c < 672) { const int jj0 = c - 640; rope8(v0, v1, CS, SN, row, jj0 >> 1); st16(w, KR + (size_t)row * 32 + jj0, pk8(v0, v1)); }
                }
            }
            if (u.pn >= 4) {
                sq = red_fq(sq); skv = red_fq(skv);
                if (fq == 0 && hq) ssq_add(ssq_q + row, sq);
                if (fq == 0 && hkv) ssq_add(ssq_kv + row, skv);
            }
        }
    }
};
struct EpiQ {
    static constexpr bool PERM = true, AFTER_DRAIN = false;
    unsigned char* ws; int j;
    DI void operator()(AccRef acc, const Unit& u, int wr, int wc, int fr, int fq) const {
        unsigned char* w = launder(ws); const u64* ssq_q = ssq_arr(w, SSQ_Q + j); bf16_t* Q = (bf16_t*)(w + WS_BIG + A_Q);
        const float *CS = (const float*)(w + WS_CS), *SN = (const float*)(w + WS_SN);
        EPI_RS8(rsv, ssq_q, 1.f / 384.f);
        EPI_LOOP_AM {
            const int row = EPI_ROW(u, ai, m); const float rs = rsv[ai][m];
#pragma unroll
            for (int bj = 0; bj < 2; ++bj) {
                const int col = u.pn * 256 + bj * 128 + wc * 32 + 8 * fq, d = col % 96;
                f32x4 v0 = acc[ai][bj][m][0] * rs, v1 = acc[ai][bj][m][1] * rs;
                if (d >= 64) rope8(v0, v1, CS, SN, row, (d - 64) >> 1);
                st16(w, Q + (size_t)row * 1536 + col, pk8(v0, v1));
            }
        }
    }
};
struct EpiKV {
    static constexpr bool PERM = true, AFTER_DRAIN = false;
    unsigned char* ws; int j;
    DI void operator()(AccRef acc, const Unit& u, int wr, int wc, int fr, int fq) const {
        unsigned char* w = launder(ws); const u64* ssq_kv = ssq_arr(w, SSQ_KV + j); bf16_t* O = (bf16_t*)(w + WS_BIG + (u.pn < 4 ? A_KN : A_VT));
        EPI_RS8(rsv, ssq_kv, 1.f / 256.f);
        EPI_LOOP_AM {
            const int row = EPI_ROW(u, ai, m); const float rs = rsv[ai][m];
#pragma unroll
            for (int bj = 0; bj < 2; ++bj) {
                const int col = (u.pn & 3) * 256 + bj * 128 + wc * 32 + 8 * fq;
                st16(w, O + (size_t)row * 1024 + col, pk8(acc[ai][bj][m][0] * rs, acc[ai][bj][m][1] * rs));
            }
        }
    }
};
struct EpiOut {
    static constexpr bool PERM = true, AFTER_DRAIN = false;
    unsigned char* ws; size_t xbb_off; int i;
    DI void operator()(AccRef acc, const Unit& u, int wr, int wc, int fr, int fq) const {
        unsigned char* w = launder(ws); u64* ssq = ssq_arr(w, SSQ_1 + i); bf16_t* XB = (bf16_t*)(w + WS_BIG + xbb_off); const bf16_t* xin = (const bf16_t*)(w + WS_XBA);
        const size_t cb = (size_t)u.pn * 256 + wc * 32 + 8 * fq;
        u32x4 cur[2], nxt[2];
#define EO_LOAD(dst, it) do { const size_t o_ = (size_t)EPI_ROW(u, (it) >> 2, (it) & 3) * 1024 + cb; dst[0] = ld16(w, xin + o_); dst[1] = ld16(w, xin + o_ + 128); } while (0)
        EO_LOAD(cur, 0);
#pragma unroll
        for (int it = 0; it < 8; ++it) {
            const int ai = it >> 2, m = it & 3;
            if (it < 7) EO_LOAD(nxt, it + 1);
            const int row = EPI_ROW(u, ai, m); float sq = 0.f;
#pragma unroll
            for (int bj = 0; bj < 2; ++bj) {
                const size_t off = (size_t)row * 1024 + cb + bj * 128;
                f32x4 x0, x1; unpk8(cur[bj], x0, x1);
                const f32x4 y0 = x0 + acc[ai][bj][m][0], y1 = x1 + acc[ai][bj][m][1];
                st16(w, XB + off, pk8(y0, y1)); sq += sq8(y0, y1);
            }
            sq = red_fq(sq); if (fq == 0) ssq_add(ssq + row, sq);
            cur[0] = nxt[0]; cur[1] = nxt[1];
        }
#undef EO_LOAD
    }
};
struct EpiPP {
    static constexpr bool PERM = true, AFTER_DRAIN = false;
    bf16_t* pp;
    DI void operator()(AccRef acc, const Unit& u, int wr, int wc, int fr, int fq) const {
        bf16_t* PP = launder(pp);
        EPI_LOOP_AM { const int row = EPI_ROW(u, ai, m);
#pragma unroll
            for (int bj = 0; bj < 2; ++bj) { const size_t off = (size_t)row * 1024 + u.pn * 256 + bj * 128 + wc * 32 + 8 * fq; st16(PP, PP + off, pk8(acc[ai][bj][m][0], acc[ai][bj][m][1])); } }
    }
};
struct EpiPle {
    static constexpr bool PERM = true, AFTER_DRAIN = false;
    unsigned char* ws; const bf16_t* pp; size_t xbb_off; int i;
    DI void operator()(AccRef acc, const Unit& u, int wr, int wc, int fr, int fq) const {
        unsigned char* w = launder(ws); const u64* ssq1 = ssq_arr(w, SSQ_1 + i); u64* ssq = ssq_arr(w, SSQ_X + i + 1);
        const bf16_t* PP = launder(pp); const bf16_t* X1 = (const bf16_t*)(w + WS_BIG + xbb_off); bf16_t* XB = (bf16_t*)(w + WS_XBA);
        const size_t cb = (size_t)u.pn * 256 + wc * 32 + 8 * fq;
        EPI_RS8(rsv, ssq1, 1.f / 1024.f);
        u32x4 cur[2], nxt[2], pc[2], pn2[2];
#define EP_LOAD(dst, pd, it) do { const size_t o_ = (size_t)EPI_ROW(u, (it) >> 2, (it) & 3) * 1024 + cb; dst[0] = ld16(w, X1 + o_); dst[1] = ld16(w, X1 + o_ + 128); \
            pd[0] = ld16(PP, PP + o_); pd[1] = ld16(PP, PP + o_ + 128); } while (0)
        EP_LOAD(cur, pc, 0);
#pragma unroll
        for (int it = 0; it < 8; ++it) {
            const int ai = it >> 2, m = it & 3;
            if (it < 7) EP_LOAD(nxt, pn2, it + 1);
            const int row = EPI_ROW(u, ai, m); const float rsl = rsv[ai][m] * -LOG2E; float sq = 0.f;
#pragma unroll
            for (int bj = 0; bj < 2; ++bj) {
                const size_t off = (size_t)row * 1024 + cb + bj * 128;
                f32x4 p0, p1, y0, y1; unpk8(pc[bj], p0, p1); unpk8(cur[bj], y0, y1);
#pragma unroll
                for (int jj = 0; jj < 4; ++jj) { y0[jj] += sigm_s(acc[ai][bj][m][0][jj] * rsl) * p0[jj]; y1[jj] += sigm_s(acc[ai][bj][m][1][jj] * rsl) * p1[jj]; }
                st16(w, XB + off, pk8(y0, y1)); sq += sq8(y0, y1);
            }
            sq = red_fq(sq); if (fq == 0) ssq_add(ssq + row, sq);
#pragma unroll
            for (int bj = 0; bj < 2; ++bj) { cur[bj] = nxt[bj]; pc[bj] = pn2[bj]; }
        }
#undef EP_LOAD
    }
};
struct EpiPleLast {
    static constexpr bool PERM = true, AFTER_DRAIN = true;
    unsigned char* ws; float* out; const float* gfin; const bf16_t* pp; size_t xbb_off; int i; unsigned xcc; volatile LAS unsigned* st;
    DI void fused(f32x4 (&acc)[2][2][4][2], const Unit& u, int wr, int wc, int fr, int fq, LAS unsigned char* lds, int wid, int lane) const {
        unsigned char* w = launder(ws); const u64* ssq1 = ssq_arr(w, SSQ_1 + i); u64* ssq = ssq_arr(w, SSQ_X + i + 1);
        const bf16_t* PP = launder(pp); const bf16_t* X1 = (const bf16_t*)(w + WS_BIG + xbb_off);
        const size_t cb = (size_t)u.pn * 256 + wc * 32 + 8 * fq;
        {
            EPI_RS8(rsv, ssq1, 1.f / 1024.f);
#pragma unroll
            for (int it = 0; it < 8; ++it) {
                const int ai = it >> 2, m = it & 3; const int row = EPI_ROW(u, ai, m); const float rsl = rsv[ai][m] * -LOG2E; float sq = 0.f;
#pragma unroll
                for (int bj = 0; bj < 2; ++bj) {
                    const size_t off = (size_t)row * 1024 + cb + bj * 128;
                    f32x4 p0, p1, y0, y1; unpk8(ld16(PP, PP + off), p0, p1); unpk8(ld16(w, X1 + off), y0, y1);
#pragma unroll
                    for (int jj = 0; jj < 4; ++jj) { y0[jj] += sigm_s(acc[ai][bj][m][0][jj] * rsl) * p0[jj]; y1[jj] += sigm_s(acc[ai][bj][m][1][jj] * rsl) * p1[jj]; }
                    acc[ai][bj][m][0] = y0; acc[ai][bj][m][1] = y1; sq += sq8(y0, y1);
                }
                sq = red_fq(sq); if (fq == 0) ssq_add(ssq + row, sq);
            }
        }
        { XcdBarrier b; b.bar = (unsigned*)(launder(ws) + WS_CTL); b.x = xcc; b.st = st; xcd_barrier(b); }
        {
            const u64* ssqf = ssq_arr(launder(ws), SSQ_X + i + 1);
            EPI_RS8(rsf, ssqf, 1.f / 1024.f);
#pragma unroll
            for (int bj = 0; bj < 2; ++bj) {
                const f32x4 g0 = *(const GAS f32x4*)(gfin + cb + bj * 128), g1 = *(const GAS f32x4*)(gfin + cb + bj * 128 + 4);
                EPI_LOOP_AM { const size_t off = (size_t)EPI_ROW(u, ai, m) * 1024 + cb + bj * 128; const float rs = rsf[ai][m];
                    if (NT_OUT) { __builtin_nontemporal_store(acc[ai][bj][m][0] * rs * g0, (GAS f32x4*)(out + off)); __builtin_nontemporal_store(acc[ai][bj][m][1] * rs * g1, (GAS f32x4*)(out + off + 4)); }
                    else { *(GAS f32x4*)(out + off) = acc[ai][bj][m][0] * rs * g0; *(GAS f32x4*)(out + off + 4) = acc[ai][bj][m][1] * rs * g1; } }
            }
        }
    }
};
struct EpiC1 {
    static constexpr bool PERM = true, AFTER_DRAIN = false;
    unsigned char* ws; int i; int dry;
    DI void operator()(AccRef acc, const Unit& u, int wr, int wc, int fr, int fq) const {
        if (dry == 1) { asm volatile("" :: "v"(acc[0][0][0][0][0]), "v"(acc[1][1][3][1][3])); return; }
        unsigned char* w = launder(ws); const u64* ssq_x = ssq_arr(w, SSQ_X + i); bf16_t *CH = (bf16_t*)(w + WS_BIG + C_CH), *BZ = (bf16_t*)(w + WS_BIG + C_BZ);
        float rsv[2][4];
        if (dry == 4) { EPI_LOOP_AM rsv[ai][m] = 1.f; } else { EPI_RS8(rsl_, ssq_x, 1.f / 1024.f); EPI_LOOP_AM rsv[ai][m] = rsl_[ai][m]; }
        EPI_LOOP_AM {
            const int row = EPI_ROW(u, ai, m); const float rs = rsv[ai][m];
            const size_t off = (size_t)row * 1024 + (u.pn & 7) * 128 + wc * 32 + 8 * fq;
            f32x4 r0, r1;
            if (u.pn < 8) { r0 = (acc[ai][0][m][0] * rs) * (acc[ai][1][m][0] * rs); r1 = (acc[ai][0][m][1] * rs) * (acc[ai][1][m][1] * rs); { const u32x4 o_ = pk8(r0, r1); if (dry == 2) asm volatile("" :: "v"(o_)); else if (dry == 3) { const int blk = ((wr * 2 + ai) * 4 + m) * 4 + wc, ln = fr + 16 * fq; st16(w, CH + (size_t)(u.pm * 256 + (blk >> 1) * 8 + (ln >> 3)) * 1024 + (u.pn & 7) * 128 + (blk & 1) * 64 + (ln & 7) * 8, o_); } else st16(w, CH + off, o_); } }
            else {
#pragma unroll
                for (int jj = 0; jj < 4; ++jj) { r0[jj] = (acc[ai][0][m][0][jj] * rs) * silu(acc[ai][1][m][0][jj] * rs); r1[jj] = (acc[ai][0][m][1][jj] * rs) * silu(acc[ai][1][m][1][jj] * rs); }
                { const u32x4 o_ = pk8(r0, r1); if (dry == 2) asm volatile("" :: "v"(o_)); else if (dry == 3) { const int blk = ((wr * 2 + ai) * 4 + m) * 4 + wc, ln = fr + 16 * fq; st16(w, BZ + (size_t)(u.pm * 256 + (blk >> 1) * 8 + (ln >> 3)) * 1024 + (u.pn & 7) * 128 + (blk & 1) * 64 + (ln & 7) * 8, o_); } else st16(w, BZ + off, o_); }
            }
        }
    }
};
struct EpiL1 {
    static constexpr bool PERM = true, AFTER_DRAIN = false;
    unsigned char* ws; int i;
    DI void operator()(AccRef acc, const Unit& u, int wr, int wc, int fr, int fq) const {
        unsigned char* w = launder(ws); const u64* ssq_x = ssq_arr(w, SSQ_X + i); unsigned char* big = w + WS_BIG;
        EPI_RS8(rsv, ssq_x, 1.f / 1024.f);
        if (u.pn < 16) {
            bf16_t* O; int ld, c0;
            if (u.pn < 4) { O = (bf16_t*)(big + L_Q); ld = 1024; c0 = u.pn * 256; } else if (u.pn < 8) { O = (bf16_t*)(big + L_K); ld = 1024; c0 = (u.pn - 4) * 256; } else { O = (bf16_t*)(big + L_VT); ld = 2048; c0 = (u.pn - 8) * 256; }
            EPI_LOOP_AM {
                const int row = EPI_ROW(u, ai, m); const float rs = rsv[ai][m];
#pragma unroll
                for (int bj = 0; bj < 2; ++bj) st16(w, O + (size_t)row * ld + c0 + bj * 128 + wc * 32 + 8 * fq, pk8(acc[ai][bj][m][0] * rs, acc[ai][bj][m][1] * rs));
            }
        } else {
            bf16_t* OG = (bf16_t*)(big + L_OG);
            EPI_LOOP_AM {
                const int row = EPI_ROW(u, ai, m); const float rs = rsv[ai][m];
                const size_t off = (size_t)row * 2048 + (u.pn - 16) * 128 + wc * 32 + 8 * fq; f32x4 r0, r1;
#pragma unroll
                for (int jj = 0; jj < 4; ++jj) { r0[jj] = sigm_silu(acc[ai][0][m][0][jj] * rs, acc[ai][1][m][0][jj] * rs); r1[jj] = sigm_silu(acc[ai][0][m][1][jj] * rs, acc[ai][1][m][1][jj] * rs); }
                st16(w, OG + off, pk8(r0, r1));
            }
        }
    }
};
#ifndef QFUSE
#define QFUSE 0
#endif
constexpr int AT_WQS = 784  , AT_WQOFF = 2 * 64 * 208 + 2 * 64 * 192;
constexpr int AT_KSTR = 208, AT_VSTR = 192, AT_KB = 64 * AT_KSTR, AT_VB = 64 * AT_VSTR;
#define MFMA32(a, b, c) __builtin_amdgcn_mfma_f32_32x32x16_bf16((a), (b), (c), 0, 0, 0)
#define MFMA16(a, b, c) __builtin_amdgcn_mfma_f32_16x16x32_bf16((a), (b), (c), 0, 0, 0)
DI float max3f(float a, float b, float c) { float r; asm("v_max3_f32 %0, %1, %2, %3" : "=v"(r) : "v"(a), "v"(b), "v"(c)); return r; }
DI bf16x8 cat4(s16x4 lo, s16x4 hi) { return __builtin_shufflevector(lo, hi, 0, 1, 2, 3, 4, 5, 6, 7); }

struct AttnT { const bf16_t *Q, *KN, *KR, *VT; bf16_t* SZOG; const bf16_t *CQ, *WQ; const u64* ssq_q; const float *CS, *SN; };
#ifndef AT_XCDMAP
#define AT_XCDMAP 0
#endif
#ifndef DIAG_NOLOAD
#define DIAG_NOLOAD 0
#endif
#ifndef AT_ORD0
#define AT_ORD0 0x3407
#define AT_ORD1 0x2516
#endif
struct AttnStage { u32x4 k, r, v; };
DI void attn_unit(LAS unsigned char* lds, const AttnT& T, int b, int h, int qb, int dry) {
    const int tid = tidx(), w = __builtin_amdgcn_readfirstlane(tid >> 6), lane = tid & 63, r = lane & 31, hh = lane >> 5;
    const int tok0 = b * S, row0 = tok0 + qb * 256 + 32 * w;
    bf16x8 qf[6];
#if QFUSE
    {
        f32x16 qT[3];
#pragma unroll
        for (int db = 0; db < 3; ++db)
#pragma unroll
            for (int i = 0; i < 16; ++i) qT[db][i] = 0.f;
        const bf16_t* cqp = T.CQ + (size_t)(row0 + r) * 384 + 8 * hh;
        bf16x8 cf[24];
#pragma unroll
        for (int ks = 0; ks < 24; ++ks) cf[ks] = *(const bf16x8*)(cqp + 16 * ks);
        const LAS unsigned char* wl = lds + AT_WQOFF + r * AT_WQS + 16 * hh;
#pragma unroll
        for (int ks = 0; ks < 24; ++ks) {
            const bf16x8 w0 = *(const LAS bf16x8*)(wl + 32 * ks), w1 = *(const LAS bf16x8*)(wl + 32 * AT_WQS + 32 * ks), w2 = *(const LAS bf16x8*)(wl + 64 * AT_WQS + 32 * ks);
            qT[0] = MFMA32(w0, cf[ks], qT[0]); qT[1] = MFMA32(w1, cf[ks], qT[1]); qT[2] = MFMA32(w2, cf[ks], qT[2]);
        }
        const float rsq = ssq_rstd(T.ssq_q + row0 + r, 1.f / 384.f);
#pragma unroll
        for (int db = 0; db < 3; ++db)
#pragma unroll
            for (int i = 0; i < 16; ++i) qT[db][i] *= rsq;
#pragma unroll
        for (int g4 = 0; g4 < 4; ++g4) {
            const f32x2 c2 = *(const f32x2*)(T.CS + (size_t)(row0 + r) * 16 + 4 * g4 + 2 * hh), s2 = *(const f32x2*)(T.SN + (size_t)(row0 + r) * 16 + 4 * g4 + 2 * hh);
#pragma unroll
            for (int e = 0; e < 2; ++e) { const float x1 = qT[2][4 * g4 + 2 * e], x2 = qT[2][4 * g4 + 2 * e + 1], cc = e ? c2[1] : c2[0], ss = e ? s2[1] : s2[0];
                qT[2][4 * g4 + 2 * e] = x1 * cc - x2 * ss; qT[2][4 * g4 + 2 * e + 1] = x1 * ss + x2 * cc; }
        }
#pragma unroll
        for (int db = 0; db < 3; ++db)
#pragma unroll
            for (int s2i = 0; s2i < 2; ++s2i) { u32x4 pw; pw.x = pk2(qT[db][8 * s2i + 0], qT[db][8 * s2i + 1]); pw.y = pk2(qT[db][8 * s2i + 2], qT[db][8 * s2i + 3]); pw.z = pk2(qT[db][8 * s2i + 4], qT[db][8 * s2i + 5]); pw.w = pk2(qT[db][8 * s2i + 6], qT[db][8 * s2i + 7]);
                qf[2 * db + s2i] = __builtin_bit_cast(bf16x8, pw); }
    }
#else
#pragma unroll
    for (int ks = 0; ks < 6; ++ks) qf[ks] = (NT_ONCE & 8) ? __builtin_nontemporal_load((const bf16x8*)(T.Q + (size_t)(row0 + r) * 1536 + 96 * h + 16 * ks + 8 * hh)) : *(const bf16x8*)(T.Q + (size_t)(row0 + r) * 1536 + 96 * h + 16 * ks + 8 * hh);
#endif
    f32x16 O0, O1;
#pragma unroll
    for (int i = 0; i < 16; ++i) { O0[i] = 0.f; O1[i] = 0.f; }
    float mrun = -1e30f, lrun = 0.f;
    const int ntiles = 4 * qb + 4, myvis = 4 * qb + (w >> 1);
    const int kkey = tid >> 3, kch = tid & 7, rkey = tid >> 2, rch = tid & 3;
    const bf16_t* gK = T.KN + (size_t)(tok0 + kkey) * 1024 + 64 * h + 8 * kch;
    const bf16_t* gR = T.KR + (size_t)(tok0 + rkey) * 32 + 8 * rch;
    const bf16_t* gV = T.VT + (size_t)(tok0 + kkey) * 1024 + 64 * h + 8 * kch;
    const int lK = QFUSE ? kkey * AT_KSTR + 32 * (kch >> 1) + 8 * (kch & 1) : kkey * AT_KSTR + 16 * kch, lR = QFUSE ? rkey * AT_KSTR + 128 + 32 * (rch >> 1) + 8 * (rch & 1) : rkey * AT_KSTR + 128 + 16 * rch, lV = kkey * AT_VSTR + 16 * kch;
    const int krd = r * AT_KSTR + 16 * hh;
    const int vrd = (4 * hh + ((lane & 15) >> 2)) * AT_VSTR + (16 * ((lane >> 4) & 1) + 4 * (lane & 3)) * 2;
#define AT_LOADK(st, kt) do { if (DIAG_NOLOAD && dry) break; (st).k = *(const u32x4*)(gK + (size_t)(kt) * 64 * 1024); if (tid < 256) (st).r = *(const u32x4*)(gR + (size_t)(kt) * 64 * 32); } while (0)
#define AT_LOADV(st, kt) do { if (DIAG_NOLOAD && dry) break; (st).v = *(const u32x4*)(gV + (size_t)(kt) * 64 * 1024); } while (0)
#define AT_WRITEK(st, buf) do { LAS unsigned char* kb_ = lds + (buf) * AT_KB; *(LAS u32x2*)(kb_ + lK) = (u32x2){(st).k.x, (st).k.y}; *(LAS u32x2*)(kb_ + lK + (QFUSE ? 16 : 8)) = (u32x2){(st).k.z, (st).k.w}; \
        if (tid < 256) { *(LAS u32x2*)(kb_ + lR) = (u32x2){(st).r.x, (st).r.y}; *(LAS u32x2*)(kb_ + lR + (QFUSE ? 16 : 8)) = (u32x2){(st).r.z, (st).r.w}; } } while (0)
#define AT_WRITEV(st, buf) do { *(LAS u32x4*)(lds + 2 * AT_KB + (buf) * AT_VB + lV) = (st).v; } while (0)
#define AT_QK1(sX, buf, blk) do { const LAS unsigned char* kb = lds + (buf) * AT_KB + krd + (blk) * 32 * AT_KSTR; \
        _Pragma("unroll") for (int i = 0; i < 16; ++i) sX[i] = 0.f; \
        _Pragma("unroll") for (int ks = 0; ks < 6; ++ks) sX = MFMA32(*(const LAS bf16x8*)(kb + 32 * ks), qf[ks], sX); } while (0)
#define AT_QK(sA, sB, buf) do { AT_QK1(sA, buf, 0); AT_QK1(sB, buf, 1); } while (0)
#define AT_MAX(s0, s1) \
          \
        asm volatile("s_nop 7\n\ts_nop 7\n\ts_nop 7" : "+v"(s0[0]), "+v"(s1[0])); \
        float mx = max3f(s0[0], s1[0], mrun); \
        _Pragma("unroll") for (int i = 1; i < 16; ++i) mx = max3f(mx, s0[i], s1[i]); \
        const float mnew = max3f(mx, __shfl_xor(mx, 32), mx), alpha = ex2(mrun - mnew); mrun = mnew;
#define AT_EXP(s0, s1) do { float ps = 0.f; \
        _Pragma("unroll") for (int i = 0; i < 16; ++i) { s0[i] = ex2(s0[i] - mrun); s1[i] = ex2(s1[i] - mrun); ps += s0[i] + s1[i]; } \
        lrun = lrun * alpha + ps; \
        _Pragma("unroll") for (int i = 0; i < 16; ++i) { O0[i] *= alpha; O1[i] *= alpha; } } while (0)
#define AT_PV(s0, s1, buf) do { LAS unsigned char* vb = lds + 2 * AT_KB + (buf) * AT_VB + vrd; \
        _Pragma("unroll") for (int kb2 = 0; kb2 < 2; ++kb2) _Pragma("unroll") for (int s = 0; s < 2; ++s) { \
            const f32x16& sx = kb2 ? s1 : s0; \
            u32x4 pw; pw.x = pk2(sx[8 * s + 0], sx[8 * s + 1]); pw.y = pk2(sx[8 * s + 2], sx[8 * s + 3]); pw.z = pk2(sx[8 * s + 4], sx[8 * s + 5]); pw.w = pk2(sx[8 * s + 6], sx[8 * s + 7]); \
            const bf16x8 pf = __builtin_bit_cast(bf16x8, pw); \
            LAS unsigned char* vp = vb + (32 * kb2 + 16 * s) * AT_VSTR; \
            const bf16x8 v0 = cat4(__builtin_amdgcn_ds_read_tr16_b64_v4i16((LAS s16x4*)vp), __builtin_amdgcn_ds_read_tr16_b64_v4i16((LAS s16x4*)(vp + 8 * AT_VSTR))); \
            const bf16x8 v1 = cat4(__builtin_amdgcn_ds_read_tr16_b64_v4i16((LAS s16x4*)(vp + 64)), __builtin_amdgcn_ds_read_tr16_b64_v4i16((LAS s16x4*)(vp + 64 + 8 * AT_VSTR))); \
            O0 = MFMA32(v0, pf, O0); O1 = MFMA32(v1, pf, O1); } } while (0)
#define AT_SOFTMAX_PV(s0, s1, buf) do { AT_MAX(s0, s1); AT_EXP(s0, s1); AT_PV(s0, s1, buf); } while (0)
#define AT_FUSED(c0, c1, n0, n1, bufK, bufV) do { AT_QK1(n0, bufK, 0); AT_MAX(c0, c1); __builtin_amdgcn_sched_barrier(0); \
        AT_QK1(n1, bufK, 1); AT_EXP(c0, c1); __builtin_amdgcn_sched_barrier(0); AT_PV(c0, c1, bufV); } while (0)
    AttnStage RA, RB;
    f32x16 a0, a1, b0, b1;
    AT_LOADK(RA, 0); AT_LOADV(RA, 0); AT_LOADK(RB, 1);
    AT_WRITEK(RA, 0); AT_WRITEV(RA, 0); AT_WRITEK(RB, 1);
    AT_LOADK(RA, 2); AT_LOADV(RA, 1);
    __syncthreads();
    AT_QK(a0, a1, 0);
    const int nmain = 4 * qb, jv = w >> 1;
    int t = 0;
#pragma unroll 1
    for (; t < nmain; t += 2) {
        AT_LOADK(RB, t + 3); AT_LOADV(RB, t + 2);
        AT_FUSED(a0, a1, b0, b1, 1, 0);
        AT_WRITEK(RA, 0); AT_WRITEV(RA, 1);
        __syncthreads();
        AT_LOADK(RA, t + 4); AT_LOADV(RA, t + 3);
        AT_FUSED(b0, b1, a0, a1, 0, 1);
        AT_WRITEK(RB, 1); AT_WRITEV(RB, 0);
        __syncthreads();
    }
    AT_LOADK(RB, t + 3); AT_LOADV(RB, t + 2);
    if (jv >= 1) AT_QK(b0, b1, 1);
    AT_SOFTMAX_PV(a0, a1, 0);
    AT_WRITEK(RA, 0); AT_WRITEV(RA, 1);
    __syncthreads();
    AT_LOADV(RA, t + 3);
    if (jv >= 2) AT_QK(a0, a1, 0);
    if (jv >= 1) AT_SOFTMAX_PV(b0, b1, 1);
    AT_WRITEK(RB, 1); AT_WRITEV(RB, 0);
    __syncthreads();
    if (jv >= 3) AT_QK(b0, b1, 1);
    if (jv >= 2) AT_SOFTMAX_PV(a0, a1, 0);
    AT_WRITEV(RA, 1);
    __syncthreads();
    if (jv >= 3) AT_SOFTMAX_PV(b0, b1, 1);
    __syncthreads();
#undef AT_LOADK
#undef AT_LOADV
#undef AT_WRITEK
#undef AT_WRITEV
#undef AT_QK
#undef AT_SOFTMAX_PV
#undef AT_QK1
#undef AT_MAX
#undef AT_EXP
#undef AT_PV
#undef AT_FUSED
    const float linv = 1.f / (lrun + __shfl_xor(lrun, 32));
    bf16_t* op = T.SZOG + (size_t)(row0 + r) * 1024 + 64 * h + 4 * hh;
#pragma unroll
    for (int db = 0; db < 2; ++db)
#pragma unroll
        for (int k2 = 0; k2 < 2; ++k2) {
            const f32x16& ox = db ? O1 : O0; u32x2 oe[2];
            bf16_t* p16 = T.SZOG + (size_t)(row0 + r) * 1024 + 64 * h + 32 * db + 8 * (2 * k2 + hh);
            const u32x4 zl = (NT_ONCE & 8) ? __builtin_nontemporal_load((const u32x4*)p16) : *(const u32x4*)p16;
            const u32x2 zs = hh ? (u32x2){zl.x, zl.y} : (u32x2){zl.z, zl.w}; u32x2 zr; zr.x = __shfl_xor(zs.x, 32); zr.y = __shfl_xor(zs.y, 32);
            const u32x2 ze[2] = {hh ? zr : (u32x2){zl.x, zl.y}, hh ? (u32x2){zl.z, zl.w} : zr};
#pragma unroll
            for (int e = 0; e < 2; ++e) { const int g4 = 2 * k2 + e; const u32x2 z = ze[e];
                oe[e].x = pk2(ox[4 * g4 + 0] * linv * bflo(z.x), ox[4 * g4 + 1] * linv * bfhi(z.x)); oe[e].y = pk2(ox[4 * g4 + 2] * linv * bflo(z.y), ox[4 * g4 + 3] * linv * bfhi(z.y)); }
            const u32x2 snd = hh ? oe[0] : oe[1]; u32x2 rcv; rcv.x = __shfl_xor(snd.x, 32); rcv.y = __shfl_xor(snd.y, 32);
            const u32x4 o16 = hh ? (u32x4){rcv.x, rcv.y, oe[1].x, oe[1].y} : (u32x4){oe[0].x, oe[0].y, rcv.x, rcv.y};
            if (!dry) gst16(T.SZOG, p16, o16);
        }
}
DI void attn_phase(LAS unsigned char* lds, const AttnT& T, int cu, int dry) {
#if AT_XCDMAP
    const int b = cu & 7, h = (cu >> 4) & 15, half = (cu >> 3) & 1;
#else
    const int bh = (cu & 7) + 8 * (cu >> 4), half = (cu >> 3) & 1, b = bh >> 4, h = bh & 15;
#endif
#if QFUSE
    {
        const int tid = tidx();
#pragma unroll
        for (int i = 0; i < 9; ++i) { const int e = tid + i * NTHR, row = e / 48, ch = e % 48; *(LAS u32x4*)(lds + AT_WQOFF + row * AT_WQS + 16 * ch) = *(const u32x4*)(T.WQ + (size_t)(96 * h + row) * 384 + 8 * ch); }
        __syncthreads();
    }
#endif
#pragma unroll 1
    for (int ui = 0; ui < 4; ++ui) attn_unit(lds, T, b, h, ((half ? AT_ORD1 : AT_ORD0) >> (4 * ui)) & 0xF, dry);
}

#ifndef CONV_ROWS
#define CONV_ROWS 8
#endif
DI void conv_phase(const bf16_t* CH, bf16_t* BZ, const float* cw, int gt, int NGT, int dry) {
    for (int it = gt; it < (M / CONV_ROWS) * 128; it += NGT) {
        const int c8 = (it & 127) * 8, m0 = (it >> 7) * CONV_ROWS, t0 = m0 & (S - 1);
        const f32x4 w0a = *(const f32x4*)(cw + c8), w0b = *(const f32x4*)(cw + c8 + 4), w1a = *(const f32x4*)(cw + 1024 + c8), w1b = *(const f32x4*)(cw + 1024 + c8 + 4), w2a = *(const f32x4*)(cw + 2048 + c8), w2b = *(const f32x4*)(cw + 2048 + c8 + 4);
        u32x4 ch[CONV_ROWS + 2], bz[CONV_ROWS];
#pragma unroll
        for (int r = 0; r < CONV_ROWS + 2; ++r) { const int m = m0 - 2 + r; ch[r] = (r >= 2 || t0 > 0) ? ((NT_ONCE & 2) ? __builtin_nontemporal_load((const u32x4*)(CH + (size_t)m * 1024 + c8)) : *(const u32x4*)(CH + (size_t)m * 1024 + c8)) : (u32x4){0u, 0u, 0u, 0u}; }
#pragma unroll
        for (int r = 0; r < CONV_ROWS; ++r) bz[r] = (NT_ONCE & 2) ? __builtin_nontemporal_load((const u32x4*)(BZ + (size_t)(m0 + r) * 1024 + c8)) : *(const u32x4*)(BZ + (size_t)(m0 + r) * 1024 + c8);
        f32x4 pa, pb, qa, qb;
        unpk8(ch[0], pa, pb); unpk8(ch[1], qa, qb);
#pragma unroll
        for (int r = 0; r < CONV_ROWS; ++r) {
            f32x4 ca, cb, ba, bb; unpk8(ch[r + 2], ca, cb); unpk8(bz[r], ba, bb);
            const f32x4 ya = w0a * pa + w1a * qa + w2a * ca, yb = w0b * pb + w1b * qb + w2b * cb;
            const u32x4 ov = pk8(ba * ya, bb * yb); if (!dry) gst16(BZ, BZ + (size_t)(m0 + r) * 1024 + c8, ov);
            pa = qa; pb = qb; qa = ca; qb = cb;
        }
    }
}

DI void gates_phase(const bf16_t* XB, const u64* ssq_x, const float* Wg8, const float* bg, float* IG, float* LF, int gw, int NGW, int lane) {
    f32x4 wv[8][2][2];
#pragma unroll
    for (int j = 0; j < 8; ++j)
#pragma unroll
        for (int half = 0; half < 2; ++half) { const int k0 = half * 512 + lane * 8; wv[j][half][0] = *(const f32x4*)(Wg8 + j * 1024 + k0); wv[j][half][1] = *(const f32x4*)(Wg8 + j * 1024 + k0 + 4); }
    const int jl = lane >> 3; const float bgl = bg[jl];
    for (int m0 = gw; m0 < M; m0 += 4 * NGW) {
        u32x4 xw[4][2]; u64 sq4[4];
#pragma unroll
        for (int r = 0; r < 4; ++r) { const int m = m0 + r * NGW, mc = m < M ? m : m0; xw[r][0] = *(const u32x4*)(XB + (size_t)mc * 1024 + lane * 8); xw[r][1] = *(const u32x4*)(XB + (size_t)mc * 1024 + 512 + lane * 8); sq4[r] = ssq_x[mc]; }
#pragma unroll
        for (int r = 0; r < 4; ++r) {
            const int m = m0 + r * NGW; if (m >= M) break;
            float acc[8];
#pragma unroll
            for (int j = 0; j < 8; ++j) acc[j] = 0.f;
#pragma unroll
            for (int half = 0; half < 2; ++half) {
                f32x4 xa, xb2; unpk8(xw[r][half], xa, xb2);
#pragma unroll
                for (int j = 0; j < 8; ++j) { const f32x4 wa = wv[j][half][0], wb = wv[j][half][1];
                    acc[j] += (xa[0] * wa[0] + xa[1] * wa[1]) + (xa[2] * wa[2] + xa[3] * wa[3]) + (xb2[0] * wb[0] + xb2[1] * wb[1]) + (xb2[2] * wb[2] + xb2[3] * wb[3]); }
            }
            float a4[4], a2[2], a1;
            { const bool hi = lane & 32;
#pragma unroll
              for (int k = 0; k < 4; ++k) { const float keep = hi ? acc[k + 4] : acc[k], send = hi ? acc[k] : acc[k + 4]; a4[k] = keep + __shfl_xor(send, 32); } }
            { const bool hi = lane & 16;
#pragma unroll
              for (int k = 0; k < 2; ++k) { const float keep = hi ? a4[k + 2] : a4[k], send = hi ? a4[k] : a4[k + 2]; a2[k] = keep + __shfl_xor(send, 16); } }
            { const bool hi = lane & 8; const float keep = hi ? a2[1] : a2[0], send = hi ? a2[0] : a2[1]; a1 = keep + __shfl_xor(send, 8); }
            a1 += __shfl_xor(a1, 4); a1 += __shfl_xor(a1, 2); a1 += __shfl_xor(a1, 1);
            const float rs = rsqrtf((float)sq4[r] * SSQ_INV * (1.f / 1024.f) + EPS);
            const float gv = a1 * rs + bgl;
            if ((lane & 7) == 0) {
                if (jl < 4) gst4f(IG + (size_t)m * 4 + jl, gv);
                else gst4f(LF + (size_t)m * 4 + (jl - 4), fminf(gv, 0.f) - log1pf(__expf(-fabsf(gv))));
            }
        }
    }
}
DI void gw8_prep(const float* w_in, const float* g, float* Wg8, int gt, int NGT) {
    for (int i = gt; i < 8 * 1024; i += NGT) { const int j = i >> 10, k = i & 1023; gst4f(Wg8 + i, w_in[(size_t)k * 8200 + 8192 + j] * g[k]); }
}

#ifndef SCAN_PCONV
#define SCAN_PCONV 0
#endif
#ifndef SCAN_DRY_NOST
#define SCAN_DRY_NOST 0
#endif
constexpr int SC_QSTR = 528, SC_VSTR = 136  , SC_VVSTR = 144  ;
constexpr int SC_QS = 0, SC_KS = 64 * SC_QSTR, SC_VS = 2 * 64 * SC_QSTR, SC_SP = SC_VS + 64 * SC_VVSTR, SC_QCX = SC_SP + 64 * SC_VSTR, SC_GT = SC_QCX + 16384, SC_VEC = SC_GT + 3 * 32 * 64 * 4 + 512, SC_OT = SC_VEC + (832 + 512) * 4;
constexpr int G_B = 0, G_CC = 2048, G_PM = 4096, G_SC = 6144;
constexpr int V_QNP = 0  , V_RS = 512  , V_WS = 768, V_WH = 832  ;
constexpr int SC_END = SC_OT + 64 * SC_VVSTR;
struct ScanT { const bf16_t *Q, *K, *VT; bf16_t* OG; const float *IG, *LF; const float* P; bf16_t* PB; int gt, ngt; };
DI float scan_add(float v, int lane) {
#pragma unroll
    for (int o = 1; o < 64; o <<= 1) { const float t = __shfl_up(v, o); if (lane >= o) v += t; }
    return v;
}
DI float scan_max(float v, int lane) {
#pragma unroll
    for (int o = 1; o < 64; o <<= 1) { const float t = __shfl_up(v, o); if (lane >= o) v = fmaxf(v, t); }
    return v;
}
DI void scan_item(LAS unsigned char* lds, const ScanT& T, int b, int h, int sl, int dry) {
    const int tid0 = tidx(), w = __builtin_amdgcn_readfirstlane(tid0 >> 6), g = w >> 2, c = w & 3;
    int tid = tid0, lane = tid & 63, l15 = lane & 15, q = lane >> 4;
    const int tok0 = b * S;
    LAS float* vec = (LAS float*)(lds + SC_VEC);
    LAS float* gt = (LAS float*)(lds + SC_GT);
    f32x4 Cacc[8];
#pragma unroll
    for (int i = 0; i < 8; ++i) Cacc[i] = (f32x4){0.f, 0.f, 0.f, 0.f};
    f32x4 nacc[2] = {(f32x4){0.f, 0.f, 0.f, 0.f}, (f32x4){0.f, 0.f, 0.f, 0.f}};
    f32x4 pcv0 = (f32x4){0.f, 0.f, 0.f, 0.f}, pcv1 = pcv0;
    u32x4 sQ[4], sK[4], sV;
    const int vd = tid >> 3, vch = tid & 7;
    const bf16_t* gQ = T.Q + (size_t)tok0 * 1024 + 256 * h;
    const bf16_t* gK = T.K + (size_t)tok0 * 1024 + 256 * h;
    const bf16_t* gV = T.VT + (size_t)(tok0 + vd) * 2048 + 512 * h + 64 * sl + 8 * vch;
#define SC_LOAD(ci) do { _Pragma("unroll") for (int i = 0; i < 4; ++i) { const int e = tid + i * NTHR, row = e >> 5, ch = e & 31; \
        sQ[i] = *(const u32x4*)(gQ + (size_t)((ci) * 64 + row) * 1024 + 8 * ch); sK[i] = *(const u32x4*)(gK + (size_t)((ci) * 64 + row) * 1024 + 8 * ch); } \
        sV = (NT_ONCE & 4) ? __builtin_nontemporal_load((const u32x4*)(gV + (size_t)(ci) * 64 * 2048)) : *(const u32x4*)(gV + (size_t)(ci) * 64 * 2048); } while (0)
    u32x4 sOG;
    bf16_t* gOG = T.OG + (size_t)(tok0 + vd) * 2048 + 512 * h + 64 * sl + 8 * vch;
#define SC_LOADOG(ci) do { sOG = (NT_ONCE & 4) ? __builtin_nontemporal_load((const u32x4*)(gOG + (size_t)(ci) * 64 * 2048)) : *(const u32x4*)(gOG + (size_t)(ci) * 64 * 2048); } while (0)
    SC_LOAD(0); SC_LOADOG(0);
    {
        float lfv[4], igv[4];
#pragma unroll
        for (int k = 0; k < 4; ++k) { const size_t gi = (size_t)(tok0 + (w + 8 * k) * 64 + lane) * 4 + h; lfv[k] = T.LF[gi]; igv[k] = T.IG[gi]; }
#pragma unroll
        for (int k = 0; k < 4; ++k) {
            const int ck = w + 8 * k; const float bb = scan_add(lfv[k], lane), cc = igv[k] - bb, pm = scan_max(cc, lane);
            gt[G_B + ck * 64 + lane] = bb; gt[G_CC + ck * 64 + lane] = cc; gt[G_PM + ck * 64 + lane] = pm;
            if (lane == 63) { gt[G_SC + ck * 4 + 0] = bb; gt[G_SC + ck * 4 + 1] = pm; }
        }
        __syncthreads();
        if (w == 0) {
            const float blv = gt[G_SC + (lane & 31) * 4], cmv = gt[G_SC + (lane & 31) * 4 + 1];
            float m = 0.f, mb = 0.f, ma = 0.f;
#pragma unroll
            for (int ck = 0; ck < 32; ++ck) { const float bl = __shfl(blv, ck), cm = __shfl(cmv, ck); const float mn = fmaxf(bl + m, bl + cm); if (lane == ck) { mb = m; ma = mn; } m = mn; }
            if (lane < 32) { gt[G_SC + lane * 4 + 2] = mb; gt[G_SC + lane * 4 + 3] = ma; }
        }
        __syncthreads();
    }
    for (int ci = 0; ci < S / 64; ++ci) {
        tid = tid0; asm volatile("" : "+v"(tid)); lane = tid & 63; l15 = lane & 15; q = lane >> 4;
#pragma unroll
        for (int i = 0; i < 4; ++i) { const int e = tid + i * NTHR, row = e >> 5, ch = e & 31; *(LAS u32x4*)(lds + SC_QS + row * SC_QSTR + 16 * ch) = sQ[i]; *(LAS u32x4*)(lds + SC_KS + row * SC_QSTR + 16 * ch) = sK[i]; }
        *(LAS u32x4*)(lds + SC_VS + vd * SC_VVSTR + 16 * vch) = sV;
        if (ci > 0 && !dry) gst16(T.OG, gOG + (size_t)(ci - 1) * 64 * 2048, *(const LAS u32x4*)(lds + SC_OT + vd * SC_VVSTR + 16 * vch));
        *(LAS u32x4*)(lds + SC_OT + vd * SC_VVSTR + 16 * vch) = sOG;
        const f32x4 scal = *(const LAS f32x4*)(gt + G_SC + ci * 4);
        const float m_c = scal[2], blast = scal[0], mnew = scal[3];
        const LAS float* gB = gt + G_B + ci * 64; const LAS float* gC = gt + G_CC + ci * 64; const LAS float* gP = gt + G_PM + ci * 64;
        __syncthreads();
        if (ci + 1 < S / 64) SC_LOAD(ci + 1);
        if (SCAN_PCONV && T.PB) {
            if ((ci & 7) == 0) { const size_t e = (size_t)T.gt + (size_t)(ci >> 3) * T.ngt; pcv0 = ((const f32x4*)T.P)[2 * e]; pcv1 = ((const f32x4*)T.P)[2 * e + 1]; }
            else if ((ci & 7) == 1) { const size_t e = (size_t)T.gt + (size_t)(ci >> 3) * T.ngt; gst16(T.PB, (u32x4*)T.PB + e, pk8(pcv0, pcv1)); }
        }
        {
            const int sb = w >> 1, tb0 = 2 * (w & 1);
#define SC_SFIN(A4, TB) do { const int t = 16 * (TB) + l15, s0 = 16 * sb + 4 * q; \
                const float a2 = -fmaxf(m_c, gP[t]) * LOG2E; const f32x4 c2 = *(const LAS f32x4*)(gC + s0); float rsum = 0.f; \
                _Pragma("unroll") for (int r2 = 0; r2 < 4; ++r2) { const float wgt = (s0 + r2 <= t) ? ex2(a2 + c2[r2] * LOG2E) : 0.f; A4[r2] *= wgt; rsum += A4[r2]; } \
                u32x2 pw; pw.x = pk2(A4[0], A4[1]); pw.y = pk2(A4[2], A4[3]); \
                *(LAS u32x2*)(lds + SC_SP + t * SC_VSTR + s0 * 2) = pw; \
                rsum = red_fq(rsum); if (q == 0) vec[V_RS + 64 * sb + t] = rsum; } while (0)
#define SC_SZERO(TB) do { const int t = 16 * (TB) + l15, s0 = 16 * sb + 4 * q; *(LAS u32x2*)(lds + SC_SP + t * SC_VSTR + s0 * 2) = (u32x2){0u, 0u}; if (q == 0) vec[V_RS + 64 * sb + t] = 0.f; } while (0)
            if (sb <= tb0 && !(SCAN_DRY_NOST && dry)) {
                f32x4 a40 = (f32x4){0.f, 0.f, 0.f, 0.f}, a41 = (f32x4){0.f, 0.f, 0.f, 0.f};
#pragma unroll
                for (int ks = 0; ks < 8; ++ks) {
                    const bf16x8 ka = *(const LAS bf16x8*)(lds + SC_KS + (16 * sb + l15) * SC_QSTR + 64 * ks + 16 * q);
                    const bf16x8 q0 = *(const LAS bf16x8*)(lds + SC_QS + (16 * tb0 + l15) * SC_QSTR + 64 * ks + 16 * q);
                    const bf16x8 q1 = *(const LAS bf16x8*)(lds + SC_QS + (16 * tb0 + 16 + l15) * SC_QSTR + 64 * ks + 16 * q);
                    a40 = MFMA16(ka, q0, a40); a41 = MFMA16(ka, q1, a41);
                }
                SC_SFIN(a40, tb0); SC_SFIN(a41, tb0 + 1);
            } else if (sb <= tb0 + 1 && !(SCAN_DRY_NOST && dry)) {
                f32x4 a41 = (f32x4){0.f, 0.f, 0.f, 0.f};
#pragma unroll
                for (int ks = 0; ks < 8; ++ks) {
                    const bf16x8 ka = *(const LAS bf16x8*)(lds + SC_KS + (16 * sb + l15) * SC_QSTR + 64 * ks + 16 * q);
                    const bf16x8 q1 = *(const LAS bf16x8*)(lds + SC_QS + (16 * tb0 + 16 + l15) * SC_QSTR + 64 * ks + 16 * q);
                    a41 = MFMA16(ka, q1, a41);
                }
                SC_SZERO(tb0); SC_SFIN(a41, tb0 + 1);
            } else { SC_SZERO(tb0); SC_SZERO(tb0 + 1); }
#undef SC_SFIN
#undef SC_SZERO
        }
        f32x4 qc[4];
        {
            bf16x8 cf[4]; f32x4 qnp[4];
            u32x4 nw; nw.x = pk2(nacc[0][0], nacc[0][1]); nw.y = pk2(nacc[0][2], nacc[0][3]); nw.z = pk2(nacc[1][0], nacc[1][1]); nw.w = pk2(nacc[1][2], nacc[1][3]);
            const bf16x8 nf = __builtin_bit_cast(bf16x8, nw);
#pragma unroll
            for (int ks = 0; ks < 4; ++ks) { u32x4 cw; cw.x = pk2(Cacc[2 * ks][0], Cacc[2 * ks][1]); cw.y = pk2(Cacc[2 * ks][2], Cacc[2 * ks][3]); cw.z = pk2(Cacc[2 * ks + 1][0], Cacc[2 * ks + 1][1]); cw.w = pk2(Cacc[2 * ks + 1][2], Cacc[2 * ks + 1][3]); cf[ks] = __builtin_bit_cast(bf16x8, cw); }
#pragma unroll
            for (int tb = 0; tb < 4; ++tb) {
                qc[tb] = (f32x4){0.f, 0.f, 0.f, 0.f}; qnp[tb] = (f32x4){0.f, 0.f, 0.f, 0.f};
#pragma unroll
                for (int ks = 0; ks < 4; ++ks) {
                    const LAS unsigned char* qp = lds + SC_QS + (16 * tb + l15) * SC_QSTR + (128 * g + 32 * ks + 4 * q) * 2;
                    const bf16x8 qa = cat4(*(const LAS s16x4*)qp, *(const LAS s16x4*)(qp + 32));
                    qc[tb] = MFMA16(cf[ks], qa, qc[tb]);
                    if (ks == c) qnp[tb] = MFMA16(nf, qa, qnp[tb]);
                }
            }
            if (q == 0) {
#pragma unroll
                for (int tb = 0; tb < 4; ++tb) vec[V_QNP + w * 64 + 16 * tb + l15] = qnp[tb][0];
            }
            LAS f32x4* qx = (LAS f32x4*)(lds + SC_QCX) + (w * 2) * 64 + lane;
            qx[0] = g ? qc[0] : qc[2]; qx[64] = g ? qc[1] : qc[3];
        }
        if (tid < 64) vec[V_WS + tid] = __expf(blast + gC[tid] - mnew);
        __syncthreads();
        bf16x8 vf[2];
#pragma unroll
        for (int ks = 0; ks < 2; ++ks) { LAS unsigned char* vp = lds + SC_VS + (32 * ks + 8 * q + (l15 >> 2)) * SC_VVSTR + (16 * c + 4 * (lane & 3)) * 2;
            vf[ks] = cat4(__builtin_amdgcn_ds_read_tr16_b64_v4i16((LAS s16x4*)vp), __builtin_amdgcn_ds_read_tr16_b64_v4i16((LAS s16x4*)(vp + 4 * SC_VVSTR))); }
        {
            LAS float* wh = vec + V_WH + w * 64;
            if (lane < 32) {
                const int t = 32 * g + lane; float qn = 0.f, rs = 0.f;
#pragma unroll
                for (int k = 0; k < 8; ++k) qn += vec[V_QNP + 64 * k + t];
#pragma unroll
                for (int k = 0; k < 4; ++k) rs += vec[V_RS + 64 * k + t];
                const float mxv = fmaxf(m_c, gP[t]), wi = __expf(m_c - mxv), em = __expf(-gB[t] - mxv);
                wh[lane] = wi; wh[32 + lane] = __builtin_amdgcn_rcpf(fmaxf(fabsf(wi * qn + rs), em));
            }
            const LAS f32x4* px = (const LAS f32x4*)(lds + SC_QCX) + ((w ^ 4) * 2) * 64 + lane;
#define SC_FIN(tt, QCV) do { const int tb = 2 * g + (tt); \
                f32x4 sv = (f32x4){0.f, 0.f, 0.f, 0.f}; \
                _Pragma("unroll") for (int ks = 0; ks < 2; ++ks) { const LAS unsigned char* sp = lds + SC_SP + (16 * tb + l15) * SC_VSTR + 64 * ks + 16 * q; const bf16x8 sa = cat4(*(const LAS s16x4*)sp, *(const LAS s16x4*)(sp + 8)); sv = MFMA16(vf[ks], sa, sv); } \
                const f32x4 qct = (QCV) + px[64 * (tt)]; \
                const float wi = wh[16 * (tt) + l15], hi_ = wh[32 + 16 * (tt) + l15]; \
                LAS u32x2* op = (LAS u32x2*)(lds + SC_OT + (16 * tb + l15) * SC_VVSTR + (16 * c + 4 * q) * 2); const u32x2 ogw = *op; \
                u32x2 ow; ow.x = pk2((wi * qct[0] + sv[0]) * hi_ * bflo(ogw.x), (wi * qct[1] + sv[1]) * hi_ * bfhi(ogw.x)); ow.y = pk2((wi * qct[2] + sv[2]) * hi_ * bflo(ogw.y), (wi * qct[3] + sv[3]) * hi_ * bfhi(ogw.y)); \
                *op = ow; } while (0)
            if (g) { SC_FIN(0, qc[2]); SC_FIN(1, qc[3]); } else { SC_FIN(0, qc[0]); SC_FIN(1, qc[1]); }
#undef SC_FIN
        }
        if (ci + 1 < S / 64) SC_LOADOG(ci + 1);
        {
            const float decay = __expf(blast + m_c - mnew);
            bf16x8 vw[2], wsf[2];
#pragma unroll
            for (int ks = 0; ks < 2; ++ks) {
                const f32x4 w0 = *(const LAS f32x4*)(vec + V_WS + 32 * ks + 8 * q), w1 = *(const LAS f32x4*)(vec + V_WS + 32 * ks + 8 * q + 4);
                f32x4 x0, x1; unpk8(__builtin_bit_cast(u32x4, vf[ks]), x0, x1); vw[ks] = __builtin_bit_cast(bf16x8, pk8(x0 * w0, x1 * w1));
                const u32x4 wz = pk8(w0, w1); wsf[ks] = __builtin_bit_cast(bf16x8, l15 == 0 ? wz : (u32x4){0u, 0u, 0u, 0u});
            }
#pragma unroll
            for (int i = 0; i < 8; ++i) {
                if ((i & 1) == 0) __builtin_amdgcn_sched_barrier(0);
                Cacc[i] *= decay;
#pragma unroll
                for (int ks = 0; ks < 2; ++ks) {
                    LAS unsigned char* kp = lds + SC_KS + (32 * ks + 8 * q + (l15 >> 2)) * SC_QSTR + (128 * g + 16 * i + 4 * (lane & 3)) * 2;
                    const s16x4 lo = __builtin_amdgcn_ds_read_tr16_b64_v4i16((LAS s16x4*)kp), hi = __builtin_amdgcn_ds_read_tr16_b64_v4i16((LAS s16x4*)(kp + 4 * SC_QSTR));
                    Cacc[i] = MFMA16(cat4(lo, hi), vw[ks], Cacc[i]);
                }
            }
#pragma unroll
            for (int ib = 0; ib < 2; ++ib) {
                nacc[ib] *= decay;
#pragma unroll
                for (int ks = 0; ks < 2; ++ks) {
                    LAS unsigned char* kp = lds + SC_KS + (32 * ks + 8 * q + (l15 >> 2)) * SC_QSTR + (128 * g + 16 * (2 * c + ib) + 4 * (lane & 3)) * 2;
                    const s16x4 lo = __builtin_amdgcn_ds_read_tr16_b64_v4i16((LAS s16x4*)kp), hi = __builtin_amdgcn_ds_read_tr16_b64_v4i16((LAS s16x4*)(kp + 4 * SC_QSTR));
                    nacc[ib] = MFMA16(cat4(lo, hi), wsf[ks], nacc[ib]);
                }
            }
        }
        __syncthreads();
    }
    if (!dry) gst16(T.OG, gOG + (size_t)(S / 64 - 1) * 64 * 2048, *(const LAS u32x4*)(lds + SC_OT + vd * SC_VVSTR + 16 * vch));
    __syncthreads();
#undef SC_LOAD
#undef SC_LOADOG
}
DI void scan_phase(LAS unsigned char* lds, const ScanT& T, int cu, int dry) {
    const int xcd = cu & 7, idx = cu >> 3, bh = xcd * 4 + (idx >> 3), sl = idx & 7;
    scan_item(lds, T, bh >> 2, bh & 3, sl, dry);
}

DI void final_phase(const bf16_t* xb, float* out, const u64* ssq, const float* g, int gw, int NGW, int lane) {
    for (int m = gw; m < M; m += NGW) {
        const float rs = ssq_rstd(ssq + m, 1.f / 1024.f);
#pragma unroll
        for (int j = 0; j < 2; ++j) {
            const int c0 = (lane + 64 * j) * 8; f32x4 a, b; unpk8(*(const u32x4*)(xb + (size_t)m * D + c0), a, b);
            *(f32x4*)(out + (size_t)m * D + c0) = a * rs * *(const f32x4*)(g + c0); *(f32x4*)(out + (size_t)m * D + c0 + 4) = b * rs * *(const f32x4*)(g + c0 + 4);
        }
    }
}
constexpr int LDS_BYTES = 147456, MISC_OFF = 146944;
static_assert(SC_END <= MISC_OFF && AT_WQOFF + 96 * AT_WQS <= MISC_OFF && AT_WQOFF == 2 * AT_KB + 2 * AT_VB, "LDS map");
constexpr int PH_PER_LAYER = 6, PH_FINAL = 1 + 4 * PH_PER_LAYER, PH_REFRESH = 100;
#ifndef GEMM_ALIGN
#define GEMM_ALIGN true
#endif
#ifndef GEMM_SP2
#define GEMM_SP2 true
#endif
#ifndef C1_DRYMODE
#define C1_DRYMODE 1
#endif
#ifndef BAR_TWICE
#define BAR_TWICE 0
#endif
#ifndef STAGGER
#define STAGGER 0
#endif
#ifndef STAGGER_MASK
#define STAGGER_MASK 3
#endif
#ifndef STAGGER_L1
#define STAGGER_L1 0
#endif
#define STAGGER_SLEEP_N(n_) do { if (n_) { for (int s_ = 0; s_ < (int)(((cu >> 3) & STAGGER_MASK) * (n_)); ++s_) __builtin_amdgcn_s_sleep(32); } } while (0)
#define STAGGER_SLEEP() STAGGER_SLEEP_N(STAGGER)
#ifndef PP_HOLES
#define PP_HOLES 0
#endif
#ifndef A2_REV
#define A2_REV 1
#endif
#ifndef A2_QREV
#define A2_QREV 0
#endif
#ifndef GEMM_ALIGN1
#define GEMM_ALIGN1 GEMM_ALIGN
#endif
#ifndef PAD_NOPS
#define PAD_NOPS 0
#endif
#define PAD_STR2(x) #x
#define PAD_STR(x) PAD_STR2(x)
#ifndef P0_ORDER
#define P0_ORDER 0
#endif
#ifndef PHM
#define PHM 0xFFFF
#endif
#define PH_ON(b) ((PHM >> (b)) & 1)
#ifndef REPEAT
#define REPEAT 0
#endif
#ifndef REPEAT_AFTER
#define REPEAT_AFTER 0
#endif
#if REPEAT_AFTER
#define REP_LOOP(b) for (int rep_ = 0, nrep_ = opaque((REPEAT >> (b)) & 1); rep_ <= nrep_; ++rep_)
#else
#define REP_LOOP(b) for (int rep_ = opaque((REPEAT >> (b)) & 1); rep_ >= 0; --rep_)
#endif
typedef const __attribute__((address_space(4))) Args* KArgs;
DI KArgs kargs() { KArgs p = (KArgs)__builtin_amdgcn_kernarg_segment_ptr(); asm volatile("" : "+s"(p)); return p; }

#define TID_DEFS const int tid = tidx(), w = __builtin_amdgcn_readfirstlane(tid >> 6), lane = tid & 63; (void)w; (void)lane
DI void prep_mixer(LAS unsigned char* lds, int i, int cu, int G) {
    TID_DEFS; KArgs A = kargs(); unsigned char* ws = A->ws; LAS float* scr = (LAS float*)lds;
    const int kind = i % 3, j = i / 3;
    const float* normg = A->in[I_NORMG] + (size_t)i * D; bf16_t* wmix = (bf16_t*)(ws + WS_WMIX);
    const PrepTask tple{A->in[I_PLE_PROJ] + (size_t)i * 256 * D, D, nullptr, 256, D, PM_ID, (bf16_t*)(ws + WS_WPLE + 2 * MiB)};
    if (kind == 0) {
        constexpr int n0 = 28 * 8, n1 = 24 * 3, n2 = 32 * 2, n3 = 16 * 8;
        const PrepTask t0{A->in[I_MLA_WIN] + (size_t)j * D * 1696, 1696, normg, D, 1792, PM_MLA_IN, wmix};
        const PrepTask t1{A->in[I_MLA_WQB] + (size_t)j * 384 * 1536, 1536, A->in[I_MLA_QN] + j * 384, 384, 1536, PM_MLA_QB, (bf16_t*)(ws + WS_WMIX + WM_QB)};
        const PrepTask t2{A->in[I_MLA_WKVB] + (size_t)j * 256 * 2048, 2048, A->in[I_MLA_KVN] + j * 256, 256, 2048, PM_MLA_KVB, (bf16_t*)(ws + WS_WMIX + WM_KVB)};
        const PrepTask t3{A->in[I_MLA_WOUT] + (size_t)j * D * D, D, nullptr, D, D, PM_ID, (bf16_t*)(ws + WS_WMIX + WM_OUT_MLA)};
        prep_batched([&](int it, auto&& f) {
            if (it < n0) f(t0, it); else if (it < n0 + n1) f(t1, it - n0); else if (it < n0 + n1 + n2) f(t2, it - n0 - n1); else if (it < n0 + n1 + n2 + n3) f(t3, it - n0 - n1 - n2); else f(tple, it - n0 - n1 - n2 - n3);
        }, n0 + n1 + n2 + n3 + 32, cu, G, scr);
    } else if (kind == 1) {
        constexpr int n0 = 64 * 8, n1 = 16 * 8;
        const PrepTask t0{A->in[I_CONV_WIN] + (size_t)j * D * 4096, 4096, normg, D, 4096, PM_CONV_IN, wmix};
        const PrepTask t1{A->in[I_CONV_WOUT] + (size_t)j * D * D, D, nullptr, D, D, PM_ID, (bf16_t*)(ws + WS_WMIX + WM_OUT_CONV)};
        prep_batched([&](int it, auto&& f) { if (it < n0) f(t0, it); else if (it < n0 + n1) f(t1, it - n0); else f(tple, it - n0 - n1); }, n0 + n1 + 32, cu, G, scr);
    } else {
        constexpr int n0 = 128 * 8, n1 = 16 * 16;
        const PrepTask t0{A->in[I_L_WIN] + (size_t)j * D * 8200, 8200, normg, D, 8192, PM_LSTM_IN, wmix};
        const PrepTask t1{A->in[I_L_WOUT] + (size_t)j * 2048 * D, D, nullptr, 2048, D, PM_ID, (bf16_t*)(ws + WS_WMIX + WM_OUT_LSTM)};
        prep_batched([&](int it, auto&& f) { if (it < n0) f(t0, it); else if (it < n0 + n1) f(t1, it - n0); else f(tple, it - n0 - n1); }, n0 + n1 + 32, cu, G, scr);
        gw8_prep(A->in[I_L_WIN] + (size_t)j * D * 8200, normg, (float*)(ws + WS_GW8), cu * NTHR + tid, G * NTHR);
    }
    if (kind != 2) p_to_bf16(A->in[I_P] + (size_t)i * M * 256, (bf16_t*)(ws + WS_BIG + A_PB), cu * NTHR + tid, G * NTHR);
}
DI void prep_ple(LAS unsigned char* lds, int i, int cu, int G) {
    KArgs A = kargs(); unsigned char* ws = A->ws; LAS float* scr = (LAS float*)lds;
    const PrepTask t0{A->in[I_PLE_GATE] + (size_t)i * D * D, D, nullptr, D, D, PM_ID, (bf16_t*)(ws + WS_WPLE)};
    prep_batched([&](int it, auto&& f) { f(t0, it); }, 16 * 8, cu, G, scr);
}

__global__ void __launch_bounds__(NTHR, 2) fwd(Args a_) {
    extern __shared__ __attribute__((aligned(16))) unsigned char lds_[];
    LAS unsigned char* lds = (LAS unsigned char*)lds_;
    const int cu = blockIdx.x, G = gridDim.x;
#if PAD_NOPS > 0
    asm volatile(".rept " PAD_STR(PAD_NOPS) "\n\ts_nop 0\n\t.endr");
#endif
#define GW (cu * 8 + w)
#define NGW (G * 8)
#define GT (cu * NTHR + tid)
#define NGT (G * NTHR)
    const int lo = a_.ph_lo, hi = a_.ph_hi;
    volatile LAS unsigned* misc = (volatile LAS unsigned*)(lds + MISC_OFF);
    { TID_DEFS; if (tid < 32) misc[tid] = 0u; }
    __syncthreads();
    const bool multi = (hi - lo) > 1;
    XcdBarrier bar; bar.bar = nullptr; bar.x = 0; bar.st = misc + 8;
    if (multi) bar = xcd_barrier_post((unsigned*)(kargs()->ws + WS_CTL), misc + 8);
#define IN(k) (lo <= (k) && (k) < hi)
#ifdef TIMELINE
#define STAMP(idx) do { if (blockIdx.x == 0 && threadIdx.x == 0) ((unsigned long long*)(kargs()->ws + WS_CTL + 32 * KiB))[(idx)] = __builtin_amdgcn_s_memrealtime(); } while (0)
#else
#define STAMP(idx) do { } while (0)
#endif
#define SEAM(k) do { if (multi && (k) + 1 < hi) { XcdBarrier b2 = bar; b2.bar = (unsigned*)(kargs()->ws + WS_CTL); xcd_barrier(b2); if (BAR_TWICE) xcd_barrier(b2); } STAMP((k) + 1); } while (0)

    STAMP(0);
    if (lo >= PH_REFRESH) {
        TID_DEFS; KArgs A = kargs(); const int i = lo - PH_REFRESH; rows_to_bf16_ssq(A->out, (bf16_t*)(A->ws + WS_XBA), ssq_arr(A->ws, SSQ_X + i), GW, NGW, lane); return;
    }
    if (IN(0)) {
#if P0_ORDER
        REP_LOOP(13) prep_mixer(lds, 0, cu, G);
        REP_LOOP(11) { TID_DEFS; KArgs A = kargs(); unsigned char* ws = A->ws; rows_to_bf16_ssq(A->in[I_X], (bf16_t*)(ws + WS_XBA), ssq_arr(ws, SSQ_X), GW, NGW, lane); }
        REP_LOOP(12) { TID_DEFS; KArgs A = kargs(); unsigned char* ws = A->ws; rope_tables((const int*)A->in[I_POS], (float*)(ws + WS_CS), (float*)(ws + WS_SN), GT, NGT); }
#else
        { TID_DEFS; u64* z = ssq_arr(kargs()->ws, 1); for (int e = GT; e < 6 * M; e += NGT) gst16(z, (u32x4*)z + e, (u32x4){0u, 0u, 0u, 0u}); }
        REP_LOOP(11) { TID_DEFS; KArgs A = kargs(); unsigned char* ws = A->ws; rows_to_bf16_ssq(A->in[I_X], (bf16_t*)(ws + WS_XBA), ssq_arr(ws, SSQ_X), GW, NGW, lane); }
        REP_LOOP(12) { TID_DEFS; KArgs A = kargs(); unsigned char* ws = A->ws; rope_tables((const int*)A->in[I_POS], (float*)(ws + WS_CS), (float*)(ws + WS_SN), GT, NGT); }
        REP_LOOP(13) prep_mixer(lds, 0, cu, G);
#endif
    }
    if (IN(0)) SEAM(0);
#pragma unroll 1
    for (int i = 0; i < 4; ++i) {
        const int kind = i % 3, j = i / 3, base = 1 + PH_PER_LAYER * i;
        if (hi <= base || lo >= base + PH_PER_LAYER) continue;
        if (IN(base + 1)) {
            REP_LOOP(0) prep_ple(lds, i, cu, G);
            if (kind == 0 && PH_ON(1)) {
                unsigned char* ws = kargs()->ws;
                pg8::Gemm g{(bf16_t*)(ws + WS_XBA), (bf16_t*)(ws + WS_WMIX), M, 1792, opaque(D)}; pg8::StaticOrder So; So.init(M, 1792, G, cu);
                EpiA1 E{ws, i, j}; STAGGER_SLEEP();
                pg8::gemm_phase<EpiA1, pg8::StaticOrder, GEMM_ALIGN, GEMM_SP2>(lds, g, So, E);
                if (PP_HOLES && G == 256 && cu >= 192) {
                    KArgs A2 = kargs(); unsigned char* ws2 = A2->ws;
                    pg8::Gemm g2{(bf16_t*)(ws2 + WS_BIG + A_PB), (bf16_t*)(ws2 + WS_WPLE + 2 * MiB), M, D, opaque(256)}; pg8::StaticOrder So2; So2.init(M, D, 64, cu - 192);
                    EpiPP E2{(bf16_t*)A2->out};
                    pg8::gemm_phase<EpiPP, pg8::StaticOrder, GEMM_ALIGN, GEMM_SP2>(lds, g2, So2, E2);
                }
            } else if (kind == 1 && PH_ON(2)) REP_LOOP(2) {
                unsigned char* ws = kargs()->ws;
                pg8::Gemm g{(bf16_t*)(ws + WS_XBA), (bf16_t*)(ws + WS_WMIX), M, 4096, opaque(D)}; pg8::StaticOrder So; So.init(M, 4096, G, cu);
                EpiC1 E{ws, i, rep_ * C1_DRYMODE}; STAGGER_SLEEP();
                pg8::gemm_phase<EpiC1, pg8::StaticOrder, GEMM_ALIGN, GEMM_SP2>(lds, g, So, E);
            } else if (kind == 2 && PH_ON(3)) REP_LOOP(3) {
                { TID_DEFS; KArgs A = kargs(); unsigned char* ws = A->ws;
                  gates_phase((bf16_t*)(ws + WS_XBA), ssq_arr(ws, SSQ_X + i), (const float*)(ws + WS_GW8), A->in[I_L_BG] + j * 8, (float*)(ws + WS_IG), (float*)(ws + WS_LF), GW, NGW, lane); }
                unsigned char* ws = kargs()->ws;
                pg8::Gemm g{(bf16_t*)(ws + WS_XBA), (bf16_t*)(ws + WS_WMIX), M, 8192, opaque(D)}; pg8::StaticOrder So; So.init(M, 8192, G, cu);
                EpiL1 E{ws, i}; STAGGER_SLEEP(); STAGGER_SLEEP_N(STAGGER_L1);
                pg8::gemm_phase<EpiL1, pg8::StaticOrder, GEMM_ALIGN, GEMM_SP2>(lds, g, So, E);
            }
            SEAM(base + 1);
        }
        if (IN(base + 2) && kind != 2) {
            if (kind == 0 && PH_ON(4)) REP_LOOP(4) {
                if (!QFUSE) { unsigned char* ws = kargs()->ws;
                  pg8::Gemm g{(bf16_t*)(ws + WS_BIG + A_CQ), (bf16_t*)(ws + WS_WMIX + WM_QB), M, 1536, opaque(384)}; pg8::StaticOrder So; So.init(M, 1536, G, A2_QREV ? G - 1 - cu : cu);
                  EpiQ E{ws, j};
                  pg8::gemm_phase<EpiQ, pg8::StaticOrder, GEMM_ALIGN, GEMM_SP2>(lds, g, So, E); }
                { unsigned char* ws = kargs()->ws;
                  pg8::Gemm g{(bf16_t*)(ws + WS_BIG + A_CKV), (bf16_t*)(ws + WS_WMIX + WM_KVB), M, 2048, opaque(256)}; pg8::StaticOrder So; So.init(M, 2048, G, A2_REV ? G - 1 - cu : cu);
                  EpiKV E{ws, j};
                  pg8::gemm_phase<EpiKV, pg8::StaticOrder, GEMM_ALIGN, GEMM_SP2>(lds, g, So, E); }
            } else if (kind == 1 && PH_ON(5)) REP_LOOP(5) {
                TID_DEFS; KArgs A = kargs(); unsigned char* ws = A->ws;
                conv_phase((const bf16_t*)(ws + WS_BIG + C_CH), (bf16_t*)(ws + WS_BIG + C_BZ), A->in[I_CONV_W] + (size_t)j * 3 * 1024, GT, NGT, rep_);
            }
            SEAM(base + 2);
        }
        if (IN(base + 3) && kind != 1) {
            if (kind == 0 && PH_ON(6)) REP_LOOP(6) {
                unsigned char* wsA = kargs()->ws; unsigned char* big = wsA + WS_BIG;
                AttnT T{(bf16_t*)(big + A_Q), (bf16_t*)(big + A_KN), (bf16_t*)(big + A_KR), (bf16_t*)(big + A_VT), (bf16_t*)(big + A_SZ),
                        (bf16_t*)(big + A_CQ), (bf16_t*)(wsA + WS_WMIX + WM_QB), ssq_arr(wsA, SSQ_Q + j), (const float*)(wsA + WS_CS), (const float*)(wsA + WS_SN)};
                attn_phase(lds, T, cu, rep_);
            } else if (kind == 2 && PH_ON(7)) {
                { unsigned char* ws = kargs()->ws; unsigned char* big = ws + WS_BIG;
                  KArgs Ap = kargs(); const int tidp = tidx();
                  ScanT T{(bf16_t*)(big + L_Q), (bf16_t*)(big + L_K), (bf16_t*)(big + L_VT), (bf16_t*)(big + L_OG), (float*)(ws + WS_IG), (float*)(ws + WS_LF),
                          Ap->in[I_P] + (size_t)i * M * 256, (SCAN_PCONV && G == 256) ? (bf16_t*)Ap->out : nullptr, cu * NTHR + tidp, G * NTHR};
                  REP_LOOP(7) scan_phase(lds, T, cu, rep_); }
                TID_DEFS; KArgs A = kargs();
                if (!(SCAN_PCONV && G == 256)) p_to_bf16(A->in[I_P] + (size_t)i * M * 256, (bf16_t*)A->out, GT, NGT);
            }
            SEAM(base + 3);
        }
        if (IN(base + 4)) {
            const size_t xbb_off = kind == 0 ? A_XBB : kind == 1 ? C_XBB : L_XBB, pp_off = kind == 0 ? A_PP : kind == 1 ? C_PP : L_PP;
            if (PH_ON(8)) { KArgs A = kargs(); unsigned char* ws = A->ws;
              const size_t oin = kind == 0 ? A_SZ : kind == 1 ? C_BZ : L_OG, wout = kind == 2 ? WM_OUT_LSTM : WM_OUT_MLA;
              pg8::Gemm g{(bf16_t*)(ws + WS_BIG + oin), (bf16_t*)(ws + WS_WMIX + wout), M, D, opaque(kind == 2 ? 2048 : 1024)}; pg8::StaticOrder So; So.init(M, D, G, cu);
              EpiOut E{ws, xbb_off, i};
              pg8::gemm_phase<EpiOut, pg8::StaticOrder, GEMM_ALIGN1, GEMM_SP2>(lds, g, So, E); }
            if (PH_ON(9) && !(PP_HOLES && kind == 0 && G == 256)) REP_LOOP(9) { KArgs A = kargs(); unsigned char* ws = A->ws;
              pg8::Gemm g{kind == 2 ? (bf16_t*)A->out : (bf16_t*)(ws + WS_BIG + A_PB), (bf16_t*)(ws + WS_WPLE + 2 * MiB), M, D, opaque(256)}; pg8::StaticOrder So; So.init(M, D, G, cu);
              EpiPP E{(bf16_t*)(ws + WS_BIG + pp_off)};
              pg8::gemm_phase<EpiPP, pg8::StaticOrder, GEMM_ALIGN, GEMM_SP2>(lds, g, So, E); }
            SEAM(base + 4);
        }
        if (IN(base + 5)) {
            if (PH_ON(10)) { KArgs A = kargs(); unsigned char* ws = A->ws;
              const size_t xbb_off = kind == 0 ? A_XBB : kind == 1 ? C_XBB : L_XBB, pp_off = kind == 0 ? A_PP : kind == 1 ? C_PP : L_PP;
              const bf16_t* ppp = (PP_HOLES && kind == 0 && G == 256) ? (const bf16_t*)A->out : (const bf16_t*)(ws + WS_BIG + pp_off);
              pg8::Gemm g{(bf16_t*)(ws + WS_BIG + xbb_off), (bf16_t*)(ws + WS_WPLE), M, D, opaque(D)}; pg8::StaticOrder So; So.init(M, D, G, cu);
              if (i == 3 && multi && G == 256 && hi > PH_FINAL) {
                  EpiPleLast E{ws, A->out, A->in[I_FNORM], ppp, xbb_off, i, bar.x, bar.st};
                  pg8::gemm_phase<EpiPleLast, pg8::StaticOrder, false, GEMM_SP2>(lds, g, So, E);
              } else {
                  EpiPle E{ws, ppp, xbb_off, i};
                  pg8::gemm_phase<EpiPle, pg8::StaticOrder, GEMM_ALIGN1, GEMM_SP2>(lds, g, So, E); } }
            if (i < 3) REP_LOOP(1) prep_mixer(lds, i + 1, cu, G);
            if (!(i == 3 && multi && G == 256 && hi > PH_FINAL)) SEAM(base + 5);
        }
    }
    if (IN(PH_FINAL) && !(multi && G == 256 && lo <= PH_FINAL - 1)) { TID_DEFS; KArgs A = kargs(); final_phase((const bf16_t*)(A->ws + WS_XBA), A->out, ssq_arr(A->ws, SSQ_X + 4), A->in[I_FNORM], GW, NGW, lane); }
#ifdef TIMELINE
    {
        SEAM(PH_FINAL);
        TID_DEFS; KArgs A = kargs(); const unsigned long long* ts = (const unsigned long long*)(A->ws + WS_CTL + 32 * KiB);
        const float dA = (float)(ts[TS_A1] - ts[TS_A0]) * 0.01f, dB = (float)(ts[TS_B1] - ts[TS_B0]) * 0.01f;
        const float c = sqrtf(dA);
        for (size_t e = GT; e < (size_t)M * D; e += NGT) A->out[e] = (e == 0) ? 60.f + dB : c;
    }
#endif
#undef IN
#undef SEAM
}
}
#ifndef FAST_LAYERS
#define FAST_LAYERS 15
#endif
#ifndef ONE_LAUNCH
#define ONE_LAUNCH 1
#endif

extern "C" void kernel_launch(void* const* d_in, const int* in_sizes, int n_in, void* d_out, int out_size, void* d_ws, size_t ws_size, hipStream_t stream) {
    static int grid = 0;
    if (grid == 0) {
        int dev = 0, cus = 0;
        if (n_in != 19 || ws_size < fk::WS_END || out_size != fk::M * fk::D) { fprintf(stderr, "kernel_launch: unexpected shapes (n_in %d, ws %zu, out %d)\n", n_in, ws_size, out_size); grid = -1; return; }
        if (hipGetDevice(&dev) != hipSuccess || hipDeviceGetAttribute(&cus, hipDeviceAttributeMultiprocessorCount, dev) != hipSuccess) { grid = -1; return; }
        if (hipFuncSetAttribute((const void*)fk::fwd, hipFuncAttributeMaxDynamicSharedMemorySize, fk::LDS_BYTES) != hipSuccess) { fprintf(stderr, "kernel_launch: hipFuncSetAttribute failed\n"); grid = -1; return; }
        int per_cu = 0;
        if (hipOccupancyMaxActiveBlocksPerMultiprocessor(&per_cu, (const void*)fk::fwd, fk::NTHR, fk::LDS_BYTES) != hipSuccess || per_cu < 1) { fprintf(stderr, "kernel_launch: occupancy query says %d\n", per_cu); }
        (void)hipGetLastError();
        grid = cus;
        if (grid != 256) fprintf(stderr, "kernel_launch: %d CUs (built for 256)\n", grid);
    }
    if (grid < 0) return;
    (void)hipMemsetAsync(d_ws, 0, fk::ZERO_BYTES, stream);
    fk::Args a{};
    for (int i = 0; i < 19; ++i) a.in[i] = (const float*)d_in[i];
    a.out = (float*)d_out; a.ws = (unsigned char*)d_ws;
#define LAUNCH(lo_, hi_) do { a.ph_lo = (lo_); a.ph_hi = (hi_); hipLaunchKernelGGL(fk::fwd, dim3(grid), dim3(fk::NTHR), fk::LDS_BYTES, stream, a); } while (0)
#if ONE_LAUNCH && (FAST_LAYERS == 15)
#ifdef TIMELINE
    LAUNCH(0, fk::PH_FINAL + 2);
#else
    LAUNCH(0, fk::PH_FINAL + 1);
#endif
#else
    nv::In in;
    in.x = (const float*)d_in[0]; in.p = (const float*)d_in[1]; in.pos = (const int*)d_in[2]; in.norm_g = (const float*)d_in[3];
    in.mla_w_in = (const float*)d_in[4]; in.mla_q_norm = (const float*)d_in[5]; in.mla_w_q_b = (const float*)d_in[6];
    in.mla_kv_norm = (const float*)d_in[7]; in.mla_w_kv_b = (const float*)d_in[8]; in.mla_w_out = (const float*)d_in[9];
    in.conv_w_in = (const float*)d_in[10]; in.conv_w = (const float*)d_in[11]; in.conv_w_out = (const float*)d_in[12];
    in.mlstm_w_in = (const float*)d_in[13]; in.mlstm_b_gates = (const float*)d_in[14]; in.mlstm_w_out = (const float*)d_in[15];
    in.ple_proj = (const float*)d_in[16]; in.ple_gate = (const float*)d_in[17]; in.final_norm = (const float*)d_in[18];
    float* nws = (float*)((char*)d_ws + 2 * fk::MiB);
    LAUNCH(0, 1);
    for (int i = 0; i < 4; ++i) {
        if ((FAST_LAYERS >> i) & 1) {
            if (i > 0 && !((FAST_LAYERS >> (i - 1)) & 1)) LAUNCH(fk::PH_REFRESH + i, fk::PH_REFRESH + i + 1);
            for (int s = 0; s < fk::PH_PER_LAYER; ++s) LAUNCH(1 + fk::PH_PER_LAYER * i + s, 1 + fk::PH_PER_LAYER * i + s + 1);
        } else {
            nv::layer(in, (float*)d_out, nws, stream, i, i == 0);
        }
    }
    if ((FAST_LAYERS >> 3) & 1) LAUNCH(fk::PH_FINAL, fk::PH_FINAL + 1);
    else nv::final_norm(in, (float*)d_out, stream);
#endif
#undef LAUNCH
}
```
